# Optimizing an MI355X kernel written in HIP

```python
import math
import jax
import jax.numpy as jnp
from jax import lax
import numpy as np

D_MODEL = 1024
BATCH = 8
SEQ = 2048
DEPTH = 2
DEC_BATCH = 32
DEC_SEQ = 64
PAST_LEN = 2048

CHUNK = 64
N_META = 16
MIX_WIDTH = 1024
POOL_WINDOWS = (2, 4, 8, 16)
POOL_GROUPS = len(POOL_WINDOWS)
POOL_GROUP_WIDTH = MIX_WIDTH // POOL_GROUPS
POOL_MAX = max(POOL_WINDOWS)
SB_HEADS = 8
SB_HEAD_DIM = MIX_WIDTH // SB_HEADS
SB_SCALE = SB_HEAD_DIM ** -0.5
QBLK = 128
HG_HEADS = 8
HG_DK = 128
HG_DV = MIX_WIDTH // HG_HEADS
N_BRANCH = 3
N_SPLIT = 13
EPS = 1e-6
LB_FLOOR = 1e-30

kernel_name = 'hybrid_pool_stickbreak_hgrn2_stream'


def rms_norm(x, g):
    xf = x.astype(jnp.float32)
    y = xf * lax.rsqrt(jnp.mean(xf * xf, axis=-1, keepdims=True) + EPS)
    return (y * g.astype(jnp.float32)).astype(x.dtype)


def pool_mixer(u, prefix, pos0, w_group, scale):
    b, l, _ = u.shape
    p = POOL_MAX - 1
    full = jnp.concatenate([prefix.astype(u.dtype), u], axis=1)
    csum = jnp.pad(jnp.cumsum(full.astype(jnp.float32), axis=1), ((0, 0), (1, 0), (0, 0)))
    pos = (pos0 + jnp.arange(l)).astype(jnp.float32)
    hi = csum[:, p + 1:p + 1 + l]
    means = []
    for gi, w in enumerate(POOL_WINDOWS):
        sl = slice(gi * POOL_GROUP_WIDTH, (gi + 1) * POOL_GROUP_WIDTH)
        lo = csum[:, p + 1 - w:p + 1 - w + l, sl]
        cnt = jnp.minimum(pos + 1.0, float(w))
        means.append((hi[..., sl] - lo) / cnt[None, :, None])
    pooled = jnp.stack(means, axis=2)
    diff = pooled - u.astype(jnp.float32).reshape(b, l, POOL_GROUPS, POOL_GROUP_WIDTH)
    y = jnp.einsum('blgc,gce->blge', diff.astype(u.dtype), w_group).reshape(b, l, MIX_WIDTH)
    return y * scale, full[:, -p:]


def stick_breaking(q, k, v, q_pos0):
    b, lq, h, d = q.shape
    lk = k.shape[1]
    qb = min(QBLK, lq)
    nblk = -(-lq // qb)
    qp = jnp.pad(q, ((0, 0), (0, nblk * qb - lq), (0, 0), (0, 0)))
    qblocks = qp.reshape(b, nblk, qb, h, d).transpose(1, 0, 2, 3, 4)
    kpos = jnp.arange(lk)

    def block(args):
        qblk, start = args
        z = jnp.einsum('bqhd,bkhd->bhqk', qblk, k).astype(jnp.float32) * SB_SCALE
        qpos = q_pos0 + start + jnp.arange(qb)
        mask = kpos[None, :] < qpos[:, None]
        log_keep = jnp.where(mask, jax.nn.log_sigmoid(-z), 0.0)
        later = lax.cumsum(log_keep, axis=3, reverse=True) - log_keep
        wts = jnp.where(mask, jnp.exp(jax.nn.log_sigmoid(z) + later), 0.0)
        return jnp.einsum('bhqk,bkhd->bqhd', wts.astype(v.dtype), v)

    out = lax.map(block, (qblocks, jnp.arange(nblk) * qb))
    return out.transpose(1, 0, 2, 3, 4).reshape(b, nblk * qb, h, d)[:, :lq]


def hgrn2(q, log_f, k, v, state0):
    b, l, h, _ = q.shape
    c = min(CHUNK, l)
    n = -(-l // c)
    pad = n * c - l
    def blocks(a):
        a = jnp.pad(a.astype(jnp.float32), ((0, 0), (0, pad), (0, 0), (0, 0)))
        return a.reshape(b, n, c, h, a.shape[-1]).transpose(1, 0, 3, 2, 4)
    causal = jnp.tril(jnp.ones((c, c), dtype=bool))[:, :, None]

    def step(s_prev, inp):
        qc, gc, kc, vc = inp
        cum = jnp.cumsum(gc, axis=2)
        o_inter = jnp.einsum('bhtk,bhkv->bhtv', qc * jnp.exp(cum), s_prev)
        gap = cum[:, :, :, None, :] - cum[:, :, None, :, :]
        decay = jnp.where(causal, jnp.exp(jnp.where(causal, gap, 0.0)), 0.0)
        att = jnp.einsum('bhtk,bhsk,bhtsk->bhts', qc, kc, decay)
        o = o_inter + jnp.einsum('bhts,bhsv->bhtv', att, vc)
        last = cum[:, :, -1:, :]
        s_new = jnp.exp(last[:, :, 0, :])[..., None] * s_prev + jnp.einsum('bhsk,bhsv->bhkv', kc * jnp.exp(last - cum), vc)
        return s_new, o

    s_fin, o = lax.scan(step, state0.astype(jnp.float32), (blocks(q), blocks(log_f), blocks(k), blocks(v)))
    o = o.transpose(1, 0, 3, 2, 4).reshape(b, n * c, h, -1)[:, :l]
    return o, s_fin


def mixer_layer(h, pos0, pool_prefix, k_past, v_past, hg_state, lb,
                norm_g, w_in, q_norm_g, k_norm_g, w_pool, pool_scale, hg_norm_g, w_branch, w_out):
    b, l, _ = h.shape
    xn = rms_norm(h, norm_g)
    (u_a, g_a, q_b, k_b, v_b, g_b, f_c, q_c, i_c, g_c,
     m_a, m_b, m_c) = jnp.split(xn @ w_in, N_SPLIT, axis=-1)
    heads = lambda t, d: t.reshape(b, l, -1, d)

    y_a, new_prefix = pool_mixer(u_a, pool_prefix, pos0, w_pool, pool_scale)
    y_a = y_a * jax.nn.silu(g_a)

    q = rms_norm(heads(q_b, SB_HEAD_DIM), q_norm_g)
    k = rms_norm(heads(k_b, SB_HEAD_DIM), k_norm_g)
    v = heads(v_b, SB_HEAD_DIM)
    if k_past is None:
        k_all, v_all, q_pos0 = k, v, 0
    else:
        k_all = jnp.concatenate([k_past.astype(k.dtype), k], axis=1)
        v_all = jnp.concatenate([v_past.astype(v.dtype), v], axis=1)
        q_pos0 = k_past.shape[1]
    y_b = stick_breaking(q, k_all, v_all, q_pos0).reshape(b, l, MIX_WIDTH) * jax.nn.silu(g_b)

    z = heads(f_c, HG_DK).astype(jnp.float32)
    lbh = lb.reshape(HG_HEADS, HG_DK).astype(jnp.float32)
    log_f = jnp.logaddexp(jnp.log(jnp.maximum(lbh, LB_FLOOR)), jnp.log1p(-lbh) + jax.nn.log_sigmoid(z))
    k_c = (1.0 - lbh) * jax.nn.sigmoid(-z)
    o_c, new_state = hgrn2(jax.nn.silu(heads(q_c, HG_DK)), log_f, k_c, heads(i_c, HG_DV), hg_state)
    o_c = rms_norm(o_c, hg_norm_g).astype(h.dtype).reshape(b, l, MIX_WIDTH)
    y_c = o_c * jax.nn.silu(g_c)

    ys = jnp.stack([y_a, y_b, y_c], axis=2)
    gates = jax.nn.sigmoid(jnp.stack([m_a, m_b, m_c], axis=2))
    merged = jnp.sum(gates * jnp.einsum('blnw,nwd->blnd', ys, w_branch), axis=2)
    h = h + merged @ w_out
    return h, k, v, new_prefix, new_state


def setup_inputs(seed: int = 0) -> dict:
    key = jax.random.key(seed)
    ks = jax.random.split(key, 17)
    nrm = lambda kk, shape, s: jax.random.normal(kk, shape, jnp.float32) * s
    return {
        'x_prompt': nrm(ks[0], (BATCH, SEQ, D_MODEL), 1.0),
        'x_sample': nrm(ks[1], (DEC_BATCH, DEC_SEQ, D_MODEL), 1.0),
        'cache_k': nrm(ks[2], (DEPTH, DEC_BATCH, PAST_LEN, SB_HEADS, SB_HEAD_DIM), 1.0),
        'cache_v': nrm(ks[3], (DEPTH, DEC_BATCH, PAST_LEN, SB_HEADS, SB_HEAD_DIM), 0.5),
        'state_pool': nrm(ks[4], (DEPTH, DEC_BATCH, POOL_MAX - 1, MIX_WIDTH), 1.0),
        'state_hgrn': nrm(ks[5], (DEPTH, DEC_BATCH, HG_HEADS, HG_DK, HG_DV), 0.5),
        'meta_tokens': nrm(ks[6], (N_META, D_MODEL), 1.0),
        'norm_g': 1.0 + nrm(ks[7], (DEPTH, D_MODEL), 0.05),
        'w_in': nrm(ks[8], (DEPTH, D_MODEL, N_SPLIT * MIX_WIDTH), D_MODEL ** -0.5),
        'q_norm_g': 1.0 + nrm(ks[9], (DEPTH, SB_HEAD_DIM), 0.05),
        'k_norm_g': 1.0 + nrm(ks[10], (DEPTH, SB_HEAD_DIM), 0.05),
        'w_pool': nrm(ks[11], (DEPTH, POOL_GROUPS, POOL_GROUP_WIDTH, POOL_GROUP_WIDTH), POOL_GROUP_WIDTH ** -0.5),
        'pool_scale': 1.0 + nrm(ks[12], (DEPTH, MIX_WIDTH), 0.05),
        'hgrn_lower_bounds': nrm(ks[13], (DEPTH, HG_HEADS * HG_DK), 0.1),
        'hgrn_norm_g': 1.0 + nrm(ks[14], (DEPTH, HG_DV), 0.05),
        'w_branch': nrm(ks[15], (DEPTH, N_BRANCH, MIX_WIDTH, D_MODEL), MIX_WIDTH ** -0.5),
        'w_out': nrm(ks[16], (DEPTH, D_MODEL, D_MODEL), D_MODEL ** -0.5),
    }


def reference(x_prompt, x_sample, cache_k, cache_v, state_pool, state_hgrn, meta_tokens,
              norm_g, w_in, q_norm_g, k_norm_g, w_pool, pool_scale, hgrn_lower_bounds,
              hgrn_norm_g, w_branch, w_out):
    lb_soft = jax.nn.softmax(hgrn_lower_bounds.astype(jnp.float32), axis=0)
    lower_bounds = jnp.cumsum(lb_soft, axis=0) - lb_soft[0:1]

    bp = x_prompt.shape[0]
    meta = jnp.broadcast_to(meta_tokens.astype(x_prompt.dtype)[None], (bp, N_META, D_MODEL))
    hp = jnp.concatenate([meta, x_prompt], axis=1)
    hs = x_sample
    past = cache_k.shape[2]
    kp, vp, pp, sp, ksm, vsm, psm, ssm = [], [], [], [], [], [], [], []
    for l in range(DEPTH):
        wl = (norm_g[l], w_in[l], q_norm_g[l], k_norm_g[l], w_pool[l], pool_scale[l],
              hgrn_norm_g[l], w_branch[l], w_out[l])
        hp, k_, v_, p_, s_ = mixer_layer(
            hp, 0, jnp.zeros((bp, POOL_MAX - 1, MIX_WIDTH), hp.dtype), None, None,
            jnp.zeros((bp, HG_HEADS, HG_DK, HG_DV), jnp.float32), lower_bounds[l], *wl)
        kp.append(k_); vp.append(v_); pp.append(p_); sp.append(s_.astype(hp.dtype))
        hs, k_, v_, p_, s_ = mixer_layer(
            hs, past, state_pool[l], cache_k[l], cache_v[l], state_hgrn[l], lower_bounds[l], *wl)
        ksm.append(k_); vsm.append(v_); psm.append(p_); ssm.append(s_.astype(state_hgrn.dtype))
    y_prompt = hp[:, N_META:]
    return (y_prompt, hs, jnp.stack(kp), jnp.stack(vp), jnp.stack(pp), jnp.stack(sp),
            jnp.stack(ksm), jnp.stack(vsm), jnp.stack(psm), jnp.stack(ssm))
```

```cpp
#define MK_LAUNCHES 1
#include <hip/hip_runtime.h>
#include <cstdio>
#include <cstdint>
constexpr int D = 1024, BATCH = 8, SEQ = 2048, DEPTH = 2, DBATCH = 32, DSEQ = 64, PAST = 2048, NMETA = 16;
constexpr int LP = NMETA + SEQ;
constexpr int MP = BATCH * LP;
constexpr int MPAD = 16640;
constexpr int MS = DBATCH * DSEQ;
constexpr int MTOT = MPAD + MS;
constexpr int NPROJ = 13 * 1024;
constexpr float EPS = 1e-6f, LB_FLOOR = 1e-30f, SB_SCALE = 0.08838834764831845f;
constexpr size_t O_YP = 0, O_YS = 16777216, O_KP = 18874368, O_VP = 52690944, O_PP = 86507520, O_HP = 86753280,
                 O_KS = 88850432, O_VS = 93044736, O_PS = 97239040, O_HS = 98222080, O_END = 106610688;
#define GAS __attribute__((address_space(1)))
#define LAS __attribute__((address_space(3)))
typedef unsigned short bf16;
typedef unsigned v4u __attribute__((ext_vector_type(4)));
typedef unsigned v2u __attribute__((ext_vector_type(2)));
typedef float f32x4 __attribute__((ext_vector_type(4)));
typedef float f32x2 __attribute__((ext_vector_type(2)));
typedef float f32x16 __attribute__((ext_vector_type(16)));
typedef short bf16x8 __attribute__((ext_vector_type(8)));
typedef short bf16x4 __attribute__((ext_vector_type(4)));
#define LDS_WAIT() asm volatile("s_waitcnt lgkmcnt(0)" ::: "memory")
#define VM_WAIT() asm volatile("s_waitcnt vmcnt(0)" ::: "memory")

typedef __bf16 bf16n2 __attribute__((ext_vector_type(2)));
__device__ __forceinline__ unsigned cvt_pk_bf16(float lo, float hi) { const f32x2 v = {lo, hi}; return __builtin_bit_cast(unsigned, __builtin_convertvector(v, bf16n2)); }
__device__ __forceinline__ float bf_lo(unsigned u) { return __uint_as_float(u << 16); }
__device__ __forceinline__ float bf_hi(unsigned u) { return __uint_as_float(u & 0xffff0000u); }
__device__ __forceinline__ float fexp2(float x) { return __builtin_amdgcn_exp2f(x); }
__device__ __forceinline__ float flog2(float x) { return __builtin_amdgcn_logf(x); }
__device__ __forceinline__ float frcp(float x) { return __builtin_amdgcn_rcpf(x); }
__device__ __forceinline__ float frsq(float x) { return __builtin_amdgcn_rsqf(x); }
__device__ __forceinline__ int lane_id() { unsigned z = 0u; asm volatile("" : "+v"(z)); return (int)__builtin_amdgcn_mbcnt_hi(~0u, __builtin_amdgcn_mbcnt_lo(~0u, z)); }
constexpr float LOG2E = 1.4426950408889634f, LN2 = 0.6931471805599453f;
__device__ __forceinline__ float fexp(float x) { return fexp2(x * LOG2E); }
__device__ __forceinline__ float fsigmoid(float x) { return frcp(1.0f + fexp2(-x * LOG2E)); }
__device__ __forceinline__ float fsilu(float x) { return x * fsigmoid(x); }

constexpr size_t MiB = 1u << 20;
constexpr size_t RB16 = (size_t)MTOT * 1024 * 2, RB32 = (size_t)MTOT * 1024 * 4;
constexpr size_t WS_CTL = 0, CTL_ZERO_BYTES = 64 * 1024;
constexpr size_t WS_RTAB = 1 * MiB + 64 * 1024;
constexpr size_t WS_LB = 1 * MiB;
constexpr size_t WS_WIN = 2 * MiB;
constexpr size_t WS_WBR = WS_WIN + (size_t)2 * NPROJ * 1024 * 2;
constexpr size_t WS_WOUT = WS_WBR + (size_t)6 * 1024 * 1024 * 2;
constexpr size_t WS_WPOOL = WS_WOUT + (size_t)2 * 1024 * 1024 * 2;
constexpr size_t WS_H = WS_WPOOL + 1 * MiB;
constexpr size_t WS_XN = WS_H + RB32;
constexpr size_t WS_UA = WS_XN + RB16, WS_SGA = WS_UA + RB16, WS_Q = WS_SGA + RB16, WS_SGB = WS_Q + RB16, WS_KC = WS_SGB + RB16,
                 WS_QC = WS_KC + RB16, WS_IC = WS_QC + RB16, WS_SGC = WS_IC + RB16, WS_GATE = WS_SGC + RB16  ,
                 WS_LOGF = WS_GATE + 3 * RB16  , WS_Y = WS_LOGF + RB32  , WS_MERGED = WS_Y + 3 * RB16, WS_FAST_END = WS_MERGED + RB16;
constexpr size_t WS_SLAB_M = WS_UA, WS_SLAB_O = WS_Q;
static_assert(108 * 262144 <= 2 * RB16 && 144 * 262144 <= 2 * RB16, "slabs");
constexpr int CW_QUEUE = 64;
constexpr int CW_BAR = 1024;

constexpr int LDS_BYTES = 160 * 1024;
constexpr int LDS_XCH = 128 * 1024;
constexpr int LDS_MISC = 159 * 1024;

#define XB_TMO      128
#define XB_XCNT(j)  (256  + 64 * (j))
#define XB_XSUB(j)  (1280 + 64 * (j))
#define XB_XGEN(j)  (2304 + 64 * (j))
#define XB_TOP      3328
#define XB_TOPGEN   3392
#define XCD_BAR_WORDS 3456
#define XB_SPIN_CAP (1u << 18)
__device__ __forceinline__ unsigned xb_ld(GAS unsigned* p)              { return __hip_atomic_load(p, __ATOMIC_RELAXED, __HIP_MEMORY_SCOPE_AGENT); }
__device__ __forceinline__ unsigned xb_add(GAS unsigned* p, unsigned v) { return __hip_atomic_fetch_add(p, v, __ATOMIC_RELAXED, __HIP_MEMORY_SCOPE_AGENT); }
__device__ __forceinline__ unsigned xb_xcc_id() { return (unsigned)__builtin_amdgcn_s_getreg((3 << 11) | 20) & 0xFu; }
#define XB_SPIN(cond, bar) do { unsigned _sp = 0; while (cond) { __builtin_amdgcn_s_sleep(1); \
    if ((++_sp & 255u) == 0u) { if (xb_ld(&(bar)[XB_TMO])) break; if (_sp > XB_SPIN_CAP) { xb_add(&(bar)[XB_TMO], 1u); break; } } } } while (0)
struct XcdBarrier { GAS unsigned* bar; unsigned x; volatile LAS unsigned* st; bool leader; };
__device__ __forceinline__ XcdBarrier xcd_barrier_post(GAS unsigned* bar, volatile LAS unsigned* st, int wave) {
    XcdBarrier b; b.bar = bar; b.x = xb_xcc_id(); b.st = st; b.leader = false;
    b.leader = (wave == 0) && (lane_id() == 0);
    if (b.leader) (void)xb_add(&bar[XB_XCNT(b.x)], 1u);
    return b;
}
__device__ __forceinline__ void xcd_barrier_complete(GAS unsigned* bar, unsigned x, unsigned& nloc, unsigned& nx) {
    const unsigned G = gridDim.x * gridDim.y * gridDim.z;
    unsigned sum, cnt, mine, sp = 0u;
    for (;;) {
        sum = 0u; cnt = 0u; mine = 0u;
#pragma unroll
        for (unsigned j = 0; j < 16; ++j) { const unsigned c = xb_ld(&bar[XB_XCNT(j)]); sum += c; cnt += (c > 0u) ? 1u : 0u; mine = (j == x) ? c : mine; }
        if (sum == G) break;
        __builtin_amdgcn_s_sleep(1);
        if ((++sp & 255u) == 0u) { if (xb_ld(&bar[XB_TMO])) break; if (sp > XB_SPIN_CAP) { xb_add(&bar[XB_TMO], 1u); break; } }
    }
    nloc = mine > 0u ? mine : 1u; nx = cnt > 0u ? cnt : 1u;
}
__device__ __forceinline__ void xcd_barrier(const XcdBarrier& b, int wave) {
    asm volatile("s_waitcnt vmcnt(0)" ::: "memory");
    __syncthreads();
    if (wave == 0 && lane_id() == 0) {
        GAS unsigned* bar = b.bar;
        __builtin_amdgcn_s_waitcnt(0);
        unsigned nloc = b.st[0], nx = b.st[1];
        if (nloc == 0u) { xcd_barrier_complete(bar, b.x, nloc, nx); b.st[0] = nloc; b.st[1] = nx; }
        const unsigned old = xb_add(&bar[XB_XSUB(b.x)], 1u);
        const unsigned gen = old / nloc;
        if (old + 1u == (gen + 1u) * nloc) {
            __builtin_amdgcn_fence(__ATOMIC_RELEASE, "agent");
            asm volatile("s_waitcnt vmcnt(0)" ::: "memory");
            const unsigned og = xb_add(&bar[XB_TOP], 1u);
            const unsigned tg = og / nx;
            if (og + 1u == (tg + 1u) * nx) xb_add(&bar[XB_TOPGEN], 1u);
            else XB_SPIN(xb_ld(&bar[XB_TOPGEN]) == tg, bar);
            __builtin_amdgcn_fence(__ATOMIC_ACQUIRE, "agent");
            xb_add(&bar[XB_XGEN(b.x)], 1u);
            asm volatile("s_waitcnt vmcnt(0)" ::: "memory");
        } else {
            XB_SPIN(xb_ld(&bar[XB_XGEN(b.x)]) == gen, bar);
            __builtin_amdgcn_fence(__ATOMIC_ACQUIRE, "agent");
            asm volatile("s_waitcnt vmcnt(0)" ::: "memory");
        }
    }
    __syncthreads();
}

struct Params { const float* in[17]; float* out; unsigned char* ws; int ph_lo, ph_hi; };
constexpr int LDS_PARAM = LDS_MISC + 256;
struct Frame {
    LAS unsigned char* lds; volatile LAS unsigned* MISC;
    int wave, G, vcu;
    __device__ __forceinline__ int lane_() const { return lane_id(); }
    __device__ __forceinline__ int tid_() const { return wave * 64 + lane_id(); }
    __device__ __forceinline__ unsigned long long rd(int i) const { const v2u v = *(const LAS v2u*)(lds + LDS_PARAM + 8 * i);
        return ((unsigned long long)(unsigned)__builtin_amdgcn_readfirstlane((int)v.y) << 32) | (unsigned)__builtin_amdgcn_readfirstlane((int)v.x); }
    __device__ __forceinline__ const GAS float* in(int i) const { return (const GAS float*)rd(i); }
    __device__ __forceinline__ GAS float* outp() const { return (GAS float*)rd(17); }
    __device__ __forceinline__ GAS unsigned char* wsp() const { return (GAS unsigned char*)rd(18); }
    __device__ __forceinline__ GAS unsigned* ctl() const { return (GAS unsigned*)(wsp() + WS_CTL); }
};
#define F_xp F.in(0)
#define F_xs F.in(1)
#define F_cache_k F.in(2)
#define F_cache_v F.in(3)
#define F_state_pool F.in(4)
#define F_state_hgrn F.in(5)
#define F_meta F.in(6)
#define F_norm_g F.in(7)
#define F_w_in F.in(8)
#define F_qng F.in(9)
#define F_kng F.in(10)
#define F_w_pool F.in(11)
#define F_pool_scale F.in(12)
#define F_hlb F.in(13)
#define F_hng F.in(14)
#define F_w_branch F.in(15)
#define F_w_out F.in(16)
__device__ __forceinline__ float wave_sum(float v) {
#pragma unroll
    for (int o = 1; o < 64; o <<= 1) v += __shfl_xor(v, o);
    return v;
}

__device__ __forceinline__ void p0_transpose_item(const GAS float* W, int K, int N, GAS bf16* WT, int item, int lane) {
    const int nblk = N / 64, kb = item / nblk, nb = item - kb * nblk, r = lane >> 4, c4 = lane & 15;
    const GAS float* src = W + (size_t)(64 * kb + 16 * r) * N + 64 * nb + 4 * c4;
    f32x4 v[16];
#pragma unroll
    for (int i = 0; i < 16; ++i) v[i] = __builtin_nontemporal_load((const GAS f32x4*)(src + (size_t)i * N));
    GAS bf16* dst = WT + (size_t)(64 * nb + 4 * c4) * K + 64 * kb + 16 * r;
#pragma unroll
    for (int j = 0; j < 4; ++j) { v4u a, b;
        a.x = cvt_pk_bf16(v[0][j], v[1][j]); a.y = cvt_pk_bf16(v[2][j], v[3][j]); a.z = cvt_pk_bf16(v[4][j], v[5][j]); a.w = cvt_pk_bf16(v[6][j], v[7][j]);
        b.x = cvt_pk_bf16(v[8][j], v[9][j]); b.y = cvt_pk_bf16(v[10][j], v[11][j]); b.z = cvt_pk_bf16(v[12][j], v[13][j]); b.w = cvt_pk_bf16(v[14][j], v[15][j]);
        *(GAS v4u*)(dst + (size_t)j * K) = a; *(GAS v4u*)(dst + (size_t)j * K + 8) = b; }
}
__device__ __forceinline__ void xn_row(const GAS float* src, GAS float* hdst, const GAS float* g, GAS bf16* xnrow, int lane) {
    const GAS f32x4* xr = (const GAS f32x4*)src + lane;
    f32x4 v[4]; float s = 0.f;
#pragma unroll
    for (int j = 0; j < 4; ++j) { v[j] = xr[64 * j]; s += (v[j].x * v[j].x + v[j].y * v[j].y) + (v[j].z * v[j].z + v[j].w * v[j].w); }
    if (hdst) { GAS f32x4* ho = (GAS f32x4*)hdst + lane;
#pragma unroll
        for (int j = 0; j < 4; ++j) __builtin_nontemporal_store(v[j], ho + 64 * j); }
    const float rs = frsq(wave_sum(s) * (1.f / D) + EPS);
    GAS v2u* o8 = (GAS v2u*)xnrow + lane;
#pragma unroll
    for (int j = 0; j < 4; ++j) { const f32x4 gg = ((const GAS f32x4*)g)[lane + 64 * j]; v2u o; o.x = cvt_pk_bf16(v[j].x * rs * gg.x, v[j].y * rs * gg.y); o.y = cvt_pk_bf16(v[j].z * rs * gg.z, v[j].w * rs * gg.w); o8[64 * j] = o; }
}
__device__ __forceinline__ void zero_xn_row(GAS bf16* xnrow, int lane) { GAS v2u* o8 = (GAS v2u*)xnrow + lane;
#pragma unroll
    for (int j = 0; j < 4; ++j) o8[64 * j] = (v2u){0u, 0u}; }

__device__ __forceinline__ void phase_prologue(Frame& F) {
    const int gw = F.vcu * 8 + F.wave, NGW = F.G * 8;
    constexpr int I_IN = (D / 64) * (NPROJ / 64), I_SQ = (D / 64) * (D / 64), I_PL = (256 / 64) * (256 / 64);
    constexpr int NITEMS = 2 * I_IN + 6 * I_SQ + 2 * I_SQ + 8 * I_PL;
    GAS bf16* win_t = (GAS bf16*)(F.wsp() + WS_WIN); GAS bf16* wbr_t = (GAS bf16*)(F.wsp() + WS_WBR); GAS bf16* wout_t = (GAS bf16*)(F.wsp() + WS_WOUT); GAS bf16* wpool_t = (GAS bf16*)(F.wsp() + WS_WPOOL);
    for (int it = gw; it < NITEMS; it += NGW) {
        int r = it;
        if (r < 2 * I_IN) { const int l = r / I_IN; p0_transpose_item(F_w_in + (size_t)l * D * NPROJ, D, NPROJ, win_t + (size_t)l * NPROJ * D, r % I_IN, F.lane_()); continue; } r -= 2 * I_IN;
        if (r < 6 * I_SQ) { const int m = r / I_SQ; p0_transpose_item(F_w_branch + (size_t)m * D * D, D, D, wbr_t + (size_t)m * D * D, r % I_SQ, F.lane_()); continue; } r -= 6 * I_SQ;
        if (r < 2 * I_SQ) { const int m = r / I_SQ; p0_transpose_item(F_w_out + (size_t)m * D * D, D, D, wout_t + (size_t)m * D * D, r % I_SQ, F.lane_()); continue; } r -= 2 * I_SQ;
        { const int m = r / I_PL; p0_transpose_item(F_w_pool + (size_t)m * 65536, 256, 256, wpool_t + (size_t)m * 65536, r % I_PL, F.lane_()); }
    }
    GAS float* H = (GAS float*)(F.wsp() + WS_H); GAS bf16* XN = (GAS bf16*)(F.wsp() + WS_XN);
    for (int r = gw; r < MTOT; r += NGW) {
        GAS unsigned long long* rt = (GAS unsigned long long*)(F.wsp() + WS_RTAB) + r;
        if (r >= MP && r < MPAD) { zero_xn_row(XN + (size_t)r * D, F.lane_()); if (F.lane_() == 0) *rt = (unsigned long long)F_meta; continue; }
        const GAS float* src;
        if (r < MP) { const int b = r / LP, t = r - b * LP; src = (t < NMETA) ? F_meta + (size_t)t * D : F_xp + ((size_t)b * SEQ + (t - NMETA)) * D; }
        else src = F_xs + (size_t)(r - MPAD) * D;
        if (F.lane_() == 0) *rt = (unsigned long long)src;
        xn_row(src, nullptr, F_norm_g, XN + (size_t)r * D, F.lane_());
    }
    if (blockIdx.x == 0) { GAS float* lbp = (GAS float*)(F.wsp() + WS_LB);
        for (int i = F.tid_(); i < 1024; i += 512) { const float a = F_hlb[i], b = F_hlb[1024 + i], m = fmaxf(a, b), ea = expf(a - m), eb = expf(b - m), s = ea + eb; const float s0 = ea / s, s1 = eb / s;
            lbp[i] = s0 - s0; lbp[1024 + i] = (s0 + s1) - s0; } }
}
__device__ __forceinline__ void phase_xn(Frame& F, int l) {
    const int gw = F.vcu * 8 + F.wave, NGW = F.G * 8;
    GAS float* H = (GAS float*)(F.wsp() + WS_H); GAS bf16* XN = (GAS bf16*)(F.wsp() + WS_XN);
    for (int r = gw; r < MTOT; r += NGW) {
        if (r >= MP && r < MPAD) { zero_xn_row(XN + (size_t)r * D, F.lane_()); continue; }
        xn_row(H + (size_t)r * D, nullptr, F_norm_g + (size_t)l * D, XN + (size_t)r * D, F.lane_());
    }
}
namespace pg8 {
constexpr int BM = 256, BK = 64, HALF = 128, HTB = HALF * BK * 2, STAGE_BYTES = 8 * HTB, NXCD = 8;
__host__ __device__ __forceinline__ int lds_byte(int r, int c) { const int st = (r >> 4) * 2 + (c >> 5), rr = r & 15, cc = c & 31, ob = rr * 64 + cc * 2; return st * 1024 + (ob ^ (((ob >> 9) & 1) << 5)); }
__host__ __device__ __forceinline__ void stage_rc(int b, int& R, int& C) { const int st = b / 1024, sb = b % 1024, swz = sb ^ (((sb >> 9) & 1) << 5); R = (st >> 1) * 16 + swz / 64; C = (st & 1) * 32 + (swz % 64) / 2; }
__host__ __device__ __forceinline__ int perm32(int rho) { const int n = rho >> 4, i = rho & 15; return 8 * (i >> 2) + 4 * n + (i & 3); }

struct Unit { int pm, pn, seg, k0, nk, slab; };
struct Gemm { const GAS bf16* A; const GAS bf16* Bt; size_t a_seg, b_seg; int nM, nN, nseg, K, tail_parts, wgm; };

struct Order {
    int nM, nN, nwg, G, c, nseg, nt, tail, WGM;
    __device__ void init(const Gemm& g, int G_, int c_) { WGM = g.wgm; nM = g.nM; nN = g.nN; nwg = nM * nN; G = G_; c = c_; nseg = g.nseg; nt = g.K / BK;
        tail = (g.tail_parts > 0 && nwg > G && nwg <= 2 * G && (nwg - G) * g.tail_parts <= G && g.tail_parts % nseg == 0 && (nt % (2 * (g.tail_parts / nseg))) == 0) ? g.tail_parts : 0; }
    __device__ void tile_of(int L, int& pm, int& pn) const {
        int wgid = L; { const int q = nwg / NXCD, r = nwg % NXCD, xcd = wgid % NXCD, off = wgid / NXCD; wgid = (xcd < r ? xcd * (q + 1) : r * (q + 1) + (xcd - r) * q) + off; }
        const int nig = WGM * nN, gid = wgid / nig, fm = gid * WGM, gsz = (nM - fm) < WGM ? (nM - fm) : WGM;
        pm = fm + ((wgid % nig) % gsz); pn = (wgid % nig) / gsz; }
    template <int MODE> __device__ bool next(int i, Unit& u) const {
        u.k0 = 0; u.nk = nt; u.slab = -1;
        if (MODE == 0) {
            if (tail == 0) { const int ti = i / nseg; u.seg = i - ti * nseg; const long L = (long)ti * G + c; if (L >= nwg) return false; tile_of((int)L, u.pm, u.pn); return true; }
            if (i >= nseg) return false; u.seg = i; tile_of(c, u.pm, u.pn); return true; }
        if (tail == 0 || i > 0 || c >= (nwg - G) * tail) return false;
        const int j = c / tail, part = c - j * tail; tile_of(G + j, u.pm, u.pn); u.slab = c;
        { const int ks = tail / nseg; u.seg = part / ks; u.nk = nt / ks; u.k0 = (part - u.seg * ks) * u.nk; }
        return true;
    }
};

typedef f32x4 Acc[2][2][4][2];

template <class Epi, int MODE = 0>
__device__ __forceinline__ void gemm_phase(LAS unsigned char* lds, const Gemm g, const Order& S, const Epi& E, int wave_id) {
    const int wid = wave_id, lane = lane_id(), tid = wid * 64 + lane; const int wr = wid >> 2, wc = wid & 3, fr = lane & 15, fq = lane >> 4;
    const int K = g.K;
    unsigned voffA[2], voffB[2];
#pragma unroll
    for (int i = 0; i < 2; ++i) { int R, C; stage_rc(tid * 16 + i * 8192, R, C); const int Rb = (R & ~31) + perm32(R & 31);
        voffA[i] = (unsigned)(R * K + C) * 2u; voffB[i] = (unsigned)(Rb * K + C) * 2u; }
    const size_t kstep = (size_t)(BK * 2);
    const size_t hstep = (size_t)HALF * K * 2;
    const size_t tstep = 2 * hstep;
    const unsigned ldsw = (unsigned)wid * 1024u;
    const int aoff = lds_byte(wr * 64 + fr, fq * 8), boff = lds_byte(wc * 32 + fr, fq * 8);
#define PG8_SA(b, h) (((b) * 2 + (h)) * HTB)
#define PG8_SB(b, h) ((4 + (b) * 2 + (h)) * HTB)
#define PG8_STAGE(bufoff, gbase, voff) do { _Pragma("unroll") for (int _i = 0; _i < 2; ++_i) \
        __builtin_amdgcn_global_load_lds((const GAS unsigned*)((const GAS char*)(gbase) + (voff)[_i]), (LAS unsigned*)(lds + (bufoff) + ldsw + _i * 8192), 16, 0, 0); } while (0)
#define PG8_LDA(dst, b, h) do { _Pragma("unroll") for (int m = 0; m < 4; ++m) _Pragma("unroll") for (int k = 0; k < 2; ++k) dst[m][k] = *(const LAS bf16x8*)(lds + PG8_SA(b, h) + aoff + m * 2048 + k * 1024); } while (0)
#define PG8_LDB(dst, b, h) do { _Pragma("unroll") for (int n = 0; n < 2; ++n) _Pragma("unroll") for (int k = 0; k < 2; ++k) dst[n][k] = *(const LAS bf16x8*)(lds + PG8_SB(b, h) + boff + n * 2048 + k * 1024); } while (0)
#define PG8_MMA(ai, bj, At, Bt) do { __builtin_amdgcn_s_setprio(1); _Pragma("unroll") for (int m = 0; m < 4; ++m) _Pragma("unroll") for (int n = 0; n < 2; ++n) _Pragma("unroll") for (int k = 0; k < 2; ++k) \
        acc[ai][bj][m][n] = __builtin_amdgcn_mfma_f32_16x16x32_bf16(Bt[n][k], At[m][k], acc[ai][bj][m][n], 0, 0, 0); __builtin_amdgcn_s_setprio(0); } while (0)
#define PG8_WAIT_V(n) asm volatile("s_waitcnt vmcnt(" #n ")" ::: "memory")
#define PG8_WAIT_L(n) asm volatile("s_waitcnt lgkmcnt(" #n ")" ::: "memory")
#define PG8_BAR __builtin_amdgcn_s_barrier()
#define PG8_SCHED __builtin_amdgcn_sched_barrier(0)
    Unit cur, nxt; int ui = 0;
    if (!S.template next<MODE>(0, cur)) return;
    Acc acc;
#pragma unroll
    for (int a = 0; a < 2; ++a)
#pragma unroll
        for (int b = 0; b < 2; ++b)
#pragma unroll
            for (int m = 0; m < 4; ++m)
#pragma unroll
                for (int n = 0; n < 2; ++n) acc[a][b][m][n] = (f32x4){0.f, 0.f, 0.f, 0.f};
    bf16x8 At[4][2], B0[2][2], B1[2][2];
    const GAS char* cA = (const GAS char*)(g.A + (size_t)cur.seg * g.a_seg) + (size_t)cur.pm * tstep + (MODE ? (size_t)cur.k0 * kstep : 0); const GAS char* cB = (const GAS char*)(g.Bt + (size_t)cur.seg * g.b_seg) + (size_t)cur.pn * tstep + (MODE ? (size_t)cur.k0 * kstep : 0);
    PG8_STAGE(PG8_SB(0, 0), cB, voffB); PG8_STAGE(PG8_SB(0, 1), cB + hstep, voffB); PG8_STAGE(PG8_SA(0, 0), cA, voffA); PG8_STAGE(PG8_SA(0, 1), cA + hstep, voffA);
    if (wr == 1) PG8_BAR;
    PG8_WAIT_V(2); PG8_BAR;
    PG8_STAGE(PG8_SB(1, 0), cB + kstep, voffB); PG8_STAGE(PG8_SA(1, 0), cA + kstep, voffA); PG8_STAGE(PG8_SB(1, 1), cB + hstep + kstep, voffB);
    PG8_WAIT_V(6); PG8_BAR;
    for (;;) {
        const bool has_next = S.template next<MODE>(ui + 1, nxt);
        const GAS char* nA = has_next ? (const GAS char*)(g.A + (size_t)nxt.seg * g.a_seg) + (size_t)nxt.pm * tstep + (MODE ? (size_t)nxt.k0 * kstep : 0) : cA; const GAS char* nB = has_next ? (const GAS char*)(g.Bt + (size_t)nxt.seg * g.b_seg) + (size_t)nxt.pn * tstep + (MODE ? (size_t)nxt.k0 * kstep : 0) : cB;
        const int nt = MODE == 0 ? K / BK : cur.nk;
        for (int t = 0; t < nt; t += 2) {
            const bool last = (t == nt - 2);
            const GAS char* a1 = cA + (size_t)(t + 1) * kstep;
            const GAS char* a2 = last ? nA : cA + (size_t)(t + 2) * kstep; const GAS char* b2 = last ? nB : cB + (size_t)(t + 2) * kstep;
            const GAS char* a3 = a2 + kstep; const GAS char* b3 = b2 + kstep;
            PG8_LDB(B0, 0, 0); PG8_LDB(B1, 0, 1); PG8_SCHED; PG8_LDA(At, 0, 0); PG8_STAGE(PG8_SA(1, 1), a1 + hstep, voffA);
            PG8_WAIT_V(8); PG8_WAIT_L(0); PG8_BAR; PG8_MMA(0, 0, At, B0); PG8_MMA(0, 1, At, B1); PG8_BAR; PG8_SCHED;
            PG8_LDA(At, 0, 1); PG8_STAGE(PG8_SB(0, 0), b2, voffB); PG8_STAGE(PG8_SB(0, 1), b2 + hstep, voffB); PG8_STAGE(PG8_SA(0, 0), a2, voffA);
            PG8_WAIT_V(8); PG8_WAIT_L(0); PG8_BAR; PG8_MMA(1, 0, At, B0); PG8_MMA(1, 1, At, B1); PG8_BAR; PG8_SCHED;
            PG8_LDB(B0, 1, 0); PG8_LDB(B1, 1, 1); PG8_SCHED; PG8_LDA(At, 1, 0); PG8_STAGE(PG8_SA(0, 1), a2 + hstep, voffA);
            PG8_WAIT_V(8); PG8_WAIT_L(0); PG8_BAR; PG8_MMA(0, 0, At, B0); PG8_MMA(0, 1, At, B1); PG8_BAR; PG8_SCHED;
            PG8_LDA(At, 1, 1); PG8_STAGE(PG8_SB(1, 0), b3, voffB); PG8_STAGE(PG8_SB(1, 1), b3 + hstep, voffB); PG8_STAGE(PG8_SA(1, 0), a3, voffA);
            PG8_WAIT_V(8); PG8_WAIT_L(0); PG8_BAR; PG8_MMA(1, 0, At, B0); PG8_MMA(1, 1, At, B1); PG8_BAR; PG8_SCHED;
        }
        if (wr == 0) PG8_BAR;
        E(acc, cur, wr, wc, fr, fq, lds);
        if (!has_next) break;
        if (MODE == 1 || cur.seg == g.nseg - 1) {
#pragma unroll
            for (int a = 0; a < 2; ++a)
#pragma unroll
                for (int b = 0; b < 2; ++b)
#pragma unroll
                    for (int m = 0; m < 4; ++m)
#pragma unroll
                        for (int n = 0; n < 2; ++n) acc[a][b][m][n] = (f32x4){0.f, 0.f, 0.f, 0.f};
        }
        cur = nxt; cA = nA; cB = nB; ++ui;
        if (wr == 1) PG8_BAR;
    }
    PG8_WAIT_V(0);
    PG8_BAR;
#undef PG8_SA
#undef PG8_SB
#undef PG8_STAGE
#undef PG8_LDA
#undef PG8_LDB
#undef PG8_MMA
#undef PG8_WAIT_V
#undef PG8_WAIT_L
#undef PG8_BAR
#undef PG8_SCHED
}

#define EPI_FOR_ROWS for (int ai = 0; ai < 2; ++ai) _Pragma("unroll") for (int m = 0; m < 4; ++m)
__device__ __forceinline__ v4u pack8(const f32x4 a, const f32x4 b) { v4u w; w.x = cvt_pk_bf16(a[0], a[1]); w.y = cvt_pk_bf16(a[2], a[3]); w.z = cvt_pk_bf16(b[0], b[1]); w.w = cvt_pk_bf16(b[2], b[3]); return w; }

#define NT_ST(p, v) __builtin_nontemporal_store((v), (p))
struct EpiProj {
    int layer; GAS unsigned char* ws; GAS float* out; const GAS float* qng; const GAS float* kng; const GAS float* lb;
    __device__ __forceinline__ void operator()(Acc& acc, const Unit& u, int wr, int wc, int fr, int fq, LAS unsigned char* lds) const {
        const int grp = u.pn >> 2, ct = u.pn & 3;
        const int row0 = u.pm * BM + wr * 64 + fr;
        const int cg0 = ct * 256 + wc * 32 + 8 * fq;
        const bool sample = u.pm >= MPAD / 256;
        if (grp == 2 || grp == 3) {
            LAS float* X = (LAS float*)(lds + LDS_XCH);
#pragma unroll
            EPI_FOR_ROWS {
#pragma unroll
                for (int bj = 0; bj < 2; ++bj) { const f32x4 a = acc[ai][bj][m][0], b = acc[ai][bj][m][1];
                    float s = (a[0] * a[0] + a[1] * a[1]) + (a[2] * a[2] + a[3] * a[3]) + (b[0] * b[0] + b[1] * b[1]) + (b[2] * b[2] + b[3] * b[3]);
                    s += __shfl_xor(s, 16); s += __shfl_xor(s, 32);
                    if (fq == 0) X[(ai * 128 + wr * 64 + m * 16 + fr) * 8 + bj * 4 + wc] = s; } }
            LDS_WAIT(); __builtin_amdgcn_s_barrier(); asm volatile("" ::: "memory");
            const GAS float* gv = (grp == 2 ? qng : kng) + wc * 32 + 8 * fq; const float qs = (grp == 2) ? SB_SCALE * LOG2E : 1.0f;
            const f32x4 g0 = *(const GAS f32x4*)gv * qs, g1 = *(const GAS f32x4*)(gv + 4) * qs;
            GAS bf16* qdst = (GAS bf16*)(ws + WS_Q);
            GAS float* kdst = sample ? out + O_KS + (size_t)layer * MS * 1024 - (size_t)MPAD * 1024 : out + O_KP + (size_t)layer * MP * 1024;
#pragma unroll
            EPI_FOR_ROWS { const int row = row0 + ai * 128 + m * 16;
#pragma unroll
                for (int bj = 0; bj < 2; ++bj) { const f32x4 p = *(const LAS f32x4*)(X + (ai * 128 + wr * 64 + m * 16 + fr) * 8 + bj * 4);
                    const float rs = frsq(((p[0] + p[1]) + (p[2] + p[3])) * (1.0f / 128.0f) + EPS);
                    const f32x4 a = acc[ai][bj][m][0] * rs * g0, b = acc[ai][bj][m][1] * rs * g1; const int col = cg0 + bj * 128;
                    if (grp == 2) NT_ST((GAS v4u*)(qdst + (size_t)row * 1024 + col), pack8(a, b));
                    else if (sample || row < MP) { GAS float* d = kdst + (size_t)row * 1024 + col; NT_ST((GAS f32x4*)d, a); NT_ST((GAS f32x4*)(d + 4), b); } } }
            return;
        }
        if (grp == 4) {
            GAS float* vdst = sample ? out + O_VS + (size_t)layer * MS * 1024 - (size_t)MPAD * 1024 : out + O_VP + (size_t)layer * MP * 1024;
#pragma unroll
            EPI_FOR_ROWS { const int row = row0 + ai * 128 + m * 16;
                if (sample || row < MP) {
#pragma unroll
                    for (int bj = 0; bj < 2; ++bj) { GAS float* d = vdst + (size_t)row * 1024 + cg0 + bj * 128; NT_ST((GAS f32x4*)d, acc[ai][bj][m][0]); NT_ST((GAS f32x4*)(d + 4), acc[ai][bj][m][1]); } } }
            return;
        }
        if (grp == 6) {
            GAS float* lf = (GAS float*)(ws + WS_LOGF); GAS bf16* kc = (GAS bf16*)(ws + WS_KC);
#pragma unroll
            for (int bj = 0; bj < 2; ++bj) { const int col = cg0 + bj * 128; const f32x4 l0 = *(const GAS f32x4*)(lb + col), l1 = *(const GAS f32x4*)(lb + col + 4);
#pragma unroll
                EPI_FOR_ROWS { const int row = row0 + ai * 128 + m * 16; f32x4 z[2] = {acc[ai][bj][m][0], acc[ai][bj][m][1]}; f32x4 lo[2], ko[2];
#pragma unroll
                    for (int n = 0; n < 2; ++n)
#pragma unroll
                        for (int j = 0; j < 4; ++j) { const float zz = z[n][j], l = n ? l1[j] : l0[j], e = fexp2(-fabsf(zz) * LOG2E), r = frcp(1.0f + e), er = e * r;
                            const float sp = zz >= 0.f ? r : er, sn = zz >= 0.f ? er : r, oml = 1.0f - l;
                            lo[n][j] = flog2(l + oml * sp); ko[n][j] = oml * sn; }
                    GAS float* d = lf + (size_t)row * 1024 + col; NT_ST((GAS f32x4*)d, lo[0]); NT_ST((GAS f32x4*)(d + 4), lo[1]);
                    NT_ST((GAS v4u*)(kc + (size_t)row * 1024 + col), pack8(ko[0], ko[1])); } }
            return;
        }
        size_t off; int act;
        switch (grp) {
            case 0: off = WS_UA; act = 0; break;   case 1: off = WS_SGA; act = 1; break;  case 5: off = WS_SGB; act = 1; break;
            case 7: off = WS_QC; act = 1; break;   case 8: off = WS_IC; act = 0; break;   case 9: off = WS_SGC; act = 1; break;
            default: off = WS_GATE + (size_t)(grp - 10) * RB16; act = 2; break;
        }
        GAS bf16* dst = (GAS bf16*)(ws + off);
#pragma unroll
        EPI_FOR_ROWS { const int row = row0 + ai * 128 + m * 16;
#pragma unroll
            for (int bj = 0; bj < 2; ++bj) { f32x4 a = acc[ai][bj][m][0], b = acc[ai][bj][m][1];
                if (act) {
#pragma unroll
                    for (int j = 0; j < 4; ++j) { const float sa = fsigmoid(a[j]), sb = fsigmoid(b[j]);
                        a[j] = act == 1 ? a[j] * sa : fmaxf(sa, 1e-30f); b[j] = act == 1 ? b[j] * sb : fmaxf(sb, 1e-30f); } }
                NT_ST((GAS v4u*)(dst + (size_t)row * 1024 + cg0 + bj * 128), pack8(a, b)); } }
        if (grp == 0) {
#pragma unroll
            EPI_FOR_ROWS { const int row = row0 + ai * 128 + m * 16; GAS float* d = nullptr;
                if (sample) { const int rr = row - MPAD, b = rr >> 6, i = rr & 63; if (i >= DSEQ - 15) d = out + O_PS + (((size_t)layer * DBATCH + b) * 15 + (i - (DSEQ - 15))) * 1024; }
                else if (row < MP) { const int b = row / LP, t = row - b * LP; if (t >= LP - 15) d = out + O_PP + (((size_t)layer * BATCH + b) * 15 + (t - (LP - 15))) * 1024; }
                if (d) {
#pragma unroll
                    for (int bj = 0; bj < 2; ++bj) { GAS float* dd = d + cg0 + bj * 128; NT_ST((GAS f32x4*)dd, acc[ai][bj][m][0]); NT_ST((GAS f32x4*)(dd + 4), acc[ai][bj][m][1]); } } }
        }
    }
};

struct EpiMerge {
    GAS unsigned char* ws;
    __device__ __forceinline__ void operator()(Acc& acc, const Unit& u, int wr, int wc, int fr, int fq, LAS unsigned char* lds) const {
        const int row0 = u.pm * BM + wr * 64 + fr, c0 = u.pn * BM + wc * 32 + 8 * fq;
        const GAS bf16* G0 = (const GAS bf16*)(ws + WS_GATE) + (size_t)u.seg * MTOT * 1024; const GAS bf16* G1 = G0 + (size_t)MTOT * 1024; GAS bf16* dst = (GAS bf16*)(ws + WS_MERGED);
        const bool fin = u.seg == 2;
#pragma unroll
        for (int ai = 0; ai < 2; ++ai)
#pragma unroll
        for (int mh = 0; mh < 2; ++mh) {
            v4u ga[2][2], gb[2][2];
#pragma unroll
            for (int mm = 0; mm < 2; ++mm)
#pragma unroll
                for (int bj = 0; bj < 2; ++bj) { const size_t ro = (size_t)(row0 + ai * 128 + (2 * mh + mm) * 16) * 1024 + c0 + bj * 128; ga[mm][bj] = *(const GAS v4u*)(G0 + ro); gb[mm][bj] = fin ? ga[mm][bj] : *(const GAS v4u*)(G1 + ro); }
#pragma unroll
            for (int mm = 0; mm < 2; ++mm)
#pragma unroll
                for (int bj = 0; bj < 2; ++bj) { const int m = 2 * mh + mm; const v4u x = ga[mm][bj], y = gb[mm][bj];
                    f32x4 fa0 = {bf_lo(x.x), bf_hi(x.x), bf_lo(x.y), bf_hi(x.y)}, fa1 = {bf_lo(x.z), bf_hi(x.z), bf_lo(x.w), bf_hi(x.w)};
                    if (!fin) { const f32x4 fb0 = {bf_lo(y.x), bf_hi(y.x), bf_lo(y.y), bf_hi(y.y)}, fb1 = {bf_lo(y.z), bf_hi(y.z), bf_lo(y.w), bf_hi(y.w)};
#pragma unroll
                        for (int j = 0; j < 4; ++j) { fa0[j] *= frcp(fb0[j]); fa1[j] *= frcp(fb1[j]); } }
                    acc[ai][bj][m][0] *= fa0; acc[ai][bj][m][1] *= fa1;
                    if (fin) *(GAS v4u*)(dst + (size_t)(row0 + ai * 128 + m * 16) * 1024 + c0 + bj * 128) = pack8(acc[ai][bj][m][0], acc[ai][bj][m][1]); }
        }
    }
};

struct EpiOut {
    GAS unsigned char* ws; GAS float* out; int last, first;
    __device__ __forceinline__ void operator()(Acc& acc, const Unit& u, int wr, int wc, int fr, int fq, LAS unsigned char* lds) const {
        const int row0 = u.pm * BM + wr * 64 + fr, c0 = u.pn * BM + wc * 32 + 8 * fq; GAS float* H = (GAS float*)(ws + WS_H); const GAS unsigned long long* RT = (const GAS unsigned long long*)(ws + WS_RTAB);
        const bool sample = u.pm >= MPAD / 256;
#pragma unroll
        for (int ai = 0; ai < 2; ++ai) {
            f32x4 hv[4][2][2];
#pragma unroll
            for (int m = 0; m < 4; ++m) { const int rw = row0 + ai * 128 + m * 16; const GAS float* hp = (first ? (const GAS float*)RT[rw] : H + (size_t)rw * 1024) + c0;
#pragma unroll
                for (int bj = 0; bj < 2; ++bj) { hv[m][bj][0] = *(const GAS f32x4*)(hp + bj * 128); hv[m][bj][1] = *(const GAS f32x4*)(hp + bj * 128 + 4); } }
#pragma unroll
            for (int m = 0; m < 4; ++m) { const int row = row0 + ai * 128 + m * 16; GAS float* dp = H + (size_t)row * 1024 + c0; bool ok = true;
                if (last) { if (sample) dp = out + O_YS + (size_t)(row - MPAD) * 1024 + c0;
                    else { const int b = row / LP, t = row - b * LP; ok = row < MP && t >= NMETA; dp = out + O_YP + ((size_t)b * SEQ + (t - NMETA)) * 1024 + c0; } }
                if (ok) {
#pragma unroll
                    for (int bj = 0; bj < 2; ++bj) { *(GAS f32x4*)(dp + bj * 128) = hv[m][bj][0] + acc[ai][bj][m][0]; *(GAS f32x4*)(dp + bj * 128 + 4) = hv[m][bj][1] + acc[ai][bj][m][1]; } } }
        }
    }
};
struct EpiMergeSlab {
    GAS unsigned char* ws;
    __device__ __forceinline__ void operator()(Acc& acc, const Unit& u, int wr, int wc, int fr, int fq, LAS unsigned char* lds) const {
        const int row0 = u.pm * BM + wr * 64 + fr, c0 = u.pn * BM + wc * 32 + 8 * fq;
        const GAS bf16* G0 = (const GAS bf16*)(ws + WS_GATE) + (size_t)u.seg * MTOT * 1024;
        {
            GAS float* sl = (GAS float*)(ws + WS_SLAB_M) + (size_t)u.slab * 65536 + (size_t)(wr * 64 + fr) * 256 + wc * 32 + 8 * fq;
#pragma unroll
            for (int ai = 0; ai < 2; ++ai) { v4u ga[4][2];
#pragma unroll
                for (int m = 0; m < 4; ++m)
#pragma unroll
                    for (int bj = 0; bj < 2; ++bj) ga[m][bj] = *(const GAS v4u*)(G0 + (size_t)(row0 + ai * 128 + m * 16) * 1024 + c0 + bj * 128);
#pragma unroll
                for (int m = 0; m < 4; ++m)
#pragma unroll
                    for (int bj = 0; bj < 2; ++bj) { const v4u x = ga[m][bj]; const f32x4 f0 = {bf_lo(x.x), bf_hi(x.x), bf_lo(x.y), bf_hi(x.y)}, f1 = {bf_lo(x.z), bf_hi(x.z), bf_lo(x.w), bf_hi(x.w)};
                        GAS float* d = sl + (size_t)(ai * 128 + m * 16) * 256 + bj * 128; *(GAS f32x4*)d = acc[ai][bj][m][0] * f0; *(GAS f32x4*)(d + 4) = acc[ai][bj][m][1] * f1; } }
        }
    }
};
struct EpiOutSlab {
    GAS unsigned char* ws;
    __device__ __forceinline__ void operator()(Acc& acc, const Unit& u, int wr, int wc, int fr, int fq, LAS unsigned char* lds) const {
        {
            GAS float* sl = (GAS float*)(ws + WS_SLAB_O) + (size_t)u.slab * 65536 + (size_t)(wr * 64 + fr) * 256 + wc * 32 + 8 * fq;
#pragma unroll
            for (int ai = 0; ai < 2; ++ai)
#pragma unroll
                for (int m = 0; m < 4; ++m)
#pragma unroll
                    for (int bj = 0; bj < 2; ++bj) { GAS float* d = sl + (size_t)(ai * 128 + m * 16) * 256 + bj * 128; *(GAS f32x4*)d = acc[ai][bj][m][0]; *(GAS f32x4*)(d + 4) = acc[ai][bj][m][1]; }
        }
    }
};
}
__device__ __forceinline__ f32x16 mfma32(bf16x8 a, bf16x8 b, f32x16 c) { return __builtin_amdgcn_mfma_f32_32x32x16_bf16(a, b, c, 0, 0, 0); }
__device__ __forceinline__ f32x16 zero16() { f32x16 z;
#pragma unroll
    for (int i = 0; i < 16; ++i) z[i] = 0.f; return z; }
__device__ __forceinline__ bf16x8 cvt8(const f32x4 a, const f32x4 b) { const v4u w = pg8::pack8(a, b); return __builtin_bit_cast(bf16x8, w); }

namespace hg {
constexpr int P136 = 136, P72 = 72;
constexpr int L_QS = 0, L_QT = L_QS + 64 * P136 * 2, L_KT = L_QT + 64 * P136 * 2, L_KTT = L_KT + 64 * P136 * 2, L_VT = L_KTT + 128 * P72 * 2,
              L_ATT = L_VT + 128 * P72 * 2, L_ST = L_ATT + 64 * P72 * 2, L_SEG = L_ST + 128 * P136 * 2, L_EV = L_SEG + 8 * 128 * 4, L_PART = L_EV + 2 * 128 * 4, L_GN = L_PART + 64 * 4 * 4, L_END = L_GN + 128 * 4;
static_assert(L_END <= LDS_MISC, "hgrn LDS");
struct Pre { f32x2 lf[8]; unsigned q[8], k[8], v[8]; v2u sg[4]; };
#define HG_BAR() do { asm volatile("s_waitcnt lgkmcnt(0)" ::: "memory"); __builtin_amdgcn_s_barrier(); asm volatile("" ::: "memory"); } while (0)

template <int PART>
__device__ __forceinline__ void prefetch(Pre& P, const GAS unsigned char* ws, size_t row0, int nvalid, int seg, int colb  , int trow  , int sgcol  ) {
    const GAS float* LF = (const GAS float*)(ws + WS_LOGF) + row0 * 1024; const GAS bf16* QC = (const GAS bf16*)(ws + WS_QC) + row0 * 1024; const GAS bf16* KC = (const GAS bf16*)(ws + WS_KC) + row0 * 1024; const GAS bf16* IC = (const GAS bf16*)(ws + WS_IC) + row0 * 1024;
    if (PART & 2) { const GAS bf16* SGC = (const GAS bf16*)(ws + WS_SGC) + row0 * 1024; const unsigned so = (unsigned)((trow < nvalid ? trow : 0) * 1024 + sgcol);
#pragma unroll
      for (int g = 0; g < 4; ++g) P.sg[g] = *(const GAS v2u*)(SGC + so + 8 * g); }
    if (nvalid == 64) {
#pragma unroll
        for (int i = 0; i < 8; ++i) { const unsigned o = (unsigned)((seg * 8 + i) * 1024 + colb);
            if (PART & 1) P.lf[i] = *(const GAS f32x2*)(LF + o);
            if (PART & 2) { P.q[i] = *(const GAS unsigned*)(QC + o); P.k[i] = *(const GAS unsigned*)(KC + o); P.v[i] = *(const GAS unsigned*)(IC + o); } }
    } else {
#pragma unroll
        for (int i = 0; i < 8; ++i) { const int t = seg * 8 + i; const unsigned o = (unsigned)(t * 1024 + colb);
            if (t < nvalid) { if (PART & 1) P.lf[i] = *(const GAS f32x2*)(LF + o); if (PART & 2) { P.q[i] = *(const GAS unsigned*)(QC + o); P.k[i] = *(const GAS unsigned*)(KC + o); P.v[i] = *(const GAS unsigned*)(IC + o); } }
            else { if (PART & 1) P.lf[i] = (f32x2){0.f, 0.f}; if (PART & 2) { P.q[i] = 0u; P.k[i] = 0u; P.v[i] = 0u; } } }
    }
}

__device__ __forceinline__ void chain(Frame& F, int layer, bool sample, int b, int h) {
    LAS unsigned char* lds = F.lds; int tid = F.tid_(); asm volatile("" : "+v"(tid));
    const int lane = tid & 63, wave = F.wave, seg = wave; int kp = tid & 63, l31 = lane & 31, hh = lane >> 5;
    const int L = sample ? DSEQ : LP, nchunks = (L + 63) / 64;
    const size_t rowbase = sample ? (size_t)MPAD + (size_t)b * DSEQ : (size_t)b * LP;
    const int colb = h * 128 + 2 * kp;
    GAS bf16* YC = (GAS bf16*)(F.wsp() + WS_Y) + (size_t)2 * MTOT * 1024;
    const int kb = wave >> 1, vb0 = 2 * (wave & 1);
    f32x16 S[2];
    if (sample) { const GAS float* s0 = F_state_hgrn + (((size_t)layer * DBATCH + b) * 8 + h) * 16384;
#pragma unroll
        for (int vbi = 0; vbi < 2; ++vbi)
#pragma unroll
            for (int r = 0; r < 16; ++r) S[vbi][r] = s0[(size_t)(32 * kb + (r & 3) + 8 * (r >> 2) + 4 * hh) * 128 + 32 * (vb0 + vbi) + l31]; }
    else { S[0] = zero16(); S[1] = zero16(); }
#pragma unroll
    for (int vbi = 0; vbi < 2; ++vbi)
#pragma unroll
        for (int g = 0; g < 4; ++g) { v2u w; w.x = cvt_pk_bf16(S[vbi][4 * g], S[vbi][4 * g + 1]); w.y = cvt_pk_bf16(S[vbi][4 * g + 2], S[vbi][4 * g + 3]);
            *(LAS v2u*)(lds + L_ST + ((32 * (vb0 + vbi) + l31) * P136 + 32 * kb + 8 * g + 4 * hh) * 2) = w; }
    const int ovb = wave & 3, otb = wave >> 2;
    if (tid < 128) *(LAS float*)(lds + L_GN + tid * 4) = F_hng[layer * 128 + tid];
    Pre P; prefetch<3>(P, F.wsp(), rowbase, min(64, L), seg, colb, 32 * otb + l31, h * 128 + 32 * ovb + 4 * hh);
    for (int c = 0; c < nchunks; ++c) {
        asm volatile("" : "+v"(l31), "+v"(hh), "+v"(kp));
        const int nvalid = min(64, L - 64 * c); const size_t row0 = rowbase + (size_t)64 * c;
        float c0[8], c1[8]; { float a0 = 0.f, a1 = 0.f;
#pragma unroll
            for (int i = 0; i < 8; ++i) { a0 += P.lf[i].x; a1 += P.lf[i].y; c0[i] = a0; c1[i] = a1; }
            *(LAS f32x2*)(lds + L_SEG + (seg * 128 + 2 * kp) * 4) = (f32x2){a0, a1}; }
        if (c + 1 < nchunks) prefetch<1>(P, F.wsp(), rowbase + (size_t)64 * (c + 1), min(64, L - 64 * (c + 1)), seg, colb, 32 * otb + l31, h * 128 + 32 * ovb + 4 * hh);
        HG_BAR();
        float off0 = 0.f, off1 = 0.f, m0 = 0.f, m1 = 0.f, la0 = 0.f, la1 = 0.f;
#pragma unroll
        for (int s = 0; s < 8; ++s) { const f32x2 tt = *(const LAS f32x2*)(lds + L_SEG + (s * 128 + 2 * kp) * 4);
            if (s < seg) { off0 += tt.x; off1 += tt.y; } if (s < 4) { m0 += tt.x; m1 += tt.y; } la0 += tt.x; la1 += tt.y; }
        unsigned ktt0[8], ktt1[8], vt0[8], vt1[8]; const float e2m0 = fexp2(m0), e2m1 = fexp2(m1);
#pragma unroll
        for (int i = 0; i < 8; ++i) { const int t = seg * 8 + i; const float cu0 = off0 + c0[i], cu1 = off1 + c1[i];
            const float q0 = bf_lo(P.q[i]), q1 = bf_hi(P.q[i]), k0 = bf_lo(P.k[i]), k1 = bf_hi(P.k[i]);
            const float em0 = fexp2(cu0 - m0), em1 = fexp2(cu1 - m1), ek0 = fexp2(m0 - cu0), ek1 = fexp2(m1 - cu1), eq0 = em0 * e2m0, eq1 = em1 * e2m1;
            *(LAS unsigned*)(lds + L_QS + (t * P136 + 2 * kp) * 2) = cvt_pk_bf16(q0 * eq0, q1 * eq1);
            *(LAS unsigned*)(lds + L_QT + (t * P136 + 2 * kp) * 2) = cvt_pk_bf16(q0 * em0, q1 * em1);
            const unsigned kt = cvt_pk_bf16(k0 * ek0, k1 * ek1);
            *(LAS unsigned*)(lds + L_KT + (t * P136 + 2 * kp) * 2) = kt;
            ktt0[i] = kt & 0xffffu; ktt1[i] = kt >> 16; vt0[i] = P.v[i] & 0xffffu; vt1[i] = P.v[i] >> 16; }
        { v4u w; w.x = ktt0[0] | (ktt0[1] << 16); w.y = ktt0[2] | (ktt0[3] << 16); w.z = ktt0[4] | (ktt0[5] << 16); w.w = ktt0[6] | (ktt0[7] << 16);
          *(LAS v4u*)(lds + L_KTT + ((2 * kp) * P72 + 8 * seg) * 2) = w;
          w.x = ktt1[0] | (ktt1[1] << 16); w.y = ktt1[2] | (ktt1[3] << 16); w.z = ktt1[4] | (ktt1[5] << 16); w.w = ktt1[6] | (ktt1[7] << 16);
          *(LAS v4u*)(lds + L_KTT + ((2 * kp + 1) * P72 + 8 * seg) * 2) = w;
          w.x = vt0[0] | (vt0[1] << 16); w.y = vt0[2] | (vt0[3] << 16); w.z = vt0[4] | (vt0[5] << 16); w.w = vt0[6] | (vt0[7] << 16);
          *(LAS v4u*)(lds + L_VT + ((2 * kp) * P72 + 8 * seg) * 2) = w;
          w.x = vt1[0] | (vt1[1] << 16); w.y = vt1[2] | (vt1[3] << 16); w.z = vt1[4] | (vt1[5] << 16); w.w = vt1[6] | (vt1[7] << 16);
          *(LAS v4u*)(lds + L_VT + ((2 * kp + 1) * P72 + 8 * seg) * 2) = w; }
        if (seg == 0) { *(LAS f32x2*)(lds + L_EV + (2 * kp) * 4) = (f32x2){fexp2(la0), fexp2(la1)}; *(LAS f32x2*)(lds + L_EV + (128 + 2 * kp) * 4) = (f32x2){fexp2(la0 - m0), fexp2(la1 - m1)}; }
        v2u sg[4] = {P.sg[0], P.sg[1], P.sg[2], P.sg[3]};
        if (c + 1 < nchunks) prefetch<2>(P, F.wsp(), rowbase + (size_t)64 * (c + 1), min(64, L - 64 * (c + 1)), seg, colb, 32 * otb + l31, h * 128 + 32 * ovb + 4 * hh);
        HG_BAR();
        if (wave < 3) { const int sb = wave == 2 ? 1 : 0, tb = wave == 0 ? 0 : 1; f32x16 a = zero16();
#pragma unroll
            for (int st = 0; st < 8; ++st) { const bf16x8 ka = *(const LAS bf16x8*)(lds + L_KT + ((32 * sb + l31) * P136 + 16 * st + 8 * hh) * 2);
                const bf16x8 qb = *(const LAS bf16x8*)(lds + L_QT + ((32 * tb + l31) * P136 + 16 * st + 8 * hh) * 2); a = mfma32(ka, qb, a); }
            const int t = 32 * tb + l31;
#pragma unroll
            for (int g = 0; g < 4; ++g) { const int s0 = 32 * sb + 8 * g + 4 * hh; float x[4];
#pragma unroll
                for (int j = 0; j < 4; ++j) x[j] = (s0 + j <= t) ? a[4 * g + j] : 0.f;
                v2u w; w.x = cvt_pk_bf16(x[0], x[1]); w.y = cvt_pk_bf16(x[2], x[3]); *(LAS v2u*)(lds + L_ATT + (t * P72 + s0) * 2) = w; } }
        HG_BAR();
        f32x16 o = zero16();
#pragma unroll
        for (int st = 0; st < 8; ++st) { const bf16x8 sa = *(const LAS bf16x8*)(lds + L_ST + ((32 * ovb + l31) * P136 + 16 * st + 8 * hh) * 2);
            const bf16x8 qb = *(const LAS bf16x8*)(lds + L_QS + ((32 * otb + l31) * P136 + 16 * st + 8 * hh) * 2); o = mfma32(sa, qb, o); }
        for (int st = 0; st < 2 + 2 * otb; ++st) { const bf16x8 va = *(const LAS bf16x8*)(lds + L_VT + ((32 * ovb + l31) * P72 + 16 * st + 8 * hh) * 2);
            const bf16x8 ab = *(const LAS bf16x8*)(lds + L_ATT + ((32 * otb + l31) * P72 + 16 * st + 8 * hh) * 2); o = mfma32(va, ab, o); }
        { float ss = 0.f;
#pragma unroll
            for (int r = 0; r < 16; ++r) ss += o[r] * o[r];
            ss += __shfl_xor(ss, 32);
            if (hh == 0) *(LAS float*)(lds + L_PART + ((32 * otb + l31) * 4 + ovb) * 4) = ss; }
        HG_BAR();
        { const f32x4 p = *(const LAS f32x4*)(lds + L_PART + (32 * otb + l31) * 16); const float rs = frsq(((p[0] + p[1]) + (p[2] + p[3])) * (1.0f / 128.0f) + EPS);
          const int t = 32 * otb + l31;
          if (t < nvalid) { GAS bf16* yp = YC + (row0 + t) * 1024 + h * 128 + 32 * ovb + 4 * hh;
#pragma unroll
              for (int g = 0; g < 4; ++g) { const f32x4 gng = *(const LAS f32x4*)(lds + L_GN + (32 * ovb + 8 * g + 4 * hh) * 4); const float y0 = o[4 * g] * rs * gng[0] * bf_lo(sg[g].x), y1 = o[4 * g + 1] * rs * gng[1] * bf_hi(sg[g].x),
                                                        y2 = o[4 * g + 2] * rs * gng[2] * bf_lo(sg[g].y), y3 = o[4 * g + 3] * rs * gng[3] * bf_hi(sg[g].y);
                  v2u w; w.x = cvt_pk_bf16(y0, y1); w.y = cvt_pk_bf16(y2, y3); *(GAS v2u*)(yp + 8 * g) = w; } } }
        f32x16 Pn[2] = {zero16(), zero16()};
#pragma unroll
        for (int st = 0; st < 4; ++st) { const bf16x8 ka = *(const LAS bf16x8*)(lds + L_KTT + ((32 * kb + l31) * P72 + 16 * st + 8 * hh) * 2);
#pragma unroll
            for (int vbi = 0; vbi < 2; ++vbi) { const bf16x8 vbf = *(const LAS bf16x8*)(lds + L_VT + ((32 * (vb0 + vbi) + l31) * P72 + 16 * st + 8 * hh) * 2); Pn[vbi] = mfma32(ka, vbf, Pn[vbi]); } }
#pragma unroll
        for (int g = 0; g < 4; ++g) { const f32x4 el = *(const LAS f32x4*)(lds + L_EV + (32 * kb + 8 * g + 4 * hh) * 4), elm = *(const LAS f32x4*)(lds + L_EV + (128 + 32 * kb + 8 * g + 4 * hh) * 4);
#pragma unroll
            for (int vbi = 0; vbi < 2; ++vbi) {
#pragma unroll
                for (int j = 0; j < 4; ++j) S[vbi][4 * g + j] = el[j] * S[vbi][4 * g + j] + elm[j] * Pn[vbi][4 * g + j];
                v2u w; w.x = cvt_pk_bf16(S[vbi][4 * g], S[vbi][4 * g + 1]); w.y = cvt_pk_bf16(S[vbi][4 * g + 2], S[vbi][4 * g + 3]);
                *(LAS v2u*)(lds + L_ST + ((32 * (vb0 + vbi) + l31) * P136 + 32 * kb + 8 * g + 4 * hh) * 2) = w; } }
    }
    GAS float* sf = sample ? F.outp() + O_HS + (((size_t)layer * DBATCH + b) * 8 + h) * 16384 : F.outp() + O_HP + (((size_t)layer * BATCH + b) * 8 + h) * 16384;
#pragma unroll
    for (int vbi = 0; vbi < 2; ++vbi)
#pragma unroll
        for (int r = 0; r < 16; ++r) sf[(size_t)(32 * kb + (r & 3) + 8 * (r >> 2) + 4 * hh) * 128 + 32 * (vb0 + vbi) + l31] = S[vbi][r];
    HG_BAR();
}
}

namespace sb {
constexpr float R_STOP = -136.0f;
constexpr int KROW = 272, SLOT = 32 * KROW + 128 * 64;
static_assert(8 * SLOT + 64 <= LDS_MISC, "attention LDS");
constexpr int L_DONE = 8 * SLOT;
struct Grp { const GAS float* k_old; const GAS float* v_old; const GAS float* k_new; const GAS float* v_new; };

struct TileRegs { f32x4 k0, k1, v0, v1; };
__device__ __forceinline__ void tile_issue(TileRegs& t, const Grp& g, int kt, int past, int L, int c, int rp) {
    const int s0 = 32 * kt; const bool old = s0 < past; const int rl = old ? 31 : (L - 1 - (s0 - past));
    const GAS float* kb = old ? g.k_old + (size_t)s0 * 1024 : g.k_new + (size_t)(s0 - past) * 1024; const GAS float* vb = old ? g.v_old + (size_t)s0 * 1024 : g.v_new + (size_t)(s0 - past) * 1024;
    if (rl >= 31) {
        const unsigned o = (unsigned)(2 * rp * 1024 + 4 * c);
        t.k0 = *(const GAS f32x4*)(kb + o); t.k1 = *(const GAS f32x4*)(kb + o + 1024); t.v0 = *(const GAS f32x4*)(vb + o); t.v1 = *(const GAS f32x4*)(vb + o + 1024);
        return; }
    const int r0 = min(2 * rp, rl), r1 = min(2 * rp + 1, rl);
    t.k0 = *(const GAS f32x4*)(kb + (size_t)r0 * 1024 + 4 * c); t.k1 = *(const GAS f32x4*)(kb + (size_t)r1 * 1024 + 4 * c);
    t.v0 = *(const GAS f32x4*)(vb + (size_t)r0 * 1024 + 4 * c); t.v1 = *(const GAS f32x4*)(vb + (size_t)r1 * 1024 + 4 * c);
}
__device__ __forceinline__ void tile_commit(const TileRegs& t, LAS unsigned char* slot, int c, int rp) {
    v2u a; a.x = cvt_pk_bf16(t.k0[0], t.k0[1]); a.y = cvt_pk_bf16(t.k0[2], t.k0[3]); *(LAS v2u*)(slot + (2 * rp) * KROW + 8 * c) = a;
    a.x = cvt_pk_bf16(t.k1[0], t.k1[1]); a.y = cvt_pk_bf16(t.k1[2], t.k1[3]); *(LAS v2u*)(slot + (2 * rp + 1) * KROW + 8 * c) = a;
    LAS unsigned char* vt = slot + 32 * KROW; const int r7 = rp & 7, f = 2 * (rp >> 3) + ((r7 >> 1) & 1);
    const int u = ((f ^ (c & 3)) * 16) + (r7 >> 2) * 8 + (rp & 1) * 4;
#pragma unroll
    for (int j = 0; j < 4; ++j) *(LAS unsigned*)(vt + (4 * c + j) * 64 + u) = cvt_pk_bf16(t.v0[j], t.v1[j]);
}

template <int NG>
__device__ __forceinline__ void block_unit(Frame& F, int layer, int unit  ) {
    constexpr int W = 8 / NG;
    int tid = F.tid_(); asm volatile("" : "+v"(tid)); const int lane = tid & 63, wave = F.wave, l31 = lane & 31, hh = lane >> 5;
    LAS unsigned char* lds = F.lds;
    const bool sample = NG > 1; const int L = sample ? DSEQ : LP, past = sample ? PAST : 0, nqt = (L + 31) / 32;
    const int gi = wave / W, wi = wave - gi * W;
    int bh, qt0; if (!sample) { const int jj = unit >> 6; bh = unit & 63; const int j = jj < 6 ? 7 - jj : jj == 6 ? 8 : 8 - jj; qt0 = 8 * j; } else { bh = unit * NG + gi; qt0 = 0; }
    const int b = bh >> 3, h = bh & 7; const int qt = qt0 + wi; const bool wave_on = qt < nqt;
    const size_t rowbase = sample ? (size_t)MPAD + (size_t)b * DSEQ : (size_t)b * LP;
    Grp g;
    g.k_new = (sample ? F.outp() + O_KS + (size_t)layer * MS * 1024 + (size_t)b * DSEQ * 1024 : F.outp() + O_KP + (size_t)layer * MP * 1024 + (size_t)b * LP * 1024) + h * 128;
    g.v_new = (sample ? F.outp() + O_VS + (size_t)layer * MS * 1024 + (size_t)b * DSEQ * 1024 : F.outp() + O_VP + (size_t)layer * MP * 1024 + (size_t)b * LP * 1024) + h * 128;
    g.k_old = F_cache_k + ((size_t)layer * DBATCH + b) * PAST * 1024 + h * 128; g.v_old = F_cache_v + ((size_t)layer * DBATCH + b) * PAST * 1024 + h * 128;
    const int dt0 = (past >> 5) + qt0;
    const int tq = 32 * qt + l31; const bool qvalid = wave_on && tq < L; const size_t qrow = rowbase + (tq < L ? tq : L - 1);
    const GAS bf16* Q = (const GAS bf16*)(F.wsp() + WS_Q) + qrow * 1024 + h * 128 + 8 * hh;
    bf16x8 qf[8];
#pragma unroll
    for (int st = 0; st < 8; ++st) qf[st] = *(const GAS bf16x8*)(Q + 16 * st);
    f32x16 O[4] = {zero16(), zero16(), zero16(), zero16()};
    const int qpos = past + tq; float R = 0.f; bool done = !wave_on;
    const int sc = tid & 31, srp = NG == 1 ? (tid >> 5) : ((tid & (64 * W - 1)) >> 5);
    if (NG == 1) { for (int j0 = 0; j0 < W; j0 += 4) { TileRegs t[4];
#pragma unroll
            for (int j = 0; j < 4; ++j) tile_issue(t[j], g, dt0 + j0 + j, past, L, sc, srp);
#pragma unroll
            for (int j = 0; j < 4; ++j) tile_commit(t[j], lds + ((dt0 + j0 + j) & (W - 1)) * SLOT, sc, srp); } }
    else { for (int j = 0; j < W; ++j) { TileRegs t[4];
#pragma unroll
            for (int ps = 0; ps < 4; ++ps) tile_issue(t[ps], g, dt0 + j, past, L, sc, srp + 4 * ps);
#pragma unroll
            for (int ps = 0; ps < 4; ++ps) tile_commit(t[ps], lds + (gi * W + ((dt0 + j) & (W - 1))) * SLOT, sc, srp + 4 * ps); } }
    if (lane == 0) *(LAS unsigned*)(lds + L_DONE + 4 * wave) = done ? 1u : 0u;
    HG_BAR();
    for (int i = 0; ; ++i) {
        const int kt = dt0 + wi - i;
        const int knew = dt0 - i - 1;
        TileRegs pre; if (NG == 1 && knew >= 0) tile_issue(pre, g, knew, past, L, sc, srp);
        if (!done && kt >= 0) {
            const LAS unsigned char* slot = lds + (gi * W + (kt & (W - 1))) * SLOT; const int s0 = 32 * kt;
            f32x16 sa = zero16();
#pragma unroll
            for (int st = 0; st < 8; ++st) sa = mfma32(*(const LAS bf16x8*)(slot + l31 * KROW + (16 * st + 8 * hh) * 2), qf[st], sa);
            const bool diag = i == 0;
            float sg[16], kp[16];
#pragma unroll
            for (int r = 0; r < 16; ++r) { const float e = fexp2(-sa[r]), rc = frcp(1.0f + e); sg[r] = rc; kp[r] = e * rc; }
            if (diag) {
#pragma unroll
                for (int r = 0; r < 16; ++r) { const int key = s0 + (r & 3) + 8 * (r >> 2) + 4 * hh; const bool ok = key < qpos; kp[r] = ok ? kp[r] : 1.0f; sg[r] = ok ? sg[r] : 0.f; } }
            float ex[16], T[4], Tp[4];
#pragma unroll
            for (int gq = 0; gq < 4; ++gq) { ex[4 * gq + 3] = 1.0f; ex[4 * gq + 2] = kp[4 * gq + 3]; ex[4 * gq + 1] = ex[4 * gq + 2] * kp[4 * gq + 2]; ex[4 * gq] = ex[4 * gq + 1] * kp[4 * gq + 1]; T[gq] = ex[4 * gq] * kp[4 * gq]; Tp[gq] = __shfl_xor(T[gq], 32); }
            float carry[4]; { float above = fexp2(R);
#pragma unroll
                for (int gq = 3; gq >= 0; --gq) { carry[gq] = above * (hh == 0 ? Tp[gq] : 1.0f); above *= T[gq] * Tp[gq]; }
                R += flog2(fmaxf(((T[0] * Tp[0]) * (T[1] * Tp[1])) * ((T[2] * Tp[2]) * (T[3] * Tp[3])), 1e-45f)); }
            float w[16];
#pragma unroll
            for (int r = 0; r < 16; ++r) w[r] = sg[r] * (carry[r >> 2] * ex[r]);
            const LAS unsigned char* vt = slot + 32 * KROW;
#pragma unroll
            for (int s = 0; s < 2; ++s) { v4u pw; pw.x = cvt_pk_bf16(w[8 * s], w[8 * s + 1]); pw.y = cvt_pk_bf16(w[8 * s + 2], w[8 * s + 3]); pw.z = cvt_pk_bf16(w[8 * s + 4], w[8 * s + 5]); pw.w = cvt_pk_bf16(w[8 * s + 6], w[8 * s + 7]);
                const bf16x8 pb = __builtin_bit_cast(bf16x8, pw);
#pragma unroll
                for (int db = 0; db < 4; ++db) { const int d = 32 * db + l31;
                    O[db] = mfma32(*(const LAS bf16x8*)(vt + d * 64 + (((2 * s + hh) ^ ((d >> 2) & 3)) * 16)), pb, O[db]); } }
            if (kt == 0 || __all(R < R_STOP)) { done = true; if (lane == 0) *(LAS unsigned*)(lds + L_DONE + 4 * wave) = 1u; }
        } else if (!done && kt < 0) { done = true; if (lane == 0) *(LAS unsigned*)(lds + L_DONE + 4 * wave) = 1u; }
        HG_BAR();
        const v4u d0 = *(const LAS v4u*)(lds + L_DONE), d1 = *(const LAS v4u*)(lds + L_DONE + 16);
        if ((d0.x & d0.y & d0.z & d0.w & d1.x & d1.y & d1.z & d1.w) != 0u) break;
        if (NG == 1) { if (knew >= 0) tile_commit(pre, lds + (knew & (W - 1)) * SLOT, sc, srp); }
        else if (knew >= 0) { TileRegs t[4];
#pragma unroll
            for (int ps = 0; ps < 4; ++ps) tile_issue(t[ps], g, knew, past, L, sc, srp + 4 * ps);
#pragma unroll
            for (int ps = 0; ps < 4; ++ps) tile_commit(t[ps], lds + (gi * W + (knew & (W - 1))) * SLOT, sc, srp + 4 * ps); }
        HG_BAR();
    }
    if (qvalid) { const GAS bf16* SG = (const GAS bf16*)(F.wsp() + WS_SGB) + qrow * 1024 + h * 128 + 4 * hh; GAS bf16* Y = (GAS bf16*)(F.wsp() + WS_Y) + (size_t)MTOT * 1024 + qrow * 1024 + h * 128 + 4 * hh;
        v2u sgv[4][4];
#pragma unroll
        for (int db = 0; db < 4; ++db)
#pragma unroll
            for (int gq = 0; gq < 4; ++gq) sgv[db][gq] = *(const GAS v2u*)(SG + 32 * db + 8 * gq);
#pragma unroll
        for (int db = 0; db < 4; ++db)
#pragma unroll
            for (int gq = 0; gq < 4; ++gq) { const v2u s = sgv[db][gq]; v2u o;
                o.x = cvt_pk_bf16(O[db][4 * gq] * bf_lo(s.x), O[db][4 * gq + 1] * bf_hi(s.x)); o.y = cvt_pk_bf16(O[db][4 * gq + 2] * bf_lo(s.y), O[db][4 * gq + 3] * bf_hi(s.y));
                *(GAS v2u*)(Y + 32 * db + 8 * gq) = o; } }
    HG_BAR();
}
constexpr int NU_P = BATCH * 8 * 9, NU_S = DBATCH * 8 / 4;
constexpr int NUNITS = NU_P + NU_S;
}

namespace pl {
constexpr int RS = 528;
constexpr int L_UT = 0, L_DF = 143 * RS, L_END = L_DF + 128 * RS;
static_assert(L_END <= LDS_MISC, "pool LDS");
constexpr int NU_P = BATCH * 17 * 4, NU_S = DBATCH * 4, NUNITS = NU_P + NU_S;
__device__ __forceinline__ void unit(Frame& F, int layer, int u) {
    LAS unsigned char* lds = F.lds; int tid = F.tid_(); asm volatile("" : "+v"(tid)); const int lane = tid & 63, wave = F.wave, l31 = lane & 31, hh = lane >> 5;
    const bool sample = u >= NU_P; int b, tile, g;
    if (!sample) { g = u & 3; const int x = u >> 2; b = x / 17; tile = x - b * 17; } else { const int x = u - NU_P; g = x & 3; b = x >> 2; tile = 0; }
    const int L = sample ? DSEQ : LP, t0 = tile * 128, nrows = min(128, L - t0), w = 2 << g;
    const size_t rowbase = sample ? (size_t)MPAD + (size_t)b * DSEQ : (size_t)b * LP;
    const GAS bf16* UA = (const GAS bf16*)(F.wsp() + WS_UA);
    { v4u sv[9];
#pragma unroll
      for (int q = 0; q < 9; ++q) { const int idx = tid + 512 * q, i = idx >> 5, ch = idx & 31, t = t0 - 15 + i; v4u v = {0u, 0u, 0u, 0u};
        if (idx < 143 * 32) { if (t >= 0 && t < L) v = *(const GAS v4u*)(UA + (rowbase + t) * 1024 + 256 * g + 8 * ch);
            else if (t < 0 && sample) { const GAS float* sp = F_state_pool + (((size_t)layer * DBATCH + b) * 15 + (15 + t)) * 1024 + 256 * g + 8 * ch; v = pg8::pack8(*(const GAS f32x4*)sp, *(const GAS f32x4*)(sp + 4)); } }
        sv[q] = v; }
#pragma unroll
      for (int q = 0; q < 9; ++q) { const int idx = tid + 512 * q, i = idx >> 5, ch = idx & 31; if (idx < 143 * 32) *(LAS v4u*)(lds + L_UT + i * RS + ch * 16) = sv[q]; } }
    const GAS bf16* WT = (const GAS bf16*)(F.wsp() + WS_WPOOL) + ((size_t)layer * 4 + g) * 65536 + (size_t)(32 * wave + l31) * 256 + 8 * hh;
    bf16x8 wf[16];
#pragma unroll
    for (int st = 0; st < 16; ++st) wf[st] = *(const GAS bf16x8*)(WT + 16 * st);
    const GAS float* sc = F_pool_scale + layer * 1024 + 256 * g + 32 * wave + 4 * hh; const GAS bf16* SGA = (const GAS bf16*)(F.wsp() + WS_SGA); GAS bf16* YA = (GAS bf16*)(F.wsp() + WS_Y);
    v2u sgv[4][4]; f32x4 scv[4];
#pragma unroll
    for (int rb = 0; rb < 4; ++rb) { const int r = 32 * rb + l31; const size_t ro = (rowbase + t0 + (r < nrows ? r : 0)) * 1024 + 256 * g + 32 * wave + 4 * hh;
#pragma unroll
        for (int gg = 0; gg < 4; ++gg) sgv[rb][gg] = __builtin_nontemporal_load((const GAS v2u*)(SGA + ro + 8 * gg)); }
#pragma unroll
    for (int gg = 0; gg < 4; ++gg) scv[gg] = *(const GAS f32x4*)(sc + 8 * gg);
    HG_BAR();
    { const int ch = tid & 31, rs = tid >> 5, r0 = 8 * rs; float sum[8];
#pragma unroll
      for (int j = 0; j < 8; ++j) sum[j] = 0.f;
      for (int j = 1; j < w; ++j) { const v4u v = *(const LAS v4u*)(lds + L_UT + (15 + r0 - j) * RS + ch * 16);
          sum[0] += bf_lo(v.x); sum[1] += bf_hi(v.x); sum[2] += bf_lo(v.y); sum[3] += bf_hi(v.y); sum[4] += bf_lo(v.z); sum[5] += bf_hi(v.z); sum[6] += bf_lo(v.w); sum[7] += bf_hi(v.w); }
#pragma unroll
      for (int i = 0; i < 8; ++i) { const int r = r0 + i; const v4u v = *(const LAS v4u*)(lds + L_UT + (15 + r) * RS + ch * 16);
          float x[8] = {bf_lo(v.x), bf_hi(v.x), bf_lo(v.y), bf_hi(v.y), bf_lo(v.z), bf_hi(v.z), bf_lo(v.w), bf_hi(v.w)};
          const float rc = sample ? 1.0f / (float)w : 1.0f / fminf((float)(t0 + r) + 1.0f, (float)w); float d[8];
#pragma unroll
          for (int j = 0; j < 8; ++j) { sum[j] += x[j]; d[j] = sum[j] * rc - x[j]; }
          *(LAS v4u*)(lds + L_DF + r * RS + ch * 16) = pg8::pack8((f32x4){d[0], d[1], d[2], d[3]}, (f32x4){d[4], d[5], d[6], d[7]});
          const v4u o = *(const LAS v4u*)(lds + L_UT + (15 + r - (w - 1)) * RS + ch * 16);
          sum[0] -= bf_lo(o.x); sum[1] -= bf_hi(o.x); sum[2] -= bf_lo(o.y); sum[3] -= bf_hi(o.y); sum[4] -= bf_lo(o.z); sum[5] -= bf_hi(o.z); sum[6] -= bf_lo(o.w); sum[7] -= bf_hi(o.w); } }
    HG_BAR();
    f32x16 acc[4] = {zero16(), zero16(), zero16(), zero16()};
#pragma unroll
    for (int st = 0; st < 16; ++st) { const bf16x8 a = wf[st];
#pragma unroll
        for (int rb = 0; rb < 4; ++rb) { const bf16x8 bb = *(const LAS bf16x8*)(lds + L_DF + (32 * rb + l31) * RS + (16 * st + 8 * hh) * 2); acc[rb] = mfma32(a, bb, acc[rb]); } }
#pragma unroll
    for (int rb = 0; rb < 4; ++rb) { const int r = 32 * rb + l31; const size_t ro = (rowbase + t0 + (r < nrows ? r : 0)) * 1024 + 256 * g + 32 * wave + 4 * hh;
        if (r < nrows) {
#pragma unroll
            for (int gg = 0; gg < 4; ++gg) { const v2u s = sgv[rb][gg]; v2u o;
                o.x = cvt_pk_bf16(acc[rb][4 * gg] * scv[gg][0] * bf_lo(s.x), acc[rb][4 * gg + 1] * scv[gg][1] * bf_hi(s.x)); o.y = cvt_pk_bf16(acc[rb][4 * gg + 2] * scv[gg][2] * bf_lo(s.y), acc[rb][4 * gg + 3] * scv[gg][3] * bf_hi(s.y));
                *(GAS v2u*)(YA + ro + 8 * gg) = o; } } }
    HG_BAR();
}
}

#ifndef MERGE_TAIL
#define MERGE_TAIL 6
#endif
#ifndef WGM_PROJ
#define WGM_PROJ 4
#endif
#ifndef WGM_SQ
#define WGM_SQ 1
#endif
constexpr int U_HG_P = BATCH * 8, U_HG_S = DBATCH * 8;
constexpr int U0_HGS = U_HG_P, U0_ATT = U0_HGS + U_HG_S, U0_POOL = U0_ATT + sb::NUNITS, U_TOTAL = U0_POOL + pl::NUNITS;
__device__ __forceinline__ void phase_mixers(Frame& F, int layer, int qslot) {
    GAS unsigned* head = F.ctl() + CW_QUEUE + 64 * qslot;
    for (;;) {
        if (F.tid_() == 0) F.MISC[4] = __hip_atomic_fetch_add(head, 1u, __ATOMIC_RELAXED, __HIP_MEMORY_SCOPE_AGENT);
        HG_BAR();
        const int u = (int)F.MISC[4];
        HG_BAR();
        if (u >= U_TOTAL) break;
        if (u < U0_ATT) { const bool smp = u >= U0_HGS; const int x = smp ? u - U0_HGS : u; hg::chain(F, layer, smp, x >> 3, x & 7); }
        else if (u < U0_POOL) { const int x = u - U0_ATT; if (x < sb::NU_P) sb::block_unit<1>(F, layer, x); else sb::block_unit<4>(F, layer, x - sb::NU_P); }
        else pl::unit(F, layer, u - U0_POOL);
    }
}

__device__ __forceinline__ void combine_merge(Frame& F) {
    pg8::Gemm g{nullptr, nullptr, 0, 0, MTOT / 256, D / 256, 3, D, MERGE_TAIL, WGM_SQ}; pg8::Order S; S.init(g, F.G, 0); if (!S.tail) return;
    const int gw = F.vcu * 8 + F.wave, NGW = F.G * 8, lane = F.lane_(), nrows = (S.nwg - S.G) * 256;
    const GAS float* sl = (const GAS float*)(F.wsp() + WS_SLAB_M); GAS bf16* M = (GAS bf16*)(F.wsp() + WS_MERGED);
    for (int x = gw; x < nrows; x += NGW) { const int j = x >> 8, r = x & 255; int pm, pn; S.tile_of(S.G + j, pm, pn);
        const GAS float* p = sl + (size_t)(MERGE_TAIL * j) * 65536 + (size_t)r * 256 + 4 * lane;
        f32x4 v = *(const GAS f32x4*)p;
#pragma unroll
        for (int q = 1; q < MERGE_TAIL; ++q) v += *(const GAS f32x4*)(p + (size_t)q * 65536);
        v2u o; o.x = cvt_pk_bf16(v[0], v[1]); o.y = cvt_pk_bf16(v[2], v[3]); *(GAS v2u*)(M + (size_t)(256 * pm + r) * 1024 + 256 * pn + 4 * lane) = o; }
}
__device__ __forceinline__ void combine_out(Frame& F, int last) {
    pg8::Gemm g{nullptr, nullptr, 0, 0, MTOT / 256, D / 256, 1, D, 4, WGM_SQ}; pg8::Order S; S.init(g, F.G, 0); if (!S.tail) return;
    const int gw = F.vcu * 8 + F.wave, NGW = F.G * 8, lane = F.lane_(), nrows = (S.nwg - S.G) * 256;
    const GAS float* sl = (const GAS float*)(F.wsp() + WS_SLAB_O); GAS float* H = (GAS float*)(F.wsp() + WS_H); GAS float* out = F.outp();
    for (int x = gw; x < nrows; x += NGW) { const int j = x >> 8, r = x & 255; int pm, pn; S.tile_of(S.G + j, pm, pn);
        const GAS float* p = sl + (size_t)(4 * j) * 65536 + (size_t)r * 256 + 4 * lane; const int row = 256 * pm + r, col = 256 * pn + 4 * lane;
        const f32x4 v = *(const GAS f32x4*)(H + (size_t)row * 1024 + col) + ((*(const GAS f32x4*)p + *(const GAS f32x4*)(p + 65536)) + (*(const GAS f32x4*)(p + 2 * 65536) + *(const GAS f32x4*)(p + 3 * 65536)));
        if (!last) *(GAS f32x4*)(H + (size_t)row * 1024 + col) = v;
        else if (row >= MPAD) *(GAS f32x4*)(out + O_YS + (size_t)(row - MPAD) * 1024 + col) = v;
        else if (row < MP) { const int b = row / LP, t = row - b * LP; if (t >= NMETA) *(GAS f32x4*)(out + O_YP + ((size_t)b * SEQ + (t - NMETA)) * 1024 + col) = v; } }
}
__device__ __forceinline__ void phase_xn_fused(Frame& F, int l) {
    pg8::Gemm g{nullptr, nullptr, 0, 0, MTOT / 256, D / 256, 1, D, 4, WGM_SQ}; pg8::Order S; S.init(g, F.G, 0);
    LAS int* tab = (LAS int*)F.lds; const int tid = F.tid_(), lane = F.lane_();
    for (int i = tid; i < (MTOT / 256) * 4; i += 512) tab[i] = -1;
    __syncthreads();
    if (S.tail && tid < S.nwg - S.G) { int pm, pn; S.tile_of(S.G + tid, pm, pn); tab[4 * pm + pn] = tid; }
    __syncthreads();
    const int gw = F.vcu * 8 + F.wave, NGW = F.G * 8;
    GAS float* H = (GAS float*)(F.wsp() + WS_H); GAS bf16* XN = (GAS bf16*)(F.wsp() + WS_XN); const GAS float* sl = (const GAS float*)(F.wsp() + WS_SLAB_O); const GAS float* gn = F_norm_g + (size_t)l * D;
    for (int r = gw; r < MTOT; r += NGW) {
        if (r >= MP && r < MPAD) { zero_xn_row(XN + (size_t)r * D, lane); continue; }
        GAS f32x4* xr = (GAS f32x4*)(H + (size_t)r * D) + lane; const int pm = r >> 8, rr = r & 255;
        const GAS f32x4* x0 = l == 1 ? (const GAS f32x4*)(*((const GAS unsigned long long*)(F.wsp() + WS_RTAB) + r)) + lane : xr;
        f32x4 v[4]; float s = 0.f;
#pragma unroll
        for (int j = 0; j < 4; ++j) { const int idx = tab[4 * pm + j]; v[j] = idx >= 0 ? x0[64 * j] : xr[64 * j];
            if (idx >= 0) { const GAS float* p = sl + (size_t)(4 * idx) * 65536 + (size_t)rr * 256 + 4 * lane;
                v[j] += (*(const GAS f32x4*)p + *(const GAS f32x4*)(p + 65536)) + (*(const GAS f32x4*)(p + 2 * 65536) + *(const GAS f32x4*)(p + 3 * 65536)); xr[64 * j] = v[j]; }
            s += (v[j].x * v[j].x + v[j].y * v[j].y) + (v[j].z * v[j].z + v[j].w * v[j].w); }
        const float rs = frsq(wave_sum(s) * (1.f / D) + EPS);
        GAS v2u* o8 = (GAS v2u*)(XN + (size_t)r * D) + lane;
#pragma unroll
        for (int j = 0; j < 4; ++j) { const f32x4 gg = ((const GAS f32x4*)gn)[lane + 64 * j]; v2u o; o.x = cvt_pk_bf16(v[j].x * rs * gg.x, v[j].y * rs * gg.y); o.y = cvt_pk_bf16(v[j].z * rs * gg.z, v[j].w * rs * gg.w); o8[64 * j] = o; }
    }
    __syncthreads();
}
constexpr int NPHASES = 1 + 5 * DEPTH;
__global__ void __launch_bounds__(512, 2) mega_fwd(Params p) {
    extern __shared__ __attribute__((aligned(16))) unsigned char lds_raw[];
    Frame F;
    F.lds = (LAS unsigned char*)lds_raw; F.MISC = (volatile LAS unsigned*)(F.lds + LDS_MISC);
    F.wave = __builtin_amdgcn_readfirstlane((int)threadIdx.x >> 6);
    F.G = gridDim.x; { const int bx = blockIdx.x; F.vcu = (F.G % 8 == 0) ? (bx % 8) * (F.G / 8) + bx / 8 : bx; }
    if (threadIdx.x < 64) F.MISC[threadIdx.x] = 0u;
    if (threadIdx.x == 0) { LAS unsigned long long* P = (LAS unsigned long long*)(F.lds + LDS_PARAM);
        P[0] = (unsigned long long)p.in[0]; P[1] = (unsigned long long)p.in[1]; P[2] = (unsigned long long)p.in[2]; P[3] = (unsigned long long)p.in[3]; P[4] = (unsigned long long)p.in[4];
        P[5] = (unsigned long long)p.in[5]; P[6] = (unsigned long long)p.in[6]; P[7] = (unsigned long long)p.in[7]; P[8] = (unsigned long long)p.in[8]; P[9] = (unsigned long long)p.in[9];
        P[10] = (unsigned long long)p.in[10]; P[11] = (unsigned long long)p.in[11]; P[12] = (unsigned long long)p.in[12]; P[13] = (unsigned long long)p.in[13]; P[14] = (unsigned long long)p.in[14];
        P[15] = (unsigned long long)p.in[15]; P[16] = (unsigned long long)p.in[16]; P[17] = (unsigned long long)p.out; P[18] = (unsigned long long)p.ws; }
    __syncthreads();
    const int lo = p.ph_lo, hi = p.ph_hi;
    XcdBarrier bar; bar.bar = F.ctl() + CW_BAR; bar.x = 0; bar.st = nullptr; bar.leader = false;
    if (hi - lo > 1) bar = xcd_barrier_post(F.ctl() + CW_BAR, F.MISC, F.wave);
#define IN(k) (lo <= (k) && (k) < hi)
#define SEAM(k) do { if (IN(k) && IN((k) + 1)) xcd_barrier(bar, F.wave); } while (0)
    if (IN(0)) { phase_prologue(F); } SEAM(0);
    for (int l = 0; l < DEPTH; ++l) {
        const int pb = 1 + 5 * l;
        if (IN(pb)) { if (l > 0) phase_xn_fused(F, l); }
        if (l > 0) SEAM(pb);
        if (IN(pb + 1)) { pg8::Gemm g{(const GAS bf16*)(F.wsp() + WS_XN), (const GAS bf16*)(F.wsp() + WS_WIN) + (size_t)l * NPROJ * D, 0, 0, MTOT / 256, NPROJ / 256, 1, D, 0, WGM_PROJ};
            pg8::Order S; S.init(g, F.G, (int)blockIdx.x);
            pg8::EpiProj E{l, F.wsp(), F.outp(), F_qng + l * 128, F_kng + l * 128, (const GAS float*)(F.wsp() + WS_LB) + l * 1024};
            pg8::gemm_phase(F.lds, g, S, E, F.wave);
            } SEAM(pb + 1);
        if (IN(pb + 2)) { phase_mixers(F, l, l); } SEAM(pb + 2);
        if (IN(pb + 3)) { pg8::Gemm g{(const GAS bf16*)(F.wsp() + WS_Y), (const GAS bf16*)(F.wsp() + WS_WBR) + (size_t)l * 3 * D * D, (size_t)MTOT * 1024, (size_t)D * D, MTOT / 256, D / 256, 3, D, MERGE_TAIL, WGM_SQ};
            pg8::Order S; S.init(g, F.G, (int)blockIdx.x);
            pg8::EpiMerge E{F.wsp()};
            pg8::gemm_phase(F.lds, g, S, E, F.wave);
            { __syncthreads(); pg8::EpiMergeSlab E2{F.wsp()}; pg8::gemm_phase<pg8::EpiMergeSlab, 1>(F.lds, g, S, E2, F.wave); }
            } SEAM(pb + 3);
        if (IN(pb + 4)) { combine_merge(F); xcd_barrier(bar, F.wave);
            pg8::Gemm g{(const GAS bf16*)(F.wsp() + WS_MERGED), (const GAS bf16*)(F.wsp() + WS_WOUT) + (size_t)l * D * D, 0, 0, MTOT / 256, D / 256, 1, D, 4, WGM_SQ};
            pg8::Order S; S.init(g, F.G, (int)blockIdx.x);
            pg8::EpiOut E{F.wsp(), F.outp(), l == DEPTH - 1 ? 1 : 0, l == 0 ? 1 : 0};
            pg8::gemm_phase(F.lds, g, S, E, F.wave);
            { __syncthreads(); pg8::EpiOutSlab E2{F.wsp()}; pg8::gemm_phase<pg8::EpiOutSlab, 1>(F.lds, g, S, E2, F.wave); }
            xcd_barrier(bar, F.wave); if (l == DEPTH - 1) combine_out(F, 1);
            }
    }
#undef IN
#undef SEAM
}
extern "C" void kernel_launch(void* const* d_in, const int* in_sizes, int n_in, void* d_out, int out_size, void* d_ws, size_t ws_size, hipStream_t stream) {
    static int grid = 0;
    if (grid == 0) {
        if (n_in != 17 || out_size != (int)O_END || ws_size < WS_FAST_END) { fprintf(stderr, "kernel_launch: unexpected sizes (n_in %d, out %d, ws %zu < %zu)\n", n_in, out_size, ws_size, (size_t)WS_FAST_END); grid = -1; return; }
        int dev = 0, cus = 0, per_cu = 0;
        if (hipGetDevice(&dev) != hipSuccess || hipDeviceGetAttribute(&cus, hipDeviceAttributeMultiprocessorCount, dev) != hipSuccess) { grid = -1; return; }
        if (hipFuncSetAttribute((const void*)mega_fwd, hipFuncAttributeMaxDynamicSharedMemorySize, LDS_BYTES) != hipSuccess) { fprintf(stderr, "kernel_launch: hipFuncSetAttribute failed\n"); grid = -1; return; }
        if (hipOccupancyMaxActiveBlocksPerMultiprocessor(&per_cu, (const void*)mega_fwd, 512, LDS_BYTES) != hipSuccess || per_cu < 1) { fprintf(stderr, "kernel_launch: occupancy query says %d blocks per CU\n", per_cu); (void)hipGetLastError(); grid = -1; return; }
        grid = cus;
    }
    if (grid < 0) return;
    (void)hipMemsetAsync((char*)d_ws + WS_CTL, 0, CTL_ZERO_BYTES, stream);
    Params p{};
    for (int i = 0; i < 17; ++i) p.in[i] = (const float*)d_in[i];
    p.out = (float*)d_out; p.ws = (unsigned char*)d_ws;
    p.ph_lo = 0; p.ph_hi = NPHASES;
    hipLaunchKernelGGL(mega_fwd, dim3(grid), dim3(512), LDS_BYTES, stream, p);
}
```

```cpp
#define MK_LAUNCHES 1
#include <hip/hip_runtime.h>
#include <cstdio>
#include <cstdint>
constexpr int D = 1024, BATCH = 8, SEQ = 2048, DEPTH = 2, DBATCH = 32, DSEQ = 64, PAST = 2048, NMETA = 16;
constexpr int LP = NMETA + SEQ;
constexpr int MP = BATCH * LP;
constexpr int MPAD = 16640;
constexpr int MS = DBATCH * DSEQ;
constexpr int MTOT = MPAD + MS;
constexpr int NPROJ = 13 * 1024;
constexpr float EPS = 1e-6f, LB_FLOOR = 1e-30f, SB_SCALE = 0.08838834764831845f;
constexpr size_t O_YP = 0, O_YS = 16777216, O_KP = 18874368, O_VP = 52690944, O_PP = 86507520, O_HP = 86753280,
                 O_KS = 88850432, O_VS = 93044736, O_PS = 97239040, O_HS = 98222080, O_END = 106610688;
#define GAS __attribute__((address_space(1)))
#define LAS __attribute__((address_space(3)))
typedef unsigned short bf16;
typedef unsigned v4u __attribute__((ext_vector_type(4)));
typedef unsigned v2u __attribute__((ext_vector_type(2)));
typedef float f32x4 __attribute__((ext_vector_type(4)));
typedef float f32x2 __attribute__((ext_vector_type(2)));
typedef float f32x16 __attribute__((ext_vector_type(16)));
typedef short bf16x8 __attribute__((ext_vector_type(8)));
typedef short bf16x4 __attribute__((ext_vector_type(4)));
#define LDS_WAIT() asm volatile("s_waitcnt lgkmcnt(0)" ::: "memory")
#define VM_WAIT() asm volatile("s_waitcnt vmcnt(0)" ::: "memory")

typedef __bf16 bf16n2 __attribute__((ext_vector_type(2)));
__device__ __forceinline__ unsigned cvt_pk_bf16(float lo, float hi) { const f32x2 v = {lo, hi}; return __builtin_bit_cast(unsigned, __builtin_convertvector(v, bf16n2)); }
__device__ __forceinline__ float bf_lo(unsigned u) { return __uint_as_float(u << 16); }
__device__ __forceinline__ float bf_hi(unsigned u) { return __uint_as_float(u & 0xffff0000u); }
__device__ __forceinline__ float fexp2(float x) { return __builtin_amdgcn_exp2f(x); }
__device__ __forceinline__ float flog2(float x) { return __builtin_amdgcn_logf(x); }
__device__ __forceinline__ float frcp(float x) { return __builtin_amdgcn_rcpf(x); }
__device__ __forceinline__ float frsq(float x) { return __builtin_amdgcn_rsqf(x); }
__device__ __forceinline__ int lane_id() { unsigned z = 0u; asm volatile("" : "+v"(z)); return (int)__builtin_amdgcn_mbcnt_hi(~0u, __builtin_amdgcn_mbcnt_lo(~0u, z)); }
constexpr float LOG2E = 1.4426950408889634f, LN2 = 0.6931471805599453f;
__device__ __forceinline__ float fexp(float x) { return fexp2(x * LOG2E); }
__device__ __forceinline__ float fsigmoid(float x) { return frcp(1.0f + fexp2(-x * LOG2E)); }
__device__ __forceinline__ float fsilu(float x) { return x * fsigmoid(x); }

constexpr size_t MiB = 1u << 20;
constexpr size_t RB16 = (size_t)MTOT * 1024 * 2, RB32 = (size_t)MTOT * 1024 * 4;
constexpr size_t WS_CTL = 0, CTL_ZERO_BYTES = 64 * 1024;
constexpr size_t WS_RTAB = 1 * MiB + 64 * 1024;
constexpr size_t WS_LB = 1 * MiB;
constexpr size_t WS_WIN = 2 * MiB;
constexpr size_t WS_WBR = WS_WIN + (size_t)2 * NPROJ * 1024 * 2;
constexpr size_t WS_WOUT = WS_WBR + (size_t)6 * 1024 * 1024 * 2;
constexpr size_t WS_WPOOL = WS_WOUT + (size_t)2 * 1024 * 1024 * 2;
constexpr size_t WS_H = WS_WPOOL + 1 * MiB;
constexpr size_t WS_XN = WS_H + RB32;
constexpr size_t WS_UA = WS_XN + RB16, WS_SGA = WS_UA + RB16, WS_Q = WS_SGA + RB16, WS_SGB = WS_Q + RB16, WS_KC = WS_SGB + RB16,
                 WS_QC = WS_KC + RB16, WS_IC = WS_QC + RB16, WS_SGC = WS_IC + RB16, WS_GATE = WS_SGC + RB16  ,
                 WS_LOGF = WS_GATE + 3 * RB16  , WS_Y = WS_LOGF + RB32  , WS_MERGED = WS_Y + 3 * RB16, WS_FAST_END = WS_MERGED + RB16;
constexpr size_t WS_SLAB_M = WS_UA, WS_SLAB_O = WS_Q;
static_assert(108 * 262144 <= 2 * RB16 && 144 * 262144 <= 2 * RB16, "slabs");
constexpr int CW_QUEUE = 64;
constexpr int CW_BAR = 1024;

constexpr int LDS_BYTES = 160 * 1024;
constexpr int LDS_XCH = 128 * 1024;
constexpr int LDS_MISC = 159 * 1024;

#define XB_TMO      128
#define XB_XCNT(j)  (256  + 64 * (j))
#define XB_XSUB(j)  (1280 + 64 * (j))
#define XB_XGEN(j)  (2304 + 64 * (j))
#define XB_TOP      3328
#define XB_TOPGEN   3392
#define XCD_BAR_WORDS 3456
#define XB_SPIN_CAP (1u << 18)
__device__ __forceinline__ unsigned xb_ld(GAS unsigned* p)              { return __hip_atomic_load(p, __ATOMIC_RELAXED, __HIP_MEMORY_SCOPE_AGENT); }
__device__ __forceinline__ unsigned xb_add(GAS unsigned* p, unsigned v) { return __hip_atomic_fetch_add(p, v, __ATOMIC_RELAXED, __HIP_MEMORY_SCOPE_AGENT); }
__device__ __forceinline__ unsigned xb_xcc_id() { return (unsigned)__builtin_amdgcn_s_getreg((3 << 11) | 20) & 0xFu; }
#define XB_SPIN(cond, bar) do { unsigned _sp = 0; while (cond) { __builtin_amdgcn_s_sleep(1); \
    if ((++_sp & 255u) == 0u) { if (xb_ld(&(bar)[XB_TMO])) break; if (_sp > XB_SPIN_CAP) { xb_add(&(bar)[XB_TMO], 1u); break; } } } } while (0)
struct XcdBarrier { GAS unsigned* bar; unsigned x; volatile LAS unsigned* st; bool leader; };
__device__ __forceinline__ XcdBarrier xcd_barrier_post(GAS unsigned* bar, volatile LAS unsigned* st, int wave) {
    XcdBarrier b; b.bar = bar; b.x = xb_xcc_id(); b.st = st; b.leader = false;
    b.leader = (wave == 0) && (lane_id() == 0);
    if (b.leader) (void)xb_add(&bar[XB_XCNT(b.x)], 1u);
    return b;
}
__device__ __forceinline__ void xcd_barrier_complete(GAS unsigned* bar, unsigned x, unsigned& nloc, unsigned& nx) {
    const unsigned G = gridDim.x * gridDim.y * gridDim.z;
    unsigned sum, cnt, mine, sp = 0u;
    for (;;) {
        sum = 0u; cnt = 0u; mine = 0u;
#pragma unroll
        for (unsigned j = 0; j < 16; ++j) { const unsigned c = xb_ld(&bar[XB_XCNT(j)]); sum += c; cnt += (c > 0u) ? 1u : 0u; mine = (j == x) ? c : mine; }
        if (sum == G) break;
        __builtin_amdgcn_s_sleep(1);
        if ((++sp & 255u) == 0u) { if (xb_ld(&bar[XB_TMO])) break; if (sp > XB_SPIN_CAP) { xb_add(&bar[XB_TMO], 1u); break; } }
    }
    nloc = mine > 0u ? mine : 1u; nx = cnt > 0u ? cnt : 1u;
}
__device__ __forceinline__ void xcd_barrier(const XcdBarrier& b, int wave) {
    asm volatile("s_waitcnt vmcnt(0)" ::: "memory");
    __syncthreads();
    if (wave == 0 && lane_id() == 0) {
        GAS unsigned* bar = b.bar;
        __builtin_amdgcn_s_waitcnt(0);
        unsigned nloc = b.st[0], nx = b.st[1];
        if (nloc == 0u) { xcd_barrier_complete(bar, b.x, nloc, nx); b.st[0] = nloc; b.st[1] = nx; }
        const unsigned old = xb_add(&bar[XB_XSUB(b.x)], 1u);
        const unsigned gen = old / nloc;
        if (old + 1u == (gen + 1u) * nloc) {
            __builtin_amdgcn_fence(__ATOMIC_RELEASE, "agent");
            asm volatile("s_waitcnt vmcnt(0)" ::: "memory");
            const unsigned og = xb_add(&bar[XB_TOP], 1u);
            const unsigned tg = og / nx;
            if (og + 1u == (tg + 1u) * nx) xb_add(&bar[XB_TOPGEN], 1u);
            else XB_SPIN(xb_ld(&bar[XB_TOPGEN]) == tg, bar);
            __builtin_amdgcn_fence(__ATOMIC_ACQUIRE, "agent");
            xb_add(&bar[XB_XGEN(b.x)], 1u);
            asm volatile("s_waitcnt vmcnt(0)" ::: "memory");
        } else {
            XB_SPIN(xb_ld(&bar[XB_XGEN(b.x)]) == gen, bar);
            __builtin_amdgcn_fence(__ATOMIC_ACQUIRE, "agent");
            asm volatile("s_waitcnt vmcnt(0)" ::: "memory");
        }
    }
    __syncthreads();
}

struct Params { const float* in[17]; float* out; unsigned char* ws; int ph_lo, ph_hi; };
constexpr int LDS_PARAM = LDS_MISC + 256;
struct Frame {
    LAS unsigned char* lds; volatile LAS unsigned* MISC;
    int wave, G, vcu;
    __device__ __forceinline__ int lane_() const { return lane_id(); }
    __device__ __forceinline__ int tid_() const { return wave * 64 + lane_id(); }
    __device__ __forceinline__ unsigned long long rd(int i) const { const v2u v = *(const LAS v2u*)(lds + LDS_PARAM + 8 * i);
        return ((unsigned long long)(unsigned)__builtin_amdgcn_readfirstlane((int)v.y) << 32) | (unsigned)__builtin_amdgcn_readfirstlane((int)v.x); }
    __device__ __forceinline__ const GAS float* in(int i) const { return (const GAS float*)rd(i); }
    __device__ __forceinline__ GAS float* outp() const { return (GAS float*)rd(17); }
    __device__ __forceinline__ GAS unsigned char* wsp() const { return (GAS unsigned char*)rd(18); }
    __device__ __forceinline__ GAS unsigned* ctl() const { return (GAS unsigned*)(wsp() + WS_CTL); }
};
#define F_xp F.in(0)
#define F_xs F.in(1)
#define F_cache_k F.in(2)
#define F_cache_v F.in(3)
#define F_state_pool F.in(4)
#define F_state_hgrn F.in(5)
#define F_meta F.in(6)
#define F_norm_g F.in(7)
#define F_w_in F.in(8)
#define F_qng F.in(9)
#define F_kng F.in(10)
#define F_w_pool F.in(11)
#define F_pool_scale F.in(12)
#define F_hlb F.in(13)
#define F_hng F.in(14)
#define F_w_branch F.in(15)
#define F_w_out F.in(16)
__device__ __forceinline__ float wave_sum(float v) {
#pragma unroll
    for (int o = 1; o < 64; o <<= 1) v += __shfl_xor(v, o);
    return v;
}

__device__ __forceinline__ void p0_transpose_item(const GAS float* W, int K, int N, GAS bf16* WT, int item, int lane) {
    const int nblk = N / 64, kb = item / nblk, nb = item - kb * nblk, r = lane >> 4, c4 = lane & 15;
    const GAS float* src = W + (size_t)(64 * kb + 16 * r) * N + 64 * nb + 4 * c4;
    f32x4 v[16];
#pragma unroll
    for (int i = 0; i < 16; ++i) v[i] = __builtin_nontemporal_load((const GAS f32x4*)(src + (size_t)i * N));
    GAS bf16* dst = WT + (size_t)(64 * nb + 4 * c4) * K + 64 * kb + 16 * r;
#pragma unroll
    for (int j = 0; j < 4; ++j) { v4u a, b;
        a.x = cvt_pk_bf16(v[0][j], v[1][j]); a.y = cvt_pk_bf16(v[2][j], v[3][j]); a.z = cvt_pk_bf16(v[4][j], v[5][j]); a.w = cvt_pk_bf16(v[6][j], v[7][j]);
        b.x = cvt_pk_bf16(v[8][j], v[9][j]); b.y = cvt_pk_bf16(v[10][j], v[11][j]); b.z = cvt_pk_bf16(v[12][j], v[13][j]); b.w = cvt_pk_bf16(v[14][j], v[15][j]);
        *(GAS v4u*)(dst + (size_t)j * K) = a; *(GAS v4u*)(dst + (size_t)j * K + 8) = b; }
}
__device__ __forceinline__ void xn_row(const GAS float* src, GAS float* hdst, const GAS float* g, GAS bf16* xnrow, int lane) {
    const GAS f32x4* xr = (const GAS f32x4*)src + lane;
    f32x4 v[4]; float s = 0.f;
#pragma unroll
    for (int j = 0; j < 4; ++j) { v[j] = xr[64 * j]; s += (v[j].x * v[j].x + v[j].y * v[j].y) + (v[j].z * v[j].z + v[j].w * v[j].w); }
    if (hdst) { GAS f32x4* ho = (GAS f32x4*)hdst + lane;
#pragma unroll
        for (int j = 0; j < 4; ++j) __builtin_nontemporal_store(v[j], ho + 64 * j); }
    const float rs = frsq(wave_sum(s) * (1.f / D) + EPS);
    GAS v2u* o8 = (GAS v2u*)xnrow + lane;
#pragma unroll
    for (int j = 0; j < 4; ++j) { const f32x4 gg = ((const GAS f32x4*)g)[lane + 64 * j]; v2u o; o.x = cvt_pk_bf16(v[j].x * rs * gg.x, v[j].y * rs * gg.y); o.y = cvt_pk_bf16(v[j].z * rs * gg.z, v[j].w * rs * gg.w); o8[64 * j] = o; }
}
__device__ __forceinline__ void zero_xn_row(GAS bf16* xnrow, int lane) { GAS v2u* o8 = (GAS v2u*)xnrow + lane;
#pragma unroll
    for (int j = 0; j < 4; ++j) o8[64 * j] = (v2u){0u, 0u}; }

__device__ __forceinline__ void phase_prologue(Frame& F) {
    const int gw = F.vcu * 8 + F.wave, NGW = F.G * 8;
    constexpr int I_IN = (D / 64) * (NPROJ / 64), I_SQ = (D / 64) * (D / 64), I_PL = (256 / 64) * (256 / 64);
    constexpr int NITEMS = 2 * I_IN + 6 * I_SQ + 2 * I_SQ + 8 * I_PL;
    GAS bf16* win_t = (GAS bf16*)(F.wsp() + WS_WIN); GAS bf16* wbr_t = (GAS bf16*)(F.wsp() + WS_WBR); GAS bf16* wout_t = (GAS bf16*)(F.wsp() + WS_WOUT); GAS bf16* wpool_t = (GAS bf16*)(F.wsp() + WS_WPOOL);
    for (int it = gw; it < NITEMS; it += NGW) {
        int r = it;
        if (r < 2 * I_IN) { const int l = r / I_IN; p0_transpose_item(F_w_in + (size_t)l * D * NPROJ, D, NPROJ, win_t + (size_t)l * NPROJ * D, r % I_IN, F.lane_()); continue; } r -= 2 * I_IN;
        if (r < 6 * I_SQ) { const int m = r / I_SQ; p0_transpose_item(F_w_branch + (size_t)m * D * D, D, D, wbr_t + (size_t)m * D * D, r % I_SQ, F.lane_()); continue; } r -= 6 * I_SQ;
        if (r < 2 * I_SQ) { const int m = r / I_SQ; p0_transpose_item(F_w_out + (size_t)m * D * D, D, D, wout_t + (size_t)m * D * D, r % I_SQ, F.lane_()); continue; } r -= 2 * I_SQ;
        { const int m = r / I_PL; p0_transpose_item(F_w_pool + (size_t)m * 65536, 256, 256, wpool_t + (size_t)m * 65536, r % I_PL, F.lane_()); }
    }
    GAS float* H = (GAS float*)(F.wsp() + WS_H); GAS bf16* XN = (GAS bf16*)(F.wsp() + WS_XN);
    for (int r = gw; r < MTOT; r += NGW) {
        GAS unsigned long long* rt = (GAS unsigned long long*)(F.wsp() + WS_RTAB) + r;
        if (r >= MP && r < MPAD) { zero_xn_row(XN + (size_t)r * D, F.lane_()); if (F.lane_() == 0) *rt = (unsigned long long)F_meta; continue; }
        const GAS float* src;
        if (r < MP) { const int b = r / LP, t = r - b * LP; src = (t < NMETA) ? F_meta + (size_t)t * D : F_xp + ((size_t)b * SEQ + (t - NMETA)) * D; }
        else src = F_xs + (size_t)(r - MPAD) * D;
        if (F.lane_() == 0) *rt = (unsigned long long)src;
        xn_row(src, nullptr, F_norm_g, XN + (size_t)r * D, F.lane_());
    }
    if (blockIdx.x == 0) { GAS float* lbp = (GAS float*)(F.wsp() + WS_LB);
        for (int i = F.tid_(); i < 1024; i += 512) { const float a = F_hlb[i], b = F_hlb[1024 + i], m = fmaxf(a, b), ea = expf(a - m), eb = expf(b - m), s = ea + eb; const float s0 = ea / s, s1 = eb / s;
            lbp[i] = s0 - s0; lbp[1024 + i] = (s0 + s1) - s0; } }
}
__device__ __forceinline__ void phase_xn(Frame& F, int l) {
    const int gw = F.vcu * 8 + F.wave, NGW = F.G * 8;
    GAS float* H = (GAS float*)(F.wsp() + WS_H); GAS bf16* XN = (GAS bf16*)(F.wsp() + WS_XN);
    for (int r = gw; r < MTOT; r += NGW) {
        if (r >= MP && r < MPAD) { zero_xn_row(XN + (size_t)r * D, F.lane_()); continue; }
        xn_row(H + (size_t)r * D, nullptr, F_norm_g + (size_t)l * D, XN + (size_t)r * D, F.lane_());
    }
}
namespace pg8 {
constexpr int BM = 256, BK = 64, HALF = 128, HTB = HALF * BK * 2, STAGE_BYTES = 8 * HTB, NXCD = 8;
__host__ __device__ __forceinline__ int lds_byte(int r, int c) { const int st = (r >> 4) * 2 + (c >> 5), rr = r & 15, cc = c & 31, ob = rr * 64 + cc * 2; return st * 1024 + (ob ^ (((ob >> 9) & 1) << 5)); }
__host__ __device__ __forceinline__ void stage_rc(int b, int& R, int& C) { const int st = b / 1024, sb = b % 1024, swz = sb ^ (((sb >> 9) & 1) << 5); R = (st >> 1) * 16 + swz / 64; C = (st & 1) * 32 + (swz % 64) / 2; }
__host__ __device__ __forceinline__ int perm32(int rho) { const int n = rho >> 4, i = rho & 15; return 8 * (i >> 2) + 4 * n + (i & 3); }

struct Unit { int pm, pn, seg, k0, nk, slab; };
struct Gemm { const GAS bf16* A; const GAS bf16* Bt; size_t a_seg, b_seg; int nM, nN, nseg, K, tail_parts, wgm; };

struct Order {
    int nM, nN, nwg, G, c, nseg, nt, tail, WGM;
    __device__ void init(const Gemm& g, int G_, int c_) { WGM = g.wgm; nM = g.nM; nN = g.nN; nwg = nM * nN; G = G_; c = c_; nseg = g.nseg; nt = g.K / BK;
        tail = (g.tail_parts > 0 && nwg > G && nwg <= 2 * G && (nwg - G) * g.tail_parts <= G && g.tail_parts % nseg == 0 && (nt % (2 * (g.tail_parts / nseg))) == 0) ? g.tail_parts : 0; }
    __device__ void tile_of(int L, int& pm, int& pn) const {
        int wgid = L; { const int q = nwg / NXCD, r = nwg % NXCD, xcd = wgid % NXCD, off = wgid / NXCD; wgid = (xcd < r ? xcd * (q + 1) : r * (q + 1) + (xcd - r) * q) + off; }
        const int nig = WGM * nN, gid = wgid / nig, fm = gid * WGM, gsz = (nM - fm) < WGM ? (nM - fm) : WGM;
        pm = fm + ((wgid % nig) % gsz); pn = (wgid % nig) / gsz; }
    template <int MODE> __device__ bool next(int i, Unit& u) const {
        u.k0 = 0; u.nk = nt; u.slab = -1;
        if (MODE == 0) {
            if (tail == 0) { const int ti = i / nseg; u.seg = i - ti * nseg; const long L = (long)ti * G + c; if (L >= nwg) return false; tile_of((int)L, u.pm, u.pn); return true; }
            if (i >= nseg) return false; u.seg = i; tile_of(c, u.pm, u.pn); return true; }
        if (tail == 0 || i > 0 || c >= (nwg - G) * tail) return false;
        const int j = c / tail, part = c - j * tail; tile_of(G + j, u.pm, u.pn); u.slab = c;
        { const int ks = tail / nseg; u.seg = part / ks; u.nk = nt / ks; u.k0 = (part - u.seg * ks) * u.nk; }
        return true;
    }
};

typedef f32x4 Acc[2][2][4][2];

template <class Epi, int MODE = 0>
__device__ __forceinline__ void gemm_phase(LAS unsigned char* lds, const Gemm g, const Order& S, const Epi& E, int wave_id) {
    const int wid = wave_id, lane = lane_id(), tid = wid * 64 + lane; const int wr = wid >> 2, wc = wid & 3, fr = lane & 15, fq = lane >> 4;
    const int K = g.K;
    unsigned voffA[2], voffB[2];
#pragma unroll
    for (int i = 0; i < 2; ++i) { int R, C; stage_rc(tid * 16 + i * 8192, R, C); const int Rb = (R & ~31) + perm32(R & 31);
        voffA[i] = (unsigned)(R * K + C) * 2u; voffB[i] = (unsigned)(Rb * K + C) * 2u; }
    const size_t kstep = (size_t)(BK * 2);
    const size_t hstep = (size_t)HALF * K * 2;
    const size_t tstep = 2 * hstep;
    const unsigned ldsw = (unsigned)wid * 1024u;
    const int aoff = lds_byte(wr * 64 + fr, fq * 8), boff = lds_byte(wc * 32 + fr, fq * 8);
#define PG8_SA(b, h) (((b) * 2 + (h)) * HTB)
#define PG8_SB(b, h) ((4 + (b) * 2 + (h)) * HTB)
#define PG8_STAGE(bufoff, gbase, voff) do { _Pragma("unroll") for (int _i = 0; _i < 2; ++_i) \
        __builtin_amdgcn_global_load_lds((const GAS unsigned*)((const GAS char*)(gbase) + (voff)[_i]), (LAS unsigned*)(lds + (bufoff) + ldsw + _i * 8192), 16, 0, 0); } while (0)
#define PG8_LDA(dst, b, h) do { _Pragma("unroll") for (int m = 0; m < 4; ++m) _Pragma("unroll") for (int k = 0; k < 2; ++k) dst[m][k] = *(const LAS bf16x8*)(lds + PG8_SA(b, h) + aoff + m * 2048 + k * 1024); } while (0)
#define PG8_LDB(dst, b, h) do { _Pragma("unroll") for (int n = 0; n < 2; ++n) _Pragma("unroll") for (int k = 0; k < 2; ++k) dst[n][k] = *(const LAS bf16x8*)(lds + PG8_SB(b, h) + boff + n * 2048 + k * 1024); } while (0)
#define PG8_MMA(ai, bj, At, Bt) do { __builtin_amdgcn_s_setprio(1); _Pragma("unroll") for (int m = 0; m < 4; ++m) _Pragma("unroll") for (int n = 0; n < 2; ++n) _Pragma("unroll") for (int k = 0; k < 2; ++k) \
        acc[ai][bj][m][n] = __builtin_amdgcn_mfma_f32_16x16x32_bf16(Bt[n][k], At[m][k], acc[ai][bj][m][n], 0, 0, 0); __builtin_amdgcn_s_setprio(0); } while (0)
#define PG8_WAIT_V(n) asm volatile("s_waitcnt vmcnt(" #n ")" ::: "memory")
#define PG8_WAIT_L(n) asm volatile("s_waitcnt lgkmcnt(" #n ")" ::: "memory")
#define PG8_BAR __builtin_amdgcn_s_barrier()
#define PG8_SCHED __builtin_amdgcn_sched_barrier(0)
    Unit cur, nxt; int ui = 0;
    if (!S.template next<MODE>(0, cur)) return;
    Acc acc;
#pragma unroll
    for (int a = 0; a < 2; ++a)
#pragma unroll
        for (int b = 0; b < 2; ++b)
#pragma unroll
            for (int m = 0; m < 4; ++m)
#pragma unroll
                for (int n = 0; n < 2; ++n) acc[a][b][m][n] = (f32x4){0.f, 0.f, 0.f, 0.f};
    bf16x8 At[4][2], B0[2][2], B1[2][2];
    const GAS char* cA = (const GAS char*)(g.A + (size_t)cur.seg * g.a_seg) + (size_t)cur.pm * tstep + (MODE ? (size_t)cur.k0 * kstep : 0); const GAS char* cB = (const GAS char*)(g.Bt + (size_t)cur.seg * g.b_seg) + (size_t)cur.pn * tstep + (MODE ? (size_t)cur.k0 * kstep : 0);
    PG8_STAGE(PG8_SB(0, 0), cB, voffB); PG8_STAGE(PG8_SB(0, 1), cB + hstep, voffB); PG8_STAGE(PG8_SA(0, 0), cA, voffA); PG8_STAGE(PG8_SA(0, 1), cA + hstep, voffA);
    if (wr == 1) PG8_BAR;
    PG8_WAIT_V(2); PG8_BAR;
    PG8_STAGE(PG8_SB(1, 0), cB + kstep, voffB); PG8_STAGE(PG8_SA(1, 0), cA + kstep, voffA); PG8_STAGE(PG8_SB(1, 1), cB + hstep + kstep, voffB);
    PG8_WAIT_V(6); PG8_BAR;
    for (;;) {
        const bool has_next = S.template next<MODE>(ui + 1, nxt);
        const GAS char* nA = has_next ? (const GAS char*)(g.A + (size_t)nxt.seg * g.a_seg) + (size_t)nxt.pm * tstep + (MODE ? (size_t)nxt.k0 * kstep : 0) : cA; const GAS char* nB = has_next ? (const GAS char*)(g.Bt + (size_t)nxt.seg * g.b_seg) + (size_t)nxt.pn * tstep + (MODE ? (size_t)nxt.k0 * kstep : 0) : cB;
        const int nt = MODE == 0 ? K / BK : cur.nk;
        for (int t = 0; t < nt; t += 2) {
            const bool last = (t == nt - 2);
            const GAS char* a1 = cA + (size_t)(t + 1) * kstep;
            const GAS char* a2 = last ? nA : cA + (size_t)(t + 2) * kstep; const GAS char* b2 = last ? nB : cB + (size_t)(t + 2) * kstep;
            const GAS char* a3 = a2 + kstep; const GAS char* b3 = b2 + kstep;
            PG8_LDB(B0, 0, 0); PG8_LDB(B1, 0, 1); PG8_SCHED; PG8_LDA(At, 0, 0); PG8_STAGE(PG8_SA(1, 1), a1 + hstep, voffA);
            PG8_WAIT_V(8); PG8_WAIT_L(0); PG8_BAR; PG8_MMA(0, 0, At, B0); PG8_MMA(0, 1, At, B1); PG8_BAR; PG8_SCHED;
            PG8_LDA(At, 0, 1); PG8_STAGE(PG8_SB(0, 0), b2, voffB); PG8_STAGE(PG8_SB(0, 1), b2 + hstep, voffB); PG8_STAGE(PG8_SA(0, 0), a2, voffA);
            PG8_WAIT_V(8); PG8_WAIT_L(0); PG8_BAR; PG8_MMA(1, 0, At, B0); PG8_MMA(1, 1, At, B1); PG8_BAR; PG8_SCHED;
            PG8_LDB(B0, 1, 0); PG8_LDB(B1, 1, 1); PG8_SCHED; PG8_LDA(At, 1, 0); PG8_STAGE(PG8_SA(0, 1), a2 + hstep, voffA);
            PG8_WAIT_V(8); PG8_WAIT_L(0); PG8_BAR; PG8_MMA(0, 0, At, B0); PG8_MMA(0, 1, At, B1); PG8_BAR; PG8_SCHED;
            PG8_LDA(At, 1, 1); PG8_STAGE(PG8_SB(1, 0), b3, voffB); PG8_STAGE(PG8_SB(1, 1), b3 + hstep, voffB); PG8_STAGE(PG8_SA(1, 0), a3, voffA);
            PG8_WAIT_V(8); PG8_WAIT_L(0); PG8_BAR; PG8_MMA(1, 0, At, B0); PG8_MMA(1, 1, At, B1); PG8_BAR; PG8_SCHED;
        }
        if (wr == 0) PG8_BAR;
        E(acc, cur, wr, wc, fr, fq, lds);
        if (!has_next) break;
        if (MODE == 1 || cur.seg == g.nseg - 1) {
#pragma unroll
            for (int a = 0; a < 2; ++a)
#pragma unroll
                for (int b = 0; b < 2; ++b)
#pragma unroll
                    for (int m = 0; m < 4; ++m)
#pragma unroll
                        for (int n = 0; n < 2; ++n) acc[a][b][m][n] = (f32x4){0.f, 0.f, 0.f, 0.f};
        }
        cur = nxt; cA = nA; cB = nB; ++ui;
        if (wr == 1) PG8_BAR;
    }
    PG8_WAIT_V(0);
    PG8_BAR;
#undef PG8_SA
#undef PG8_SB
#undef PG8_STAGE
#undef PG8_LDA
#undef PG8_LDB
#undef PG8_MMA
#undef PG8_WAIT_V
#undef PG8_WAIT_L
#undef PG8_BAR
#undef PG8_SCHED
}

typedef _Float16 h16x2 __attribute__((ext_vector_type(2)));
__device__ __forceinline__ unsigned cvt_pk_f16(float a, float b) { const f32x2 t = {a, b}; return __builtin_bit_cast(unsigned, __builtin_convertvector(t, h16x2)); }
__device__ __forceinline__ v4u pack8h(const f32x4 a, const f32x4 b) { v4u w; w.x = cvt_pk_f16(a[0], a[1]); w.y = cvt_pk_f16(a[2], a[3]); w.z = cvt_pk_f16(b[0], b[1]); w.w = cvt_pk_f16(b[2], b[3]); return w; }
#define EPI_FOR_ROWS for (int ai = 0; ai < 2; ++ai) _Pragma("unroll") for (int m = 0; m < 4; ++m)
__device__ __forceinline__ v4u pack8(const f32x4 a, const f32x4 b) { v4u w; w.x = cvt_pk_bf16(a[0], a[1]); w.y = cvt_pk_bf16(a[2], a[3]); w.z = cvt_pk_bf16(b[0], b[1]); w.w = cvt_pk_bf16(b[2], b[3]); return w; }

#define NT_ST(p, v) __builtin_nontemporal_store((v), (p))
struct EpiProj {
    int layer; GAS unsigned char* ws; GAS float* out; const GAS float* qng; const GAS float* kng; const GAS float* lb;
    __device__ __forceinline__ void operator()(Acc& acc, const Unit& u, int wr, int wc, int fr, int fq, LAS unsigned char* lds) const {
        const int grp = u.pn >> 2, ct = u.pn & 3;
        const int row0 = u.pm * BM + wr * 64 + fr;
        const int cg0 = ct * 256 + wc * 32 + 8 * fq;
        const bool sample = u.pm >= MPAD / 256;
        if (grp == 2 || grp == 3) {
            LAS float* X = (LAS float*)(lds + LDS_XCH);
#pragma unroll
            EPI_FOR_ROWS {
#pragma unroll
                for (int bj = 0; bj < 2; ++bj) { const f32x4 a = acc[ai][bj][m][0], b = acc[ai][bj][m][1];
                    float s = (a[0] * a[0] + a[1] * a[1]) + (a[2] * a[2] + a[3] * a[3]) + (b[0] * b[0] + b[1] * b[1]) + (b[2] * b[2] + b[3] * b[3]);
                    s += __shfl_xor(s, 16); s += __shfl_xor(s, 32);
                    if (fq == 0) X[(ai * 128 + wr * 64 + m * 16 + fr) * 8 + bj * 4 + wc] = s; } }
            LDS_WAIT(); __builtin_amdgcn_s_barrier(); asm volatile("" ::: "memory");
            const GAS float* gv = (grp == 2 ? qng : kng) + wc * 32 + 8 * fq; const float qs = (grp == 2) ? SB_SCALE * LOG2E : 1.0f;
            const f32x4 g0 = *(const GAS f32x4*)gv * qs, g1 = *(const GAS f32x4*)(gv + 4) * qs;
            GAS bf16* qdst = (GAS bf16*)(ws + WS_Q);
            GAS float* kdst = sample ? out + O_KS + (size_t)layer * MS * 1024 - (size_t)MPAD * 1024 : out + O_KP + (size_t)layer * MP * 1024;
#pragma unroll
            EPI_FOR_ROWS { const int row = row0 + ai * 128 + m * 16;
#pragma unroll
                for (int bj = 0; bj < 2; ++bj) { const f32x4 p = *(const LAS f32x4*)(X + (ai * 128 + wr * 64 + m * 16 + fr) * 8 + bj * 4);
                    const float rs = frsq(((p[0] + p[1]) + (p[2] + p[3])) * (1.0f / 128.0f) + EPS);
                    const f32x4 a = acc[ai][bj][m][0] * rs * g0, b = acc[ai][bj][m][1] * rs * g1; const int col = cg0 + bj * 128;
                    if (grp == 2) NT_ST((GAS v4u*)(qdst + (size_t)row * 1024 + col), pack8(a, b));
                    else if (sample || row < MP) { GAS float* d = kdst + (size_t)row * 1024 + col; NT_ST((GAS f32x4*)d, a); NT_ST((GAS f32x4*)(d + 4), b); } } }
            return;
        }
        if (grp == 4) {
            GAS float* vdst = sample ? out + O_VS + (size_t)layer * MS * 1024 - (size_t)MPAD * 1024 : out + O_VP + (size_t)layer * MP * 1024;
#pragma unroll
            EPI_FOR_ROWS { const int row = row0 + ai * 128 + m * 16;
                if (sample || row < MP) {
#pragma unroll
                    for (int bj = 0; bj < 2; ++bj) { GAS float* d = vdst + (size_t)row * 1024 + cg0 + bj * 128; NT_ST((GAS f32x4*)d, acc[ai][bj][m][0]); NT_ST((GAS f32x4*)(d + 4), acc[ai][bj][m][1]); } } }
            return;
        }
        if (grp == 6) {
            GAS _Float16* lf = (GAS _Float16*)(ws + WS_LOGF); GAS bf16* kc = (GAS bf16*)(ws + WS_KC);
#pragma unroll
            for (int bj = 0; bj < 2; ++bj) { const int col = cg0 + bj * 128; const f32x4 l0 = *(const GAS f32x4*)(lb + col), l1 = *(const GAS f32x4*)(lb + col + 4);
#pragma unroll
                EPI_FOR_ROWS { const int row = row0 + ai * 128 + m * 16; f32x4 z[2] = {acc[ai][bj][m][0], acc[ai][bj][m][1]}; f32x4 lo[2], ko[2];
#pragma unroll
                    for (int n = 0; n < 2; ++n)
#pragma unroll
                        for (int j = 0; j < 4; ++j) { const float zz = z[n][j], l = n ? l1[j] : l0[j], e = fexp2(-fabsf(zz) * LOG2E), r = frcp(1.0f + e), er = e * r;
                            const float sp = zz >= 0.f ? r : er, sn = zz >= 0.f ? er : r, oml = 1.0f - l;
                            lo[n][j] = flog2(l + oml * sp); ko[n][j] = oml * sn; }
                    NT_ST((GAS v4u*)(lf + (size_t)row * 1024 + col), pack8h(lo[0], lo[1]));
                    NT_ST((GAS v4u*)(kc + (size_t)row * 1024 + col), pack8(ko[0], ko[1])); } }
            return;
        }
        size_t off; int act;
        switch (grp) {
            case 0: off = WS_UA; act = 0; break;   case 1: off = WS_SGA; act = 1; break;  case 5: off = WS_SGB; act = 1; break;
            case 7: off = WS_QC; act = 1; break;   case 8: off = WS_IC; act = 0; break;   case 9: off = WS_SGC; act = 1; break;
            default: off = WS_GATE + (size_t)(grp - 10) * RB16; act = 2; break;
        }
        GAS bf16* dst = (GAS bf16*)(ws + off);
#pragma unroll
        EPI_FOR_ROWS { const int row = row0 + ai * 128 + m * 16;
#pragma unroll
            for (int bj = 0; bj < 2; ++bj) { f32x4 a = acc[ai][bj][m][0], b = acc[ai][bj][m][1];
                if (act) {
#pragma unroll
                    for (int j = 0; j < 4; ++j) { const float sa = fsigmoid(a[j]), sb = fsigmoid(b[j]);
                        a[j] = act == 1 ? a[j] * sa : fmaxf(sa, 1e-30f); b[j] = act == 1 ? b[j] * sb : fmaxf(sb, 1e-30f); } }
                NT_ST((GAS v4u*)(dst + (size_t)row * 1024 + cg0 + bj * 128), pack8(a, b)); } }
        if (grp == 0) {
#pragma unroll
            EPI_FOR_ROWS { const int row = row0 + ai * 128 + m * 16; GAS float* d = nullptr;
                if (sample) { const int rr = row - MPAD, b = rr >> 6, i = rr & 63; if (i >= DSEQ - 15) d = out + O_PS + (((size_t)layer * DBATCH + b) * 15 + (i - (DSEQ - 15))) * 1024; }
                else if (row < MP) { const int b = row / LP, t = row - b * LP; if (t >= LP - 15) d = out + O_PP + (((size_t)layer * BATCH + b) * 15 + (t - (LP - 15))) * 1024; }
                if (d) {
#pragma unroll
                    for (int bj = 0; bj < 2; ++bj) { GAS float* dd = d + cg0 + bj * 128; NT_ST((GAS f32x4*)dd, acc[ai][bj][m][0]); NT_ST((GAS f32x4*)(dd + 4), acc[ai][bj][m][1]); } } }
        }
    }
};

struct EpiMerge {
    GAS unsigned char* ws;
    __device__ __forceinline__ void operator()(Acc& acc, const Unit& u, int wr, int wc, int fr, int fq, LAS unsigned char* lds) const {
        const int row0 = u.pm * BM + wr * 64 + fr, c0 = u.pn * BM + wc * 32 + 8 * fq;
        const GAS bf16* G0 = (const GAS bf16*)(ws + WS_GATE) + (size_t)u.seg * MTOT * 1024; const GAS bf16* G1 = G0 + (size_t)MTOT * 1024; GAS bf16* dst = (GAS bf16*)(ws + WS_MERGED);
        const bool fin = u.seg == 2;
#pragma unroll
        for (int ai = 0; ai < 2; ++ai)
#pragma unroll
        for (int mh = 0; mh < 2; ++mh) {
            v4u ga[2][2], gb[2][2];
#pragma unroll
            for (int mm = 0; mm < 2; ++mm)
#pragma unroll
                for (int bj = 0; bj < 2; ++bj) { const size_t ro = (size_t)(row0 + ai * 128 + (2 * mh + mm) * 16) * 1024 + c0 + bj * 128; ga[mm][bj] = *(const GAS v4u*)(G0 + ro); gb[mm][bj] = fin ? ga[mm][bj] : *(const GAS v4u*)(G1 + ro); }
#pragma unroll
            for (int mm = 0; mm < 2; ++mm)
#pragma unroll
                for (int bj = 0; bj < 2; ++bj) { const int m = 2 * mh + mm; const v4u x = ga[mm][bj], y = gb[mm][bj];
                    f32x4 fa0 = {bf_lo(x.x), bf_hi(x.x), bf_lo(x.y), bf_hi(x.y)}, fa1 = {bf_lo(x.z), bf_hi(x.z), bf_lo(x.w), bf_hi(x.w)};
                    if (!fin) { const f32x4 fb0 = {bf_lo(y.x), bf_hi(y.x), bf_lo(y.y), bf_hi(y.y)}, fb1 = {bf_lo(y.z), bf_hi(y.z), bf_lo(y.w), bf_hi(y.w)};
#pragma unroll
                        for (int j = 0; j < 4; ++j) { fa0[j] *= frcp(fb0[j]); fa1[j] *= frcp(fb1[j]); } }
                    acc[ai][bj][m][0] *= fa0; acc[ai][bj][m][1] *= fa1;
                    if (fin) *(GAS v4u*)(dst + (size_t)(row0 + ai * 128 + m * 16) * 1024 + c0 + bj * 128) = pack8(acc[ai][bj][m][0], acc[ai][bj][m][1]); }
        }
    }
};

struct EpiOut {
    GAS unsigned char* ws; GAS float* out; int last, first;
    __device__ __forceinline__ void operator()(Acc& acc, const Unit& u, int wr, int wc, int fr, int fq, LAS unsigned char* lds) const {
        const int row0 = u.pm * BM + wr * 64 + fr, c0 = u.pn * BM + wc * 32 + 8 * fq; GAS float* H = (GAS float*)(ws + WS_H); const GAS unsigned long long* RT = (const GAS unsigned long long*)(ws + WS_RTAB);
        const bool sample = u.pm >= MPAD / 256;
#pragma unroll
        for (int ai = 0; ai < 2; ++ai) {
            f32x4 hv[4][2][2];
#pragma unroll
            for (int m = 0; m < 4; ++m) { const int rw = row0 + ai * 128 + m * 16; const GAS float* hp = (first ? (const GAS float*)RT[rw] : H + (size_t)rw * 1024) + c0;
#pragma unroll
                for (int bj = 0; bj < 2; ++bj) { hv[m][bj][0] = *(const GAS f32x4*)(hp + bj * 128); hv[m][bj][1] = *(const GAS f32x4*)(hp + bj * 128 + 4); } }
#pragma unroll
            for (int m = 0; m < 4; ++m) { const int row = row0 + ai * 128 + m * 16; GAS float* dp = H + (size_t)row * 1024 + c0; bool ok = true;
                if (last) { if (sample) dp = out + O_YS + (size_t)(row - MPAD) * 1024 + c0;
                    else { const int b = row / LP, t = row - b * LP; ok = row < MP && t >= NMETA; dp = out + O_YP + ((size_t)b * SEQ + (t - NMETA)) * 1024 + c0; } }
                if (ok) {
#pragma unroll
                    for (int bj = 0; bj < 2; ++bj) { *(GAS f32x4*)(dp + bj * 128) = hv[m][bj][0] + acc[ai][bj][m][0]; *(GAS f32x4*)(dp + bj * 128 + 4) = hv[m][bj][1] + acc[ai][bj][m][1]; } } }
        }
    }
};
struct EpiMergeSlab {
    GAS unsigned char* ws;
    __device__ __forceinline__ void operator()(Acc& acc, const Unit& u, int wr, int wc, int fr, int fq, LAS unsigned char* lds) const {
        const int row0 = u.pm * BM + wr * 64 + fr, c0 = u.pn * BM + wc * 32 + 8 * fq;
        const GAS bf16* G0 = (const GAS bf16*)(ws + WS_GATE) + (size_t)u.seg * MTOT * 1024;
        {
            GAS float* sl = (GAS float*)(ws + WS_SLAB_M) + (size_t)u.slab * 65536 + (size_t)(wr * 64 + fr) * 256 + wc * 32 + 8 * fq;
#pragma unroll
            for (int ai = 0; ai < 2; ++ai) { v4u ga[4][2];
#pragma unroll
                for (int m = 0; m < 4; ++m)
#pragma unroll
                    for (int bj = 0; bj < 2; ++bj) ga[m][bj] = *(const GAS v4u*)(G0 + (size_t)(row0 + ai * 128 + m * 16) * 1024 + c0 + bj * 128);
#pragma unroll
                for (int m = 0; m < 4; ++m)
#pragma unroll
                    for (int bj = 0; bj < 2; ++bj) { const v4u x = ga[m][bj]; const f32x4 f0 = {bf_lo(x.x), bf_hi(x.x), bf_lo(x.y), bf_hi(x.y)}, f1 = {bf_lo(x.z), bf_hi(x.z), bf_lo(x.w), bf_hi(x.w)};
                        GAS float* d = sl + (size_t)(ai * 128 + m * 16) * 256 + bj * 128; *(GAS f32x4*)d = acc[ai][bj][m][0] * f0; *(GAS f32x4*)(d + 4) = acc[ai][bj][m][1] * f1; } }
        }
    }
};
struct EpiOutSlab {
    GAS unsigned char* ws;
    __device__ __forceinline__ void operator()(Acc& acc, const Unit& u, int wr, int wc, int fr, int fq, LAS unsigned char* lds) const {
        {
            GAS float* sl = (GAS float*)(ws + WS_SLAB_O) + (size_t)u.slab * 65536 + (size_t)(wr * 64 + fr) * 256 + wc * 32 + 8 * fq;
#pragma unroll
            for (int ai = 0; ai < 2; ++ai)
#pragma unroll
                for (int m = 0; m < 4; ++m)
#pragma unroll
                    for (int bj = 0; bj < 2; ++bj) { GAS float* d = sl + (size_t)(ai * 128 + m * 16) * 256 + bj * 128; *(GAS f32x4*)d = acc[ai][bj][m][0]; *(GAS f32x4*)(d + 4) = acc[ai][bj][m][1]; }
        }
    }
};
}
__device__ __forceinline__ f32x16 mfma32(bf16x8 a, bf16x8 b, f32x16 c) { return __builtin_amdgcn_mfma_f32_32x32x16_bf16(a, b, c, 0, 0, 0); }
__device__ __forceinline__ f32x16 zero16() { f32x16 z;
#pragma unroll
    for (int i = 0; i < 16; ++i) z[i] = 0.f; return z; }
__device__ __forceinline__ bf16x8 cvt8(const f32x4 a, const f32x4 b) { const v4u w = pg8::pack8(a, b); return __builtin_bit_cast(bf16x8, w); }

namespace hg {
constexpr int P136 = 136, P72 = 72;
constexpr int L_QS = 0, L_QT = L_QS + 64 * P136 * 2, L_KT = L_QT + 64 * P136 * 2, L_KTT = L_KT + 64 * P136 * 2, L_VT = L_KTT + 128 * P72 * 2,
              L_ATT = L_VT + 128 * P72 * 2, L_ST = L_ATT + 64 * P72 * 2, L_SEG = L_ST + 128 * P136 * 2, L_EV = L_SEG + 8 * 128 * 4, L_PART = L_EV + 2 * 128 * 4, L_GN = L_PART + 64 * 4 * 4, L_END = L_GN + 128 * 4;
static_assert(L_END <= LDS_MISC, "hgrn LDS");
struct Pre { unsigned lf[8]; unsigned q[8], k[8], v[8]; v2u sg[4]; };
#define HG_BAR() do { asm volatile("s_waitcnt lgkmcnt(0)" ::: "memory"); __builtin_amdgcn_s_barrier(); asm volatile("" ::: "memory"); } while (0)

template <int PART>
__device__ __forceinline__ void prefetch(Pre& P, const GAS unsigned char* ws, size_t row0, int nvalid, int seg, int colb  , int trow  , int sgcol  ) {
    const GAS _Float16* LF = (const GAS _Float16*)(ws + WS_LOGF) + row0 * 1024; const GAS bf16* QC = (const GAS bf16*)(ws + WS_QC) + row0 * 1024; const GAS bf16* KC = (const GAS bf16*)(ws + WS_KC) + row0 * 1024; const GAS bf16* IC = (const GAS bf16*)(ws + WS_IC) + row0 * 1024;
    if (PART & 2) { const GAS bf16* SGC = (const GAS bf16*)(ws + WS_SGC) + row0 * 1024; const unsigned so = (unsigned)((trow < nvalid ? trow : 0) * 1024 + sgcol);
#pragma unroll
      for (int g = 0; g < 4; ++g) P.sg[g] = *(const GAS v2u*)(SGC + so + 8 * g); }
    if (nvalid == 64) {
#pragma unroll
        for (int i = 0; i < 8; ++i) { const unsigned o = (unsigned)((seg * 8 + i) * 1024 + colb);
            if (PART & 1) P.lf[i] = *(const GAS unsigned*)(LF + o);
            if (PART & 2) { P.q[i] = *(const GAS unsigned*)(QC + o); P.k[i] = *(const GAS unsigned*)(KC + o); P.v[i] = *(const GAS unsigned*)(IC + o); } }
    } else {
#pragma unroll
        for (int i = 0; i < 8; ++i) { const int t = seg * 8 + i; const unsigned o = (unsigned)(t * 1024 + colb);
            if (t < nvalid) { if (PART & 1) P.lf[i] = *(const GAS unsigned*)(LF + o); if (PART & 2) { P.q[i] = *(const GAS unsigned*)(QC + o); P.k[i] = *(const GAS unsigned*)(KC + o); P.v[i] = *(const GAS unsigned*)(IC + o); } }
            else { if (PART & 1) P.lf[i] = 0u; if (PART & 2) { P.q[i] = 0u; P.k[i] = 0u; P.v[i] = 0u; } } }
    }
}

__device__ __forceinline__ void chain(Frame& F, int layer, bool sample, int b, int h) {
    LAS unsigned char* lds = F.lds; int tid = F.tid_(); asm volatile("" : "+v"(tid));
    const int lane = tid & 63, wave = F.wave, seg = wave; int kp = tid & 63, l31 = lane & 31, hh = lane >> 5;
    const int L = sample ? DSEQ : LP, nchunks = (L + 63) / 64;
    const size_t rowbase = sample ? (size_t)MPAD + (size_t)b * DSEQ : (size_t)b * LP;
    const int colb = h * 128 + 2 * kp;
    GAS bf16* YC = (GAS bf16*)(F.wsp() + WS_Y) + (size_t)2 * MTOT * 1024;
    const int kb = wave >> 1, vb0 = 2 * (wave & 1);
    f32x16 S[2];
    if (sample) { const GAS float* s0 = F_state_hgrn + (((size_t)layer * DBATCH + b) * 8 + h) * 16384;
#pragma unroll
        for (int vbi = 0; vbi < 2; ++vbi)
#pragma unroll
            for (int r = 0; r < 16; ++r) S[vbi][r] = s0[(size_t)(32 * kb + (r & 3) + 8 * (r >> 2) + 4 * hh) * 128 + 32 * (vb0 + vbi) + l31]; }
    else { S[0] = zero16(); S[1] = zero16(); }
#pragma unroll
    for (int vbi = 0; vbi < 2; ++vbi)
#pragma unroll
        for (int g = 0; g < 4; ++g) { v2u w; w.x = cvt_pk_bf16(S[vbi][4 * g], S[vbi][4 * g + 1]); w.y = cvt_pk_bf16(S[vbi][4 * g + 2], S[vbi][4 * g + 3]);
            *(LAS v2u*)(lds + L_ST + ((32 * (vb0 + vbi) + l31) * P136 + 32 * kb + 8 * g + 4 * hh) * 2) = w; }
    const int ovb = wave & 3, otb = wave >> 2;
    if (tid < 128) *(LAS float*)(lds + L_GN + tid * 4) = F_hng[layer * 128 + tid];
    Pre P; prefetch<3>(P, F.wsp(), rowbase, min(64, L), seg, colb, 32 * otb + l31, h * 128 + 32 * ovb + 4 * hh);
    for (int c = 0; c < nchunks; ++c) {
        asm volatile("" : "+v"(l31), "+v"(hh), "+v"(kp));
        const int nvalid = min(64, L - 64 * c); const size_t row0 = rowbase + (size_t)64 * c;
        float c0[8], c1[8]; { float a0 = 0.f, a1 = 0.f;
#pragma unroll
            for (int i = 0; i < 8; ++i) { const pg8::h16x2 hv = __builtin_bit_cast(pg8::h16x2, P.lf[i]); a0 += (float)hv.x; a1 += (float)hv.y; c0[i] = a0; c1[i] = a1; }
            *(LAS f32x2*)(lds + L_SEG + (seg * 128 + 2 * kp) * 4) = (f32x2){a0, a1}; }
        if (c + 1 < nchunks) prefetch<1>(P, F.wsp(), rowbase + (size_t)64 * (c + 1), min(64, L - 64 * (c + 1)), seg, colb, 32 * otb + l31, h * 128 + 32 * ovb + 4 * hh);
        HG_BAR();
        float off0 = 0.f, off1 = 0.f, m0 = 0.f, m1 = 0.f, la0 = 0.f, la1 = 0.f;
#pragma unroll
        for (int s = 0; s < 8; ++s) { const f32x2 tt = *(const LAS f32x2*)(lds + L_SEG + (s * 128 + 2 * kp) * 4);
            if (s < seg) { off0 += tt.x; off1 += tt.y; } if (s < 4) { m0 += tt.x; m1 += tt.y; } la0 += tt.x; la1 += tt.y; }
        unsigned ktt0[8], ktt1[8], vt0[8], vt1[8]; const float e2m0 = fexp2(m0), e2m1 = fexp2(m1);
#pragma unroll
        for (int i = 0; i < 8; ++i) { const int t = seg * 8 + i; const float cu0 = off0 + c0[i], cu1 = off1 + c1[i];
            const float q0 = bf_lo(P.q[i]), q1 = bf_hi(P.q[i]), k0 = bf_lo(P.k[i]), k1 = bf_hi(P.k[i]);
            const float em0 = fexp2(cu0 - m0), em1 = fexp2(cu1 - m1), ek0 = fexp2(m0 - cu0), ek1 = fexp2(m1 - cu1), eq0 = em0 * e2m0, eq1 = em1 * e2m1;
            *(LAS unsigned*)(lds + L_QS + (t * P136 + 2 * kp) * 2) = cvt_pk_bf16(q0 * eq0, q1 * eq1);
            *(LAS unsigned*)(lds + L_QT + (t * P136 + 2 * kp) * 2) = cvt_pk_bf16(q0 * em0, q1 * em1);
            const unsigned kt = cvt_pk_bf16(k0 * ek0, k1 * ek1);
            *(LAS unsigned*)(lds + L_KT + (t * P136 + 2 * kp) * 2) = kt;
            ktt0[i] = kt & 0xffffu; ktt1[i] = kt >> 16; vt0[i] = P.v[i] & 0xffffu; vt1[i] = P.v[i] >> 16; }
        { v4u w; w.x = ktt0[0] | (ktt0[1] << 16); w.y = ktt0[2] | (ktt0[3] << 16); w.z = ktt0[4] | (ktt0[5] << 16); w.w = ktt0[6] | (ktt0[7] << 16);
          *(LAS v4u*)(lds + L_KTT + ((2 * kp) * P72 + 8 * seg) * 2) = w;
          w.x = ktt1[0] | (ktt1[1] << 16); w.y = ktt1[2] | (ktt1[3] << 16); w.z = ktt1[4] | (ktt1[5] << 16); w.w = ktt1[6] | (ktt1[7] << 16);
          *(LAS v4u*)(lds + L_KTT + ((2 * kp + 1) * P72 + 8 * seg) * 2) = w;
          w.x = vt0[0] | (vt0[1] << 16); w.y = vt0[2] | (vt0[3] << 16); w.z = vt0[4] | (vt0[5] << 16); w.w = vt0[6] | (vt0[7] << 16);
          *(LAS v4u*)(lds + L_VT + ((2 * kp) * P72 + 8 * seg) * 2) = w;
          w.x = vt1[0] | (vt1[1] << 16); w.y = vt1[2] | (vt1[3] << 16); w.z = vt1[4] | (vt1[5] << 16); w.w = vt1[6] | (vt1[7] << 16);
          *(LAS v4u*)(lds + L_VT + ((2 * kp + 1) * P72 + 8 * seg) * 2) = w; }
        if (seg == 0) { *(LAS f32x2*)(lds + L_EV + (2 * kp) * 4) = (f32x2){fexp2(la0), fexp2(la1)}; *(LAS f32x2*)(lds + L_EV + (128 + 2 * kp) * 4) = (f32x2){fexp2(la0 - m0), fexp2(la1 - m1)}; }
        v2u sg[4] = {P.sg[0], P.sg[1], P.sg[2], P.sg[3]};
        if (c + 1 < nchunks) prefetch<2>(P, F.wsp(), rowbase + (size_t)64 * (c + 1), min(64, L - 64 * (c + 1)), seg, colb, 32 * otb + l31, h * 128 + 32 * ovb + 4 * hh);
        HG_BAR();
        if (wave < 3) { const int sb = wave == 2 ? 1 : 0, tb = wave == 0 ? 0 : 1; f32x16 a = zero16();
#pragma unroll
            for (int st = 0; st < 8; ++st) { const bf16x8 ka = *(const LAS bf16x8*)(lds + L_KT + ((32 * sb + l31) * P136 + 16 * st + 8 * hh) * 2);
                const bf16x8 qb = *(const LAS bf16x8*)(lds + L_QT + ((32 * tb + l31) * P136 + 16 * st + 8 * hh) * 2); a = mfma32(ka, qb, a); }
            const int t = 32 * tb + l31;
#pragma unroll
            for (int g = 0; g < 4; ++g) { const int s0 = 32 * sb + 8 * g + 4 * hh; float x[4];
#pragma unroll
                for (int j = 0; j < 4; ++j) x[j] = (s0 + j <= t) ? a[4 * g + j] : 0.f;
                v2u w; w.x = cvt_pk_bf16(x[0], x[1]); w.y = cvt_pk_bf16(x[2], x[3]); *(LAS v2u*)(lds + L_ATT + (t * P72 + s0) * 2) = w; } }
        HG_BAR();
        f32x16 o = zero16();
#pragma unroll
        for (int st = 0; st < 8; ++st) { const bf16x8 sa = *(const LAS bf16x8*)(lds + L_ST + ((32 * ovb + l31) * P136 + 16 * st + 8 * hh) * 2);
            const bf16x8 qb = *(const LAS bf16x8*)(lds + L_QS + ((32 * otb + l31) * P136 + 16 * st + 8 * hh) * 2); o = mfma32(sa, qb, o); }
        for (int st = 0; st < 2 + 2 * otb; ++st) { const bf16x8 va = *(const LAS bf16x8*)(lds + L_VT + ((32 * ovb + l31) * P72 + 16 * st + 8 * hh) * 2);
            const bf16x8 ab = *(const LAS bf16x8*)(lds + L_ATT + ((32 * otb + l31) * P72 + 16 * st + 8 * hh) * 2); o = mfma32(va, ab, o); }
        { float ss = 0.f;
#pragma unroll
            for (int r = 0; r < 16; ++r) ss += o[r] * o[r];
            ss += __shfl_xor(ss, 32);
            if (hh == 0) *(LAS float*)(lds + L_PART + ((32 * otb + l31) * 4 + ovb) * 4) = ss; }
        HG_BAR();
        { const f32x4 p = *(const LAS f32x4*)(lds + L_PART + (32 * otb + l31) * 16); const float rs = frsq(((p[0] + p[1]) + (p[2] + p[3])) * (1.0f / 128.0f) + EPS);
          const int t = 32 * otb + l31;
          if (t < nvalid) { GAS bf16* yp = YC + (row0 + t) * 1024 + h * 128 + 32 * ovb + 4 * hh;
#pragma unroll
              for (int g = 0; g < 4; ++g) { const f32x4 gng = *(const LAS f32x4*)(lds + L_GN + (32 * ovb + 8 * g + 4 * hh) * 4); const float y0 = o[4 * g] * rs * gng[0] * bf_lo(sg[g].x), y1 = o[4 * g + 1] * rs * gng[1] * bf_hi(sg[g].x),
                                                        y2 = o[4 * g + 2] * rs * gng[2] * bf_lo(sg[g].y), y3 = o[4 * g + 3] * rs * gng[3] * bf_hi(sg[g].y);
                  v2u w; w.x = cvt_pk_bf16(y0, y1); w.y = cvt_pk_bf16(y2, y3); *(GAS v2u*)(yp + 8 * g) = w; } } }
        f32x16 Pn[2] = {zero16(), zero16()};
#pragma unroll
        for (int st = 0; st < 4; ++st) { const bf16x8 ka = *(const LAS bf16x8*)(lds + L_KTT + ((32 * kb + l31) * P72 + 16 * st + 8 * hh) * 2);
#pragma unroll
            for (int vbi = 0; vbi < 2; ++vbi) { const bf16x8 vbf = *(const LAS bf16x8*)(lds + L_VT + ((32 * (vb0 + vbi) + l31) * P72 + 16 * st + 8 * hh) * 2); Pn[vbi] = mfma32(ka, vbf, Pn[vbi]); } }
#pragma unroll
        for (int g = 0; g < 4; ++g) { const f32x4 el = *(const LAS f32x4*)(lds + L_EV + (32 * kb + 8 * g + 4 * hh) * 4), elm = *(const LAS f32x4*)(lds + L_EV + (128 + 32 * kb + 8 * g + 4 * hh) * 4);
#pragma unroll
            for (int vbi = 0; vbi < 2; ++vbi) {
#pragma unroll
                for (int j = 0; j < 4; ++j) S[vbi][4 * g + j] = el[j] * S[vbi][4 * g + j] + elm[j] * Pn[vbi][4 * g + j];
                v2u w; w.x = cvt_pk_bf16(S[vbi][4 * g], S[vbi][4 * g + 1]); w.y = cvt_pk_bf16(S[vbi][4 * g + 2], S[vbi][4 * g + 3]);
                *(LAS v2u*)(lds + L_ST + ((32 * (vb0 + vbi) + l31) * P136 + 32 * kb + 8 * g + 4 * hh) * 2) = w; } }
    }
    GAS float* sf = sample ? F.outp() + O_HS + (((size_t)layer * DBATCH + b) * 8 + h) * 16384 : F.outp() + O_HP + (((size_t)layer * BATCH + b) * 8 + h) * 16384;
#pragma unroll
    for (int vbi = 0; vbi < 2; ++vbi)
#pragma unroll
        for (int r = 0; r < 16; ++r) sf[(size_t)(32 * kb + (r & 3) + 8 * (r >> 2) + 4 * hh) * 128 + 32 * (vb0 + vbi) + l31] = S[vbi][r];
    HG_BAR();
}
}

namespace sb {
constexpr float R_STOP = -136.0f;
constexpr int KROW = 272, SLOT = 32 * KROW + 128 * 64;
static_assert(8 * SLOT + 64 <= LDS_MISC, "attention LDS");
constexpr int L_DONE = 8 * SLOT;
struct Grp { const GAS float* k_old; const GAS float* v_old; const GAS float* k_new; const GAS float* v_new; };

struct TileRegs { f32x4 k0, k1, v0, v1; };
__device__ __forceinline__ void tile_issue(TileRegs& t, const Grp& g, int kt, int past, int L, int c, int rp, int sh) {
    const int s0 = 32 * kt - sh; const bool old = s0 + sh < past; const int rl = old ? 31 : (L - 1 - (s0 - past)), lo = s0 < 0 ? -s0 : 0;
    const GAS float* kb = old ? g.k_old + (ptrdiff_t)s0 * 1024 : g.k_new + (ptrdiff_t)(s0 - past) * 1024; const GAS float* vb = old ? g.v_old + (ptrdiff_t)s0 * 1024 : g.v_new + (ptrdiff_t)(s0 - past) * 1024;
    if (rl >= 31 && lo == 0) {
        const unsigned o = (unsigned)(2 * rp * 1024 + 4 * c);
        t.k0 = *(const GAS f32x4*)(kb + o); t.k1 = *(const GAS f32x4*)(kb + o + 1024); t.v0 = *(const GAS f32x4*)(vb + o); t.v1 = *(const GAS f32x4*)(vb + o + 1024);
        return; }
    const int r0 = max(min(2 * rp, rl), lo), r1 = max(min(2 * rp + 1, rl), lo);
    t.k0 = *(const GAS f32x4*)(kb + (ptrdiff_t)r0 * 1024 + 4 * c); t.k1 = *(const GAS f32x4*)(kb + (ptrdiff_t)r1 * 1024 + 4 * c);
    t.v0 = *(const GAS f32x4*)(vb + (ptrdiff_t)r0 * 1024 + 4 * c); t.v1 = *(const GAS f32x4*)(vb + (ptrdiff_t)r1 * 1024 + 4 * c);
}
__device__ __forceinline__ void tile_commit(const TileRegs& t, LAS unsigned char* slot, int c, int rp) {
    v2u a; a.x = cvt_pk_bf16(t.k0[0], t.k0[1]); a.y = cvt_pk_bf16(t.k0[2], t.k0[3]); *(LAS v2u*)(slot + (2 * rp) * KROW + 8 * c) = a;
    a.x = cvt_pk_bf16(t.k1[0], t.k1[1]); a.y = cvt_pk_bf16(t.k1[2], t.k1[3]); *(LAS v2u*)(slot + (2 * rp + 1) * KROW + 8 * c) = a;
    LAS unsigned char* vt = slot + 32 * KROW; const int r7 = rp & 7, f = 2 * (rp >> 3) + ((r7 >> 1) & 1);
    const int u = ((f ^ (c & 3)) * 16) + (r7 >> 2) * 8 + (rp & 1) * 4;
#pragma unroll
    for (int j = 0; j < 4; ++j) *(LAS unsigned*)(vt + (4 * c + j) * 64 + u) = cvt_pk_bf16(t.v0[j], t.v1[j]);
}

template <int NG>
__device__ __forceinline__ void block_unit(Frame& F, int layer, int unit  ) {
    constexpr int W = 8 / NG;
    int tid = F.tid_(); asm volatile("" : "+v"(tid)); const int lane = tid & 63, wave = F.wave, l31 = lane & 31, hh = lane >> 5;
    LAS unsigned char* lds = F.lds;
    const bool sample = NG > 1; constexpr int sh = NG == 1 ? 16 : 0; const int L = sample ? DSEQ : LP, past = sample ? PAST : 0, nqt = (L + sh + 31) / 32;
    const int gi = wave / W, wi = wave - gi * W;
    int bh, qt0; bool wave_on; if (!sample) { const int j = 8 - (unit >> 6); bh = unit & 63; qt0 = j == 0 ? 0 : 8 * j - 7; wave_on = j > 0 || wi == 0; } else { bh = unit * NG + gi; qt0 = 0; wave_on = wi < nqt; }
    const int b = bh >> 3, h = bh & 7; const int qt = qt0 + wi;
    const size_t rowbase = sample ? (size_t)MPAD + (size_t)b * DSEQ : (size_t)b * LP;
    Grp g;
    g.k_new = (sample ? F.outp() + O_KS + (size_t)layer * MS * 1024 + (size_t)b * DSEQ * 1024 : F.outp() + O_KP + (size_t)layer * MP * 1024 + (size_t)b * LP * 1024) + h * 128;
    g.v_new = (sample ? F.outp() + O_VS + (size_t)layer * MS * 1024 + (size_t)b * DSEQ * 1024 : F.outp() + O_VP + (size_t)layer * MP * 1024 + (size_t)b * LP * 1024) + h * 128;
    g.k_old = F_cache_k + ((size_t)layer * DBATCH + b) * PAST * 1024 + h * 128; g.v_old = F_cache_v + ((size_t)layer * DBATCH + b) * PAST * 1024 + h * 128;
    const int dt0 = (past >> 5) + qt0;
    const int tq = 32 * qt - sh + l31; const bool qvalid = wave_on && tq >= 0 && tq < L; const size_t qrow = rowbase + (tq < 0 ? 0 : tq < L ? tq : L - 1);
    const GAS bf16* Q = (const GAS bf16*)(F.wsp() + WS_Q) + qrow * 1024 + h * 128 + 8 * hh;
    bf16x8 qf[8];
#pragma unroll
    for (int st = 0; st < 8; ++st) qf[st] = *(const GAS bf16x8*)(Q + 16 * st);
    f32x16 O[4] = {zero16(), zero16(), zero16(), zero16()};
    const int qpos = past + tq; float R = 0.f; bool done = !wave_on;
    const int sc = tid & 31, srp = NG == 1 ? (tid >> 5) : ((tid & (64 * W - 1)) >> 5);
    if (NG == 1) { for (int j0 = 0; j0 < W; j0 += 4) { TileRegs t[4];
#pragma unroll
            for (int j = 0; j < 4; ++j) tile_issue(t[j], g, dt0 + j0 + j, past, L, sc, srp, sh);
#pragma unroll
            for (int j = 0; j < 4; ++j) tile_commit(t[j], lds + ((dt0 + j0 + j) & (W - 1)) * SLOT, sc, srp); } }
    else { for (int j = 0; j < W; ++j) { TileRegs t[4];
#pragma unroll
            for (int ps = 0; ps < 4; ++ps) tile_issue(t[ps], g, dt0 + j, past, L, sc, srp + 4 * ps, sh);
#pragma unroll
            for (int ps = 0; ps < 4; ++ps) tile_commit(t[ps], lds + (gi * W + ((dt0 + j) & (W - 1))) * SLOT, sc, srp + 4 * ps); } }
    if (lane == 0) *(LAS unsigned*)(lds + L_DONE + 4 * wave) = done ? 1u : 0u;
    TileRegs pre; if (NG == 1 && dt0 - 1 >= 0) tile_issue(pre, g, dt0 - 1, past, L, sc, srp, sh);
    HG_BAR();
    for (int i = 0; ; ++i) {
        const int kt = dt0 + wi - i;
        const int knew = dt0 - i - 1;
        TileRegs pre2; if (NG == 1 && knew - 1 >= 0) tile_issue(pre2, g, knew - 1, past, L, sc, srp, sh);
        if (!done && kt >= 0) {
            const LAS unsigned char* slot = lds + (gi * W + (kt & (W - 1))) * SLOT; const int s0 = 32 * kt - sh;
            f32x16 sa = zero16();
#pragma unroll
            for (int st = 0; st < 8; ++st) sa = mfma32(*(const LAS bf16x8*)(slot + l31 * KROW + (16 * st + 8 * hh) * 2), qf[st], sa);
            const bool diag = i == 0;
            float sg[16], kp[16];
#pragma unroll
            for (int r = 0; r < 16; ++r) { const float e = fexp2(-sa[r]), rc = frcp(1.0f + e); sg[r] = rc; kp[r] = e * rc; }
            if (diag || (sh != 0 && kt == 0)) { const int khi = diag ? qpos : 0x7fffffff;
#pragma unroll
                for (int r = 0; r < 16; ++r) { const int key = s0 + (r & 3) + 8 * (r >> 2) + 4 * hh; const bool ok = key < khi && key >= 0; kp[r] = ok ? kp[r] : 1.0f; sg[r] = ok ? sg[r] : 0.f; } }
            float ex[16], T[4], Tp[4];
#pragma unroll
            for (int gq = 0; gq < 4; ++gq) { ex[4 * gq + 3] = 1.0f; ex[4 * gq + 2] = kp[4 * gq + 3]; ex[4 * gq + 1] = ex[4 * gq + 2] * kp[4 * gq + 2]; ex[4 * gq] = ex[4 * gq + 1] * kp[4 * gq + 1]; T[gq] = ex[4 * gq] * kp[4 * gq]; Tp[gq] = __shfl_xor(T[gq], 32); }
            float carry[4]; { float above = fexp2(R);
#pragma unroll
                for (int gq = 3; gq >= 0; --gq) { carry[gq] = above * (hh == 0 ? Tp[gq] : 1.0f); above *= T[gq] * Tp[gq]; }
                R += flog2(fmaxf(((T[0] * Tp[0]) * (T[1] * Tp[1])) * ((T[2] * Tp[2]) * (T[3] * Tp[3])), 1e-45f)); }
            float w[16];
#pragma unroll
            for (int r = 0; r < 16; ++r) w[r] = sg[r] * (carry[r >> 2] * ex[r]);
            const LAS unsigned char* vt = slot + 32 * KROW;
#pragma unroll
            for (int s = 0; s < 2; ++s) { v4u pw; pw.x = cvt_pk_bf16(w[8 * s], w[8 * s + 1]); pw.y = cvt_pk_bf16(w[8 * s + 2], w[8 * s + 3]); pw.z = cvt_pk_bf16(w[8 * s + 4], w[8 * s + 5]); pw.w = cvt_pk_bf16(w[8 * s + 6], w[8 * s + 7]);
                const bf16x8 pb = __builtin_bit_cast(bf16x8, pw);
#pragma unroll
                for (int db = 0; db < 4; ++db) { const int d = 32 * db + l31;
                    O[db] = mfma32(*(const LAS bf16x8*)(vt + d * 64 + (((2 * s + hh) ^ ((d >> 2) & 3)) * 16)), pb, O[db]); } }
            if (kt == 0 || __all(R < R_STOP)) { done = true; if (lane == 0) *(LAS unsigned*)(lds + L_DONE + 4 * wave) = 1u; }
        } else if (!done && kt < 0) { done = true; if (lane == 0) *(LAS unsigned*)(lds + L_DONE + 4 * wave) = 1u; }
        HG_BAR();
        const v4u d0 = *(const LAS v4u*)(lds + L_DONE), d1 = *(const LAS v4u*)(lds + L_DONE + 16);
        if ((d0.x & d0.y & d0.z & d0.w & d1.x & d1.y & d1.z & d1.w) != 0u) break;
        if (NG == 1) { if (knew >= 0) tile_commit(pre, lds + (knew & (W - 1)) * SLOT, sc, srp); pre = pre2; }
        else if (knew >= 0) { TileRegs t[4];
#pragma unroll
            for (int ps = 0; ps < 4; ++ps) tile_issue(t[ps], g, knew, past, L, sc, srp + 4 * ps, sh);
#pragma unroll
            for (int ps = 0; ps < 4; ++ps) tile_commit(t[ps], lds + (gi * W + (knew & (W - 1))) * SLOT, sc, srp + 4 * ps); }
        HG_BAR();
    }
    if (qvalid) { const GAS bf16* SG = (const GAS bf16*)(F.wsp() + WS_SGB) + qrow * 1024 + h * 128 + 4 * hh; GAS bf16* Y = (GAS bf16*)(F.wsp() + WS_Y) + (size_t)MTOT * 1024 + qrow * 1024 + h * 128 + 4 * hh;
        v2u sgv[4][4];
#pragma unroll
        for (int db = 0; db < 4; ++db)
#pragma unroll
            for (int gq = 0; gq < 4; ++gq) sgv[db][gq] = *(const GAS v2u*)(SG + 32 * db + 8 * gq);
#pragma unroll
        for (int db = 0; db < 4; ++db)
#pragma unroll
            for (int gq = 0; gq < 4; ++gq) { const v2u s = sgv[db][gq]; v2u o;
                o.x = cvt_pk_bf16(O[db][4 * gq] * bf_lo(s.x), O[db][4 * gq + 1] * bf_hi(s.x)); o.y = cvt_pk_bf16(O[db][4 * gq + 2] * bf_lo(s.y), O[db][4 * gq + 3] * bf_hi(s.y));
                *(GAS v2u*)(Y + 32 * db + 8 * gq) = o; } }
    HG_BAR();
}
constexpr int NU_P = BATCH * 8 * 9, NU_S = DBATCH * 8 / 4;
constexpr int NUNITS = NU_P + NU_S;
}

namespace pl {
constexpr int RS = 528;
constexpr int L_UT = 0, L_DF = 143 * RS, L_END = L_DF + 128 * RS;
static_assert(L_END <= LDS_MISC, "pool LDS");
constexpr int NU_P = BATCH * 17 * 4, NU_S = DBATCH * 4, NUNITS = NU_P + NU_S;
__device__ __forceinline__ void unit(Frame& F, int layer, int u) {
    LAS unsigned char* lds = F.lds; int tid = F.tid_(); asm volatile("" : "+v"(tid)); const int lane = tid & 63, wave = F.wave, l31 = lane & 31, hh = lane >> 5;
    const bool sample = u >= NU_P; int b, tile, g;
    if (!sample) { g = u & 3; const int x = u >> 2; b = x / 17; tile = x - b * 17; } else { const int x = u - NU_P; g = x & 3; b = x >> 2; tile = 0; }
    const int L = sample ? DSEQ : LP, t0 = tile * 128, nrows = min(128, L - t0), w = 2 << g;
    const size_t rowbase = sample ? (size_t)MPAD + (size_t)b * DSEQ : (size_t)b * LP;
    const GAS bf16* UA = (const GAS bf16*)(F.wsp() + WS_UA);
    { v4u sv[9];
#pragma unroll
      for (int q = 0; q < 9; ++q) { const int idx = tid + 512 * q, i = idx >> 5, ch = idx & 31, t = t0 - 15 + i; v4u v = {0u, 0u, 0u, 0u};
        if (idx < 143 * 32) { if (t >= 0 && t < L) v = *(const GAS v4u*)(UA + (rowbase + t) * 1024 + 256 * g + 8 * ch);
            else if (t < 0 && sample) { const GAS float* sp = F_state_pool + (((size_t)layer * DBATCH + b) * 15 + (15 + t)) * 1024 + 256 * g + 8 * ch; v = pg8::pack8(*(const GAS f32x4*)sp, *(const GAS f32x4*)(sp + 4)); } }
        sv[q] = v; }
#pragma unroll
      for (int q = 0; q < 9; ++q) { const int idx = tid + 512 * q, i = idx >> 5, ch = idx & 31; if (idx < 143 * 32) *(LAS v4u*)(lds + L_UT + i * RS + ch * 16) = sv[q]; } }
    const GAS bf16* WT = (const GAS bf16*)(F.wsp() + WS_WPOOL) + ((size_t)layer * 4 + g) * 65536 + (size_t)(32 * wave + l31) * 256 + 8 * hh;
    bf16x8 wf[16];
#pragma unroll
    for (int st = 0; st < 16; ++st) wf[st] = *(const GAS bf16x8*)(WT + 16 * st);
    const GAS float* sc = F_pool_scale + layer * 1024 + 256 * g + 32 * wave + 4 * hh; const GAS bf16* SGA = (const GAS bf16*)(F.wsp() + WS_SGA); GAS bf16* YA = (GAS bf16*)(F.wsp() + WS_Y);
    v4u sgq[8]; f32x4 scv[4];
#pragma unroll
    for (int q = 0; q < 8; ++q) { const int cq = tid + 512 * q, row = cq >> 5, ch8 = cq & 31;
        sgq[q] = __builtin_nontemporal_load((const GAS v4u*)(SGA + (rowbase + t0 + (row < nrows ? row : 0)) * 1024 + 256 * g + 8 * ch8)); }
#pragma unroll
    for (int gg = 0; gg < 4; ++gg) scv[gg] = *(const GAS f32x4*)(sc + 8 * gg);
    HG_BAR();
    { const int ch = tid & 31, rs = tid >> 5, r0 = 8 * rs; float sum[8];
#pragma unroll
      for (int j = 0; j < 8; ++j) sum[j] = 0.f;
      for (int j = 1; j < w; ++j) { const v4u v = *(const LAS v4u*)(lds + L_UT + (15 + r0 - j) * RS + ch * 16);
          sum[0] += bf_lo(v.x); sum[1] += bf_hi(v.x); sum[2] += bf_lo(v.y); sum[3] += bf_hi(v.y); sum[4] += bf_lo(v.z); sum[5] += bf_hi(v.z); sum[6] += bf_lo(v.w); sum[7] += bf_hi(v.w); }
#pragma unroll
      for (int i = 0; i < 8; ++i) { const int r = r0 + i; const v4u v = *(const LAS v4u*)(lds + L_UT + (15 + r) * RS + ch * 16);
          float x[8] = {bf_lo(v.x), bf_hi(v.x), bf_lo(v.y), bf_hi(v.y), bf_lo(v.z), bf_hi(v.z), bf_lo(v.w), bf_hi(v.w)};
          const float rc = sample ? 1.0f / (float)w : 1.0f / fminf((float)(t0 + r) + 1.0f, (float)w); float d[8];
#pragma unroll
          for (int j = 0; j < 8; ++j) { sum[j] += x[j]; d[j] = sum[j] * rc - x[j]; }
          *(LAS v4u*)(lds + L_DF + r * RS + ch * 16) = pg8::pack8((f32x4){d[0], d[1], d[2], d[3]}, (f32x4){d[4], d[5], d[6], d[7]});
          const v4u o = *(const LAS v4u*)(lds + L_UT + (15 + r - (w - 1)) * RS + ch * 16);
          sum[0] -= bf_lo(o.x); sum[1] -= bf_hi(o.x); sum[2] -= bf_lo(o.y); sum[3] -= bf_hi(o.y); sum[4] -= bf_lo(o.z); sum[5] -= bf_hi(o.z); sum[6] -= bf_lo(o.w); sum[7] -= bf_hi(o.w); } }
    HG_BAR();
    f32x16 acc[4] = {zero16(), zero16(), zero16(), zero16()};
#pragma unroll
    for (int st = 0; st < 16; ++st) { const bf16x8 a = wf[st];
#pragma unroll
        for (int rb = 0; rb < 4; ++rb) { const bf16x8 bb = *(const LAS bf16x8*)(lds + L_DF + (32 * rb + l31) * RS + (16 * st + 8 * hh) * 2); acc[rb] = mfma32(a, bb, acc[rb]); } }
    HG_BAR();
    constexpr int TS = 1040;
    static_assert(128 * TS <= L_END, "pool output image");
#pragma unroll
    for (int rb = 0; rb < 4; ++rb)
#pragma unroll
        for (int gg = 0; gg < 4; ++gg) { const f32x4 t = {acc[rb][4 * gg] * scv[gg][0], acc[rb][4 * gg + 1] * scv[gg][1], acc[rb][4 * gg + 2] * scv[gg][2], acc[rb][4 * gg + 3] * scv[gg][3]};
            *(LAS f32x4*)(lds + (32 * rb + l31) * TS + (32 * wave + 8 * gg + 4 * hh) * 4) = t; }
    HG_BAR();
#pragma unroll
    for (int q = 0; q < 8; ++q) { const int cq = tid + 512 * q, row = cq >> 5, ch8 = cq & 31;
        if (row < nrows) { const f32x4 a = *(const LAS f32x4*)(lds + row * TS + ch8 * 32), b = *(const LAS f32x4*)(lds + row * TS + ch8 * 32 + 16); const v4u s = sgq[q];
            const f32x4 ga = {bf_lo(s.x), bf_hi(s.x), bf_lo(s.y), bf_hi(s.y)}, gb = {bf_lo(s.z), bf_hi(s.z), bf_lo(s.w), bf_hi(s.w)};
            *(GAS v4u*)(YA + (rowbase + t0 + row) * 1024 + 256 * g + 8 * ch8) = pg8::pack8(a * ga, b * gb); } }
    HG_BAR();
}
}

#ifndef MERGE_TAIL
#define MERGE_TAIL 6
#endif
#ifndef WGM_PROJ
#define WGM_PROJ 4
#endif
#ifndef WGM_SQ
#define WGM_SQ 1
#endif
constexpr int U_HG_P = BATCH * 8, U_HG_S = DBATCH * 8;
constexpr int U0_HGS = U_HG_P, U0_ATT = U0_HGS + U_HG_S, U0_POOL = U0_ATT + sb::NUNITS, U_TOTAL = U0_POOL + pl::NUNITS;
__device__ __forceinline__ void phase_mixers(Frame& F, int layer, int qslot) {
    GAS unsigned* head = F.ctl() + CW_QUEUE + 64 * qslot;
    for (;;) {
        if (F.tid_() == 0) F.MISC[4] = __hip_atomic_fetch_add(head, 1u, __ATOMIC_RELAXED, __HIP_MEMORY_SCOPE_AGENT);
        HG_BAR();
        const int u = (int)F.MISC[4];
        HG_BAR();
        if (u >= U_TOTAL) break;
        if (u < U0_ATT) { const bool smp = u >= U0_HGS; const int x = smp ? u - U0_HGS : u; hg::chain(F, layer, smp, x >> 3, x & 7); }
        else if (u < U0_POOL) { const int x = u - U0_ATT; if (x < sb::NU_P) sb::block_unit<1>(F, layer, x); else sb::block_unit<4>(F, layer, x - sb::NU_P); }
        else pl::unit(F, layer, u - U0_POOL);
    }
}

__device__ __forceinline__ void combine_merge(Frame& F) {
    pg8::Gemm g{nullptr, nullptr, 0, 0, MTOT / 256, D / 256, 3, D, MERGE_TAIL, WGM_SQ}; pg8::Order S; S.init(g, F.G, 0); if (!S.tail) return;
    const int gw = F.vcu * 8 + F.wave, NGW = F.G * 8, lane = F.lane_(), nrows = (S.nwg - S.G) * 256;
    const GAS float* sl = (const GAS float*)(F.wsp() + WS_SLAB_M); GAS bf16* M = (GAS bf16*)(F.wsp() + WS_MERGED);
    for (int x = gw; x < nrows; x += NGW) { const int j = x >> 8, r = x & 255; int pm, pn; S.tile_of(S.G + j, pm, pn);
        const GAS float* p = sl + (size_t)(MERGE_TAIL * j) * 65536 + (size_t)r * 256 + 4 * lane;
        f32x4 v = *(const GAS f32x4*)p;
#pragma unroll
        for (int q = 1; q < MERGE_TAIL; ++q) v += *(const GAS f32x4*)(p + (size_t)q * 65536);
        v2u o; o.x = cvt_pk_bf16(v[0], v[1]); o.y = cvt_pk_bf16(v[2], v[3]); *(GAS v2u*)(M + (size_t)(256 * pm + r) * 1024 + 256 * pn + 4 * lane) = o; }
}
__device__ __forceinline__ void combine_out(Frame& F, int last) {
    pg8::Gemm g{nullptr, nullptr, 0, 0, MTOT / 256, D / 256, 1, D, 4, WGM_SQ}; pg8::Order S; S.init(g, F.G, 0); if (!S.tail) return;
    const int gw = F.vcu * 8 + F.wave, NGW = F.G * 8, lane = F.lane_(), nrows = (S.nwg - S.G) * 256;
    const GAS float* sl = (const GAS float*)(F.wsp() + WS_SLAB_O); GAS float* H = (GAS float*)(F.wsp() + WS_H); GAS float* out = F.outp();
    for (int x = gw; x < nrows; x += NGW) { const int j = x >> 8, r = x & 255; int pm, pn; S.tile_of(S.G + j, pm, pn);
        const GAS float* p = sl + (size_t)(4 * j) * 65536 + (size_t)r * 256 + 4 * lane; const int row = 256 * pm + r, col = 256 * pn + 4 * lane;
        const f32x4 v = *(const GAS f32x4*)(H + (size_t)row * 1024 + col) + ((*(const GAS f32x4*)p + *(const GAS f32x4*)(p + 65536)) + (*(const GAS f32x4*)(p + 2 * 65536) + *(const GAS f32x4*)(p + 3 * 65536)));
        if (!last) *(GAS f32x4*)(H + (size_t)row * 1024 + col) = v;
        else if (row >= MPAD) *(GAS f32x4*)(out + O_YS + (size_t)(row - MPAD) * 1024 + col) = v;
        else if (row < MP) { const int b = row / LP, t = row - b * LP; if (t >= NMETA) *(GAS f32x4*)(out + O_YP + ((size_t)b * SEQ + (t - NMETA)) * 1024 + col) = v; } }
}
__device__ __forceinline__ void phase_xn_fused(Frame& F, int l) {
    pg8::Gemm g{nullptr, nullptr, 0, 0, MTOT / 256, D / 256, 1, D, 4, WGM_SQ}; pg8::Order S; S.init(g, F.G, 0);
    LAS int* tab = (LAS int*)F.lds; const int tid = F.tid_(), lane = F.lane_();
    for (int i = tid; i < (MTOT / 256) * 4; i += 512) tab[i] = -1;
    __syncthreads();
    if (S.tail && tid < S.nwg - S.G) { int pm, pn; S.tile_of(S.G + tid, pm, pn); tab[4 * pm + pn] = tid; }
    __syncthreads();
    const int gw = F.vcu * 8 + F.wave, NGW = F.G * 8;
    GAS float* H = (GAS float*)(F.wsp() + WS_H); GAS bf16* XN = (GAS bf16*)(F.wsp() + WS_XN); const GAS float* sl = (const GAS float*)(F.wsp() + WS_SLAB_O); const GAS float* gn = F_norm_g + (size_t)l * D;
    for (int r = gw; r < MTOT; r += NGW) {
        if (r >= MP && r < MPAD) { zero_xn_row(XN + (size_t)r * D, lane); continue; }
        GAS f32x4* xr = (GAS f32x4*)(H + (size_t)r * D) + lane; const int pm = r >> 8, rr = r & 255;
        const GAS f32x4* x0 = l == 1 ? (const GAS f32x4*)(*((const GAS unsigned long long*)(F.wsp() + WS_RTAB) + r)) + lane : xr;
        f32x4 v[4]; float s = 0.f;
#pragma unroll
        for (int j = 0; j < 4; ++j) { const int idx = tab[4 * pm + j]; v[j] = idx >= 0 ? x0[64 * j] : xr[64 * j];
            if (idx >= 0) { const GAS float* p = sl + (size_t)(4 * idx) * 65536 + (size_t)rr * 256 + 4 * lane;
                v[j] += (*(const GAS f32x4*)p + *(const GAS f32x4*)(p + 65536)) + (*(const GAS f32x4*)(p + 2 * 65536) + *(const GAS f32x4*)(p + 3 * 65536)); xr[64 * j] = v[j]; }
            s += (v[j].x * v[j].x + v[j].y * v[j].y) + (v[j].z * v[j].z + v[j].w * v[j].w); }
        const float rs = frsq(wave_sum(s) * (1.f / D) + EPS);
        GAS v2u* o8 = (GAS v2u*)(XN + (size_t)r * D) + lane;
#pragma unroll
        for (int j = 0; j < 4; ++j) { const f32x4 gg = ((const GAS f32x4*)gn)[lane + 64 * j]; v2u o; o.x = cvt_pk_bf16(v[j].x * rs * gg.x, v[j].y * rs * gg.y); o.y = cvt_pk_bf16(v[j].z * rs * gg.z, v[j].w * rs * gg.w); o8[64 * j] = o; }
    }
    __syncthreads();
}
constexpr int NPHASES = 1 + 5 * DEPTH;
__global__ void __launch_bounds__(512, 2) mega_fwd(Params p) {
    extern __shared__ __attribute__((aligned(16))) unsigned char lds_raw[];
    Frame F;
    F.lds = (LAS unsigned char*)lds_raw; F.MISC = (volatile LAS unsigned*)(F.lds + LDS_MISC);
    F.wave = __builtin_amdgcn_readfirstlane((int)threadIdx.x >> 6);
    F.G = gridDim.x; { const int bx = blockIdx.x; F.vcu = (F.G % 8 == 0) ? (bx % 8) * (F.G / 8) + bx / 8 : bx; }
    if (threadIdx.x < 64) F.MISC[threadIdx.x] = 0u;
    if (threadIdx.x == 0) { LAS unsigned long long* P = (LAS unsigned long long*)(F.lds + LDS_PARAM);
        P[0] = (unsigned long long)p.in[0]; P[1] = (unsigned long long)p.in[1]; P[2] = (unsigned long long)p.in[2]; P[3] = (unsigned long long)p.in[3]; P[4] = (unsigned long long)p.in[4];
        P[5] = (unsigned long long)p.in[5]; P[6] = (unsigned long long)p.in[6]; P[7] = (unsigned long long)p.in[7]; P[8] = (unsigned long long)p.in[8]; P[9] = (unsigned long long)p.in[9];
        P[10] = (unsigned long long)p.in[10]; P[11] = (unsigned long long)p.in[11]; P[12] = (unsigned long long)p.in[12]; P[13] = (unsigned long long)p.in[13]; P[14] = (unsigned long long)p.in[14];
        P[15] = (unsigned long long)p.in[15]; P[16] = (unsigned long long)p.in[16]; P[17] = (unsigned long long)p.out; P[18] = (unsigned long long)p.ws; }
    __syncthreads();
    const int lo = p.ph_lo, hi = p.ph_hi;
    XcdBarrier bar; bar.bar = F.ctl() + CW_BAR; bar.x = 0; bar.st = nullptr; bar.leader = false;
    if (hi - lo > 1) bar = xcd_barrier_post(F.ctl() + CW_BAR, F.MISC, F.wave);
#define IN(k) (lo <= (k) && (k) < hi)
#define SEAM(k) do { if (IN(k) && IN((k) + 1)) xcd_barrier(bar, F.wave); } while (0)
    if (IN(0)) { phase_prologue(F); } SEAM(0);
    for (int l = 0; l < DEPTH; ++l) {
        const int pb = 1 + 5 * l;
        if (IN(pb)) { if (l > 0) phase_xn_fused(F, l); }
        if (l > 0) SEAM(pb);
        if (IN(pb + 1)) { pg8::Gemm g{(const GAS bf16*)(F.wsp() + WS_XN), (const GAS bf16*)(F.wsp() + WS_WIN) + (size_t)l * NPROJ * D, 0, 0, MTOT / 256, NPROJ / 256, 1, D, 0, WGM_PROJ};
            pg8::Order S; S.init(g, F.G, (int)blockIdx.x);
            pg8::EpiProj E{l, F.wsp(), F.outp(), F_qng + l * 128, F_kng + l * 128, (const GAS float*)(F.wsp() + WS_LB) + l * 1024};
            pg8::gemm_phase(F.lds, g, S, E, F.wave);
            } SEAM(pb + 1);
        if (IN(pb + 2)) { phase_mixers(F, l, l); } SEAM(pb + 2);
        if (IN(pb + 3)) { pg8::Gemm g{(const GAS bf16*)(F.wsp() + WS_Y), (const GAS bf16*)(F.wsp() + WS_WBR) + (size_t)l * 3 * D * D, (size_t)MTOT * 1024, (size_t)D * D, MTOT / 256, D / 256, 3, D, MERGE_TAIL, WGM_SQ};
            pg8::Order S; S.init(g, F.G, (int)blockIdx.x);
            pg8::EpiMerge E{F.wsp()};
            pg8::gemm_phase(F.lds, g, S, E, F.wave);
            { __syncthreads(); pg8::EpiMergeSlab E2{F.wsp()}; pg8::gemm_phase<pg8::EpiMergeSlab, 1>(F.lds, g, S, E2, F.wave); }
            } SEAM(pb + 3);
        if (IN(pb + 4)) { combine_merge(F); xcd_barrier(bar, F.wave);
            pg8::Gemm g{(const GAS bf16*)(F.wsp() + WS_MERGED), (const GAS bf16*)(F.wsp() + WS_WOUT) + (size_t)l * D * D, 0, 0, MTOT / 256, D / 256, 1, D, 4, WGM_SQ};
            pg8::Order S; S.init(g, F.G, (int)blockIdx.x);
            pg8::EpiOut E{F.wsp(), F.outp(), l == DEPTH - 1 ? 1 : 0, l == 0 ? 1 : 0};
            pg8::gemm_phase(F.lds, g, S, E, F.wave);
            { __syncthreads(); pg8::EpiOutSlab E2{F.wsp()}; pg8::gemm_phase<pg8::EpiOutSlab, 1>(F.lds, g, S, E2, F.wave); }
            xcd_barrier(bar, F.wave); if (l == DEPTH - 1) combine_out(F, 1);
            }
    }
#undef IN
#undef SEAM
}
extern "C" void kernel_launch(void* const* d_in, const int* in_sizes, int n_in, void* d_out, int out_size, void* d_ws, size_t ws_size, hipStream_t stream) {
    static int grid = 0;
    if (grid == 0) {
        if (n_in != 17 || out_size != (int)O_END || ws_size < WS_FAST_END) { fprintf(stderr, "kernel_launch: unexpected sizes (n_in %d, out %d, ws %zu < %zu)\n", n_in, out_size, ws_size, (size_t)WS_FAST_END); grid = -1; return; }
        int dev = 0, cus = 0, per_cu = 0;
        if (hipGetDevice(&dev) != hipSuccess || hipDeviceGetAttribute(&cus, hipDeviceAttributeMultiprocessorCount, dev) != hipSuccess) { grid = -1; return; }
        if (hipFuncSetAttribute((const void*)mega_fwd, hipFuncAttributeMaxDynamicSharedMemorySize, LDS_BYTES) != hipSuccess) { fprintf(stderr, "kernel_launch: hipFuncSetAttribute failed\n"); grid = -1; return; }
        if (hipOccupancyMaxActiveBlocksPerMultiprocessor(&per_cu, (const void*)mega_fwd, 512, LDS_BYTES) != hipSuccess || per_cu < 1) { fprintf(stderr, "kernel_launch: occupancy query says %d blocks per CU\n", per_cu); (void)hipGetLastError(); grid = -1; return; }
        grid = cus;
    }
    if (grid < 0) return;
    (void)hipMemsetAsync((char*)d_ws + WS_CTL, 0, CTL_ZERO_BYTES, stream);
    Params p{};
    for (int i = 0; i < 17; ++i) p.in[i] = (const float*)d_in[i];
    p.out = (float*)d_out; p.ws = (unsigned char*)d_ws;
    p.ph_lo = 0; p.ph_hi = NPHASES;
    hipLaunchKernelGGL(mega_fwd, dim3(grid), dim3(512), LDS_BYTES, stream, p);
}
```

```cpp
#define MK_LAUNCHES 1
#include <hip/hip_runtime.h>
#include <cstdio>
#include <cstdint>
constexpr int D = 1024, BATCH = 8, SEQ = 2048, DEPTH = 2, DBATCH = 32, DSEQ = 64, PAST = 2048, NMETA = 16;
constexpr int LP = NMETA + SEQ;
constexpr int MP = BATCH * LP;
constexpr int MPAD = 16640;
constexpr int MS = DBATCH * DSEQ;
constexpr int MTOT = MPAD + MS;
constexpr int NPROJ = 13 * 1024;
constexpr float EPS = 1e-6f, LB_FLOOR = 1e-30f, SB_SCALE = 0.08838834764831845f;
constexpr size_t O_YP = 0, O_YS = 16777216, O_KP = 18874368, O_VP = 52690944, O_PP = 86507520, O_HP = 86753280,
                 O_KS = 88850432, O_VS = 93044736, O_PS = 97239040, O_HS = 98222080, O_END = 106610688;
#define GAS __attribute__((address_space(1)))
#define LAS __attribute__((address_space(3)))
typedef unsigned short bf16;
typedef unsigned v4u __attribute__((ext_vector_type(4)));
typedef unsigned v2u __attribute__((ext_vector_type(2)));
typedef float f32x4 __attribute__((ext_vector_type(4)));
typedef float f32x2 __attribute__((ext_vector_type(2)));
typedef float f32x16 __attribute__((ext_vector_type(16)));
typedef short bf16x8 __attribute__((ext_vector_type(8)));
typedef short bf16x4 __attribute__((ext_vector_type(4)));
#define LDS_WAIT() asm volatile("s_waitcnt lgkmcnt(0)" ::: "memory")
#define VM_WAIT() asm volatile("s_waitcnt vmcnt(0)" ::: "memory")

typedef __bf16 bf16n2 __attribute__((ext_vector_type(2)));
__device__ __forceinline__ unsigned cvt_pk_bf16(float lo, float hi) { const f32x2 v = {lo, hi}; return __builtin_bit_cast(unsigned, __builtin_convertvector(v, bf16n2)); }
__device__ __forceinline__ float bf_lo(unsigned u) { return __uint_as_float(u << 16); }
__device__ __forceinline__ float bf_hi(unsigned u) { return __uint_as_float(u & 0xffff0000u); }
__device__ __forceinline__ float fexp2(float x) { return __builtin_amdgcn_exp2f(x); }
__device__ __forceinline__ float flog2(float x) { return __builtin_amdgcn_logf(x); }
__device__ __forceinline__ float frcp(float x) { return __builtin_amdgcn_rcpf(x); }
__device__ __forceinline__ float frsq(float x) { return __builtin_amdgcn_rsqf(x); }
__device__ __forceinline__ int lane_id() { unsigned z = 0u; asm volatile("" : "+v"(z)); return (int)__builtin_amdgcn_mbcnt_hi(~0u, __builtin_amdgcn_mbcnt_lo(~0u, z)); }
constexpr float LOG2E = 1.4426950408889634f, LN2 = 0.6931471805599453f;
__device__ __forceinline__ float fexp(float x) { return fexp2(x * LOG2E); }
__device__ __forceinline__ float fsigmoid(float x) { return frcp(1.0f + fexp2(-x * LOG2E)); }
__device__ __forceinline__ float fsilu(float x) { return x * fsigmoid(x); }

constexpr size_t MiB = 1u << 20;
constexpr size_t RB16 = (size_t)MTOT * 1024 * 2, RB32 = (size_t)MTOT * 1024 * 4;
constexpr size_t WS_CTL = 0, CTL_ZERO_BYTES = 64 * 1024;
constexpr size_t WS_RTAB = 1 * MiB + 64 * 1024;
constexpr size_t WS_LB = 1 * MiB;
constexpr size_t WS_WIN = 2 * MiB;
constexpr size_t WS_WBR = WS_WIN + (size_t)2 * NPROJ * 1024 * 2;
constexpr size_t WS_WOUT = WS_WBR + (size_t)6 * 1024 * 1024 * 2;
constexpr size_t WS_WPOOL = WS_WOUT + (size_t)2 * 1024 * 1024 * 2;
constexpr size_t WS_H = WS_WPOOL + 1 * MiB;
constexpr size_t WS_XN = WS_H + RB32;
constexpr size_t WS_UA = WS_XN + RB16, WS_SGA = WS_UA + RB16, WS_Q = WS_SGA + RB16, WS_SGB = WS_Q + RB16, WS_KC = WS_SGB + RB16,
                 WS_QC = WS_KC + RB16, WS_IC = WS_QC + RB16, WS_SGC = WS_IC + RB16, WS_GATE = WS_SGC + RB16  ,
                 WS_LOGF = WS_GATE + 3 * RB16  , WS_Y = WS_LOGF + RB32  , WS_MERGED = WS_Y + 3 * RB16, WS_FAST_END = WS_MERGED + RB16;
constexpr size_t WS_SLAB_M = WS_UA, WS_SLAB_O = WS_Q;
static_assert(108 * 262144 <= 2 * RB16 && 144 * 262144 <= 2 * RB16, "slabs");
constexpr int CW_QUEUE = 64;
constexpr int CW_BAR = 1024;

constexpr int LDS_BYTES = 160 * 1024;
constexpr int LDS_XCH = 128 * 1024;
constexpr int LDS_MISC = 159 * 1024;

#define XB_TMO      128
#define XB_XCNT(j)  (256  + 64 * (j))
#define XB_XSUB(j)  (1280 + 64 * (j))
#define XB_XGEN(j)  (2304 + 64 * (j))
#define XB_TOP      3328
#define XB_TOPGEN   3392
#define XCD_BAR_WORDS 3456
#define XB_SPIN_CAP (1u << 18)
__device__ __forceinline__ unsigned xb_ld(GAS unsigned* p)              { return __hip_atomic_load(p, __ATOMIC_RELAXED, __HIP_MEMORY_SCOPE_AGENT); }
__device__ __forceinline__ unsigned xb_add(GAS unsigned* p, unsigned v) { return __hip_atomic_fetch_add(p, v, __ATOMIC_RELAXED, __HIP_MEMORY_SCOPE_AGENT); }
__device__ __forceinline__ unsigned xb_xcc_id() { return (unsigned)__builtin_amdgcn_s_getreg((3 << 11) | 20) & 0xFu; }
#define XB_SPIN(cond, bar) do { unsigned _sp = 0; while (cond) { __builtin_amdgcn_s_sleep(1); \
    if ((++_sp & 255u) == 0u) { if (xb_ld(&(bar)[XB_TMO])) break; if (_sp > XB_SPIN_CAP) { xb_add(&(bar)[XB_TMO], 1u); break; } } } } while (0)
struct XcdBarrier { GAS unsigned* bar; unsigned x; volatile LAS unsigned* st; bool leader; };
__device__ __forceinline__ XcdBarrier xcd_barrier_post(GAS unsigned* bar, volatile LAS unsigned* st, int wave) {
    XcdBarrier b; b.bar = bar; b.x = xb_xcc_id(); b.st = st; b.leader = false;
    b.leader = (wave == 0) && (lane_id() == 0);
    if (b.leader) (void)xb_add(&bar[XB_XCNT(b.x)], 1u);
    return b;
}
__device__ __forceinline__ void xcd_barrier_complete(GAS unsigned* bar, unsigned x, unsigned& nloc, unsigned& nx) {
    const unsigned G = gridDim.x * gridDim.y * gridDim.z;
    unsigned sum, cnt, mine, sp = 0u;
    for (;;) {
        sum = 0u; cnt = 0u; mine = 0u;
#pragma unroll
        for (unsigned j = 0; j < 16; ++j) { const unsigned c = xb_ld(&bar[XB_XCNT(j)]); sum += c; cnt += (c > 0u) ? 1u : 0u; mine = (j == x) ? c : mine; }
        if (sum == G) break;
        __builtin_amdgcn_s_sleep(1);
        if ((++sp & 255u) == 0u) { if (xb_ld(&bar[XB_TMO])) break; if (sp > XB_SPIN_CAP) { xb_add(&bar[XB_TMO], 1u); break; } }
    }
    nloc = mine > 0u ? mine : 1u; nx = cnt > 0u ? cnt : 1u;
}
__device__ __forceinline__ void xcd_barrier(const XcdBarrier& b, int wave) {
    asm volatile("s_waitcnt vmcnt(0)" ::: "memory");
    __syncthreads();
    if (wave == 0 && lane_id() == 0) {
        GAS unsigned* bar = b.bar;
        __builtin_amdgcn_s_waitcnt(0);
        unsigned nloc = b.st[0], nx = b.st[1];
        if (nloc == 0u) { xcd_barrier_complete(bar, b.x, nloc, nx); b.st[0] = nloc; b.st[1] = nx; }
        const unsigned old = xb_add(&bar[XB_XSUB(b.x)], 1u);
        const unsigned gen = old / nloc;
        if (old + 1u == (gen + 1u) * nloc) {
            __builtin_amdgcn_fence(__ATOMIC_RELEASE, "agent");
            asm volatile("s_waitcnt vmcnt(0)" ::: "memory");
            const unsigned og = xb_add(&bar[XB_TOP], 1u);
            const unsigned tg = og / nx;
            if (og + 1u == (tg + 1u) * nx) xb_add(&bar[XB_TOPGEN], 1u);
            else XB_SPIN(xb_ld(&bar[XB_TOPGEN]) == tg, bar);
            __builtin_amdgcn_fence(__ATOMIC_ACQUIRE, "agent");
            xb_add(&bar[XB_XGEN(b.x)], 1u);
            asm volatile("s_waitcnt vmcnt(0)" ::: "memory");
        } else {
            XB_SPIN(xb_ld(&bar[XB_XGEN(b.x)]) == gen, bar);
            __builtin_amdgcn_fence(__ATOMIC_ACQUIRE, "agent");
            asm volatile("s_waitcnt vmcnt(0)" ::: "memory");
        }
    }
    __syncthreads();
}

struct Params { const float* in[17]; float* out; unsigned char* ws; int ph_lo, ph_hi; };
constexpr int LDS_PARAM = LDS_MISC + 256;
struct Frame {
    LAS unsigned char* lds; volatile LAS unsigned* MISC;
    int wave, G, vcu;
    __device__ __forceinline__ int lane_() const { return lane_id(); }
    __device__ __forceinline__ int tid_() const { return wave * 64 + lane_id(); }
    __device__ __forceinline__ unsigned long long rd(int i) const { const v2u v = *(const LAS v2u*)(lds + LDS_PARAM + 8 * i);
        return ((unsigned long long)(unsigned)__builtin_amdgcn_readfirstlane((int)v.y) << 32) | (unsigned)__builtin_amdgcn_readfirstlane((int)v.x); }
    __device__ __forceinline__ const GAS float* in(int i) const { return (const GAS float*)rd(i); }
    __device__ __forceinline__ GAS float* outp() const { return (GAS float*)rd(17); }
    __device__ __forceinline__ GAS unsigned char* wsp() const { return (GAS unsigned char*)rd(18); }
    __device__ __forceinline__ GAS unsigned* ctl() const { return (GAS unsigned*)(wsp() + WS_CTL); }
};
#define F_xp F.in(0)
#define F_xs F.in(1)
#define F_cache_k F.in(2)
#define F_cache_v F.in(3)
#define F_state_pool F.in(4)
#define F_state_hgrn F.in(5)
#define F_meta F.in(6)
#define F_norm_g F.in(7)
#define F_w_in F.in(8)
#define F_qng F.in(9)
#define F_kng F.in(10)
#define F_w_pool F.in(11)
#define F_pool_scale F.in(12)
#define F_hlb F.in(13)
#define F_hng F.in(14)
#define F_w_branch F.in(15)
#define F_w_out F.in(16)
__device__ __forceinline__ float wave_sum(float v) {
#pragma unroll
    for (int o = 1; o < 64; o <<= 1) v += __shfl_xor(v, o);
    return v;
}

__device__ __forceinline__ void p0_transpose_item(const GAS float* W, int K, int N, GAS bf16* WT, int item, int lane) {
    const int nblk = N / 64, kb = item / nblk, nb = item - kb * nblk, r = lane >> 4, c4 = lane & 15;
    const GAS float* src = W + (size_t)(64 * kb + 16 * r) * N + 64 * nb + 4 * c4;
    f32x4 v[16];
#pragma unroll
    for (int i = 0; i < 16; ++i) v[i] = __builtin_nontemporal_load((const GAS f32x4*)(src + (size_t)i * N));
    GAS bf16* dst = WT + (size_t)(64 * nb + 4 * c4) * K + 64 * kb + 16 * r;
#pragma unroll
    for (int j = 0; j < 4; ++j) { v4u a, b;
        a.x = cvt_pk_bf16(v[0][j], v[1][j]); a.y = cvt_pk_bf16(v[2][j], v[3][j]); a.z = cvt_pk_bf16(v[4][j], v[5][j]); a.w = cvt_pk_bf16(v[6][j], v[7][j]);
        b.x = cvt_pk_bf16(v[8][j], v[9][j]); b.y = cvt_pk_bf16(v[10][j], v[11][j]); b.z = cvt_pk_bf16(v[12][j], v[13][j]); b.w = cvt_pk_bf16(v[14][j], v[15][j]);
        *(GAS v4u*)(dst + (size_t)j * K) = a; *(GAS v4u*)(dst + (size_t)j * K + 8) = b; }
}
__device__ __forceinline__ void xn_row(const GAS float* src, GAS float* hdst, const GAS float* g, GAS bf16* xnrow, int lane) {
    const GAS f32x4* xr = (const GAS f32x4*)src + lane;
    f32x4 v[4]; float s = 0.f;
#pragma unroll
    for (int j = 0; j < 4; ++j) { v[j] = xr[64 * j]; s += (v[j].x * v[j].x + v[j].y * v[j].y) + (v[j].z * v[j].z + v[j].w * v[j].w); }
    if (hdst) { GAS f32x4* ho = (GAS f32x4*)hdst + lane;
#pragma unroll
        for (int j = 0; j < 4; ++j) __builtin_nontemporal_store(v[j], ho + 64 * j); }
    const float rs = frsq(wave_sum(s) * (1.f / D) + EPS);
    GAS v2u* o8 = (GAS v2u*)xnrow + lane;
#pragma unroll
    for (int j = 0; j < 4; ++j) { const f32x4 gg = ((const GAS f32x4*)g)[lane + 64 * j]; v2u o; o.x = cvt_pk_bf16(v[j].x * rs * gg.x, v[j].y * rs * gg.y); o.y = cvt_pk_bf16(v[j].z * rs * gg.z, v[j].w * rs * gg.w); o8[64 * j] = o; }
}
__device__ __forceinline__ void zero_xn_row(GAS bf16* xnrow, int lane) { GAS v2u* o8 = (GAS v2u*)xnrow + lane;
#pragma unroll
    for (int j = 0; j < 4; ++j) o8[64 * j] = (v2u){0u, 0u}; }

__device__ __forceinline__ void phase_prologue(Frame& F) {
    const int gw = F.vcu * 8 + F.wave, NGW = F.G * 8;
    constexpr int I_IN = (D / 64) * (NPROJ / 64), I_SQ = (D / 64) * (D / 64), I_PL = (256 / 64) * (256 / 64);
    constexpr int NITEMS = 2 * I_IN + 6 * I_SQ + 2 * I_SQ + 8 * I_PL;
    GAS bf16* win_t = (GAS bf16*)(F.wsp() + WS_WIN); GAS bf16* wbr_t = (GAS bf16*)(F.wsp() + WS_WBR); GAS bf16* wout_t = (GAS bf16*)(F.wsp() + WS_WOUT); GAS bf16* wpool_t = (GAS bf16*)(F.wsp() + WS_WPOOL);
    for (int it = gw; it < NITEMS; it += NGW) {
        int r = it;
        if (r < 2 * I_IN) { const int l = r / I_IN; p0_transpose_item(F_w_in + (size_t)l * D * NPROJ, D, NPROJ, win_t + (size_t)l * NPROJ * D, r % I_IN, F.lane_()); continue; } r -= 2 * I_IN;
        if (r < 6 * I_SQ) { const int m = r / I_SQ; p0_transpose_item(F_w_branch + (size_t)m * D * D, D, D, wbr_t + (size_t)m * D * D, r % I_SQ, F.lane_()); continue; } r -= 6 * I_SQ;
        if (r < 2 * I_SQ) { const int m = r / I_SQ; p0_transpose_item(F_w_out + (size_t)m * D * D, D, D, wout_t + (size_t)m * D * D, r % I_SQ, F.lane_()); continue; } r -= 2 * I_SQ;
        { const int m = r / I_PL; p0_transpose_item(F_w_pool + (size_t)m * 65536, 256, 256, wpool_t + (size_t)m * 65536, r % I_PL, F.lane_()); }
    }
    GAS float* H = (GAS float*)(F.wsp() + WS_H); GAS bf16* XN = (GAS bf16*)(F.wsp() + WS_XN);
    for (int r = gw; r < MTOT; r += NGW) {
        GAS unsigned long long* rt = (GAS unsigned long long*)(F.wsp() + WS_RTAB) + r;
        if (r >= MP && r < MPAD) { zero_xn_row(XN + (size_t)r * D, F.lane_()); if (F.lane_() == 0) *rt = (unsigned long long)F_meta; continue; }
        const GAS float* src;
        if (r < MP) { const int b = r / LP, t = r - b * LP; src = (t < NMETA) ? F_meta + (size_t)t * D : F_xp + ((size_t)b * SEQ + (t - NMETA)) * D; }
        else src = F_xs + (size_t)(r - MPAD) * D;
        if (F.lane_() == 0) *rt = (unsigned long long)src;
        xn_row(src, nullptr, F_norm_g, XN + (size_t)r * D, F.lane_());
    }
    if (blockIdx.x == 0) { GAS float* lbp = (GAS float*)(F.wsp() + WS_LB);
        for (int i = F.tid_(); i < 1024; i += 512) { const float a = F_hlb[i], b = F_hlb[1024 + i], m = fmaxf(a, b), ea = expf(a - m), eb = expf(b - m), s = ea + eb; const float s0 = ea / s, s1 = eb / s;
            lbp[i] = s0 - s0; lbp[1024 + i] = (s0 + s1) - s0; } }
}
__device__ __forceinline__ void phase_xn(Frame& F, int l) {
    const int gw = F.vcu * 8 + F.wave, NGW = F.G * 8;
    GAS float* H = (GAS float*)(F.wsp() + WS_H); GAS bf16* XN = (GAS bf16*)(F.wsp() + WS_XN);
    for (int r = gw; r < MTOT; r += NGW) {
        if (r >= MP && r < MPAD) { zero_xn_row(XN + (size_t)r * D, F.lane_()); continue; }
        xn_row(H + (size_t)r * D, nullptr, F_norm_g + (size_t)l * D, XN + (size_t)r * D, F.lane_());
    }
}
namespace pg8 {
constexpr int BM = 256, BK = 64, HALF = 128, HTB = HALF * BK * 2, STAGE_BYTES = 8 * HTB, NXCD = 8;
__host__ __device__ __forceinline__ int lds_byte(int r, int c) { const int st = (r >> 4) * 2 + (c >> 5), rr = r & 15, cc = c & 31, ob = rr * 64 + cc * 2; return st * 1024 + (ob ^ (((ob >> 9) & 1) << 5)); }
__host__ __device__ __forceinline__ void stage_rc(int b, int& R, int& C) { const int st = b / 1024, sb = b % 1024, swz = sb ^ (((sb >> 9) & 1) << 5); R = (st >> 1) * 16 + swz / 64; C = (st & 1) * 32 + (swz % 64) / 2; }
__host__ __device__ __forceinline__ int perm32(int rho) { const int n = rho >> 4, i = rho & 15; return 8 * (i >> 2) + 4 * n + (i & 3); }

struct Unit { int pm, pn, seg, k0, nk, slab; };
struct Gemm { const GAS bf16* A; const GAS bf16* Bt; size_t a_seg, b_seg; int nM, nN, nseg, K, tail_parts, wgm; };

struct Order {
    int nM, nN, nwg, G, c, nseg, nt, tail, WGM;
    __device__ void init(const Gemm& g, int G_, int c_) { WGM = g.wgm; nM = g.nM; nN = g.nN; nwg = nM * nN; G = G_; c = c_; nseg = g.nseg; nt = g.K / BK;
        tail = (g.tail_parts > 0 && nwg > G && nwg <= 2 * G && (nwg - G) * g.tail_parts <= G && g.tail_parts % nseg == 0 && (nt % (2 * (g.tail_parts / nseg))) == 0) ? g.tail_parts : 0; }
    __device__ void tile_of(int L, int& pm, int& pn) const {
        int wgid = L; { const int q = nwg / NXCD, r = nwg % NXCD, xcd = wgid % NXCD, off = wgid / NXCD; wgid = (xcd < r ? xcd * (q + 1) : r * (q + 1) + (xcd - r) * q) + off; }
        const int nig = WGM * nN, gid = wgid / nig, fm = gid * WGM, gsz = (nM - fm) < WGM ? (nM - fm) : WGM;
        pm = fm + ((wgid % nig) % gsz); pn = (wgid % nig) / gsz; }
    template <int MODE> __device__ bool next(int i, Unit& u) const {
        u.k0 = 0; u.nk = nt; u.slab = -1;
        if (MODE == 0) {
            if (tail == 0) { const int ti = i / nseg; u.seg = i - ti * nseg; const long L = (long)ti * G + c; if (L >= nwg) return false; tile_of((int)L, u.pm, u.pn); return true; }
            if (i >= nseg) return false; u.seg = i; tile_of(c, u.pm, u.pn); return true; }
        if (tail == 0 || i > 0 || c >= (nwg - G) * tail) return false;
        const int j = c / tail, part = c - j * tail; tile_of(G + j, u.pm, u.pn); u.slab = c;
        { const int ks = tail / nseg; u.seg = part / ks; u.nk = nt / ks; u.k0 = (part - u.seg * ks) * u.nk; }
        return true;
    }
};

typedef f32x4 Acc[2][2][4][2];

template <class Epi, int MODE = 0>
__device__ __forceinline__ void gemm_phase(LAS unsigned char* lds, const Gemm g, const Order& S, const Epi& E, int wave_id) {
    const int wid = wave_id, lane = lane_id(), tid = wid * 64 + lane; const int wr = wid >> 2, wc = wid & 3, fr = lane & 15, fq = lane >> 4;
    const int K = g.K;
    unsigned voffA[2], voffB[2];
#pragma unroll
    for (int i = 0; i < 2; ++i) { int R, C; stage_rc(tid * 16 + i * 8192, R, C); const int Rb = (R & ~31) + perm32(R & 31);
        voffA[i] = (unsigned)(R * K + C) * 2u; voffB[i] = (unsigned)(Rb * K + C) * 2u; }
    const size_t kstep = (size_t)(BK * 2);
    const size_t hstep = (size_t)HALF * K * 2;
    const size_t tstep = 2 * hstep;
    const unsigned ldsw = (unsigned)wid * 1024u;
    const int aoff = lds_byte(wr * 64 + fr, fq * 8), boff = lds_byte(wc * 32 + fr, fq * 8);
#define PG8_SA(b, h) (((b) * 2 + (h)) * HTB)
#define PG8_SB(b, h) ((4 + (b) * 2 + (h)) * HTB)
#define PG8_STAGE(bufoff, gbase, voff) do { _Pragma("unroll") for (int _i = 0; _i < 2; ++_i) \
        __builtin_amdgcn_global_load_lds((const GAS unsigned*)((const GAS char*)(gbase) + (voff)[_i]), (LAS unsigned*)(lds + (bufoff) + ldsw + _i * 8192), 16, 0, 0); } while (0)
#define PG8_LDA(dst, b, h) do { _Pragma("unroll") for (int m = 0; m < 4; ++m) _Pragma("unroll") for (int k = 0; k < 2; ++k) dst[m][k] = *(const LAS bf16x8*)(lds + PG8_SA(b, h) + aoff + m * 2048 + k * 1024); } while (0)
#define PG8_LDB(dst, b, h) do { _Pragma("unroll") for (int n = 0; n < 2; ++n) _Pragma("unroll") for (int k = 0; k < 2; ++k) dst[n][k] = *(const LAS bf16x8*)(lds + PG8_SB(b, h) + boff + n * 2048 + k * 1024); } while (0)
#define PG8_MMA(ai, bj, At, Bt) do { __builtin_amdgcn_s_setprio(1); _Pragma("unroll") for (int m = 0; m < 4; ++m) _Pragma("unroll") for (int n = 0; n < 2; ++n) _Pragma("unroll") for (int k = 0; k < 2; ++k) \
        acc[ai][bj][m][n] = __builtin_amdgcn_mfma_f32_16x16x32_bf16(Bt[n][k], At[m][k], acc[ai][bj][m][n], 0, 0, 0); __builtin_amdgcn_s_setprio(0); } while (0)
#define PG8_WAIT_V(n) asm volatile("s_waitcnt vmcnt(" #n ")" ::: "memory")
#define PG8_WAIT_L(n) asm volatile("s_waitcnt lgkmcnt(" #n ")" ::: "memory")
#define PG8_BAR __builtin_amdgcn_s_barrier()
#define PG8_SCHED __builtin_amdgcn_sched_barrier(0)
    Unit cur, nxt; int ui = 0;
    if (!S.template next<MODE>(0, cur)) return;
    Acc acc;
#pragma unroll
    for (int a = 0; a < 2; ++a)
#pragma unroll
        for (int b = 0; b < 2; ++b)
#pragma unroll
            for (int m = 0; m < 4; ++m)
#pragma unroll
                for (int n = 0; n < 2; ++n) acc[a][b][m][n] = (f32x4){0.f, 0.f, 0.f, 0.f};
    bf16x8 At[4][2], B0[2][2], B1[2][2];
    const GAS char* cA = (const GAS char*)(g.A + (size_t)cur.seg * g.a_seg) + (size_t)cur.pm * tstep + (MODE ? (size_t)cur.k0 * kstep : 0); const GAS char* cB = (const GAS char*)(g.Bt + (size_t)cur.seg * g.b_seg) + (size_t)cur.pn * tstep + (MODE ? (size_t)cur.k0 * kstep : 0);
    PG8_STAGE(PG8_SB(0, 0), cB, voffB); PG8_STAGE(PG8_SB(0, 1), cB + hstep, voffB); PG8_STAGE(PG8_SA(0, 0), cA, voffA); PG8_STAGE(PG8_SA(0, 1), cA + hstep, voffA);
    if (wr == 1) PG8_BAR;
    PG8_WAIT_V(2); PG8_BAR;
    PG8_STAGE(PG8_SB(1, 0), cB + kstep, voffB); PG8_STAGE(PG8_SA(1, 0), cA + kstep, voffA); PG8_STAGE(PG8_SB(1, 1), cB + hstep + kstep, voffB);
    PG8_WAIT_V(6); PG8_BAR;
    for (;;) {
        const bool has_next = S.template next<MODE>(ui + 1, nxt);
        const GAS char* nA = has_next ? (const GAS char*)(g.A + (size_t)nxt.seg * g.a_seg) + (size_t)nxt.pm * tstep + (MODE ? (size_t)nxt.k0 * kstep : 0) : cA; const GAS char* nB = has_next ? (const GAS char*)(g.Bt + (size_t)nxt.seg * g.b_seg) + (size_t)nxt.pn * tstep + (MODE ? (size_t)nxt.k0 * kstep : 0) : cB;
        const int nt = MODE == 0 ? K / BK : cur.nk;
        for (int t = 0; t < nt; t += 2) {
            const bool last = (t == nt - 2);
            const GAS char* a1 = cA + (size_t)(t + 1) * kstep;
            const GAS char* a2 = last ? nA : cA + (size_t)(t + 2) * kstep; const GAS char* b2 = last ? nB : cB + (size_t)(t + 2) * kstep;
            const GAS char* a3 = a2 + kstep; const GAS char* b3 = b2 + kstep;
            PG8_LDB(B0, 0, 0); PG8_LDB(B1, 0, 1); PG8_SCHED; PG8_LDA(At, 0, 0); PG8_STAGE(PG8_SA(1, 1), a1 + hstep, voffA);
            PG8_WAIT_V(8); PG8_WAIT_L(0); PG8_BAR; PG8_MMA(0, 0, At, B0); PG8_MMA(0, 1, At, B1); PG8_BAR; PG8_SCHED;
            PG8_LDA(At, 0, 1); PG8_STAGE(PG8_SB(0, 0), b2, voffB); PG8_STAGE(PG8_SB(0, 1), b2 + hstep, voffB); PG8_STAGE(PG8_SA(0, 0), a2, voffA);
            PG8_WAIT_V(8); PG8_WAIT_L(0); PG8_BAR; PG8_MMA(1, 0, At, B0); PG8_MMA(1, 1, At, B1); PG8_BAR; PG8_SCHED;
            PG8_LDB(B0, 1, 0); PG8_LDB(B1, 1, 1); PG8_SCHED; PG8_LDA(At, 1, 0); PG8_STAGE(PG8_SA(0, 1), a2 + hstep, voffA);
            PG8_WAIT_V(8); PG8_WAIT_L(0); PG8_BAR; PG8_MMA(0, 0, At, B0); PG8_MMA(0, 1, At, B1); PG8_BAR; PG8_SCHED;
            PG8_LDA(At, 1, 1); PG8_STAGE(PG8_SB(1, 0), b3, voffB); PG8_STAGE(PG8_SB(1, 1), b3 + hstep, voffB); PG8_STAGE(PG8_SA(1, 0), a3, voffA);
            PG8_WAIT_V(8); PG8_WAIT_L(0); PG8_BAR; PG8_MMA(1, 0, At, B0); PG8_MMA(1, 1, At, B1); PG8_BAR; PG8_SCHED;
        }
        if (wr == 0) PG8_BAR;
        E(acc, cur, wr, wc, fr, fq, lds);
        if (!has_next) break;
        if (MODE == 1 || cur.seg == g.nseg - 1) {
#pragma unroll
            for (int a = 0; a < 2; ++a)
#pragma unroll
                for (int b = 0; b < 2; ++b)
#pragma unroll
                    for (int m = 0; m < 4; ++m)
#pragma unroll
                        for (int n = 0; n < 2; ++n) acc[a][b][m][n] = (f32x4){0.f, 0.f, 0.f, 0.f};
        }
        cur = nxt; cA = nA; cB = nB; ++ui;
        if (wr == 1) PG8_BAR;
    }
    PG8_WAIT_V(0);
    PG8_BAR;
#undef PG8_SA
#undef PG8_SB
#undef PG8_STAGE
#undef PG8_LDA
#undef PG8_LDB
#undef PG8_MMA
#undef PG8_WAIT_V
#undef PG8_WAIT_L
#undef PG8_BAR
#undef PG8_SCHED
}

typedef _Float16 h16x2 __attribute__((ext_vector_type(2)));
__device__ __forceinline__ unsigned cvt_pk_f16(float a, float b) { const f32x2 t = {a, b}; return __builtin_bit_cast(unsigned, __builtin_convertvector(t, h16x2)); }
__device__ __forceinline__ v4u pack8h(const f32x4 a, const f32x4 b) { v4u w; w.x = cvt_pk_f16(a[0], a[1]); w.y = cvt_pk_f16(a[2], a[3]); w.z = cvt_pk_f16(b[0], b[1]); w.w = cvt_pk_f16(b[2], b[3]); return w; }
#define EPI_FOR_ROWS for (int ai = 0; ai < 2; ++ai) _Pragma("unroll") for (int m = 0; m < 4; ++m)
__device__ __forceinline__ v4u pack8(const f32x4 a, const f32x4 b) { v4u w; w.x = cvt_pk_bf16(a[0], a[1]); w.y = cvt_pk_bf16(a[2], a[3]); w.z = cvt_pk_bf16(b[0], b[1]); w.w = cvt_pk_bf16(b[2], b[3]); return w; }

#define NT_ST(p, v) __builtin_nontemporal_store((v), (p))
struct EpiProj {
    int layer; GAS unsigned char* ws; GAS float* out; const GAS float* qng; const GAS float* kng; const GAS float* lb;
    __device__ __forceinline__ void operator()(Acc& acc, const Unit& u, int wr, int wc, int fr, int fq, LAS unsigned char* lds) const {
        const int grp = u.pn >> 2, ct = u.pn & 3;
        const int row0 = u.pm * BM + wr * 64 + fr;
        const int cg0 = ct * 256 + wc * 32 + 8 * fq;
        const bool sample = u.pm >= MPAD / 256;
        if (grp == 2 || grp == 3) {
            LAS float* X = (LAS float*)(lds + LDS_XCH);
#pragma unroll
            EPI_FOR_ROWS {
#pragma unroll
                for (int bj = 0; bj < 2; ++bj) { const f32x4 a = acc[ai][bj][m][0], b = acc[ai][bj][m][1];
                    float s = (a[0] * a[0] + a[1] * a[1]) + (a[2] * a[2] + a[3] * a[3]) + (b[0] * b[0] + b[1] * b[1]) + (b[2] * b[2] + b[3] * b[3]);
                    s += __shfl_xor(s, 16); s += __shfl_xor(s, 32);
                    if (fq == 0) X[(ai * 128 + wr * 64 + m * 16 + fr) * 8 + bj * 4 + wc] = s; } }
            LDS_WAIT(); __builtin_amdgcn_s_barrier(); asm volatile("" ::: "memory");
            const GAS float* gv = (grp == 2 ? qng : kng) + wc * 32 + 8 * fq; const float qs = (grp == 2) ? SB_SCALE * LOG2E : 1.0f;
            const f32x4 g0 = *(const GAS f32x4*)gv * qs, g1 = *(const GAS f32x4*)(gv + 4) * qs;
            GAS bf16* qdst = (GAS bf16*)(ws + WS_Q);
            GAS float* kdst = sample ? out + O_KS + (size_t)layer * MS * 1024 - (size_t)MPAD * 1024 : out + O_KP + (size_t)layer * MP * 1024;
#pragma unroll
            EPI_FOR_ROWS { const int row = row0 + ai * 128 + m * 16;
#pragma unroll
                for (int bj = 0; bj < 2; ++bj) { const f32x4 p = *(const LAS f32x4*)(X + (ai * 128 + wr * 64 + m * 16 + fr) * 8 + bj * 4);
                    const float rs = frsq(((p[0] + p[1]) + (p[2] + p[3])) * (1.0f / 128.0f) + EPS);
                    const f32x4 a = acc[ai][bj][m][0] * rs * g0, b = acc[ai][bj][m][1] * rs * g1; const int col = cg0 + bj * 128;
                    if (grp == 2) NT_ST((GAS v4u*)(qdst + (size_t)row * 1024 + col), pack8(a, b));
                    else if (sample || row < MP) { GAS float* d = kdst + (size_t)row * 1024 + col; NT_ST((GAS f32x4*)d, a); NT_ST((GAS f32x4*)(d + 4), b); } } }
            return;
        }
        if (grp == 4) {
            GAS float* vdst = sample ? out + O_VS + (size_t)layer * MS * 1024 - (size_t)MPAD * 1024 : out + O_VP + (size_t)layer * MP * 1024;
#pragma unroll
            EPI_FOR_ROWS { const int row = row0 + ai * 128 + m * 16;
                if (sample || row < MP) {
#pragma unroll
                    for (int bj = 0; bj < 2; ++bj) { GAS float* d = vdst + (size_t)row * 1024 + cg0 + bj * 128; NT_ST((GAS f32x4*)d, acc[ai][bj][m][0]); NT_ST((GAS f32x4*)(d + 4), acc[ai][bj][m][1]); } } }
            return;
        }
        if (grp == 6) {
            GAS _Float16* lf = (GAS _Float16*)(ws + WS_LOGF); GAS bf16* kc = (GAS bf16*)(ws + WS_KC);
#pragma unroll
            for (int bj = 0; bj < 2; ++bj) { const int col = cg0 + bj * 128; const f32x4 l0 = *(const GAS f32x4*)(lb + col), l1 = *(const GAS f32x4*)(lb + col + 4);
#pragma unroll
                EPI_FOR_ROWS { const int row = row0 + ai * 128 + m * 16; f32x4 z[2] = {acc[ai][bj][m][0], acc[ai][bj][m][1]}; f32x4 lo[2], ko[2];
#pragma unroll
                    for (int n = 0; n < 2; ++n)
#pragma unroll
                        for (int j = 0; j < 4; ++j) { const float zz = z[n][j], l = n ? l1[j] : l0[j], e = fexp2(-fabsf(zz) * LOG2E), r = frcp(1.0f + e), er = e * r;
                            const float sp = zz >= 0.f ? r : er, sn = zz >= 0.f ? er : r, oml = 1.0f - l;
                            lo[n][j] = flog2(l + oml * sp); ko[n][j] = oml * sn; }
                    NT_ST((GAS v4u*)(lf + (size_t)row * 1024 + col), pack8h(lo[0], lo[1]));
                    NT_ST((GAS v4u*)(kc + (size_t)row * 1024 + col), pack8(ko[0], ko[1])); } }
            return;
        }
        size_t off; int act;
        switch (grp) {
            case 0: off = WS_UA; act = 0; break;   case 1: off = WS_SGA; act = 1; break;  case 5: off = WS_SGB; act = 1; break;
            case 7: off = WS_QC; act = 1; break;   case 8: off = WS_IC; act = 0; break;   case 9: off = WS_SGC; act = 1; break;
            default: off = WS_GATE + (size_t)(grp - 10) * RB16; act = 2; break;
        }
        GAS bf16* dst = (GAS bf16*)(ws + off);
#pragma unroll
        EPI_FOR_ROWS { const int row = row0 + ai * 128 + m * 16;
#pragma unroll
            for (int bj = 0; bj < 2; ++bj) { f32x4 a = acc[ai][bj][m][0], b = acc[ai][bj][m][1];
                if (act) {
#pragma unroll
                    for (int j = 0; j < 4; ++j) { const float sa = fsigmoid(a[j]), sb = fsigmoid(b[j]);
                        a[j] = act == 1 ? a[j] * sa : fmaxf(sa, 1e-30f); b[j] = act == 1 ? b[j] * sb : fmaxf(sb, 1e-30f); } }
                NT_ST((GAS v4u*)(dst + (size_t)row * 1024 + cg0 + bj * 128), pack8(a, b)); } }
        if (grp == 0) {
#pragma unroll
            EPI_FOR_ROWS { const int row = row0 + ai * 128 + m * 16; GAS float* d = nullptr;
                if (sample) { const int rr = row - MPAD, b = rr >> 6, i = rr & 63; if (i >= DSEQ - 15) d = out + O_PS + (((size_t)layer * DBATCH + b) * 15 + (i - (DSEQ - 15))) * 1024; }
                else if (row < MP) { const int b = row / LP, t = row - b * LP; if (t >= LP - 15) d = out + O_PP + (((size_t)layer * BATCH + b) * 15 + (t - (LP - 15))) * 1024; }
                if (d) {
#pragma unroll
                    for (int bj = 0; bj < 2; ++bj) { GAS float* dd = d + cg0 + bj * 128; NT_ST((GAS f32x4*)dd, acc[ai][bj][m][0]); NT_ST((GAS f32x4*)(dd + 4), acc[ai][bj][m][1]); } } }
        }
    }
};

struct EpiMerge {
    GAS unsigned char* ws;
    __device__ __forceinline__ void operator()(Acc& acc, const Unit& u, int wr, int wc, int fr, int fq, LAS unsigned char* lds) const {
        const int row0 = u.pm * BM + wr * 64 + fr, c0 = u.pn * BM + wc * 32 + 8 * fq;
        const GAS bf16* G0 = (const GAS bf16*)(ws + WS_GATE) + (size_t)u.seg * MTOT * 1024; const GAS bf16* G1 = G0 + (size_t)MTOT * 1024; GAS bf16* dst = (GAS bf16*)(ws + WS_MERGED);
        const bool fin = u.seg == 2;
#pragma unroll
        for (int ai = 0; ai < 2; ++ai)
#pragma unroll
        for (int mh = 0; mh < 2; ++mh) {
            v4u ga[2][2], gb[2][2];
#pragma unroll
            for (int mm = 0; mm < 2; ++mm)
#pragma unroll
                for (int bj = 0; bj < 2; ++bj) { const size_t ro = (size_t)(row0 + ai * 128 + (2 * mh + mm) * 16) * 1024 + c0 + bj * 128; ga[mm][bj] = *(const GAS v4u*)(G0 + ro); gb[mm][bj] = fin ? ga[mm][bj] : *(const GAS v4u*)(G1 + ro); }
#pragma unroll
            for (int mm = 0; mm < 2; ++mm)
#pragma unroll
                for (int bj = 0; bj < 2; ++bj) { const int m = 2 * mh + mm; const v4u x = ga[mm][bj], y = gb[mm][bj];
                    f32x4 fa0 = {bf_lo(x.x), bf_hi(x.x), bf_lo(x.y), bf_hi(x.y)}, fa1 = {bf_lo(x.z), bf_hi(x.z), bf_lo(x.w), bf_hi(x.w)};
                    if (!fin) { const f32x4 fb0 = {bf_lo(y.x), bf_hi(y.x), bf_lo(y.y), bf_hi(y.y)}, fb1 = {bf_lo(y.z), bf_hi(y.z), bf_lo(y.w), bf_hi(y.w)};
#pragma unroll
                        for (int j = 0; j < 4; ++j) { fa0[j] *= frcp(fb0[j]); fa1[j] *= frcp(fb1[j]); } }
                    acc[ai][bj][m][0] *= fa0; acc[ai][bj][m][1] *= fa1;
                    if (fin) *(GAS v4u*)(dst + (size_t)(row0 + ai * 128 + m * 16) * 1024 + c0 + bj * 128) = pack8(acc[ai][bj][m][0], acc[ai][bj][m][1]); }
        }
    }
};

struct EpiOut {
    GAS unsigned char* ws; GAS float* out; int last, first;
    __device__ __forceinline__ void operator()(Acc& acc, const Unit& u, int wr, int wc, int fr, int fq, LAS unsigned char* lds) const {
        const int row0 = u.pm * BM + wr * 64 + fr, c0 = u.pn * BM + wc * 32 + 8 * fq; GAS float* H = (GAS float*)(ws + WS_H); const GAS unsigned long long* RT = (const GAS unsigned long long*)(ws + WS_RTAB);
        const bool sample = u.pm >= MPAD / 256;
#pragma unroll
        for (int ai = 0; ai < 2; ++ai) {
            f32x4 hv[4][2][2];
#pragma unroll
            for (int m = 0; m < 4; ++m) { const int rw = row0 + ai * 128 + m * 16; const GAS float* hp = (first ? (const GAS float*)RT[rw] : H + (size_t)rw * 1024) + c0;
#pragma unroll
                for (int bj = 0; bj < 2; ++bj) { hv[m][bj][0] = *(const GAS f32x4*)(hp + bj * 128); hv[m][bj][1] = *(const GAS f32x4*)(hp + bj * 128 + 4); } }
#pragma unroll
            for (int m = 0; m < 4; ++m) { const int row = row0 + ai * 128 + m * 16; GAS float* dp = H + (size_t)row * 1024 + c0; bool ok = true;
                if (last) { if (sample) dp = out + O_YS + (size_t)(row - MPAD) * 1024 + c0;
                    else { const int b = row / LP, t = row - b * LP; ok = row < MP && t >= NMETA; dp = out + O_YP + ((size_t)b * SEQ + (t - NMETA)) * 1024 + c0; } }
                if (ok) {
#pragma unroll
                    for (int bj = 0; bj < 2; ++bj) { *(GAS f32x4*)(dp + bj * 128) = hv[m][bj][0] + acc[ai][bj][m][0]; *(GAS f32x4*)(dp + bj * 128 + 4) = hv[m][bj][1] + acc[ai][bj][m][1]; } } }
        }
    }
};
struct EpiMergeSlab {
    GAS unsigned char* ws;
    __device__ __forceinline__ void operator()(Acc& acc, const Unit& u, int wr, int wc, int fr, int fq, LAS unsigned char* lds) const {
        const int row0 = u.pm * BM + wr * 64 + fr, c0 = u.pn * BM + wc * 32 + 8 * fq;
        const GAS bf16* G0 = (const GAS bf16*)(ws + WS_GATE) + (size_t)u.seg * MTOT * 1024;
        {
            GAS float* sl = (GAS float*)(ws + WS_SLAB_M) + (size_t)u.slab * 65536 + (size_t)(wr * 64 + fr) * 256 + wc * 32 + 8 * fq;
#pragma unroll
            for (int ai = 0; ai < 2; ++ai) { v4u ga[4][2];
#pragma unroll
                for (int m = 0; m < 4; ++m)
#pragma unroll
                    for (int bj = 0; bj < 2; ++bj) ga[m][bj] = *(const GAS v4u*)(G0 + (size_t)(row0 + ai * 128 + m * 16) * 1024 + c0 + bj * 128);
#pragma unroll
                for (int m = 0; m < 4; ++m)
#pragma unroll
                    for (int bj = 0; bj < 2; ++bj) { const v4u x = ga[m][bj]; const f32x4 f0 = {bf_lo(x.x), bf_hi(x.x), bf_lo(x.y), bf_hi(x.y)}, f1 = {bf_lo(x.z), bf_hi(x.z), bf_lo(x.w), bf_hi(x.w)};
                        GAS float* d = sl + (size_t)(ai * 128 + m * 16) * 256 + bj * 128; *(GAS f32x4*)d = acc[ai][bj][m][0] * f0; *(GAS f32x4*)(d + 4) = acc[ai][bj][m][1] * f1; } }
        }
    }
};
struct EpiOutSlab {
    GAS unsigned char* ws;
    __device__ __forceinline__ void operator()(Acc& acc, const Unit& u, int wr, int wc, int fr, int fq, LAS unsigned char* lds) const {
        {
            GAS float* sl = (GAS float*)(ws + WS_SLAB_O) + (size_t)u.slab * 65536 + (size_t)(wr * 64 + fr) * 256 + wc * 32 + 8 * fq;
#pragma unroll
            for (int ai = 0; ai < 2; ++ai)
#pragma unroll
                for (int m = 0; m < 4; ++m)
#pragma unroll
                    for (int bj = 0; bj < 2; ++bj) { GAS float* d = sl + (size_t)(ai * 128 + m * 16) * 256 + bj * 128; *(GAS f32x4*)d = acc[ai][bj][m][0]; *(GAS f32x4*)(d + 4) = acc[ai][bj][m][1]; }
        }
    }
};
}
__device__ __forceinline__ f32x16 mfma32(bf16x8 a, bf16x8 b, f32x16 c) { return __builtin_amdgcn_mfma_f32_32x32x16_bf16(a, b, c, 0, 0, 0); }
__device__ __forceinline__ f32x16 zero16() { f32x16 z;
#pragma unroll
    for (int i = 0; i < 16; ++i) z[i] = 0.f; return z; }
__device__ __forceinline__ bf16x8 cvt8(const f32x4 a, const f32x4 b) { const v4u w = pg8::pack8(a, b); return __builtin_bit_cast(bf16x8, w); }

namespace hg {
constexpr int P136 = 136, P72 = 72;
constexpr int L_QS = 0, L_QT = L_QS + 64 * P136 * 2, L_KT = L_QT + 64 * P136 * 2, L_KTT = L_KT + 64 * P136 * 2, L_VT = L_KTT + 128 * P72 * 2,
              L_ATT = L_VT + 128 * P72 * 2, L_ST = L_ATT + 64 * P72 * 2, L_SEG = L_ST + 128 * P136 * 2, L_EV = L_SEG + 8 * 128 * 4, L_PART = L_EV + 2 * 128 * 4, L_GN = L_PART + 64 * 4 * 4, L_END = L_GN + 128 * 4;
static_assert(L_END <= LDS_MISC, "hgrn LDS");
struct Pre { unsigned lf[8]; unsigned q[8], k[8], v[8]; v2u sg[4]; };
#define HG_BAR() do { asm volatile("s_waitcnt lgkmcnt(0)" ::: "memory"); __builtin_amdgcn_s_barrier(); asm volatile("" ::: "memory"); } while (0)

template <int PART>
__device__ __forceinline__ void prefetch(Pre& P, const GAS unsigned char* ws, size_t row0, int nvalid, int seg, int colb  , int trow  , int sgcol  ) {
    const GAS _Float16* LF = (const GAS _Float16*)(ws + WS_LOGF) + row0 * 1024; const GAS bf16* QC = (const GAS bf16*)(ws + WS_QC) + row0 * 1024; const GAS bf16* KC = (const GAS bf16*)(ws + WS_KC) + row0 * 1024; const GAS bf16* IC = (const GAS bf16*)(ws + WS_IC) + row0 * 1024;
    if (PART & 2) { const GAS bf16* SGC = (const GAS bf16*)(ws + WS_SGC) + row0 * 1024; const unsigned so = (unsigned)((trow < nvalid ? trow : 0) * 1024 + sgcol);
#pragma unroll
      for (int g = 0; g < 4; ++g) P.sg[g] = *(const GAS v2u*)(SGC + so + 8 * g); }
    if (nvalid == 64) {
#pragma unroll
        for (int i = 0; i < 8; ++i) { const unsigned o = (unsigned)((seg * 8 + i) * 1024 + colb);
            if (PART & 1) P.lf[i] = *(const GAS unsigned*)(LF + o);
            if (PART & 2) { P.q[i] = *(const GAS unsigned*)(QC + o); P.k[i] = *(const GAS unsigned*)(KC + o); P.v[i] = *(const GAS unsigned*)(IC + o); } }
    } else {
#pragma unroll
        for (int i = 0; i < 8; ++i) { const int t = seg * 8 + i; const unsigned o = (unsigned)(t * 1024 + colb);
            if (t < nvalid) { if (PART & 1) P.lf[i] = *(const GAS unsigned*)(LF + o); if (PART & 2) { P.q[i] = *(const GAS unsigned*)(QC + o); P.k[i] = *(const GAS unsigned*)(KC + o); P.v[i] = *(const GAS unsigned*)(IC + o); } }
            else { if (PART & 1) P.lf[i] = 0u; if (PART & 2) { P.q[i] = 0u; P.k[i] = 0u; P.v[i] = 0u; } } }
    }
}

__device__ __forceinline__ void chain(Frame& F, int layer, bool sample, int b, int h) {
    LAS unsigned char* lds = F.lds; int tid = F.tid_(); asm volatile("" : "+v"(tid));
    const int lane = tid & 63, wave = F.wave, seg = wave; int kp = tid & 63, l31 = lane & 31, hh = lane >> 5;
    const int L = sample ? DSEQ : LP, nchunks = (L + 63) / 64;
    const size_t rowbase = sample ? (size_t)MPAD + (size_t)b * DSEQ : (size_t)b * LP;
    const int colb = h * 128 + 2 * kp;
    GAS bf16* YC = (GAS bf16*)(F.wsp() + WS_Y) + (size_t)2 * MTOT * 1024;
    const int kb = wave >> 1, vb0 = 2 * (wave & 1);
    f32x16 S[2];
    if (sample) { const GAS float* s0 = F_state_hgrn + (((size_t)layer * DBATCH + b) * 8 + h) * 16384;
#pragma unroll
        for (int vbi = 0; vbi < 2; ++vbi)
#pragma unroll
            for (int r = 0; r < 16; ++r) S[vbi][r] = s0[(size_t)(32 * kb + (r & 3) + 8 * (r >> 2) + 4 * hh) * 128 + 32 * (vb0 + vbi) + l31]; }
    else { S[0] = zero16(); S[1] = zero16(); }
#pragma unroll
    for (int vbi = 0; vbi < 2; ++vbi)
#pragma unroll
        for (int g = 0; g < 4; ++g) { v2u w; w.x = cvt_pk_bf16(S[vbi][4 * g], S[vbi][4 * g + 1]); w.y = cvt_pk_bf16(S[vbi][4 * g + 2], S[vbi][4 * g + 3]);
            *(LAS v2u*)(lds + L_ST + ((32 * (vb0 + vbi) + l31) * P136 + 32 * kb + 8 * g + 4 * hh) * 2) = w; }
    const int ovb = wave & 3, otb = wave >> 2;
    if (tid < 128) *(LAS float*)(lds + L_GN + tid * 4) = F_hng[layer * 128 + tid];
    Pre P; prefetch<3>(P, F.wsp(), rowbase, min(64, L), seg, colb, 32 * otb + l31, h * 128 + 32 * ovb + 4 * hh);
    for (int c = 0; c < nchunks; ++c) {
        asm volatile("" : "+v"(l31), "+v"(hh), "+v"(kp));
        const int nvalid = min(64, L - 64 * c); const size_t row0 = rowbase + (size_t)64 * c;
        float c0[8], c1[8]; { float a0 = 0.f, a1 = 0.f;
#pragma unroll
            for (int i = 0; i < 8; ++i) { const pg8::h16x2 hv = __builtin_bit_cast(pg8::h16x2, P.lf[i]); a0 += (float)hv.x; a1 += (float)hv.y; c0[i] = a0; c1[i] = a1; }
            *(LAS f32x2*)(lds + L_SEG + (seg * 128 + 2 * kp) * 4) = (f32x2){a0, a1}; }
        if (c + 1 < nchunks) prefetch<1>(P, F.wsp(), rowbase + (size_t)64 * (c + 1), min(64, L - 64 * (c + 1)), seg, colb, 32 * otb + l31, h * 128 + 32 * ovb + 4 * hh);
        HG_BAR();
        float off0 = 0.f, off1 = 0.f, m0 = 0.f, m1 = 0.f, la0 = 0.f, la1 = 0.f;
#pragma unroll
        for (int s = 0; s < 8; ++s) { const f32x2 tt = *(const LAS f32x2*)(lds + L_SEG + (s * 128 + 2 * kp) * 4);
            if (s < seg) { off0 += tt.x; off1 += tt.y; } if (s < 4) { m0 += tt.x; m1 += tt.y; } la0 += tt.x; la1 += tt.y; }
        unsigned ktt0[8], ktt1[8], vt0[8], vt1[8]; const float e2m0 = fexp2(m0), e2m1 = fexp2(m1);
#pragma unroll
        for (int i = 0; i < 8; ++i) { const int t = seg * 8 + i; const float cu0 = off0 + c0[i], cu1 = off1 + c1[i];
            const float q0 = bf_lo(P.q[i]), q1 = bf_hi(P.q[i]), k0 = bf_lo(P.k[i]), k1 = bf_hi(P.k[i]);
            const float em0 = fexp2(cu0 - m0), em1 = fexp2(cu1 - m1), ek0 = fexp2(m0 - cu0), ek1 = fexp2(m1 - cu1), eq0 = em0 * e2m0, eq1 = em1 * e2m1;
            *(LAS unsigned*)(lds + L_QS + (t * P136 + 2 * kp) * 2) = cvt_pk_bf16(q0 * eq0, q1 * eq1);
            *(LAS unsigned*)(lds + L_QT + (t * P136 + 2 * kp) * 2) = cvt_pk_bf16(q0 * em0, q1 * em1);
            const unsigned kt = cvt_pk_bf16(k0 * ek0, k1 * ek1);
            *(LAS unsigned*)(lds + L_KT + (t * P136 + 2 * kp) * 2) = kt;
            ktt0[i] = kt & 0xffffu; ktt1[i] = kt >> 16; vt0[i] = P.v[i] & 0xffffu; vt1[i] = P.v[i] >> 16; }
        { v4u w; w.x = ktt0[0] | (ktt0[1] << 16); w.y = ktt0[2] | (ktt0[3] << 16); w.z = ktt0[4] | (ktt0[5] << 16); w.w = ktt0[6] | (ktt0[7] << 16);
          *(LAS v4u*)(lds + L_KTT + ((2 * kp) * P72 + 8 * seg) * 2) = w;
          w.x = ktt1[0] | (ktt1[1] << 16); w.y = ktt1[2] | (ktt1[3] << 16); w.z = ktt1[4] | (ktt1[5] << 16); w.w = ktt1[6] | (ktt1[7] << 16);
          *(LAS v4u*)(lds + L_KTT + ((2 * kp + 1) * P72 + 8 * seg) * 2) = w;
          w.x = vt0[0] | (vt0[1] << 16); w.y = vt0[2] | (vt0[3] << 16); w.z = vt0[4] | (vt0[5] << 16); w.w = vt0[6] | (vt0[7] << 16);
          *(LAS v4u*)(lds + L_VT + ((2 * kp) * P72 + 8 * seg) * 2) = w;
          w.x = vt1[0] | (vt1[1] << 16); w.y = vt1[2] | (vt1[3] << 16); w.z = vt1[4] | (vt1[5] << 16); w.w = vt1[6] | (vt1[7] << 16);
          *(LAS v4u*)(lds + L_VT + ((2 * kp + 1) * P72 + 8 * seg) * 2) = w; }
        if (seg == 0) { *(LAS f32x2*)(lds + L_EV + (2 * kp) * 4) = (f32x2){fexp2(la0), fexp2(la1)}; *(LAS f32x2*)(lds + L_EV + (128 + 2 * kp) * 4) = (f32x2){fexp2(la0 - m0), fexp2(la1 - m1)}; }
        v2u sg[4] = {P.sg[0], P.sg[1], P.sg[2], P.sg[3]};
        if (c + 1 < nchunks) prefetch<2>(P, F.wsp(), rowbase + (size_t)64 * (c + 1), min(64, L - 64 * (c + 1)), seg, colb, 32 * otb + l31, h * 128 + 32 * ovb + 4 * hh);
        HG_BAR();
        if (wave < 3) { const int sb = wave == 2 ? 1 : 0, tb = wave == 0 ? 0 : 1; f32x16 a = zero16();
#pragma unroll
            for (int st = 0; st < 8; ++st) { const bf16x8 ka = *(const LAS bf16x8*)(lds + L_KT + ((32 * sb + l31) * P136 + 16 * st + 8 * hh) * 2);
                const bf16x8 qb = *(const LAS bf16x8*)(lds + L_QT + ((32 * tb + l31) * P136 + 16 * st + 8 * hh) * 2); a = mfma32(ka, qb, a); }
            const int t = 32 * tb + l31;
#pragma unroll
            for (int g = 0; g < 4; ++g) { const int s0 = 32 * sb + 8 * g + 4 * hh; float x[4];
#pragma unroll
                for (int j = 0; j < 4; ++j) x[j] = (s0 + j <= t) ? a[4 * g + j] : 0.f;
                v2u w; w.x = cvt_pk_bf16(x[0], x[1]); w.y = cvt_pk_bf16(x[2], x[3]); *(LAS v2u*)(lds + L_ATT + (t * P72 + s0) * 2) = w; } }
        HG_BAR();
        f32x16 o = zero16();
#pragma unroll
        for (int st = 0; st < 8; ++st) { const bf16x8 sa = *(const LAS bf16x8*)(lds + L_ST + ((32 * ovb + l31) * P136 + 16 * st + 8 * hh) * 2);
            const bf16x8 qb = *(const LAS bf16x8*)(lds + L_QS + ((32 * otb + l31) * P136 + 16 * st + 8 * hh) * 2); o = mfma32(sa, qb, o); }
        for (int st = 0; st < 2 + 2 * otb; ++st) { const bf16x8 va = *(const LAS bf16x8*)(lds + L_VT + ((32 * ovb + l31) * P72 + 16 * st + 8 * hh) * 2);
            const bf16x8 ab = *(const LAS bf16x8*)(lds + L_ATT + ((32 * otb + l31) * P72 + 16 * st + 8 * hh) * 2); o = mfma32(va, ab, o); }
        { float ss = 0.f;
#pragma unroll
            for (int r = 0; r < 16; ++r) ss += o[r] * o[r];
            ss += __shfl_xor(ss, 32);
            if (hh == 0) *(LAS float*)(lds + L_PART + ((32 * otb + l31) * 4 + ovb) * 4) = ss; }
        HG_BAR();
        { const f32x4 p = *(const LAS f32x4*)(lds + L_PART + (32 * otb + l31) * 16); const float rs = frsq(((p[0] + p[1]) + (p[2] + p[3])) * (1.0f / 128.0f) + EPS);
          const int t = 32 * otb + l31;
          if (t < nvalid) { GAS bf16* yp = YC + (row0 + t) * 1024 + h * 128 + 32 * ovb + 4 * hh;
#pragma unroll
              for (int g = 0; g < 4; ++g) { const f32x4 gng = *(const LAS f32x4*)(lds + L_GN + (32 * ovb + 8 * g + 4 * hh) * 4); const float y0 = o[4 * g] * rs * gng[0] * bf_lo(sg[g].x), y1 = o[4 * g + 1] * rs * gng[1] * bf_hi(sg[g].x),
                                                        y2 = o[4 * g + 2] * rs * gng[2] * bf_lo(sg[g].y), y3 = o[4 * g + 3] * rs * gng[3] * bf_hi(sg[g].y);
                  v2u w; w.x = cvt_pk_bf16(y0, y1); w.y = cvt_pk_bf16(y2, y3); *(GAS v2u*)(yp + 8 * g) = w; } } }
        f32x16 Pn[2] = {zero16(), zero16()};
#pragma unroll
        for (int st = 0; st < 4; ++st) { const bf16x8 ka = *(const LAS bf16x8*)(lds + L_KTT + ((32 * kb + l31) * P72 + 16 * st + 8 * hh) * 2);
#pragma unroll
            for (int vbi = 0; vbi < 2; ++vbi) { const bf16x8 vbf = *(const LAS bf16x8*)(lds + L_VT + ((32 * (vb0 + vbi) + l31) * P72 + 16 * st + 8 * hh) * 2); Pn[vbi] = mfma32(ka, vbf, Pn[vbi]); } }
#pragma unroll
        for (int g = 0; g < 4; ++g) { const f32x4 el = *(const LAS f32x4*)(lds + L_EV + (32 * kb + 8 * g + 4 * hh) * 4), elm = *(const LAS f32x4*)(lds + L_EV + (128 + 32 * kb + 8 * g + 4 * hh) * 4);
#pragma unroll
            for (int vbi = 0; vbi < 2; ++vbi) {
#pragma unroll
                for (int j = 0; j < 4; ++j) S[vbi][4 * g + j] = el[j] * S[vbi][4 * g + j] + elm[j] * Pn[vbi][4 * g + j];
                v2u w; w.x = cvt_pk_bf16(S[vbi][4 * g], S[vbi][4 * g + 1]); w.y = cvt_pk_bf16(S[vbi][4 * g + 2], S[vbi][4 * g + 3]);
                *(LAS v2u*)(lds + L_ST + ((32 * (vb0 + vbi) + l31) * P136 + 32 * kb + 8 * g + 4 * hh) * 2) = w; } }
    }
    GAS float* sf = sample ? F.outp() + O_HS + (((size_t)layer * DBATCH + b) * 8 + h) * 16384 : F.outp() + O_HP + (((size_t)layer * BATCH + b) * 8 + h) * 16384;
#pragma unroll
    for (int vbi = 0; vbi < 2; ++vbi)
#pragma unroll
        for (int r = 0; r < 16; ++r) sf[(size_t)(32 * kb + (r & 3) + 8 * (r >> 2) + 4 * hh) * 128 + 32 * (vb0 + vbi) + l31] = S[vbi][r];
    HG_BAR();
}
}

namespace sb {
constexpr float R_STOP = -136.0f;
constexpr int KROW = 272, SLOT = 32 * KROW + 128 * 64;
static_assert(8 * SLOT + 64 <= LDS_MISC, "attention LDS");
constexpr int L_DONE = 8 * SLOT;
struct Grp { const GAS float* k_old; const GAS float* v_old; const GAS float* k_new; const GAS float* v_new; };

struct TileRegs { f32x4 k0, k1, v0, v1; };
__device__ __forceinline__ void tile_issue(TileRegs& t, const Grp& g, int kt, int past, int L, int c, int rp, int sh) {
    const int s0 = 32 * kt - sh; const bool old = s0 + sh < past; const int rl = old ? 31 : (L - 1 - (s0 - past)), lo = s0 < 0 ? -s0 : 0;
    const GAS float* kb = old ? g.k_old + (ptrdiff_t)s0 * 1024 : g.k_new + (ptrdiff_t)(s0 - past) * 1024; const GAS float* vb = old ? g.v_old + (ptrdiff_t)s0 * 1024 : g.v_new + (ptrdiff_t)(s0 - past) * 1024;
    if (rl >= 31 && lo == 0) {
        const unsigned o = (unsigned)(2 * rp * 1024 + 4 * c);
        t.k0 = *(const GAS f32x4*)(kb + o); t.k1 = *(const GAS f32x4*)(kb + o + 1024); t.v0 = *(const GAS f32x4*)(vb + o); t.v1 = *(const GAS f32x4*)(vb + o + 1024);
        return; }
    const int r0 = max(min(2 * rp, rl), lo), r1 = max(min(2 * rp + 1, rl), lo);
    t.k0 = *(const GAS f32x4*)(kb + (ptrdiff_t)r0 * 1024 + 4 * c); t.k1 = *(const GAS f32x4*)(kb + (ptrdiff_t)r1 * 1024 + 4 * c);
    t.v0 = *(const GAS f32x4*)(vb + (ptrdiff_t)r0 * 1024 + 4 * c); t.v1 = *(const GAS f32x4*)(vb + (ptrdiff_t)r1 * 1024 + 4 * c);
}
__device__ __forceinline__ void tile_commit(const TileRegs& t, LAS unsigned char* slot, int c, int rp) {
    v2u a; a.x = cvt_pk_bf16(t.k0[0], t.k0[1]); a.y = cvt_pk_bf16(t.k0[2], t.k0[3]); *(LAS v2u*)(slot + (2 * rp) * KROW + 8 * c) = a;
    a.x = cvt_pk_bf16(t.k1[0], t.k1[1]); a.y = cvt_pk_bf16(t.k1[2], t.k1[3]); *(LAS v2u*)(slot + (2 * rp + 1) * KROW + 8 * c) = a;
    LAS unsigned char* vt = slot + 32 * KROW; const int r7 = rp & 7, f = 2 * (rp >> 3) + ((r7 >> 1) & 1);
    const int u = ((f ^ (c & 3)) * 16) + (r7 >> 2) * 8 + (rp & 1) * 4;
#pragma unroll
    for (int j = 0; j < 4; ++j) *(LAS unsigned*)(vt + (4 * c + j) * 64 + u) = cvt_pk_bf16(t.v0[j], t.v1[j]);
}

template <int NG>
__device__ __forceinline__ void block_unit(Frame& F, int layer, int unit  ) {
    constexpr int W = 8 / NG;
    int tid = F.tid_(); asm volatile("" : "+v"(tid)); const int lane = tid & 63, wave = F.wave, l31 = lane & 31, hh = lane >> 5;
    LAS unsigned char* lds = F.lds;
    const bool sample = NG > 1; constexpr int sh = NG == 1 ? 16 : 0; const int L = sample ? DSEQ : LP, past = sample ? PAST : 0, nqt = (L + sh + 31) / 32;
    const int gi = wave / W, wi = wave - gi * W;
    int bh, qt0; bool wave_on; if (!sample) { const int j = 8 - (unit >> 6); bh = unit & 63; qt0 = j == 0 ? 0 : 8 * j - 7; wave_on = j > 0 || wi == 0; } else { bh = unit * NG + gi; qt0 = 0; wave_on = wi < nqt; }
    const int b = bh >> 3, h = bh & 7; const int qt = qt0 + wi;
    const size_t rowbase = sample ? (size_t)MPAD + (size_t)b * DSEQ : (size_t)b * LP;
    Grp g;
    g.k_new = (sample ? F.outp() + O_KS + (size_t)layer * MS * 1024 + (size_t)b * DSEQ * 1024 : F.outp() + O_KP + (size_t)layer * MP * 1024 + (size_t)b * LP * 1024) + h * 128;
    g.v_new = (sample ? F.outp() + O_VS + (size_t)layer * MS * 1024 + (size_t)b * DSEQ * 1024 : F.outp() + O_VP + (size_t)layer * MP * 1024 + (size_t)b * LP * 1024) + h * 128;
    g.k_old = F_cache_k + ((size_t)layer * DBATCH + b) * PAST * 1024 + h * 128; g.v_old = F_cache_v + ((size_t)layer * DBATCH + b) * PAST * 1024 + h * 128;
    const int dt0 = (past >> 5) + qt0;
    const int tq = 32 * qt - sh + l31; const bool qvalid = wave_on && tq >= 0 && tq < L; const size_t qrow = rowbase + (tq < 0 ? 0 : tq < L ? tq : L - 1);
    const GAS bf16* Q = (const GAS bf16*)(F.wsp() + WS_Q) + qrow * 1024 + h * 128 + 8 * hh;
    bf16x8 qf[8];
#pragma unroll
    for (int st = 0; st < 8; ++st) qf[st] = *(const GAS bf16x8*)(Q + 16 * st);
    f32x16 O[4] = {zero16(), zero16(), zero16(), zero16()};
    const int qpos = past + tq; float R = 0.f; bool done = !wave_on;
    const int sc = tid & 31, srp = NG == 1 ? (tid >> 5) : ((tid & (64 * W - 1)) >> 5);
    if (NG == 1) { for (int j0 = 0; j0 < W; j0 += 4) { TileRegs t[4];
#pragma unroll
            for (int j = 0; j < 4; ++j) tile_issue(t[j], g, dt0 + j0 + j, past, L, sc, srp, sh);
#pragma unroll
            for (int j = 0; j < 4; ++j) tile_commit(t[j], lds + ((dt0 + j0 + j) & (W - 1)) * SLOT, sc, srp); } }
    else { for (int j = 0; j < W; ++j) { TileRegs t[4];
#pragma unroll
            for (int ps = 0; ps < 4; ++ps) tile_issue(t[ps], g, dt0 + j, past, L, sc, srp + 4 * ps, sh);
#pragma unroll
            for (int ps = 0; ps < 4; ++ps) tile_commit(t[ps], lds + (gi * W + ((dt0 + j) & (W - 1))) * SLOT, sc, srp + 4 * ps); } }
    if (lane == 0) *(LAS unsigned*)(lds + L_DONE + 4 * wave) = done ? 1u : 0u;
    TileRegs pre; if (NG == 1 && dt0 - 1 >= 0) tile_issue(pre, g, dt0 - 1, past, L, sc, srp, sh);
    HG_BAR();
    for (int i = 0; ; ++i) {
        const int kt = dt0 + wi - i;
        const int knew = dt0 - i - 1;
        TileRegs pre2; if (NG == 1 && knew - 1 >= 0) tile_issue(pre2, g, knew - 1, past, L, sc, srp, sh);
        if (!done && kt >= 0) {
            const LAS unsigned char* slot = lds + (gi * W + (kt & (W - 1))) * SLOT; const int s0 = 32 * kt - sh;
            f32x16 sa = zero16();
#pragma unroll
            for (int st = 0; st < 8; ++st) sa = mfma32(*(const LAS bf16x8*)(slot + l31 * KROW + (16 * st + 8 * hh) * 2), qf[st], sa);
            const bool diag = i == 0;
            float sg[16], kp[16];
#pragma unroll
            for (int r = 0; r < 16; ++r) { const float e = fexp2(-sa[r]), rc = frcp(1.0f + e); sg[r] = rc; kp[r] = e * rc; }
            if (diag || (sh != 0 && kt == 0)) { const int khi = diag ? qpos : 0x7fffffff;
#pragma unroll
                for (int r = 0; r < 16; ++r) { const int key = s0 + (r & 3) + 8 * (r >> 2) + 4 * hh; const bool ok = key < khi && key >= 0; kp[r] = ok ? kp[r] : 1.0f; sg[r] = ok ? sg[r] : 0.f; } }
            float ex[16], T[4], Tp[4];
#pragma unroll
            for (int gq = 0; gq < 4; ++gq) { ex[4 * gq + 3] = 1.0f; ex[4 * gq + 2] = kp[4 * gq + 3]; ex[4 * gq + 1] = ex[4 * gq + 2] * kp[4 * gq + 2]; ex[4 * gq] = ex[4 * gq + 1] * kp[4 * gq + 1]; T[gq] = ex[4 * gq] * kp[4 * gq]; Tp[gq] = __shfl_xor(T[gq], 32); }
            float carry[4]; { float above = fexp2(R);
#pragma unroll
                for (int gq = 3; gq >= 0; --gq) { carry[gq] = above * (hh == 0 ? Tp[gq] : 1.0f); above *= T[gq] * Tp[gq]; }
                R += flog2(fmaxf(((T[0] * Tp[0]) * (T[1] * Tp[1])) * ((T[2] * Tp[2]) * (T[3] * Tp[3])), 1e-45f)); }
            float w[16];
#pragma unroll
            for (int r = 0; r < 16; ++r) w[r] = sg[r] * (carry[r >> 2] * ex[r]);
            const LAS unsigned char* vt = slot + 32 * KROW;
#pragma unroll
            for (int s = 0; s < 2; ++s) { v4u pw; pw.x = cvt_pk_bf16(w[8 * s], w[8 * s + 1]); pw.y = cvt_pk_bf16(w[8 * s + 2], w[8 * s + 3]); pw.z = cvt_pk_bf16(w[8 * s + 4], w[8 * s + 5]); pw.w = cvt_pk_bf16(w[8 * s + 6], w[8 * s + 7]);
                const bf16x8 pb = __builtin_bit_cast(bf16x8, pw);
#pragma unroll
                for (int db = 0; db < 4; ++db) { const int d = 32 * db + l31;
                    O[db] = mfma32(*(const LAS bf16x8*)(vt + d * 64 + (((2 * s + hh) ^ ((d >> 2) & 3)) * 16)), pb, O[db]); } }
            if (kt == 0 || __all(R < R_STOP)) { done = true; if (lane == 0) *(LAS unsigned*)(lds + L_DONE + 4 * wave) = 1u; }
        } else if (!done && kt < 0) { done = true; if (lane == 0) *(LAS unsigned*)(lds + L_DONE + 4 * wave) = 1u; }
        HG_BAR();
        const v4u d0 = *(const LAS v4u*)(lds + L_DONE), d1 = *(const LAS v4u*)(lds + L_DONE + 16);
        if ((d0.x & d0.y & d0.z & d0.w & d1.x & d1.y & d1.z & d1.w) != 0u) break;
        if (NG == 1) { if (knew >= 0) tile_commit(pre, lds + (knew & (W - 1)) * SLOT, sc, srp); pre = pre2; }
        else if (knew >= 0) { TileRegs t[4];
#pragma unroll
            for (int ps = 0; ps < 4; ++ps) tile_issue(t[ps], g, knew, past, L, sc, srp + 4 * ps, sh);
#pragma unroll
            for (int ps = 0; ps < 4; ++ps) tile_commit(t[ps], lds + (gi * W + (knew & (W - 1))) * SLOT, sc, srp + 4 * ps); }
        HG_BAR();
    }
    if (qvalid) { const GAS bf16* SG = (const GAS bf16*)(F.wsp() + WS_SGB) + qrow * 1024 + h * 128 + 4 * hh; GAS bf16* Y = (GAS bf16*)(F.wsp() + WS_Y) + (size_t)MTOT * 1024 + qrow * 1024 + h * 128 + 4 * hh;
        v2u sgv[4][4];
#pragma unroll
        for (int db = 0; db < 4; ++db)
#pragma unroll
            for (int gq = 0; gq < 4; ++gq) sgv[db][gq] = *(const GAS v2u*)(SG + 32 * db + 8 * gq);
#pragma unroll
        for (int db = 0; db < 4; ++db)
#pragma unroll
            for (int gq = 0; gq < 4; ++gq) { const v2u s = sgv[db][gq]; v2u o;
                o.x = cvt_pk_bf16(O[db][4 * gq] * bf_lo(s.x), O[db][4 * gq + 1] * bf_hi(s.x)); o.y = cvt_pk_bf16(O[db][4 * gq + 2] * bf_lo(s.y), O[db][4 * gq + 3] * bf_hi(s.y));
                *(GAS v2u*)(Y + 32 * db + 8 * gq) = o; } }
    HG_BAR();
}
constexpr int NU_P = BATCH * 8 * 9, NU_S = DBATCH * 8 / 4;
constexpr int NUNITS = NU_P + NU_S;
}

namespace pl {
constexpr int RS = 528;
constexpr int L_UT = 0, L_DF = 143 * RS, L_END = L_DF + 128 * RS;
static_assert(L_END <= LDS_MISC, "pool LDS");
constexpr int NU_P = BATCH * 17 * 4, NU_S = DBATCH * 4, NUNITS = NU_P + NU_S;
__device__ __forceinline__ void unit(Frame& F, int layer, int u) {
    LAS unsigned char* lds = F.lds; int tid = F.tid_(); asm volatile("" : "+v"(tid)); const int lane = tid & 63, wave = F.wave, l31 = lane & 31, hh = lane >> 5;
    const bool sample = u >= NU_P; int b, tile, g;
    if (!sample) { g = u & 3; const int x = u >> 2; b = x / 17; tile = x - b * 17; } else { const int x = u - NU_P; g = x & 3; b = x >> 2; tile = 0; }
    const int L = sample ? DSEQ : LP, t0 = tile * 128, nrows = min(128, L - t0), w = 2 << g;
    const size_t rowbase = sample ? (size_t)MPAD + (size_t)b * DSEQ : (size_t)b * LP;
    const GAS bf16* UA = (const GAS bf16*)(F.wsp() + WS_UA);
    { v4u sv[9];
#pragma unroll
      for (int q = 0; q < 9; ++q) { const int idx = tid + 512 * q, i = idx >> 5, ch = idx & 31, t = t0 - 15 + i; v4u v = {0u, 0u, 0u, 0u};
        if (idx < 143 * 32) { if (t >= 0 && t < L) v = *(const GAS v4u*)(UA + (rowbase + t) * 1024 + 256 * g + 8 * ch);
            else if (t < 0 && sample) { const GAS float* sp = F_state_pool + (((size_t)layer * DBATCH + b) * 15 + (15 + t)) * 1024 + 256 * g + 8 * ch; v = pg8::pack8(*(const GAS f32x4*)sp, *(const GAS f32x4*)(sp + 4)); } }
        sv[q] = v; }
#pragma unroll
      for (int q = 0; q < 9; ++q) { const int idx = tid + 512 * q, i = idx >> 5, ch = idx & 31; if (idx < 143 * 32) *(LAS v4u*)(lds + L_UT + i * RS + ch * 16) = sv[q]; } }
    const GAS bf16* WT = (const GAS bf16*)(F.wsp() + WS_WPOOL) + ((size_t)layer * 4 + g) * 65536 + (size_t)(32 * wave + l31) * 256 + 8 * hh;
    bf16x8 wf[16];
#pragma unroll
    for (int st = 0; st < 16; ++st) wf[st] = *(const GAS bf16x8*)(WT + 16 * st);
    const GAS float* sc = F_pool_scale + layer * 1024 + 256 * g + 32 * wave + 4 * hh; const GAS bf16* SGA = (const GAS bf16*)(F.wsp() + WS_SGA); GAS bf16* YA = (GAS bf16*)(F.wsp() + WS_Y);
    v4u sgq[8]; f32x4 scv[4];
#pragma unroll
    for (int q = 0; q < 8; ++q) { const int cq = tid + 512 * q, row = cq >> 5, ch8 = cq & 31;
        sgq[q] = __builtin_nontemporal_load((const GAS v4u*)(SGA + (rowbase + t0 + (row < nrows ? row : 0)) * 1024 + 256 * g + 8 * ch8)); }
#pragma unroll
    for (int gg = 0; gg < 4; ++gg) scv[gg] = *(const GAS f32x4*)(sc + 8 * gg);
    HG_BAR();
    { const int ch = tid & 31, rs = tid >> 5, r0 = 8 * rs; float sum[8];
#pragma unroll
      for (int j = 0; j < 8; ++j) sum[j] = 0.f;
      for (int j = 1; j < w; ++j) { const v4u v = *(const LAS v4u*)(lds + L_UT + (15 + r0 - j) * RS + ch * 16);
          sum[0] += bf_lo(v.x); sum[1] += bf_hi(v.x); sum[2] += bf_lo(v.y); sum[3] += bf_hi(v.y); sum[4] += bf_lo(v.z); sum[5] += bf_hi(v.z); sum[6] += bf_lo(v.w); sum[7] += bf_hi(v.w); }
#pragma unroll
      for (int i = 0; i < 8; ++i) { const int r = r0 + i; const v4u v = *(const LAS v4u*)(lds + L_UT + (15 + r) * RS + ch * 16);
          float x[8] = {bf_lo(v.x), bf_hi(v.x), bf_lo(v.y), bf_hi(v.y), bf_lo(v.z), bf_hi(v.z), bf_lo(v.w), bf_hi(v.w)};
          const float rc = sample ? 1.0f / (float)w : 1.0f / fminf((float)(t0 + r) + 1.0f, (float)w); float d[8];
#pragma unroll
          for (int j = 0; j < 8; ++j) { sum[j] += x[j]; d[j] = sum[j] * rc - x[j]; }
          *(LAS v4u*)(lds + L_DF + r * RS + ch * 16) = pg8::pack8((f32x4){d[0], d[1], d[2], d[3]}, (f32x4){d[4], d[5], d[6], d[7]});
          const v4u o = *(const LAS v4u*)(lds + L_UT + (15 + r - (w - 1)) * RS + ch * 16);
          sum[0] -= bf_lo(o.x); sum[1] -= bf_hi(o.x); sum[2] -= bf_lo(o.y); sum[3] -= bf_hi(o.y); sum[4] -= bf_lo(o.z); sum[5] -= bf_hi(o.z); sum[6] -= bf_lo(o.w); sum[7] -= bf_hi(o.w); } }
    HG_BAR();
    f32x16 acc[4] = {zero16(), zero16(), zero16(), zero16()};
#pragma unroll
    for (int st = 0; st < 16; ++st) { const bf16x8 a = wf[st];
#pragma unroll
        for (int rb = 0; rb < 4; ++rb) { const bf16x8 bb = *(const LAS bf16x8*)(lds + L_DF + (32 * rb + l31) * RS + (16 * st + 8 * hh) * 2); acc[rb] = mfma32(a, bb, acc[rb]); } }
    HG_BAR();
    constexpr int TS = 1040;
    static_assert(128 * TS <= L_END, "pool output image");
#pragma unroll
    for (int rb = 0; rb < 4; ++rb)
#pragma unroll
        for (int gg = 0; gg < 4; ++gg) { const f32x4 t = {acc[rb][4 * gg] * scv[gg][0], acc[rb][4 * gg + 1] * scv[gg][1], acc[rb][4 * gg + 2] * scv[gg][2], acc[rb][4 * gg + 3] * scv[gg][3]};
            *(LAS f32x4*)(lds + (32 * rb + l31) * TS + (32 * wave + 8 * gg + 4 * hh) * 4) = t; }
    HG_BAR();
#pragma unroll
    for (int q = 0; q < 8; ++q) { const int cq = tid + 512 * q, row = cq >> 5, ch8 = cq & 31;
        if (row < nrows) { const f32x4 a = *(const LAS f32x4*)(lds + row * TS + ch8 * 32), b = *(const LAS f32x4*)(lds + row * TS + ch8 * 32 + 16); const v4u s = sgq[q];
            const f32x4 ga = {bf_lo(s.x), bf_hi(s.x), bf_lo(s.y), bf_hi(s.y)}, gb = {bf_lo(s.z), bf_hi(s.z), bf_lo(s.w), bf_hi(s.w)};
            *(GAS v4u*)(YA + (rowbase + t0 + row) * 1024 + 256 * g + 8 * ch8) = pg8::pack8(a * ga, b * gb); } }
    HG_BAR();
}
}

#ifndef MERGE_TAIL
#define MERGE_TAIL 6
#endif
#ifndef WGM_PROJ
#define WGM_PROJ 4
#endif
#ifndef WGM_SQ
#define WGM_SQ 1
#endif
constexpr int U_HG_P = BATCH * 8, U_HG_S = DBATCH * 8;
constexpr int U0_HGS = U_HG_P, U0_ATT = U0_HGS + U_HG_S, U0_POOL = U0_ATT + sb::NUNITS, U_TOTAL = U0_POOL + pl::NUNITS;
__device__ __forceinline__ void phase_mixers(Frame& F, int layer, int qslot) {
    GAS unsigned* head = F.ctl() + CW_QUEUE + 64 * qslot;
    for (;;) {
        if (F.tid_() == 0) F.MISC[4] = __hip_atomic_fetch_add(head, 1u, __ATOMIC_RELAXED, __HIP_MEMORY_SCOPE_AGENT);
        HG_BAR();
        int u = (int)F.MISC[4];
        HG_BAR();
        if (u >= U_TOTAL) break;
        if (u >= U0_HGS && u < U0_POOL) u = u < U0_HGS + sb::NUNITS ? u + U_HG_S : u - sb::NUNITS;
        if (u < U0_ATT) { const bool smp = u >= U0_HGS; const int x = smp ? u - U0_HGS : u; hg::chain(F, layer, smp, x >> 3, x & 7); }
        else if (u < U0_POOL) { const int x = u - U0_ATT; if (x < sb::NU_P) sb::block_unit<1>(F, layer, x); else sb::block_unit<4>(F, layer, x - sb::NU_P); }
        else pl::unit(F, layer, u - U0_POOL);
    }
}

__device__ __forceinline__ void combine_merge(Frame& F) {
    pg8::Gemm g{nullptr, nullptr, 0, 0, MTOT / 256, D / 256, 3, D, MERGE_TAIL, WGM_SQ}; pg8::Order S; S.init(g, F.G, 0); if (!S.tail) return;
    const int gw = F.vcu * 8 + F.wave, NGW = F.G * 8, lane = F.lane_(), nrows = (S.nwg - S.G) * 256;
    const GAS float* sl = (const GAS float*)(F.wsp() + WS_SLAB_M); GAS bf16* M = (GAS bf16*)(F.wsp() + WS_MERGED);
    for (int x = gw; x < nrows; x += NGW) { const int j = x >> 8, r = x & 255; int pm, pn; S.tile_of(S.G + j, pm, pn);
        const GAS float* p = sl + (size_t)(MERGE_TAIL * j) * 65536 + (size_t)r * 256 + 4 * lane;
        f32x4 v = *(const GAS f32x4*)p;
#pragma unroll
        for (int q = 1; q < MERGE_TAIL; ++q) v += *(const GAS f32x4*)(p + (size_t)q * 65536);
        v2u o; o.x = cvt_pk_bf16(v[0], v[1]); o.y = cvt_pk_bf16(v[2], v[3]); *(GAS v2u*)(M + (size_t)(256 * pm + r) * 1024 + 256 * pn + 4 * lane) = o; }
}
__device__ __forceinline__ void combine_out(Frame& F, int last) {
    pg8::Gemm g{nullptr, nullptr, 0, 0, MTOT / 256, D / 256, 1, D, 4, WGM_SQ}; pg8::Order S; S.init(g, F.G, 0); if (!S.tail) return;
    const int gw = F.vcu * 8 + F.wave, NGW = F.G * 8, lane = F.lane_(), nrows = (S.nwg - S.G) * 256;
    const GAS float* sl = (const GAS float*)(F.wsp() + WS_SLAB_O); GAS float* H = (GAS float*)(F.wsp() + WS_H); GAS float* out = F.outp();
    for (int x = gw; x < nrows; x += NGW) { const int j = x >> 8, r = x & 255; int pm, pn; S.tile_of(S.G + j, pm, pn);
        const GAS float* p = sl + (size_t)(4 * j) * 65536 + (size_t)r * 256 + 4 * lane; const int row = 256 * pm + r, col = 256 * pn + 4 * lane;
        const f32x4 v = *(const GAS f32x4*)(H + (size_t)row * 1024 + col) + ((*(const GAS f32x4*)p + *(const GAS f32x4*)(p + 65536)) + (*(const GAS f32x4*)(p + 2 * 65536) + *(const GAS f32x4*)(p + 3 * 65536)));
        if (!last) *(GAS f32x4*)(H + (size_t)row * 1024 + col) = v;
        else if (row >= MPAD) *(GAS f32x4*)(out + O_YS + (size_t)(row - MPAD) * 1024 + col) = v;
        else if (row < MP) { const int b = row / LP, t = row - b * LP; if (t >= NMETA) *(GAS f32x4*)(out + O_YP + ((size_t)b * SEQ + (t - NMETA)) * 1024 + col) = v; } }
}
__device__ __forceinline__ void phase_xn_fused(Frame& F, int l) {
    pg8::Gemm g{nullptr, nullptr, 0, 0, MTOT / 256, D / 256, 1, D, 4, WGM_SQ}; pg8::Order S; S.init(g, F.G, 0);
    LAS int* tab = (LAS int*)F.lds; const int tid = F.tid_(), lane = F.lane_();
    for (int i = tid; i < (MTOT / 256) * 4; i += 512) tab[i] = -1;
    __syncthreads();
    if (S.tail && tid < S.nwg - S.G) { int pm, pn; S.tile_of(S.G + tid, pm, pn); tab[4 * pm + pn] = tid; }
    __syncthreads();
    const int gw = F.vcu * 8 + F.wave, NGW = F.G * 8;
    GAS float* H = (GAS float*)(F.wsp() + WS_H); GAS bf16* XN = (GAS bf16*)(F.wsp() + WS_XN); const GAS float* sl = (const GAS float*)(F.wsp() + WS_SLAB_O); const GAS float* gn = F_norm_g + (size_t)l * D;
    for (int r = gw; r < MTOT; r += NGW) {
        if (r >= MP && r < MPAD) { zero_xn_row(XN + (size_t)r * D, lane); continue; }
        GAS f32x4* xr = (GAS f32x4*)(H + (size_t)r * D) + lane; const int pm = r >> 8, rr = r & 255;
        const GAS f32x4* x0 = l == 1 ? (const GAS f32x4*)(*((const GAS unsigned long long*)(F.wsp() + WS_RTAB) + r)) + lane : xr;
        f32x4 v[4]; float s = 0.f;
#pragma unroll
        for (int j = 0; j < 4; ++j) { const int idx = tab[4 * pm + j]; v[j] = idx >= 0 ? x0[64 * j] : xr[64 * j];
            if (idx >= 0) { const GAS float* p = sl + (size_t)(4 * idx) * 65536 + (size_t)rr * 256 + 4 * lane;
                v[j] += (*(const GAS f32x4*)p + *(const GAS f32x4*)(p + 65536)) + (*(const GAS f32x4*)(p + 2 * 65536) + *(const GAS f32x4*)(p + 3 * 65536)); xr[64 * j] = v[j]; }
            s += (v[j].x * v[j].x + v[j].y * v[j].y) + (v[j].z * v[j].z + v[j].w * v[j].w); }
        const float rs = frsq(wave_sum(s) * (1.f / D) + EPS);
        GAS v2u* o8 = (GAS v2u*)(XN + (size_t)r * D) + lane;
#pragma unroll
        for (int j = 0; j < 4; ++j) { const f32x4 gg = ((const GAS f32x4*)gn)[lane + 64 * j]; v2u o; o.x = cvt_pk_bf16(v[j].x * rs * gg.x, v[j].y * rs * gg.y); o.y = cvt_pk_bf16(v[j].z * rs * gg.z, v[j].w * rs * gg.w); o8[64 * j] = o; }
    }
    __syncthreads();
}
constexpr int NPHASES = 1 + 5 * DEPTH;
__global__ void __launch_bounds__(512, 2) mega_fwd(Params p) {
    extern __shared__ __attribute__((aligned(16))) unsigned char lds_raw[];
    Frame F;
    F.lds = (LAS unsigned char*)lds_raw; F.MISC = (volatile LAS unsigned*)(F.lds + LDS_MISC);
    F.wave = __builtin_amdgcn_readfirstlane((int)threadIdx.x >> 6);
    F.G = gridDim.x; { const int bx = blockIdx.x; F.vcu = (F.G % 8 == 0) ? (bx % 8) * (F.G / 8) + bx / 8 : bx; }
    if (threadIdx.x < 64) F.MISC[threadIdx.x] = 0u;
    if (threadIdx.x == 0) { LAS unsigned long long* P = (LAS unsigned long long*)(F.lds + LDS_PARAM);
        P[0] = (unsigned long long)p.in[0]; P[1] = (unsigned long long)p.in[1]; P[2] = (unsigned long long)p.in[2]; P[3] = (unsigned long long)p.in[3]; P[4] = (unsigned long long)p.in[4];
        P[5] = (unsigned long long)p.in[5]; P[6] = (unsigned long long)p.in[6]; P[7] = (unsigned long long)p.in[7]; P[8] = (unsigned long long)p.in[8]; P[9] = (unsigned long long)p.in[9];
        P[10] = (unsigned long long)p.in[10]; P[11] = (unsigned long long)p.in[11]; P[12] = (unsigned long long)p.in[12]; P[13] = (unsigned long long)p.in[13]; P[14] = (unsigned long long)p.in[14];
        P[15] = (unsigned long long)p.in[15]; P[16] = (unsigned long long)p.in[16]; P[17] = (unsigned long long)p.out; P[18] = (unsigned long long)p.ws; }
    __syncthreads();
    const int lo = p.ph_lo, hi = p.ph_hi;
    XcdBarrier bar; bar.bar = F.ctl() + CW_BAR; bar.x = 0; bar.st = nullptr; bar.leader = false;
    if (hi - lo > 1) bar = xcd_barrier_post(F.ctl() + CW_BAR, F.MISC, F.wave);
#define IN(k) (lo <= (k) && (k) < hi)
#define SEAM(k) do { if (IN(k) && IN((k) + 1)) xcd_barrier(bar, F.wave); } while (0)
    if (IN(0)) { phase_prologue(F); } SEAM(0);
    for (int l = 0; l < DEPTH; ++l) {
        const int pb = 1 + 5 * l;
        if (IN(pb)) { if (l > 0) phase_xn_fused(F, l); }
        if (l > 0) SEAM(pb);
        if (IN(pb + 1)) { pg8::Gemm g{(const GAS bf16*)(F.wsp() + WS_XN), (const GAS bf16*)(F.wsp() + WS_WIN) + (size_t)l * NPROJ * D, 0, 0, MTOT / 256, NPROJ / 256, 1, D, 0, WGM_PROJ};
            pg8::Order S; S.init(g, F.G, (int)blockIdx.x);
            pg8::EpiProj E{l, F.wsp(), F.outp(), F_qng + l * 128, F_kng + l * 128, (const GAS float*)(F.wsp() + WS_LB) + l * 1024};
            pg8::gemm_phase(F.lds, g, S, E, F.wave);
            } SEAM(pb + 1);
        if (IN(pb + 2)) { phase_mixers(F, l, l); } SEAM(pb + 2);
        if (IN(pb + 3)) { pg8::Gemm g{(const GAS bf16*)(F.wsp() + WS_Y), (const GAS bf16*)(F.wsp() + WS_WBR) + (size_t)l * 3 * D * D, (size_t)MTOT * 1024, (size_t)D * D, MTOT / 256, D / 256, 3, D, MERGE_TAIL, WGM_SQ};
            pg8::Order S; S.init(g, F.G, (int)blockIdx.x);
            pg8::EpiMerge E{F.wsp()};
            pg8::gemm_phase(F.lds, g, S, E, F.wave);
            { __syncthreads(); pg8::EpiMergeSlab E2{F.wsp()}; pg8::gemm_phase<pg8::EpiMergeSlab, 1>(F.lds, g, S, E2, F.wave); }
            } SEAM(pb + 3);
        if (IN(pb + 4)) { combine_merge(F); xcd_barrier(bar, F.wave);
            pg8::Gemm g{(const GAS bf16*)(F.wsp() + WS_MERGED), (const GAS bf16*)(F.wsp() + WS_WOUT) + (size_t)l * D * D, 0, 0, MTOT / 256, D / 256, 1, D, 4, WGM_SQ};
            pg8::Order S; S.init(g, F.G, (int)blockIdx.x);
            pg8::EpiOut E{F.wsp(), F.outp(), l == DEPTH - 1 ? 1 : 0, l == 0 ? 1 : 0};
            pg8::gemm_phase(F.lds, g, S, E, F.wave);
            { __syncthreads(); pg8::EpiOutSlab E2{F.wsp()}; pg8::gemm_phase<pg8::EpiOutSlab, 1>(F.lds, g, S, E2, F.wave); }
            xcd_barrier(bar, F.wave); if (l == DEPTH - 1) combine_out(F, 1);
            }
    }
#undef IN
#undef SEAM
}
extern "C" void kernel_launch(void* const* d_in, const int* in_sizes, int n_in, void* d_out, int out_size, void* d_ws, size_t ws_size, hipStream_t stream) {
    static int grid = 0;
    if (grid == 0) {
        if (n_in != 17 || out_size != (int)O_END || ws_size < WS_FAST_END) { fprintf(stderr, "kernel_launch: unexpected sizes (n_in %d, out %d, ws %zu < %zu)\n", n_in, out_size, ws_size, (size_t)WS_FAST_END); grid = -1; return; }
        int dev = 0, cus = 0, per_cu = 0;
        if (hipGetDevice(&dev) != hipSuccess || hipDeviceGetAttribute(&cus, hipDeviceAttributeMultiprocessorCount, dev) != hipSuccess) { grid = -1; return; }
        if (hipFuncSetAttribute((const void*)mega_fwd, hipFuncAttributeMaxDynamicSharedMemorySize, LDS_BYTES) != hipSuccess) { fprintf(stderr, "kernel_launch: hipFuncSetAttribute failed\n"); grid = -1; return; }
        if (hipOccupancyMaxActiveBlocksPerMultiprocessor(&per_cu, (const void*)mega_fwd, 512, LDS_BYTES) != hipSuccess || per_cu < 1) { fprintf(stderr, "kernel_launch: occupancy query says %d blocks per CU\n", per_cu); (void)hipGetLastError(); grid = -1; return; }
        grid = cus;
    }
    if (grid < 0) return;
    (void)hipMemsetAsync((char*)d_ws + WS_CTL, 0, CTL_ZERO_BYTES, stream);
    Params p{};
    for (int i = 0; i < 17; ++i) p.in[i] = (const float*)d_in[i];
    p.out = (float*)d_out; p.ws = (unsigned char*)d_ws;
    p.ph_lo = 0; p.ph_hi = NPHASES;
    hipLaunchKernelGGL(mega_fwd, dim3(grid), dim3(512), LDS_BYTES, stream, p);
}
```

```cpp
#define MK_LAUNCHES 1
#include <hip/hip_runtime.h>
#include <cstdio>
#include <cstdint>
constexpr int D = 1024, BATCH = 8, SEQ = 2048, DEPTH = 2, DBATCH = 32, DSEQ = 64, PAST = 2048, NMETA = 16;
constexpr int LP = NMETA + SEQ;
constexpr int MP = BATCH * LP;
constexpr int MPAD = 16640;
constexpr int MS = DBATCH * DSEQ;
constexpr int MTOT = MPAD + MS;
constexpr int NPROJ = 13 * 1024;
constexpr float EPS = 1e-6f, LB_FLOOR = 1e-30f, SB_SCALE = 0.08838834764831845f;
constexpr size_t O_YP = 0, O_YS = 16777216, O_KP = 18874368, O_VP = 52690944, O_PP = 86507520, O_HP = 86753280,
                 O_KS = 88850432, O_VS = 93044736, O_PS = 97239040, O_HS = 98222080, O_END = 106610688;
#define GAS __attribute__((address_space(1)))
#define LAS __attribute__((address_space(3)))
typedef unsigned short bf16;
typedef unsigned v4u __attribute__((ext_vector_type(4)));
typedef unsigned v2u __attribute__((ext_vector_type(2)));
typedef float f32x4 __attribute__((ext_vector_type(4)));
typedef float f32x2 __attribute__((ext_vector_type(2)));
typedef float f32x16 __attribute__((ext_vector_type(16)));
typedef short bf16x8 __attribute__((ext_vector_type(8)));
typedef short bf16x4 __attribute__((ext_vector_type(4)));
#define LDS_WAIT() asm volatile("s_waitcnt lgkmcnt(0)" ::: "memory")
#define VM_WAIT() asm volatile("s_waitcnt vmcnt(0)" ::: "memory")

typedef __bf16 bf16n2 __attribute__((ext_vector_type(2)));
__device__ __forceinline__ unsigned cvt_pk_bf16(float lo, float hi) { const f32x2 v = {lo, hi}; return __builtin_bit_cast(unsigned, __builtin_convertvector(v, bf16n2)); }
__device__ __forceinline__ float bf_lo(unsigned u) { return __uint_as_float(u << 16); }
__device__ __forceinline__ float bf_hi(unsigned u) { return __uint_as_float(u & 0xffff0000u); }
__device__ __forceinline__ float fexp2(float x) { return __builtin_amdgcn_exp2f(x); }
__device__ __forceinline__ float flog2(float x) { return __builtin_amdgcn_logf(x); }
__device__ __forceinline__ float frcp(float x) { return __builtin_amdgcn_rcpf(x); }
__device__ __forceinline__ float frsq(float x) { return __builtin_amdgcn_rsqf(x); }
__device__ __forceinline__ int lane_id() { unsigned z = 0u; asm volatile("" : "+v"(z)); return (int)__builtin_amdgcn_mbcnt_hi(~0u, __builtin_amdgcn_mbcnt_lo(~0u, z)); }
constexpr float LOG2E = 1.4426950408889634f, LN2 = 0.6931471805599453f;
__device__ __forceinline__ float fexp(float x) { return fexp2(x * LOG2E); }
__device__ __forceinline__ float fsigmoid(float x) { return frcp(1.0f + fexp2(-x * LOG2E)); }
__device__ __forceinline__ float fsilu(float x) { return x * fsigmoid(x); }

constexpr size_t MiB = 1u << 20;
constexpr size_t RB16 = (size_t)MTOT * 1024 * 2, RB32 = (size_t)MTOT * 1024 * 4;
constexpr size_t WS_CTL = 0, CTL_ZERO_BYTES = 64 * 1024;
constexpr size_t WS_RTAB = 1 * MiB + 64 * 1024;
constexpr size_t WS_LB = 1 * MiB;
constexpr size_t WS_WIN = 2 * MiB;
constexpr size_t WS_WBR = WS_WIN + (size_t)2 * NPROJ * 1024 * 2;
constexpr size_t WS_WOUT = WS_WBR + (size_t)6 * 1024 * 1024 * 2;
constexpr size_t WS_WPOOL = WS_WOUT + (size_t)2 * 1024 * 1024 * 2;
constexpr size_t WS_H = WS_WPOOL + 1 * MiB;
constexpr size_t WS_XN = WS_H + RB32;
constexpr size_t WS_UA = WS_XN + RB16, WS_SGA = WS_UA + RB16, WS_Q = WS_SGA + RB16, WS_SGB = WS_Q + RB16, WS_KC = WS_SGB + RB16,
                 WS_QC = WS_KC + RB16, WS_IC = WS_QC + RB16, WS_SGC = WS_IC + RB16, WS_GATE = WS_SGC + RB16  ,
                 WS_LOGF = WS_GATE + 3 * RB16  , WS_Y = WS_LOGF + RB32  , WS_MERGED = WS_Y + 3 * RB16, WS_FAST_END = WS_MERGED + RB16;
constexpr size_t WS_SLAB_M = WS_UA, WS_SLAB_O = WS_Q;
static_assert(108 * 262144 <= 2 * RB16 && 144 * 262144 <= 2 * RB16, "slabs");
constexpr int CW_QUEUE = 64;
constexpr int CW_BAR = 1024;

constexpr int LDS_BYTES = 160 * 1024;
constexpr int LDS_XCH = 128 * 1024;
constexpr int LDS_MISC = 159 * 1024;

#define XB_TMO      128
#define XB_XCNT(j)  (256  + 64 * (j))
#define XB_XSUB(j)  (1280 + 64 * (j))
#define XB_XGEN(j)  (2304 + 64 * (j))
#define XB_TOP      3328
#define XB_TOPGEN   3392
#define XCD_BAR_WORDS 3456
#define XB_SPIN_CAP (1u << 18)
__device__ __forceinline__ unsigned xb_ld(GAS unsigned* p)              { return __hip_atomic_load(p, __ATOMIC_RELAXED, __HIP_MEMORY_SCOPE_AGENT); }
__device__ __forceinline__ unsigned xb_add(GAS unsigned* p, unsigned v) { return __hip_atomic_fetch_add(p, v, __ATOMIC_RELAXED, __HIP_MEMORY_SCOPE_AGENT); }
__device__ __forceinline__ unsigned xb_xcc_id() { return (unsigned)__builtin_amdgcn_s_getreg((3 << 11) | 20) & 0xFu; }
#define XB_SPIN(cond, bar) do { unsigned _sp = 0; while (cond) { __builtin_amdgcn_s_sleep(1); \
    if ((++_sp & 255u) == 0u) { if (xb_ld(&(bar)[XB_TMO])) break; if (_sp > XB_SPIN_CAP) { xb_add(&(bar)[XB_TMO], 1u); break; } } } } while (0)
struct XcdBarrier { GAS unsigned* bar; unsigned x; volatile LAS unsigned* st; bool leader; };
__device__ __forceinline__ XcdBarrier xcd_barrier_post(GAS unsigned* bar, volatile LAS unsigned* st, int wave) {
    XcdBarrier b; b.bar = bar; b.x = xb_xcc_id(); b.st = st; b.leader = false;
    b.leader = (wave == 0) && (lane_id() == 0);
    if (b.leader) (void)xb_add(&bar[XB_XCNT(b.x)], 1u);
    return b;
}
__device__ __forceinline__ void xcd_barrier_complete(GAS unsigned* bar, unsigned x, unsigned& nloc, unsigned& nx) {
    const unsigned G = gridDim.x * gridDim.y * gridDim.z;
    unsigned sum, cnt, mine, sp = 0u;
    for (;;) {
        sum = 0u; cnt = 0u; mine = 0u;
#pragma unroll
        for (unsigned j = 0; j < 16; ++j) { const unsigned c = xb_ld(&bar[XB_XCNT(j)]); sum += c; cnt += (c > 0u) ? 1u : 0u; mine = (j == x) ? c : mine; }
        if (sum == G) break;
        __builtin_amdgcn_s_sleep(1);
        if ((++sp & 255u) == 0u) { if (xb_ld(&bar[XB_TMO])) break; if (sp > XB_SPIN_CAP) { xb_add(&bar[XB_TMO], 1u); break; } }
    }
    nloc = mine > 0u ? mine : 1u; nx = cnt > 0u ? cnt : 1u;
}
__device__ __forceinline__ void xcd_barrier(const XcdBarrier& b, int wave) {
    asm volatile("s_waitcnt vmcnt(0)" ::: "memory");
    __syncthreads();
    if (wave == 0 && lane_id() == 0) {
        GAS unsigned* bar = b.bar;
        __builtin_amdgcn_s_waitcnt(0);
        unsigned nloc = b.st[0], nx = b.st[1];
        if (nloc == 0u) { xcd_barrier_complete(bar, b.x, nloc, nx); b.st[0] = nloc; b.st[1] = nx; }
        const unsigned old = xb_add(&bar[XB_XSUB(b.x)], 1u);
        const unsigned gen = old / nloc;
        if (old + 1u == (gen + 1u) * nloc) {
            __builtin_amdgcn_fence(__ATOMIC_RELEASE, "agent");
            asm volatile("s_waitcnt vmcnt(0)" ::: "memory");
            const unsigned og = xb_add(&bar[XB_TOP], 1u);
            const unsigned tg = og / nx;
            if (og + 1u == (tg + 1u) * nx) xb_add(&bar[XB_TOPGEN], 1u);
            else XB_SPIN(xb_ld(&bar[XB_TOPGEN]) == tg, bar);
            __builtin_amdgcn_fence(__ATOMIC_ACQUIRE, "agent");
            xb_add(&bar[XB_XGEN(b.x)], 1u);
            asm volatile("s_waitcnt vmcnt(0)" ::: "memory");
        } else {
            XB_SPIN(xb_ld(&bar[XB_XGEN(b.x)]) == gen, bar);
            __builtin_amdgcn_fence(__ATOMIC_ACQUIRE, "agent");
            asm volatile("s_waitcnt vmcnt(0)" ::: "memory");
        }
    }
    __syncthreads();
}

struct Params { const float* in[17]; float* out; unsigned char* ws; int ph_lo, ph_hi; };
constexpr int LDS_PARAM = LDS_MISC + 256;
struct Frame {
    LAS unsigned char* lds; volatile LAS unsigned* MISC;
    int wave, G, vcu;
    __device__ __forceinline__ int lane_() const { return lane_id(); }
    __device__ __forceinline__ int tid_() const { return wave * 64 + lane_id(); }
    __device__ __forceinline__ unsigned long long rd(int i) const { const v2u v = *(const LAS v2u*)(lds + LDS_PARAM + 8 * i);
        return ((unsigned long long)(unsigned)__builtin_amdgcn_readfirstlane((int)v.y) << 32) | (unsigned)__builtin_amdgcn_readfirstlane((int)v.x); }
    __device__ __forceinline__ const GAS float* in(int i) const { return (const GAS float*)rd(i); }
    __device__ __forceinline__ GAS float* outp() const { return (GAS float*)rd(17); }
    __device__ __forceinline__ GAS unsigned char* wsp() const { return (GAS unsigned char*)rd(18); }
    __device__ __forceinline__ GAS unsigned* ctl() const { return (GAS unsigned*)(wsp() + WS_CTL); }
};
#define F_xp F.in(0)
#define F_xs F.in(1)
#define F_cache_k F.in(2)
#define F_cache_v F.in(3)
#define F_state_pool F.in(4)
#define F_state_hgrn F.in(5)
#define F_meta F.in(6)
#define F_norm_g F.in(7)
#define F_w_in F.in(8)
#define F_qng F.in(9)
#define F_kng F.in(10)
#define F_w_pool F.in(11)
#define F_pool_scale F.in(12)
#define F_hlb F.in(13)
#define F_hng F.in(14)
#define F_w_branch F.in(15)
#define F_w_out F.in(16)
__device__ __forceinline__ float wave_sum(float v) {
#pragma unroll
    for (int o = 1; o < 64; o <<= 1) v += __shfl_xor(v, o);
    return v;
}

__device__ __forceinline__ void p0_transpose_item(const GAS float* W, int K, int N, GAS bf16* WT, int item, int lane) {
    const int nblk = N / 64, kb = item / nblk, nb = item - kb * nblk, r = lane >> 4, c4 = lane & 15;
    const GAS float* src = W + (size_t)(64 * kb + 16 * r) * N + 64 * nb + 4 * c4;
    f32x4 v[16];
#pragma unroll
    for (int i = 0; i < 16; ++i) v[i] = __builtin_nontemporal_load((const GAS f32x4*)(src + (size_t)i * N));
    GAS bf16* dst = WT + (size_t)(64 * nb + 4 * c4) * K + 64 * kb + 16 * r;
#pragma unroll
    for (int j = 0; j < 4; ++j) { v4u a, b;
        a.x = cvt_pk_bf16(v[0][j], v[1][j]); a.y = cvt_pk_bf16(v[2][j], v[3][j]); a.z = cvt_pk_bf16(v[4][j], v[5][j]); a.w = cvt_pk_bf16(v[6][j], v[7][j]);
        b.x = cvt_pk_bf16(v[8][j], v[9][j]); b.y = cvt_pk_bf16(v[10][j], v[11][j]); b.z = cvt_pk_bf16(v[12][j], v[13][j]); b.w = cvt_pk_bf16(v[14][j], v[15][j]);
        *(GAS v4u*)(dst + (size_t)j * K) = a; *(GAS v4u*)(dst + (size_t)j * K + 8) = b; }
}
__device__ __forceinline__ void xn_row(const GAS float* src, GAS float* hdst, const GAS float* g, GAS bf16* xnrow, int lane) {
    const GAS f32x4* xr = (const GAS f32x4*)src + lane;
    f32x4 v[4]; float s = 0.f;
#pragma unroll
    for (int j = 0; j < 4; ++j) { v[j] = xr[64 * j]; s += (v[j].x * v[j].x + v[j].y * v[j].y) + (v[j].z * v[j].z + v[j].w * v[j].w); }
    if (hdst) { GAS f32x4* ho = (GAS f32x4*)hdst + lane;
#pragma unroll
        for (int j = 0; j < 4; ++j) __builtin_nontemporal_store(v[j], ho + 64 * j); }
    const float rs = frsq(wave_sum(s) * (1.f / D) + EPS);
    GAS v2u* o8 = (GAS v2u*)xnrow + lane;
#pragma unroll
    for (int j = 0; j < 4; ++j) { const f32x4 gg = ((const GAS f32x4*)g)[lane + 64 * j]; v2u o; o.x = cvt_pk_bf16(v[j].x * rs * gg.x, v[j].y * rs * gg.y); o.y = cvt_pk_bf16(v[j].z * rs * gg.z, v[j].w * rs * gg.w); o8[64 * j] = o; }
}
__device__ __forceinline__ void zero_xn_row(GAS bf16* xnrow, int lane) { GAS v2u* o8 = (GAS v2u*)xnrow + lane;
#pragma unroll
    for (int j = 0; j < 4; ++j) o8[64 * j] = (v2u){0u, 0u}; }

__device__ __forceinline__ void phase_prologue(Frame& F) {
    const int gw = F.vcu * 8 + F.wave, NGW = F.G * 8;
    constexpr int I_IN = (D / 64) * (NPROJ / 64), I_SQ = (D / 64) * (D / 64), I_PL = (256 / 64) * (256 / 64);
    constexpr int NITEMS = 2 * I_IN + 6 * I_SQ + 2 * I_SQ + 8 * I_PL;
    GAS bf16* win_t = (GAS bf16*)(F.wsp() + WS_WIN); GAS bf16* wbr_t = (GAS bf16*)(F.wsp() + WS_WBR); GAS bf16* wout_t = (GAS bf16*)(F.wsp() + WS_WOUT); GAS bf16* wpool_t = (GAS bf16*)(F.wsp() + WS_WPOOL);
    for (int it = gw; it < NITEMS; it += NGW) {
        int r = it;
        if (r < 2 * I_IN) { const int l = r / I_IN; p0_transpose_item(F_w_in + (size_t)l * D * NPROJ, D, NPROJ, win_t + (size_t)l * NPROJ * D, r % I_IN, F.lane_()); continue; } r -= 2 * I_IN;
        if (r < 6 * I_SQ) { const int m = r / I_SQ; p0_transpose_item(F_w_branch + (size_t)m * D * D, D, D, wbr_t + (size_t)m * D * D, r % I_SQ, F.lane_()); continue; } r -= 6 * I_SQ;
        if (r < 2 * I_SQ) { const int m = r / I_SQ; p0_transpose_item(F_w_out + (size_t)m * D * D, D, D, wout_t + (size_t)m * D * D, r % I_SQ, F.lane_()); continue; } r -= 2 * I_SQ;
        { const int m = r / I_PL; p0_transpose_item(F_w_pool + (size_t)m * 65536, 256, 256, wpool_t + (size_t)m * 65536, r % I_PL, F.lane_()); }
    }
    GAS float* H = (GAS float*)(F.wsp() + WS_H); GAS bf16* XN = (GAS bf16*)(F.wsp() + WS_XN);
    for (int r = gw; r < MTOT; r += NGW) {
        GAS unsigned long long* rt = (GAS unsigned long long*)(F.wsp() + WS_RTAB) + r;
        if (r >= MP && r < MPAD) { zero_xn_row(XN + (size_t)r * D, F.lane_()); if (F.lane_() == 0) *rt = (unsigned long long)F_meta; continue; }
        const GAS float* src;
        if (r < MP) { const int b = r / LP, t = r - b * LP; src = (t < NMETA) ? F_meta + (size_t)t * D : F_xp + ((size_t)b * SEQ + (t - NMETA)) * D; }
        else src = F_xs + (size_t)(r - MPAD) * D;
        if (F.lane_() == 0) *rt = (unsigned long long)src;
        xn_row(src, nullptr, F_norm_g, XN + (size_t)r * D, F.lane_());
    }
    if (blockIdx.x == 0) { GAS float* lbp = (GAS float*)(F.wsp() + WS_LB);
        for (int i = F.tid_(); i < 1024; i += 512) { const float a = F_hlb[i], b = F_hlb[1024 + i], m = fmaxf(a, b), ea = expf(a - m), eb = expf(b - m), s = ea + eb; const float s0 = ea / s, s1 = eb / s;
            lbp[i] = s0 - s0; lbp[1024 + i] = (s0 + s1) - s0; } }
}
__device__ __forceinline__ void phase_xn(Frame& F, int l) {
    const int gw = F.vcu * 8 + F.wave, NGW = F.G * 8;
    GAS float* H = (GAS float*)(F.wsp() + WS_H); GAS bf16* XN = (GAS bf16*)(F.wsp() + WS_XN);
    for (int r = gw; r < MTOT; r += NGW) {
        if (r >= MP && r < MPAD) { zero_xn_row(XN + (size_t)r * D, F.lane_()); continue; }
        xn_row(H + (size_t)r * D, nullptr, F_norm_g + (size_t)l * D, XN + (size_t)r * D, F.lane_());
    }
}
namespace pg8 {
constexpr int BM = 256, BK = 64, HALF = 128, HTB = HALF * BK * 2, STAGE_BYTES = 8 * HTB, NXCD = 8;
__host__ __device__ __forceinline__ int lds_byte(int r, int c) { const int st = (r >> 4) * 2 + (c >> 5), rr = r & 15, cc = c & 31, ob = rr * 64 + cc * 2; return st * 1024 + (ob ^ (((ob >> 9) & 1) << 5)); }
__host__ __device__ __forceinline__ void stage_rc(int b, int& R, int& C) { const int st = b / 1024, sb = b % 1024, swz = sb ^ (((sb >> 9) & 1) << 5); R = (st >> 1) * 16 + swz / 64; C = (st & 1) * 32 + (swz % 64) / 2; }
__host__ __device__ __forceinline__ int perm32(int rho) { const int n = rho >> 4, i = rho & 15; return 8 * (i >> 2) + 4 * n + (i & 3); }

struct Unit { int pm, pn, seg, k0, nk, slab; };
struct Gemm { const GAS bf16* A; const GAS bf16* Bt; size_t a_seg, b_seg; int nM, nN, nseg, K, tail_parts, wgm; };

struct Order {
    int nM, nN, nwg, G, c, nseg, nt, tail, WGM;
    __device__ void init(const Gemm& g, int G_, int c_) { WGM = g.wgm; nM = g.nM; nN = g.nN; nwg = nM * nN; G = G_; c = c_; nseg = g.nseg; nt = g.K / BK;
        tail = (g.tail_parts > 0 && nwg > G && nwg <= 2 * G && (nwg - G) * g.tail_parts <= G && g.tail_parts % nseg == 0 && (nt % (2 * (g.tail_parts / nseg))) == 0) ? g.tail_parts : 0; }
    __device__ void tile_of(int L, int& pm, int& pn) const {
        int wgid = L; { const int q = nwg / NXCD, r = nwg % NXCD, xcd = wgid % NXCD, off = wgid / NXCD; wgid = (xcd < r ? xcd * (q + 1) : r * (q + 1) + (xcd - r) * q) + off; }
        const int nig = WGM * nN, gid = wgid / nig, fm = gid * WGM, gsz = (nM - fm) < WGM ? (nM - fm) : WGM;
        pm = fm + ((wgid % nig) % gsz); pn = (wgid % nig) / gsz; }
    template <int MODE> __device__ bool next(int i, Unit& u) const {
        u.k0 = 0; u.nk = nt; u.slab = -1;
        if (MODE == 0) {
            if (tail == 0) { const int ti = i / nseg; u.seg = i - ti * nseg; const long L = (long)ti * G + c; if (L >= nwg) return false; tile_of((int)L, u.pm, u.pn); return true; }
            if (i >= nseg) return false; u.seg = i; tile_of(c, u.pm, u.pn); return true; }
        if (tail == 0 || i > 0 || c >= (nwg - G) * tail) return false;
        const int j = c / tail, part = c - j * tail; tile_of(G + j, u.pm, u.pn); u.slab = c;
        { const int ks = tail / nseg; u.seg = part / ks; u.nk = nt / ks; u.k0 = (part - u.seg * ks) * u.nk; }
        return true;
    }
};

typedef f32x4 Acc[2][2][4][2];

template <class Epi, int MODE = 0>
__device__ __forceinline__ void gemm_phase(LAS unsigned char* lds, const Gemm g, const Order& S, const Epi& E, int wave_id) {
    const int wid = wave_id, lane = lane_id(), tid = wid * 64 + lane; const int wr = wid >> 2, wc = wid & 3, fr = lane & 15, fq = lane >> 4;
    const int K = g.K;
    unsigned voffA[2], voffB[2];
#pragma unroll
    for (int i = 0; i < 2; ++i) { int R, C; stage_rc(tid * 16 + i * 8192, R, C); const int Rb = (R & ~31) + perm32(R & 31);
        voffA[i] = (unsigned)(R * K + C) * 2u; voffB[i] = (unsigned)(Rb * K + C) * 2u; }
    const size_t kstep = (size_t)(BK * 2);
    const size_t hstep = (size_t)HALF * K * 2;
    const size_t tstep = 2 * hstep;
    const unsigned ldsw = (unsigned)wid * 1024u;
    const int aoff = lds_byte(wr * 64 + fr, fq * 8), boff = lds_byte(wc * 32 + fr, fq * 8);
#define PG8_SA(b, h) (((b) * 2 + (h)) * HTB)
#define PG8_SB(b, h) ((4 + (b) * 2 + (h)) * HTB)
#define PG8_STAGE(bufoff, gbase, voff) do { _Pragma("unroll") for (int _i = 0; _i < 2; ++_i) \
        __builtin_amdgcn_global_load_lds((const GAS unsigned*)((const GAS char*)(gbase) + (voff)[_i]), (LAS unsigned*)(lds + (bufoff) + ldsw + _i * 8192), 16, 0, 0); } while (0)
#define PG8_LDA(dst, b, h) do { _Pragma("unroll") for (int m = 0; m < 4; ++m) _Pragma("unroll") for (int k = 0; k < 2; ++k) dst[m][k] = *(const LAS bf16x8*)(lds + PG8_SA(b, h) + aoff + m * 2048 + k * 1024); } while (0)
#define PG8_LDB(dst, b, h) do { _Pragma("unroll") for (int n = 0; n < 2; ++n) _Pragma("unroll") for (int k = 0; k < 2; ++k) dst[n][k] = *(const LAS bf16x8*)(lds + PG8_SB(b, h) + boff + n * 2048 + k * 1024); } while (0)
#define PG8_MMA(ai, bj, At, Bt) do { __builtin_amdgcn_s_setprio(1); _Pragma("unroll") for (int m = 0; m < 4; ++m) _Pragma("unroll") for (int n = 0; n < 2; ++n) _Pragma("unroll") for (int k = 0; k < 2; ++k) \
        acc[ai][bj][m][n] = __builtin_amdgcn_mfma_f32_16x16x32_bf16(Bt[n][k], At[m][k], acc[ai][bj][m][n], 0, 0, 0); __builtin_amdgcn_s_setprio(0); } while (0)
#define PG8_WAIT_V(n) asm volatile("s_waitcnt vmcnt(" #n ")" ::: "memory")
#define PG8_WAIT_L(n) asm volatile("s_waitcnt lgkmcnt(" #n ")" ::: "memory")
#define PG8_BAR __builtin_amdgcn_s_barrier()
#define PG8_SCHED __builtin_amdgcn_sched_barrier(0)
    Unit cur, nxt; int ui = 0;
    if (!S.template next<MODE>(0, cur)) return;
    Acc acc;
#pragma unroll
    for (int a = 0; a < 2; ++a)
#pragma unroll
        for (int b = 0; b < 2; ++b)
#pragma unroll
            for (int m = 0; m < 4; ++m)
#pragma unroll
                for (int n = 0; n < 2; ++n) acc[a][b][m][n] = (f32x4){0.f, 0.f, 0.f, 0.f};
    bf16x8 At[4][2], B0[2][2], B1[2][2];
    const GAS char* cA = (const GAS char*)(g.A + (size_t)cur.seg * g.a_seg) + (size_t)cur.pm * tstep + (MODE ? (size_t)cur.k0 * kstep : 0); const GAS char* cB = (const GAS char*)(g.Bt + (size_t)cur.seg * g.b_seg) + (size_t)cur.pn * tstep + (MODE ? (size_t)cur.k0 * kstep : 0);
    PG8_STAGE(PG8_SB(0, 0), cB, voffB); PG8_STAGE(PG8_SB(0, 1), cB + hstep, voffB); PG8_STAGE(PG8_SA(0, 0), cA, voffA); PG8_STAGE(PG8_SA(0, 1), cA + hstep, voffA);
    if (wr == 1) PG8_BAR;
    PG8_WAIT_V(2); PG8_BAR;
    PG8_STAGE(PG8_SB(1, 0), cB + kstep, voffB); PG8_STAGE(PG8_SA(1, 0), cA + kstep, voffA); PG8_STAGE(PG8_SB(1, 1), cB + hstep + kstep, voffB);
    PG8_WAIT_V(6); PG8_BAR;
    for (;;) {
        const bool has_next = S.template next<MODE>(ui + 1, nxt);
        const GAS char* nA = has_next ? (const GAS char*)(g.A + (size_t)nxt.seg * g.a_seg) + (size_t)nxt.pm * tstep + (MODE ? (size_t)nxt.k0 * kstep : 0) : cA; const GAS char* nB = has_next ? (const GAS char*)(g.Bt + (size_t)nxt.seg * g.b_seg) + (size_t)nxt.pn * tstep + (MODE ? (size_t)nxt.k0 * kstep : 0) : cB;
        const int nt = MODE == 0 ? K / BK : cur.nk;
        for (int t = 0; t < nt; t += 2) {
            const bool last = (t == nt - 2);
            const GAS char* a1 = cA + (size_t)(t + 1) * kstep;
            const GAS char* a2 = last ? nA : cA + (size_t)(t + 2) * kstep; const GAS char* b2 = last ? nB : cB + (size_t)(t + 2) * kstep;
            const GAS char* a3 = a2 + kstep; const GAS char* b3 = b2 + kstep;
            PG8_LDB(B0, 0, 0); PG8_LDB(B1, 0, 1); PG8_SCHED; PG8_LDA(At, 0, 0); PG8_STAGE(PG8_SA(1, 1), a1 + hstep, voffA);
            PG8_WAIT_V(8); PG8_WAIT_L(0); PG8_BAR; PG8_MMA(0, 0, At, B0); PG8_MMA(0, 1, At, B1); PG8_BAR; PG8_SCHED;
            PG8_LDA(At, 0, 1); PG8_STAGE(PG8_SB(0, 0), b2, voffB); PG8_STAGE(PG8_SB(0, 1), b2 + hstep, voffB); PG8_STAGE(PG8_SA(0, 0), a2, voffA);
            PG8_WAIT_V(8); PG8_WAIT_L(0); PG8_BAR; PG8_MMA(1, 0, At, B0); PG8_MMA(1, 1, At, B1); PG8_BAR; PG8_SCHED;
            PG8_LDB(B0, 1, 0); PG8_LDB(B1, 1, 1); PG8_SCHED; PG8_LDA(At, 1, 0); PG8_STAGE(PG8_SA(0, 1), a2 + hstep, voffA);
            PG8_WAIT_V(8); PG8_WAIT_L(0); PG8_BAR; PG8_MMA(0, 0, At, B0); PG8_MMA(0, 1, At, B1); PG8_BAR; PG8_SCHED;
            PG8_LDA(At, 1, 1); PG8_STAGE(PG8_SB(1, 0), b3, voffB); PG8_STAGE(PG8_SB(1, 1), b3 + hstep, voffB); PG8_STAGE(PG8_SA(1, 0), a3, voffA);
            PG8_WAIT_V(8); PG8_WAIT_L(0); PG8_BAR; PG8_MMA(1, 0, At, B0); PG8_MMA(1, 1, At, B1); PG8_BAR; PG8_SCHED;
        }
        if (wr == 0) PG8_BAR;
        E(acc, cur, wr, wc, fr, fq, lds);
        if (!has_next) break;
        if (MODE == 1 || cur.seg == g.nseg - 1) {
#pragma unroll
            for (int a = 0; a < 2; ++a)
#pragma unroll
                for (int b = 0; b < 2; ++b)
#pragma unroll
                    for (int m = 0; m < 4; ++m)
#pragma unroll
                        for (int n = 0; n < 2; ++n) acc[a][b][m][n] = (f32x4){0.f, 0.f, 0.f, 0.f};
        }
        cur = nxt; cA = nA; cB = nB; ++ui;
        if (wr == 1) PG8_BAR;
    }
    PG8_WAIT_V(0);
    PG8_BAR;
#undef PG8_SA
#undef PG8_SB
#undef PG8_STAGE
#undef PG8_LDA
#undef PG8_LDB
#undef PG8_MMA
#undef PG8_WAIT_V
#undef PG8_WAIT_L
#undef PG8_BAR
#undef PG8_SCHED
}

typedef _Float16 h16x2 __attribute__((ext_vector_type(2)));
__device__ __forceinline__ unsigned cvt_pk_f16(float a, float b) { const f32x2 t = {a, b}; return __builtin_bit_cast(unsigned, __builtin_convertvector(t, h16x2)); }
__device__ __forceinline__ v4u pack8h(const f32x4 a, const f32x4 b) { v4u w; w.x = cvt_pk_f16(a[0], a[1]); w.y = cvt_pk_f16(a[2], a[3]); w.z = cvt_pk_f16(b[0], b[1]); w.w = cvt_pk_f16(b[2], b[3]); return w; }
#define EPI_FOR_ROWS for (int ai = 0; ai < 2; ++ai) _Pragma("unroll") for (int m = 0; m < 4; ++m)
__device__ __forceinline__ v4u pack8(const f32x4 a, const f32x4 b) { v4u w; w.x = cvt_pk_bf16(a[0], a[1]); w.y = cvt_pk_bf16(a[2], a[3]); w.z = cvt_pk_bf16(b[0], b[1]); w.w = cvt_pk_bf16(b[2], b[3]); return w; }

#define NT_ST(p, v) __builtin_nontemporal_store((v), (p))
struct EpiProj {
    int layer; GAS unsigned char* ws; GAS float* out; const GAS float* qng; const GAS float* kng; const GAS float* lb;
    __device__ __forceinline__ void operator()(Acc& acc, const Unit& u, int wr, int wc, int fr, int fq, LAS unsigned char* lds) const {
        const int grp = u.pn >> 2, ct = u.pn & 3;
        const int row0 = u.pm * BM + wr * 64 + fr;
        const int cg0 = ct * 256 + wc * 32 + 8 * fq;
        const bool sample = u.pm >= MPAD / 256;
        if (grp == 2 || grp == 3) {
            LAS float* X = (LAS float*)(lds + LDS_XCH);
#pragma unroll
            EPI_FOR_ROWS {
#pragma unroll
                for (int bj = 0; bj < 2; ++bj) { const f32x4 a = acc[ai][bj][m][0], b = acc[ai][bj][m][1];
                    float s = (a[0] * a[0] + a[1] * a[1]) + (a[2] * a[2] + a[3] * a[3]) + (b[0] * b[0] + b[1] * b[1]) + (b[2] * b[2] + b[3] * b[3]);
                    s += __shfl_xor(s, 16); s += __shfl_xor(s, 32);
                    if (fq == 0) X[(ai * 128 + wr * 64 + m * 16 + fr) * 8 + bj * 4 + wc] = s; } }
            LDS_WAIT(); __builtin_amdgcn_s_barrier(); asm volatile("" ::: "memory");
            const GAS float* gv = (grp == 2 ? qng : kng) + wc * 32 + 8 * fq; const float qs = (grp == 2) ? SB_SCALE * LOG2E : 1.0f;
            const f32x4 g0 = *(const GAS f32x4*)gv * qs, g1 = *(const GAS f32x4*)(gv + 4) * qs;
            GAS bf16* qdst = (GAS bf16*)(ws + WS_Q);
            GAS float* kdst = sample ? out + O_KS + (size_t)layer * MS * 1024 - (size_t)MPAD * 1024 : out + O_KP + (size_t)layer * MP * 1024;
#pragma unroll
            EPI_FOR_ROWS { const int row = row0 + ai * 128 + m * 16;
#pragma unroll
                for (int bj = 0; bj < 2; ++bj) { const f32x4 p = *(const LAS f32x4*)(X + (ai * 128 + wr * 64 + m * 16 + fr) * 8 + bj * 4);
                    const float rs = frsq(((p[0] + p[1]) + (p[2] + p[3])) * (1.0f / 128.0f) + EPS);
                    const f32x4 a = acc[ai][bj][m][0] * rs * g0, b = acc[ai][bj][m][1] * rs * g1; const int col = cg0 + bj * 128;
                    if (grp == 2) NT_ST((GAS v4u*)(qdst + (size_t)row * 1024 + col), pack8(a, b));
                    else if (sample || row < MP) { GAS float* d = kdst + (size_t)row * 1024 + col; NT_ST((GAS f32x4*)d, a); NT_ST((GAS f32x4*)(d + 4), b); } } }
            return;
        }
        if (grp == 4) {
            GAS float* vdst = sample ? out + O_VS + (size_t)layer * MS * 1024 - (size_t)MPAD * 1024 : out + O_VP + (size_t)layer * MP * 1024;
#pragma unroll
            EPI_FOR_ROWS { const int row = row0 + ai * 128 + m * 16;
                if (sample || row < MP) {
#pragma unroll
                    for (int bj = 0; bj < 2; ++bj) { GAS float* d = vdst + (size_t)row * 1024 + cg0 + bj * 128; NT_ST((GAS f32x4*)d, acc[ai][bj][m][0]); NT_ST((GAS f32x4*)(d + 4), acc[ai][bj][m][1]); } } }
            return;
        }
        if (grp == 6) {
            GAS _Float16* lf = (GAS _Float16*)(ws + WS_LOGF); GAS bf16* kc = (GAS bf16*)(ws + WS_KC);
#pragma unroll
            for (int bj = 0; bj < 2; ++bj) { const int col = cg0 + bj * 128; const f32x4 l0 = *(const GAS f32x4*)(lb + col), l1 = *(const GAS f32x4*)(lb + col + 4);
#pragma unroll
                EPI_FOR_ROWS { const int row = row0 + ai * 128 + m * 16; f32x4 z[2] = {acc[ai][bj][m][0], acc[ai][bj][m][1]}; f32x4 lo[2], ko[2];
#pragma unroll
                    for (int n = 0; n < 2; ++n)
#pragma unroll
                        for (int j = 0; j < 4; ++j) { const float zz = z[n][j], l = n ? l1[j] : l0[j], e = fexp2(-fabsf(zz) * LOG2E), r = frcp(1.0f + e), er = e * r;
                            const float sp = zz >= 0.f ? r : er, sn = zz >= 0.f ? er : r, oml = 1.0f - l;
                            lo[n][j] = flog2(l + oml * sp); ko[n][j] = oml * sn; }
                    NT_ST((GAS v4u*)(lf + (size_t)row * 1024 + col), pack8h(lo[0], lo[1]));
                    NT_ST((GAS v4u*)(kc + (size_t)row * 1024 + col), pack8(ko[0], ko[1])); } }
            return;
        }
        size_t off; int act;
        switch (grp) {
            case 0: off = WS_UA; act = 0; break;   case 1: off = WS_SGA; act = 1; break;  case 5: off = WS_SGB; act = 1; break;
            case 7: off = WS_QC; act = 1; break;   case 8: off = WS_IC; act = 0; break;   case 9: off = WS_SGC; act = 1; break;
            default: off = WS_GATE + (size_t)(grp - 10) * RB16; act = 2; break;
        }
        GAS bf16* dst = (GAS bf16*)(ws + off);
#pragma unroll
        EPI_FOR_ROWS { const int row = row0 + ai * 128 + m * 16;
#pragma unroll
            for (int bj = 0; bj < 2; ++bj) { f32x4 a = acc[ai][bj][m][0], b = acc[ai][bj][m][1];
                if (act) {
#pragma unroll
                    for (int j = 0; j < 4; ++j) { const float sa = fsigmoid(a[j]), sb = fsigmoid(b[j]);
                        a[j] = act == 1 ? a[j] * sa : fmaxf(sa, 1e-30f); b[j] = act == 1 ? b[j] * sb : fmaxf(sb, 1e-30f); } }
                NT_ST((GAS v4u*)(dst + (size_t)row * 1024 + cg0 + bj * 128), pack8(a, b)); } }
        if (grp == 0) {
#pragma unroll
            EPI_FOR_ROWS { const int row = row0 + ai * 128 + m * 16; GAS float* d = nullptr;
                if (sample) { const int rr = row - MPAD, b = rr >> 6, i = rr & 63; if (i >= DSEQ - 15) d = out + O_PS + (((size_t)layer * DBATCH + b) * 15 + (i - (DSEQ - 15))) * 1024; }
                else if (row < MP) { const int b = row / LP, t = row - b * LP; if (t >= LP - 15) d = out + O_PP + (((size_t)layer * BATCH + b) * 15 + (t - (LP - 15))) * 1024; }
                if (d) {
#pragma unroll
                    for (int bj = 0; bj < 2; ++bj) { GAS float* dd = d + cg0 + bj * 128; NT_ST((GAS f32x4*)dd, acc[ai][bj][m][0]); NT_ST((GAS f32x4*)(dd + 4), acc[ai][bj][m][1]); } } }
        }
    }
};

struct EpiMerge {
    GAS unsigned char* ws;
    __device__ __forceinline__ void operator()(Acc& acc, const Unit& u, int wr, int wc, int fr, int fq, LAS unsigned char* lds) const {
        const int row0 = u.pm * BM + wr * 64 + fr, c0 = u.pn * BM + wc * 32 + 8 * fq;
        const GAS bf16* G0 = (const GAS bf16*)(ws + WS_GATE) + (size_t)u.seg * MTOT * 1024; const GAS bf16* G1 = G0 + (size_t)MTOT * 1024; GAS bf16* dst = (GAS bf16*)(ws + WS_MERGED);
        const bool fin = u.seg == 2;
#pragma unroll
        for (int ai = 0; ai < 2; ++ai)
#pragma unroll
        for (int mh = 0; mh < 2; ++mh) {
            v4u ga[2][2], gb[2][2];
#pragma unroll
            for (int mm = 0; mm < 2; ++mm)
#pragma unroll
                for (int bj = 0; bj < 2; ++bj) { const size_t ro = (size_t)(row0 + ai * 128 + (2 * mh + mm) * 16) * 1024 + c0 + bj * 128; ga[mm][bj] = *(const GAS v4u*)(G0 + ro); gb[mm][bj] = fin ? ga[mm][bj] : *(const GAS v4u*)(G1 + ro); }
#pragma unroll
            for (int mm = 0; mm < 2; ++mm)
#pragma unroll
                for (int bj = 0; bj < 2; ++bj) { const int m = 2 * mh + mm; const v4u x = ga[mm][bj], y = gb[mm][bj];
                    f32x4 fa0 = {bf_lo(x.x), bf_hi(x.x), bf_lo(x.y), bf_hi(x.y)}, fa1 = {bf_lo(x.z), bf_hi(x.z), bf_lo(x.w), bf_hi(x.w)};
                    if (!fin) { const f32x4 fb0 = {bf_lo(y.x), bf_hi(y.x), bf_lo(y.y), bf_hi(y.y)}, fb1 = {bf_lo(y.z), bf_hi(y.z), bf_lo(y.w), bf_hi(y.w)};
#pragma unroll
                        for (int j = 0; j < 4; ++j) { fa0[j] *= frcp(fb0[j]); fa1[j] *= frcp(fb1[j]); } }
                    acc[ai][bj][m][0] *= fa0; acc[ai][bj][m][1] *= fa1;
                    if (fin) *(GAS v4u*)(dst + (size_t)(row0 + ai * 128 + m * 16) * 1024 + c0 + bj * 128) = pack8(acc[ai][bj][m][0], acc[ai][bj][m][1]); }
        }
    }
};

struct EpiOut {
    GAS unsigned char* ws; GAS float* out; int last, first;
    __device__ __forceinline__ void operator()(Acc& acc, const Unit& u, int wr, int wc, int fr, int fq, LAS unsigned char* lds) const {
        const int row0 = u.pm * BM + wr * 64 + fr, c0 = u.pn * BM + wc * 32 + 8 * fq; GAS float* H = (GAS float*)(ws + WS_H); const GAS unsigned long long* RT = (const GAS unsigned long long*)(ws + WS_RTAB);
        const bool sample = u.pm >= MPAD / 256;
#pragma unroll
        for (int ai = 0; ai < 2; ++ai) {
            f32x4 hv[4][2][2];
#pragma unroll
            for (int m = 0; m < 4; ++m) { const int rw = row0 + ai * 128 + m * 16; const GAS float* hp = (first ? (const GAS float*)RT[rw] : H + (size_t)rw * 1024) + c0;
#pragma unroll
                for (int bj = 0; bj < 2; ++bj) { hv[m][bj][0] = *(const GAS f32x4*)(hp + bj * 128); hv[m][bj][1] = *(const GAS f32x4*)(hp + bj * 128 + 4); } }
#pragma unroll
            for (int m = 0; m < 4; ++m) { const int row = row0 + ai * 128 + m * 16; GAS float* dp = H + (size_t)row * 1024 + c0; bool ok = true;
                if (last) { if (sample) dp = out + O_YS + (size_t)(row - MPAD) * 1024 + c0;
                    else { const int b = row / LP, t = row - b * LP; ok = row < MP && t >= NMETA; dp = out + O_YP + ((size_t)b * SEQ + (t - NMETA)) * 1024 + c0; } }
                if (ok) {
#pragma unroll
                    for (int bj = 0; bj < 2; ++bj) { *(GAS f32x4*)(dp + bj * 128) = hv[m][bj][0] + acc[ai][bj][m][0]; *(GAS f32x4*)(dp + bj * 128 + 4) = hv[m][bj][1] + acc[ai][bj][m][1]; } } }
        }
    }
};
struct EpiMergeSlab {
    GAS unsigned char* ws;
    __device__ __forceinline__ void operator()(Acc& acc, const Unit& u, int wr, int wc, int fr, int fq, LAS unsigned char* lds) const {
        const int row0 = u.pm * BM + wr * 64 + fr, c0 = u.pn * BM + wc * 32 + 8 * fq;
        const GAS bf16* G0 = (const GAS bf16*)(ws + WS_GATE) + (size_t)u.seg * MTOT * 1024;
        {
            GAS bf16* sl = (GAS bf16*)(ws + WS_SLAB_M) + (size_t)u.slab * 65536 + (size_t)(wr * 64 + fr) * 256 + wc * 32 + 8 * fq;
#pragma unroll
            for (int ai = 0; ai < 2; ++ai) { v4u ga[4][2];
#pragma unroll
                for (int m = 0; m < 4; ++m)
#pragma unroll
                    for (int bj = 0; bj < 2; ++bj) ga[m][bj] = *(const GAS v4u*)(G0 + (size_t)(row0 + ai * 128 + m * 16) * 1024 + c0 + bj * 128);
#pragma unroll
                for (int m = 0; m < 4; ++m)
#pragma unroll
                    for (int bj = 0; bj < 2; ++bj) { const v4u x = ga[m][bj]; const f32x4 f0 = {bf_lo(x.x), bf_hi(x.x), bf_lo(x.y), bf_hi(x.y)}, f1 = {bf_lo(x.z), bf_hi(x.z), bf_lo(x.w), bf_hi(x.w)};
                        *(GAS v4u*)(sl + (size_t)(ai * 128 + m * 16) * 256 + bj * 128) = pack8(acc[ai][bj][m][0] * f0, acc[ai][bj][m][1] * f1); } }
        }
    }
};
struct EpiOutSlab {
    GAS unsigned char* ws;
    __device__ __forceinline__ void operator()(Acc& acc, const Unit& u, int wr, int wc, int fr, int fq, LAS unsigned char* lds) const {
        {
            GAS float* sl = (GAS float*)(ws + WS_SLAB_O) + (size_t)u.slab * 65536 + (size_t)(wr * 64 + fr) * 256 + wc * 32 + 8 * fq;
#pragma unroll
            for (int ai = 0; ai < 2; ++ai)
#pragma unroll
                for (int m = 0; m < 4; ++m)
#pragma unroll
                    for (int bj = 0; bj < 2; ++bj) { GAS float* d = sl + (size_t)(ai * 128 + m * 16) * 256 + bj * 128; *(GAS f32x4*)d = acc[ai][bj][m][0]; *(GAS f32x4*)(d + 4) = acc[ai][bj][m][1]; }
        }
    }
};
}
__device__ __forceinline__ f32x16 mfma32(bf16x8 a, bf16x8 b, f32x16 c) { return __builtin_amdgcn_mfma_f32_32x32x16_bf16(a, b, c, 0, 0, 0); }
__device__ __forceinline__ f32x16 zero16() { f32x16 z;
#pragma unroll
    for (int i = 0; i < 16; ++i) z[i] = 0.f; return z; }
__device__ __forceinline__ bf16x8 cvt8(const f32x4 a, const f32x4 b) { const v4u w = pg8::pack8(a, b); return __builtin_bit_cast(bf16x8, w); }

namespace hg {
constexpr int P136 = 136, P72 = 72;
constexpr int L_QS = 0, L_QT = L_QS + 64 * P136 * 2, L_KT = L_QT + 64 * P136 * 2, L_KTT = L_KT + 64 * P136 * 2, L_VT = L_KTT + 128 * P72 * 2,
              L_ATT = L_VT + 128 * P72 * 2, L_ST = L_ATT + 64 * P72 * 2, L_SEG = L_ST + 128 * P136 * 2, L_EV = L_SEG + 8 * 128 * 4, L_PART = L_EV + 2 * 128 * 4, L_GN = L_PART + 64 * 4 * 4, L_END = L_GN + 128 * 4;
static_assert(L_END <= LDS_MISC, "hgrn LDS");
struct Pre { unsigned lf[8]; unsigned q[8], k[8], v[8]; v2u sg[4]; };
#define HG_BAR() do { asm volatile("s_waitcnt lgkmcnt(0)" ::: "memory"); __builtin_amdgcn_s_barrier(); asm volatile("" ::: "memory"); } while (0)

template <int PART>
__device__ __forceinline__ void prefetch(Pre& P, const GAS unsigned char* ws, size_t row0, int nvalid, int seg, int colb  , int trow  , int sgcol  ) {
    const GAS _Float16* LF = (const GAS _Float16*)(ws + WS_LOGF) + row0 * 1024; const GAS bf16* QC = (const GAS bf16*)(ws + WS_QC) + row0 * 1024; const GAS bf16* KC = (const GAS bf16*)(ws + WS_KC) + row0 * 1024; const GAS bf16* IC = (const GAS bf16*)(ws + WS_IC) + row0 * 1024;
    if (PART & 2) { const GAS bf16* SGC = (const GAS bf16*)(ws + WS_SGC) + row0 * 1024; const unsigned so = (unsigned)((trow < nvalid ? trow : 0) * 1024 + sgcol);
#pragma unroll
      for (int g = 0; g < 4; ++g) P.sg[g] = *(const GAS v2u*)(SGC + so + 8 * g); }
    if (nvalid == 64) {
#pragma unroll
        for (int i = 0; i < 8; ++i) { const unsigned o = (unsigned)((seg * 8 + i) * 1024 + colb);
            if (PART & 1) P.lf[i] = *(const GAS unsigned*)(LF + o);
            if (PART & 2) { P.q[i] = *(const GAS unsigned*)(QC + o); P.k[i] = *(const GAS unsigned*)(KC + o); P.v[i] = *(const GAS unsigned*)(IC + o); } }
    } else {
#pragma unroll
        for (int i = 0; i < 8; ++i) { const int t = seg * 8 + i; const unsigned o = (unsigned)(t * 1024 + colb);
            if (t < nvalid) { if (PART & 1) P.lf[i] = *(const GAS unsigned*)(LF + o); if (PART & 2) { P.q[i] = *(const GAS unsigned*)(QC + o); P.k[i] = *(const GAS unsigned*)(KC + o); P.v[i] = *(const GAS unsigned*)(IC + o); } }
            else { if (PART & 1) P.lf[i] = 0u; if (PART & 2) { P.q[i] = 0u; P.k[i] = 0u; P.v[i] = 0u; } } }
    }
}

__device__ __forceinline__ void chain(Frame& F, int layer, bool sample, int b, int h) {
    LAS unsigned char* lds = F.lds; int tid = F.tid_(); asm volatile("" : "+v"(tid));
    const int lane = tid & 63, wave = F.wave, seg = wave; int kp = tid & 63, l31 = lane & 31, hh = lane >> 5;
    const int L = sample ? DSEQ : LP, nchunks = (L + 63) / 64;
    const size_t rowbase = sample ? (size_t)MPAD + (size_t)b * DSEQ : (size_t)b * LP;
    const int colb = h * 128 + 2 * kp;
    GAS bf16* YC = (GAS bf16*)(F.wsp() + WS_Y) + (size_t)2 * MTOT * 1024;
    const int kb = wave >> 1, vb0 = 2 * (wave & 1);
    f32x16 S[2];
    if (sample) { const GAS float* s0 = F_state_hgrn + (((size_t)layer * DBATCH + b) * 8 + h) * 16384;
#pragma unroll
        for (int vbi = 0; vbi < 2; ++vbi)
#pragma unroll
            for (int r = 0; r < 16; ++r) S[vbi][r] = s0[(size_t)(32 * kb + (r & 3) + 8 * (r >> 2) + 4 * hh) * 128 + 32 * (vb0 + vbi) + l31]; }
    else { S[0] = zero16(); S[1] = zero16(); }
#pragma unroll
    for (int vbi = 0; vbi < 2; ++vbi)
#pragma unroll
        for (int g = 0; g < 4; ++g) { v2u w; w.x = cvt_pk_bf16(S[vbi][4 * g], S[vbi][4 * g + 1]); w.y = cvt_pk_bf16(S[vbi][4 * g + 2], S[vbi][4 * g + 3]);
            *(LAS v2u*)(lds + L_ST + ((32 * (vb0 + vbi) + l31) * P136 + 32 * kb + 8 * g + 4 * hh) * 2) = w; }
    const int ovb = wave & 3, otb = wave >> 2;
    if (tid < 128) *(LAS float*)(lds + L_GN + tid * 4) = F_hng[layer * 128 + tid];
    Pre P; prefetch<3>(P, F.wsp(), rowbase, min(64, L), seg, colb, 32 * otb + l31, h * 128 + 32 * ovb + 4 * hh);
    for (int c = 0; c < nchunks; ++c) {
        asm volatile("" : "+v"(l31), "+v"(hh), "+v"(kp));
        const int nvalid = min(64, L - 64 * c); const size_t row0 = rowbase + (size_t)64 * c;
        float c0[8], c1[8]; { float a0 = 0.f, a1 = 0.f;
#pragma unroll
            for (int i = 0; i < 8; ++i) { const pg8::h16x2 hv = __builtin_bit_cast(pg8::h16x2, P.lf[i]); a0 += (float)hv.x; a1 += (float)hv.y; c0[i] = a0; c1[i] = a1; }
            *(LAS f32x2*)(lds + L_SEG + (seg * 128 + 2 * kp) * 4) = (f32x2){a0, a1}; }
        if (c + 1 < nchunks) prefetch<1>(P, F.wsp(), rowbase + (size_t)64 * (c + 1), min(64, L - 64 * (c + 1)), seg, colb, 32 * otb + l31, h * 128 + 32 * ovb + 4 * hh);
        HG_BAR();
        float off0 = 0.f, off1 = 0.f, m0 = 0.f, m1 = 0.f, la0 = 0.f, la1 = 0.f;
#pragma unroll
        for (int s = 0; s < 8; ++s) { const f32x2 tt = *(const LAS f32x2*)(lds + L_SEG + (s * 128 + 2 * kp) * 4);
            if (s < seg) { off0 += tt.x; off1 += tt.y; } if (s < 4) { m0 += tt.x; m1 += tt.y; } la0 += tt.x; la1 += tt.y; }
        unsigned ktt0[8], ktt1[8], vt0[8], vt1[8]; const float e2m0 = fexp2(m0), e2m1 = fexp2(m1);
#pragma unroll
        for (int i = 0; i < 8; ++i) { const int t = seg * 8 + i; const float cu0 = off0 + c0[i], cu1 = off1 + c1[i];
            const float q0 = bf_lo(P.q[i]), q1 = bf_hi(P.q[i]), k0 = bf_lo(P.k[i]), k1 = bf_hi(P.k[i]);
            const float em0 = fexp2(cu0 - m0), em1 = fexp2(cu1 - m1), ek0 = fexp2(m0 - cu0), ek1 = fexp2(m1 - cu1), eq0 = em0 * e2m0, eq1 = em1 * e2m1;
            *(LAS unsigned*)(lds + L_QS + (t * P136 + 2 * kp) * 2) = cvt_pk_bf16(q0 * eq0, q1 * eq1);
            *(LAS unsigned*)(lds + L_QT + (t * P136 + 2 * kp) * 2) = cvt_pk_bf16(q0 * em0, q1 * em1);
            const unsigned kt = cvt_pk_bf16(k0 * ek0, k1 * ek1);
            *(LAS unsigned*)(lds + L_KT + (t * P136 + 2 * kp) * 2) = kt;
            ktt0[i] = kt & 0xffffu; ktt1[i] = kt >> 16; vt0[i] = P.v[i] & 0xffffu; vt1[i] = P.v[i] >> 16; }
        { v4u w; w.x = ktt0[0] | (ktt0[1] << 16); w.y = ktt0[2] | (ktt0[3] << 16); w.z = ktt0[4] | (ktt0[5] << 16); w.w = ktt0[6] | (ktt0[7] << 16);
          *(LAS v4u*)(lds + L_KTT + ((2 * kp) * P72 + 8 * seg) * 2) = w;
          w.x = ktt1[0] | (ktt1[1] << 16); w.y = ktt1[2] | (ktt1[3] << 16); w.z = ktt1[4] | (ktt1[5] << 16); w.w = ktt1[6] | (ktt1[7] << 16);
          *(LAS v4u*)(lds + L_KTT + ((2 * kp + 1) * P72 + 8 * seg) * 2) = w;
          w.x = vt0[0] | (vt0[1] << 16); w.y = vt0[2] | (vt0[3] << 16); w.z = vt0[4] | (vt0[5] << 16); w.w = vt0[6] | (vt0[7] << 16);
          *(LAS v4u*)(lds + L_VT + ((2 * kp) * P72 + 8 * seg) * 2) = w;
          w.x = vt1[0] | (vt1[1] << 16); w.y = vt1[2] | (vt1[3] << 16); w.z = vt1[4] | (vt1[5] << 16); w.w = vt1[6] | (vt1[7] << 16);
          *(LAS v4u*)(lds + L_VT + ((2 * kp + 1) * P72 + 8 * seg) * 2) = w; }
        if (seg == 0) { *(LAS f32x2*)(lds + L_EV + (2 * kp) * 4) = (f32x2){fexp2(la0), fexp2(la1)}; *(LAS f32x2*)(lds + L_EV + (128 + 2 * kp) * 4) = (f32x2){fexp2(la0 - m0), fexp2(la1 - m1)}; }
        v2u sg[4] = {P.sg[0], P.sg[1], P.sg[2], P.sg[3]};
        if (c + 1 < nchunks) prefetch<2>(P, F.wsp(), rowbase + (size_t)64 * (c + 1), min(64, L - 64 * (c + 1)), seg, colb, 32 * otb + l31, h * 128 + 32 * ovb + 4 * hh);
        HG_BAR();
        if (wave < 3) { const int sb = wave == 2 ? 1 : 0, tb = wave == 0 ? 0 : 1; f32x16 a = zero16();
#pragma unroll
            for (int st = 0; st < 8; ++st) { const bf16x8 ka = *(const LAS bf16x8*)(lds + L_KT + ((32 * sb + l31) * P136 + 16 * st + 8 * hh) * 2);
                const bf16x8 qb = *(const LAS bf16x8*)(lds + L_QT + ((32 * tb + l31) * P136 + 16 * st + 8 * hh) * 2); a = mfma32(ka, qb, a); }
            const int t = 32 * tb + l31;
#pragma unroll
            for (int g = 0; g < 4; ++g) { const int s0 = 32 * sb + 8 * g + 4 * hh; float x[4];
#pragma unroll
                for (int j = 0; j < 4; ++j) x[j] = (s0 + j <= t) ? a[4 * g + j] : 0.f;
                v2u w; w.x = cvt_pk_bf16(x[0], x[1]); w.y = cvt_pk_bf16(x[2], x[3]); *(LAS v2u*)(lds + L_ATT + (t * P72 + s0) * 2) = w; } }
        HG_BAR();
        f32x16 o = zero16();
#pragma unroll
        for (int st = 0; st < 8; ++st) { const bf16x8 sa = *(const LAS bf16x8*)(lds + L_ST + ((32 * ovb + l31) * P136 + 16 * st + 8 * hh) * 2);
            const bf16x8 qb = *(const LAS bf16x8*)(lds + L_QS + ((32 * otb + l31) * P136 + 16 * st + 8 * hh) * 2); o = mfma32(sa, qb, o); }
        for (int st = 0; st < 2 + 2 * otb; ++st) { const bf16x8 va = *(const LAS bf16x8*)(lds + L_VT + ((32 * ovb + l31) * P72 + 16 * st + 8 * hh) * 2);
            const bf16x8 ab = *(const LAS bf16x8*)(lds + L_ATT + ((32 * otb + l31) * P72 + 16 * st + 8 * hh) * 2); o = mfma32(va, ab, o); }
        { float ss = 0.f;
#pragma unroll
            for (int r = 0; r < 16; ++r) ss += o[r] * o[r];
            ss += __shfl_xor(ss, 32);
            if (hh == 0) *(LAS float*)(lds + L_PART + ((32 * otb + l31) * 4 + ovb) * 4) = ss; }
        HG_BAR();
        { const f32x4 p = *(const LAS f32x4*)(lds + L_PART + (32 * otb + l31) * 16); const float rs = frsq(((p[0] + p[1]) + (p[2] + p[3])) * (1.0f / 128.0f) + EPS);
          const int t = 32 * otb + l31;
          if (t < nvalid) { GAS bf16* yp = YC + (row0 + t) * 1024 + h * 128 + 32 * ovb + 4 * hh;
#pragma unroll
              for (int g = 0; g < 4; ++g) { const f32x4 gng = *(const LAS f32x4*)(lds + L_GN + (32 * ovb + 8 * g + 4 * hh) * 4); const float y0 = o[4 * g] * rs * gng[0] * bf_lo(sg[g].x), y1 = o[4 * g + 1] * rs * gng[1] * bf_hi(sg[g].x),
                                                        y2 = o[4 * g + 2] * rs * gng[2] * bf_lo(sg[g].y), y3 = o[4 * g + 3] * rs * gng[3] * bf_hi(sg[g].y);
                  v2u w; w.x = cvt_pk_bf16(y0, y1); w.y = cvt_pk_bf16(y2, y3); *(GAS v2u*)(yp + 8 * g) = w; } } }
        f32x16 Pn[2] = {zero16(), zero16()};
#pragma unroll
        for (int st = 0; st < 4; ++st) { const bf16x8 ka = *(const LAS bf16x8*)(lds + L_KTT + ((32 * kb + l31) * P72 + 16 * st + 8 * hh) * 2);
#pragma unroll
            for (int vbi = 0; vbi < 2; ++vbi) { const bf16x8 vbf = *(const LAS bf16x8*)(lds + L_VT + ((32 * (vb0 + vbi) + l31) * P72 + 16 * st + 8 * hh) * 2); Pn[vbi] = mfma32(ka, vbf, Pn[vbi]); } }
#pragma unroll
        for (int g = 0; g < 4; ++g) { const f32x4 el = *(const LAS f32x4*)(lds + L_EV + (32 * kb + 8 * g + 4 * hh) * 4), elm = *(const LAS f32x4*)(lds + L_EV + (128 + 32 * kb + 8 * g + 4 * hh) * 4);
#pragma unroll
            for (int vbi = 0; vbi < 2; ++vbi) {
#pragma unroll
                for (int j = 0; j < 4; ++j) S[vbi][4 * g + j] = el[j] * S[vbi][4 * g + j] + elm[j] * Pn[vbi][4 * g + j];
                v2u w; w.x = cvt_pk_bf16(S[vbi][4 * g], S[vbi][4 * g + 1]); w.y = cvt_pk_bf16(S[vbi][4 * g + 2], S[vbi][4 * g + 3]);
                *(LAS v2u*)(lds + L_ST + ((32 * (vb0 + vbi) + l31) * P136 + 32 * kb + 8 * g + 4 * hh) * 2) = w; } }
    }
    GAS float* sf = sample ? F.outp() + O_HS + (((size_t)layer * DBATCH + b) * 8 + h) * 16384 : F.outp() + O_HP + (((size_t)layer * BATCH + b) * 8 + h) * 16384;
#pragma unroll
    for (int vbi = 0; vbi < 2; ++vbi)
#pragma unroll
        for (int r = 0; r < 16; ++r) sf[(size_t)(32 * kb + (r & 3) + 8 * (r >> 2) + 4 * hh) * 128 + 32 * (vb0 + vbi) + l31] = S[vbi][r];
    HG_BAR();
}
}

namespace sb {
constexpr float R_STOP = -136.0f;
constexpr int KROW = 272, SLOT = 32 * KROW + 128 * 64;
static_assert(8 * SLOT + 64 <= LDS_MISC, "attention LDS");
constexpr int L_DONE = 8 * SLOT;
struct Grp { const GAS float* k_old; const GAS float* v_old; const GAS float* k_new; const GAS float* v_new; };

struct TileRegs { f32x4 k0, k1, v0, v1; };
__device__ __forceinline__ void tile_issue(TileRegs& t, const Grp& g, int kt, int past, int L, int c, int rp, int sh) {
    const int s0 = 32 * kt - sh; const bool old = s0 + sh < past; const int rl = old ? 31 : (L - 1 - (s0 - past)), lo = s0 < 0 ? -s0 : 0;
    const GAS float* kb = old ? g.k_old + (ptrdiff_t)s0 * 1024 : g.k_new + (ptrdiff_t)(s0 - past) * 1024; const GAS float* vb = old ? g.v_old + (ptrdiff_t)s0 * 1024 : g.v_new + (ptrdiff_t)(s0 - past) * 1024;
    if (rl >= 31 && lo == 0) {
        const unsigned o = (unsigned)(2 * rp * 1024 + 4 * c);
        t.k0 = *(const GAS f32x4*)(kb + o); t.k1 = *(const GAS f32x4*)(kb + o + 1024); t.v0 = *(const GAS f32x4*)(vb + o); t.v1 = *(const GAS f32x4*)(vb + o + 1024);
        return; }
    const int r0 = max(min(2 * rp, rl), lo), r1 = max(min(2 * rp + 1, rl), lo);
    t.k0 = *(const GAS f32x4*)(kb + (ptrdiff_t)r0 * 1024 + 4 * c); t.k1 = *(const GAS f32x4*)(kb + (ptrdiff_t)r1 * 1024 + 4 * c);
    t.v0 = *(const GAS f32x4*)(vb + (ptrdiff_t)r0 * 1024 + 4 * c); t.v1 = *(const GAS f32x4*)(vb + (ptrdiff_t)r1 * 1024 + 4 * c);
}
__device__ __forceinline__ void tile_commit(const TileRegs& t, LAS unsigned char* slot, int c, int rp) {
    v2u a; a.x = cvt_pk_bf16(t.k0[0], t.k0[1]); a.y = cvt_pk_bf16(t.k0[2], t.k0[3]); *(LAS v2u*)(slot + (2 * rp) * KROW + 8 * c) = a;
    a.x = cvt_pk_bf16(t.k1[0], t.k1[1]); a.y = cvt_pk_bf16(t.k1[2], t.k1[3]); *(LAS v2u*)(slot + (2 * rp + 1) * KROW + 8 * c) = a;
    LAS unsigned char* vt = slot + 32 * KROW; const int r7 = rp & 7, f = 2 * (rp >> 3) + ((r7 >> 1) & 1);
    const int u = ((f ^ (c & 3)) * 16) + (r7 >> 2) * 8 + (rp & 1) * 4;
#pragma unroll
    for (int j = 0; j < 4; ++j) *(LAS unsigned*)(vt + (4 * c + j) * 64 + u) = cvt_pk_bf16(t.v0[j], t.v1[j]);
}

template <int NG>
__device__ __forceinline__ void block_unit(Frame& F, int layer, int unit  ) {
    constexpr int W = 8 / NG;
    int tid = F.tid_(); asm volatile("" : "+v"(tid)); const int lane = tid & 63, wave = F.wave, l31 = lane & 31, hh = lane >> 5;
    LAS unsigned char* lds = F.lds;
    const bool sample = NG > 1; constexpr int sh = NG == 1 ? 16 : 0; const int L = sample ? DSEQ : LP, past = sample ? PAST : 0, nqt = (L + sh + 31) / 32;
    const int gi = wave / W, wi = wave - gi * W;
    int bh, qt0; bool wave_on; if (!sample) { const int j = 8 - (unit >> 6); bh = unit & 63; qt0 = j == 0 ? 0 : 8 * j - 7; wave_on = j > 0 || wi == 0; } else { bh = unit * NG + gi; qt0 = 0; wave_on = wi < nqt; }
    const int b = bh >> 3, h = bh & 7; const int qt = qt0 + wi;
    const size_t rowbase = sample ? (size_t)MPAD + (size_t)b * DSEQ : (size_t)b * LP;
    Grp g;
    g.k_new = (sample ? F.outp() + O_KS + (size_t)layer * MS * 1024 + (size_t)b * DSEQ * 1024 : F.outp() + O_KP + (size_t)layer * MP * 1024 + (size_t)b * LP * 1024) + h * 128;
    g.v_new = (sample ? F.outp() + O_VS + (size_t)layer * MS * 1024 + (size_t)b * DSEQ * 1024 : F.outp() + O_VP + (size_t)layer * MP * 1024 + (size_t)b * LP * 1024) + h * 128;
    g.k_old = F_cache_k + ((size_t)layer * DBATCH + b) * PAST * 1024 + h * 128; g.v_old = F_cache_v + ((size_t)layer * DBATCH + b) * PAST * 1024 + h * 128;
    const int dt0 = (past >> 5) + qt0;
    const int tq = 32 * qt - sh + l31; const bool qvalid = wave_on && tq >= 0 && tq < L; const size_t qrow = rowbase + (tq < 0 ? 0 : tq < L ? tq : L - 1);
    const GAS bf16* Q = (const GAS bf16*)(F.wsp() + WS_Q) + qrow * 1024 + h * 128 + 8 * hh;
    bf16x8 qf[8];
#pragma unroll
    for (int st = 0; st < 8; ++st) qf[st] = *(const GAS bf16x8*)(Q + 16 * st);
    f32x16 O[4] = {zero16(), zero16(), zero16(), zero16()};
    const int qpos = past + tq; float R = 0.f; bool done = !wave_on;
    const int sc = tid & 31, srp = NG == 1 ? (tid >> 5) : ((tid & (64 * W - 1)) >> 5);
    if (NG == 1) { for (int j0 = 0; j0 < W; j0 += 4) { TileRegs t[4];
#pragma unroll
            for (int j = 0; j < 4; ++j) tile_issue(t[j], g, dt0 + j0 + j, past, L, sc, srp, sh);
#pragma unroll
            for (int j = 0; j < 4; ++j) tile_commit(t[j], lds + ((dt0 + j0 + j) & (W - 1)) * SLOT, sc, srp); } }
    else { for (int j = 0; j < W; ++j) { TileRegs t[4];
#pragma unroll
            for (int ps = 0; ps < 4; ++ps) tile_issue(t[ps], g, dt0 + j, past, L, sc, srp + 4 * ps, sh);
#pragma unroll
            for (int ps = 0; ps < 4; ++ps) tile_commit(t[ps], lds + (gi * W + ((dt0 + j) & (W - 1))) * SLOT, sc, srp + 4 * ps); } }
    if (lane == 0) *(LAS unsigned*)(lds + L_DONE + 4 * wave) = done ? 1u : 0u;
    TileRegs pre; if (NG == 1 && dt0 - 1 >= 0) tile_issue(pre, g, dt0 - 1, past, L, sc, srp, sh);
    HG_BAR();
    for (int i = 0; ; ++i) {
        const int kt = dt0 + wi - i;
        const int knew = dt0 - i - 1;
        TileRegs pre2; if (NG == 1 && knew - 1 >= 0) tile_issue(pre2, g, knew - 1, past, L, sc, srp, sh);
        if (!done && kt >= 0) {
            const LAS unsigned char* slot = lds + (gi * W + (kt & (W - 1))) * SLOT; const int s0 = 32 * kt - sh;
            f32x16 sa = zero16();
#pragma unroll
            for (int st = 0; st < 8; ++st) sa = mfma32(*(const LAS bf16x8*)(slot + l31 * KROW + (16 * st + 8 * hh) * 2), qf[st], sa);
            const bool diag = i == 0;
            float sg[16], kp[16];
#pragma unroll
            for (int r = 0; r < 16; ++r) { const float e = fexp2(-sa[r]), rc = frcp(1.0f + e); sg[r] = rc; kp[r] = e * rc; }
            if (diag || (sh != 0 && kt == 0)) { const int khi = diag ? qpos : 0x7fffffff;
#pragma unroll
                for (int r = 0; r < 16; ++r) { const int key = s0 + (r & 3) + 8 * (r >> 2) + 4 * hh; const bool ok = key < khi && key >= 0; kp[r] = ok ? kp[r] : 1.0f; sg[r] = ok ? sg[r] : 0.f; } }
            float ex[16], T[4], Tp[4];
#pragma unroll
            for (int gq = 0; gq < 4; ++gq) { ex[4 * gq + 3] = 1.0f; ex[4 * gq + 2] = kp[4 * gq + 3]; ex[4 * gq + 1] = ex[4 * gq + 2] * kp[4 * gq + 2]; ex[4 * gq] = ex[4 * gq + 1] * kp[4 * gq + 1]; T[gq] = ex[4 * gq] * kp[4 * gq]; Tp[gq] = __shfl_xor(T[gq], 32); }
            float carry[4]; { float above = fexp2(R);
#pragma unroll
                for (int gq = 3; gq >= 0; --gq) { carry[gq] = above * (hh == 0 ? Tp[gq] : 1.0f); above *= T[gq] * Tp[gq]; }
                R += flog2(fmaxf(((T[0] * Tp[0]) * (T[1] * Tp[1])) * ((T[2] * Tp[2]) * (T[3] * Tp[3])), 1e-45f)); }
            float w[16];
#pragma unroll
            for (int r = 0; r < 16; ++r) w[r] = sg[r] * (carry[r >> 2] * ex[r]);
            const LAS unsigned char* vt = slot + 32 * KROW;
#pragma unroll
            for (int s = 0; s < 2; ++s) { v4u pw; pw.x = cvt_pk_bf16(w[8 * s], w[8 * s + 1]); pw.y = cvt_pk_bf16(w[8 * s + 2], w[8 * s + 3]); pw.z = cvt_pk_bf16(w[8 * s + 4], w[8 * s + 5]); pw.w = cvt_pk_bf16(w[8 * s + 6], w[8 * s + 7]);
                const bf16x8 pb = __builtin_bit_cast(bf16x8, pw);
#pragma unroll
                for (int db = 0; db < 4; ++db) { const int d = 32 * db + l31;
                    O[db] = mfma32(*(const LAS bf16x8*)(vt + d * 64 + (((2 * s + hh) ^ ((d >> 2) & 3)) * 16)), pb, O[db]); } }
            if (kt == 0 || __all(R < R_STOP)) { done = true; if (lane == 0) *(LAS unsigned*)(lds + L_DONE + 4 * wave) = 1u; }
        } else if (!done && kt < 0) { done = true; if (lane == 0) *(LAS unsigned*)(lds + L_DONE + 4 * wave) = 1u; }
        HG_BAR();
        const v4u d0 = *(const LAS v4u*)(lds + L_DONE), d1 = *(const LAS v4u*)(lds + L_DONE + 16);
        if ((d0.x & d0.y & d0.z & d0.w & d1.x & d1.y & d1.z & d1.w) != 0u) break;
        if (NG == 1) { if (knew >= 0) tile_commit(pre, lds + (knew & (W - 1)) * SLOT, sc, srp); pre = pre2; }
        else if (knew >= 0) { TileRegs t[4];
#pragma unroll
            for (int ps = 0; ps < 4; ++ps) tile_issue(t[ps], g, knew, past, L, sc, srp + 4 * ps, sh);
#pragma unroll
            for (int ps = 0; ps < 4; ++ps) tile_commit(t[ps], lds + (gi * W + (knew & (W - 1))) * SLOT, sc, srp + 4 * ps); }
        HG_BAR();
    }
    if (qvalid) { const GAS bf16* SG = (const GAS bf16*)(F.wsp() + WS_SGB) + qrow * 1024 + h * 128 + 4 * hh; GAS bf16* Y = (GAS bf16*)(F.wsp() + WS_Y) + (size_t)MTOT * 1024 + qrow * 1024 + h * 128 + 4 * hh;
        v2u sgv[4][4];
#pragma unroll
        for (int db = 0; db < 4; ++db)
#pragma unroll
            for (int gq = 0; gq < 4; ++gq) sgv[db][gq] = *(const GAS v2u*)(SG + 32 * db + 8 * gq);
#pragma unroll
        for (int db = 0; db < 4; ++db)
#pragma unroll
            for (int gq = 0; gq < 4; ++gq) { const v2u s = sgv[db][gq]; v2u o;
                o.x = cvt_pk_bf16(O[db][4 * gq] * bf_lo(s.x), O[db][4 * gq + 1] * bf_hi(s.x)); o.y = cvt_pk_bf16(O[db][4 * gq + 2] * bf_lo(s.y), O[db][4 * gq + 3] * bf_hi(s.y));
                *(GAS v2u*)(Y + 32 * db + 8 * gq) = o; } }
    HG_BAR();
}
constexpr int NU_P = BATCH * 8 * 9, NU_S = DBATCH * 8 / 4;
constexpr int NUNITS = NU_P + NU_S;
}

namespace pl {
constexpr int RS = 528;
constexpr int L_UT = 0, L_DF = 143 * RS, L_END = L_DF + 128 * RS;
static_assert(L_END <= LDS_MISC, "pool LDS");
constexpr int NU_P = BATCH * 17 * 4, NU_S = DBATCH * 4, NUNITS = NU_P + NU_S;
__device__ __forceinline__ void unit(Frame& F, int layer, int u) {
    LAS unsigned char* lds = F.lds; int tid = F.tid_(); asm volatile("" : "+v"(tid)); const int lane = tid & 63, wave = F.wave, l31 = lane & 31, hh = lane >> 5;
    const bool sample = u >= NU_P; int b, tile, g;
    if (!sample) { g = u & 3; const int x = u >> 2; b = x / 17; tile = x - b * 17; } else { const int x = u - NU_P; g = x & 3; b = x >> 2; tile = 0; }
    const int L = sample ? DSEQ : LP, t0 = tile * 128, nrows = min(128, L - t0), w = 2 << g;
    const size_t rowbase = sample ? (size_t)MPAD + (size_t)b * DSEQ : (size_t)b * LP;
    const GAS bf16* UA = (const GAS bf16*)(F.wsp() + WS_UA);
    { v4u sv[9];
#pragma unroll
      for (int q = 0; q < 9; ++q) { const int idx = tid + 512 * q, i = idx >> 5, ch = idx & 31, t = t0 - 15 + i; v4u v = {0u, 0u, 0u, 0u};
        if (idx < 143 * 32) { if (t >= 0 && t < L) v = *(const GAS v4u*)(UA + (rowbase + t) * 1024 + 256 * g + 8 * ch);
            else if (t < 0 && sample) { const GAS float* sp = F_state_pool + (((size_t)layer * DBATCH + b) * 15 + (15 + t)) * 1024 + 256 * g + 8 * ch; v = pg8::pack8(*(const GAS f32x4*)sp, *(const GAS f32x4*)(sp + 4)); } }
        sv[q] = v; }
#pragma unroll
      for (int q = 0; q < 9; ++q) { const int idx = tid + 512 * q, i = idx >> 5, ch = idx & 31; if (idx < 143 * 32) *(LAS v4u*)(lds + L_UT + i * RS + ch * 16) = sv[q]; } }
    const GAS bf16* WT = (const GAS bf16*)(F.wsp() + WS_WPOOL) + ((size_t)layer * 4 + g) * 65536 + (size_t)(32 * wave + l31) * 256 + 8 * hh;
    bf16x8 wf[16];
#pragma unroll
    for (int st = 0; st < 16; ++st) wf[st] = *(const GAS bf16x8*)(WT + 16 * st);
    const GAS float* sc = F_pool_scale + layer * 1024 + 256 * g + 32 * wave + 4 * hh; const GAS bf16* SGA = (const GAS bf16*)(F.wsp() + WS_SGA); GAS bf16* YA = (GAS bf16*)(F.wsp() + WS_Y);
    v4u sgq[8]; f32x4 scv[4];
#pragma unroll
    for (int q = 0; q < 8; ++q) { const int cq = tid + 512 * q, row = cq >> 5, ch8 = cq & 31;
        sgq[q] = __builtin_nontemporal_load((const GAS v4u*)(SGA + (rowbase + t0 + (row < nrows ? row : 0)) * 1024 + 256 * g + 8 * ch8)); }
#pragma unroll
    for (int gg = 0; gg < 4; ++gg) scv[gg] = *(const GAS f32x4*)(sc + 8 * gg);
    HG_BAR();
    { const int ch = tid & 31, rs = tid >> 5, r0 = 8 * rs; float sum[8];
#pragma unroll
      for (int j = 0; j < 8; ++j) sum[j] = 0.f;
      for (int j = 1; j < w; ++j) { const v4u v = *(const LAS v4u*)(lds + L_UT + (15 + r0 - j) * RS + ch * 16);
          sum[0] += bf_lo(v.x); sum[1] += bf_hi(v.x); sum[2] += bf_lo(v.y); sum[3] += bf_hi(v.y); sum[4] += bf_lo(v.z); sum[5] += bf_hi(v.z); sum[6] += bf_lo(v.w); sum[7] += bf_hi(v.w); }
#pragma unroll
      for (int i = 0; i < 8; ++i) { const int r = r0 + i; const v4u v = *(const LAS v4u*)(lds + L_UT + (15 + r) * RS + ch * 16);
          float x[8] = {bf_lo(v.x), bf_hi(v.x), bf_lo(v.y), bf_hi(v.y), bf_lo(v.z), bf_hi(v.z), bf_lo(v.w), bf_hi(v.w)};
          const float rc = sample ? 1.0f / (float)w : 1.0f / fminf((float)(t0 + r) + 1.0f, (float)w); float d[8];
#pragma unroll
          for (int j = 0; j < 8; ++j) { sum[j] += x[j]; d[j] = sum[j] * rc - x[j]; }
          *(LAS v4u*)(lds + L_DF + r * RS + ch * 16) = pg8::pack8((f32x4){d[0], d[1], d[2], d[3]}, (f32x4){d[4], d[5], d[6], d[7]});
          const v4u o = *(const LAS v4u*)(lds + L_UT + (15 + r - (w - 1)) * RS + ch * 16);
          sum[0] -= bf_lo(o.x); sum[1] -= bf_hi(o.x); sum[2] -= bf_lo(o.y); sum[3] -= bf_hi(o.y); sum[4] -= bf_lo(o.z); sum[5] -= bf_hi(o.z); sum[6] -= bf_lo(o.w); sum[7] -= bf_hi(o.w); } }
    HG_BAR();
    f32x16 acc[4] = {zero16(), zero16(), zero16(), zero16()};
#pragma unroll
    for (int st = 0; st < 16; ++st) { const bf16x8 a = wf[st];
#pragma unroll
        for (int rb = 0; rb < 4; ++rb) { const bf16x8 bb = *(const LAS bf16x8*)(lds + L_DF + (32 * rb + l31) * RS + (16 * st + 8 * hh) * 2); acc[rb] = mfma32(a, bb, acc[rb]); } }
    HG_BAR();
    constexpr int TS = 1040;
    static_assert(128 * TS <= L_END, "pool output image");
#pragma unroll
    for (int rb = 0; rb < 4; ++rb)
#pragma unroll
        for (int gg = 0; gg < 4; ++gg) { const f32x4 t = {acc[rb][4 * gg] * scv[gg][0], acc[rb][4 * gg + 1] * scv[gg][1], acc[rb][4 * gg + 2] * scv[gg][2], acc[rb][4 * gg + 3] * scv[gg][3]};
            *(LAS f32x4*)(lds + (32 * rb + l31) * TS + (32 * wave + 8 * gg + 4 * hh) * 4) = t; }
    HG_BAR();
#pragma unroll
    for (int q = 0; q < 8; ++q) { const int cq = tid + 512 * q, row = cq >> 5, ch8 = cq & 31;
        if (row < nrows) { const f32x4 a = *(const LAS f32x4*)(lds + row * TS + ch8 * 32), b = *(const LAS f32x4*)(lds + row * TS + ch8 * 32 + 16); const v4u s = sgq[q];
            const f32x4 ga = {bf_lo(s.x), bf_hi(s.x), bf_lo(s.y), bf_hi(s.y)}, gb = {bf_lo(s.z), bf_hi(s.z), bf_lo(s.w), bf_hi(s.w)};
            *(GAS v4u*)(YA + (rowbase + t0 + row) * 1024 + 256 * g + 8 * ch8) = pg8::pack8(a * ga, b * gb); } }
    HG_BAR();
}
}

#ifndef MERGE_TAIL
#define MERGE_TAIL 6
#endif
#ifndef WGM_PROJ
#define WGM_PROJ 4
#endif
#ifndef WGM_SQ
#define WGM_SQ 1
#endif
constexpr int U_HG_P = BATCH * 8, U_HG_S = DBATCH * 8;
constexpr int U0_HGS = U_HG_P, U0_ATT = U0_HGS + U_HG_S, U0_POOL = U0_ATT + sb::NUNITS, U_TOTAL = U0_POOL + pl::NUNITS;
__device__ __forceinline__ void phase_mixers(Frame& F, int layer, int qslot) {
    GAS unsigned* head = F.ctl() + CW_QUEUE + 64 * qslot;
    for (;;) {
        if (F.tid_() == 0) F.MISC[4] = __hip_atomic_fetch_add(head, 1u, __ATOMIC_RELAXED, __HIP_MEMORY_SCOPE_AGENT);
        HG_BAR();
        int u = (int)F.MISC[4];
        HG_BAR();
        if (u >= U_TOTAL) break;
        if (u >= U0_HGS && u < U0_POOL) u = u < U0_HGS + sb::NUNITS ? u + U_HG_S : u - sb::NUNITS;
        if (u < U0_ATT) { const bool smp = u >= U0_HGS; const int x = smp ? u - U0_HGS : u; hg::chain(F, layer, smp, x >> 3, x & 7); }
        else if (u < U0_POOL) { const int x = u - U0_ATT; if (x < sb::NU_P) sb::block_unit<1>(F, layer, x); else sb::block_unit<4>(F, layer, x - sb::NU_P); }
        else pl::unit(F, layer, u - U0_POOL);
    }
}

__device__ __forceinline__ void combine_merge(Frame& F) {
    pg8::Gemm g{nullptr, nullptr, 0, 0, MTOT / 256, D / 256, 3, D, MERGE_TAIL, WGM_SQ}; pg8::Order S; S.init(g, F.G, 0); if (!S.tail) return;
    const int gw = F.vcu * 8 + F.wave, NGW = F.G * 8, lane = F.lane_(), nrows = (S.nwg - S.G) * 256;
    const GAS bf16* sl = (const GAS bf16*)(F.wsp() + WS_SLAB_M); GAS bf16* M = (GAS bf16*)(F.wsp() + WS_MERGED);
    for (int x = gw; x < nrows; x += NGW) { const int j = x >> 8, r = x & 255; int pm, pn; S.tile_of(S.G + j, pm, pn);
        const GAS bf16* p = sl + (size_t)(MERGE_TAIL * j) * 65536 + (size_t)r * 256 + 4 * lane;
        f32x4 v = {0.f, 0.f, 0.f, 0.f};
#pragma unroll
        for (int q = 0; q < MERGE_TAIL; ++q) { const v2u t = *(const GAS v2u*)(p + (size_t)q * 65536); v += (f32x4){bf_lo(t.x), bf_hi(t.x), bf_lo(t.y), bf_hi(t.y)}; }
        v2u o; o.x = cvt_pk_bf16(v[0], v[1]); o.y = cvt_pk_bf16(v[2], v[3]); *(GAS v2u*)(M + (size_t)(256 * pm + r) * 1024 + 256 * pn + 4 * lane) = o; }
}
__device__ __forceinline__ void combine_out(Frame& F, int last) {
    pg8::Gemm g{nullptr, nullptr, 0, 0, MTOT / 256, D / 256, 1, D, 4, WGM_SQ}; pg8::Order S; S.init(g, F.G, 0); if (!S.tail) return;
    const int gw = F.vcu * 8 + F.wave, NGW = F.G * 8, lane = F.lane_(), nrows = (S.nwg - S.G) * 256;
    const GAS float* sl = (const GAS float*)(F.wsp() + WS_SLAB_O); GAS float* H = (GAS float*)(F.wsp() + WS_H); GAS float* out = F.outp();
    for (int x = gw; x < nrows; x += NGW) { const int j = x >> 8, r = x & 255; int pm, pn; S.tile_of(S.G + j, pm, pn);
        const GAS float* p = sl + (size_t)(4 * j) * 65536 + (size_t)r * 256 + 4 * lane; const int row = 256 * pm + r, col = 256 * pn + 4 * lane;
        const f32x4 v = *(const GAS f32x4*)(H + (size_t)row * 1024 + col) + ((*(const GAS f32x4*)p + *(const GAS f32x4*)(p + 65536)) + (*(const GAS f32x4*)(p + 2 * 65536) + *(const GAS f32x4*)(p + 3 * 65536)));
        if (!last) *(GAS f32x4*)(H + (size_t)row * 1024 + col) = v;
        else if (row >= MPAD) *(GAS f32x4*)(out + O_YS + (size_t)(row - MPAD) * 1024 + col) = v;
        else if (row < MP) { const int b = row / LP, t = row - b * LP; if (t >= NMETA) *(GAS f32x4*)(out + O_YP + ((size_t)b * SEQ + (t - NMETA)) * 1024 + col) = v; } }
}
__device__ __forceinline__ void phase_xn_fused(Frame& F, int l) {
    pg8::Gemm g{nullptr, nullptr, 0, 0, MTOT / 256, D / 256, 1, D, 4, WGM_SQ}; pg8::Order S; S.init(g, F.G, 0);
    LAS int* tab = (LAS int*)F.lds; const int tid = F.tid_(), lane = F.lane_();
    for (int i = tid; i < (MTOT / 256) * 4; i += 512) tab[i] = -1;
    __syncthreads();
    if (S.tail && tid < S.nwg - S.G) { int pm, pn; S.tile_of(S.G + tid, pm, pn); tab[4 * pm + pn] = tid; }
    __syncthreads();
    const int gw = F.vcu * 8 + F.wave, NGW = F.G * 8;
    GAS float* H = (GAS float*)(F.wsp() + WS_H); GAS bf16* XN = (GAS bf16*)(F.wsp() + WS_XN); const GAS float* sl = (const GAS float*)(F.wsp() + WS_SLAB_O); const GAS float* gn = F_norm_g + (size_t)l * D;
    for (int r = gw; r < MTOT; r += NGW) {
        if (r >= MP && r < MPAD) { zero_xn_row(XN + (size_t)r * D, lane); continue; }
        GAS f32x4* xr = (GAS f32x4*)(H + (size_t)r * D) + lane; const int pm = r >> 8, rr = r & 255;
        const GAS f32x4* x0 = l == 1 ? (const GAS f32x4*)(*((const GAS unsigned long long*)(F.wsp() + WS_RTAB) + r)) + lane : xr;
        f32x4 v[4]; float s = 0.f;
#pragma unroll
        for (int j = 0; j < 4; ++j) { const int idx = tab[4 * pm + j]; v[j] = idx >= 0 ? x0[64 * j] : xr[64 * j];
            if (idx >= 0) { const GAS float* p = sl + (size_t)(4 * idx) * 65536 + (size_t)rr * 256 + 4 * lane;
                v[j] += (*(const GAS f32x4*)p + *(const GAS f32x4*)(p + 65536)) + (*(const GAS f32x4*)(p + 2 * 65536) + *(const GAS f32x4*)(p + 3 * 65536)); xr[64 * j] = v[j]; }
            s += (v[j].x * v[j].x + v[j].y * v[j].y) + (v[j].z * v[j].z + v[j].w * v[j].w); }
        const float rs = frsq(wave_sum(s) * (1.f / D) + EPS);
        GAS v2u* o8 = (GAS v2u*)(XN + (size_t)r * D) + lane;
#pragma unroll
        for (int j = 0; j < 4; ++j) { const f32x4 gg = ((const GAS f32x4*)gn)[lane + 64 * j]; v2u o; o.x = cvt_pk_bf16(v[j].x * rs * gg.x, v[j].y * rs * gg.y); o.y = cvt_pk_bf16(v[j].z * rs * gg.z, v[j].w * rs * gg.w); o8[64 * j] = o; }
    }
    __syncthreads();
}
constexpr int NPHASES = 1 + 5 * DEPTH;
__global__ void __launch_bounds__(512, 2) mega_fwd(Params p) {
    extern __shared__ __attribute__((aligned(16))) unsigned char lds_raw[];
    Frame F;
    F.lds = (LAS unsigned char*)lds_raw; F.MISC = (volatile LAS unsigned*)(F.lds + LDS_MISC);
    F.wave = __builtin_amdgcn_readfirstlane((int)threadIdx.x >> 6);
    F.G = gridDim.x; { const int bx = blockIdx.x; F.vcu = (F.G % 8 == 0) ? (bx % 8) * (F.G / 8) + bx / 8 : bx; }
    if (threadIdx.x < 64) F.MISC[threadIdx.x] = 0u;
    if (threadIdx.x == 0) { LAS unsigned long long* P = (LAS unsigned long long*)(F.lds + LDS_PARAM);
        P[0] = (unsigned long long)p.in[0]; P[1] = (unsigned long long)p.in[1]; P[2] = (unsigned long long)p.in[2]; P[3] = (unsigned long long)p.in[3]; P[4] = (unsigned long long)p.in[4];
        P[5] = (unsigned long long)p.in[5]; P[6] = (unsigned long long)p.in[6]; P[7] = (unsigned long long)p.in[7]; P[8] = (unsigned long long)p.in[8]; P[9] = (unsigned long long)p.in[9];
        P[10] = (unsigned long long)p.in[10]; P[11] = (unsigned long long)p.in[11]; P[12] = (unsigned long long)p.in[12]; P[13] = (unsigned long long)p.in[13]; P[14] = (unsigned long long)p.in[14];
        P[15] = (unsigned long long)p.in[15]; P[16] = (unsigned long long)p.in[16]; P[17] = (unsigned long long)p.out; P[18] = (unsigned long long)p.ws; }
    __syncthreads();
    const int lo = p.ph_lo, hi = p.ph_hi;
    XcdBarrier bar; bar.bar = F.ctl() + CW_BAR; bar.x = 0; bar.st = nullptr; bar.leader = false;
    if (hi - lo > 1) bar = xcd_barrier_post(F.ctl() + CW_BAR, F.MISC, F.wave);
#define IN(k) (lo <= (k) && (k) < hi)
#define SEAM(k) do { if (IN(k) && IN((k) + 1)) xcd_barrier(bar, F.wave); } while (0)
    if (IN(0)) { phase_prologue(F); } SEAM(0);
    for (int l = 0; l < DEPTH; ++l) {
        const int pb = 1 + 5 * l;
        if (IN(pb)) { if (l > 0) phase_xn_fused(F, l); }
        if (l > 0) SEAM(pb);
        if (IN(pb + 1)) { pg8::Gemm g{(const GAS bf16*)(F.wsp() + WS_XN), (const GAS bf16*)(F.wsp() + WS_WIN) + (size_t)l * NPROJ * D, 0, 0, MTOT / 256, NPROJ / 256, 1, D, 0, WGM_PROJ};
            pg8::Order S; S.init(g, F.G, (int)blockIdx.x);
            pg8::EpiProj E{l, F.wsp(), F.outp(), F_qng + l * 128, F_kng + l * 128, (const GAS float*)(F.wsp() + WS_LB) + l * 1024};
            pg8::gemm_phase(F.lds, g, S, E, F.wave);
            } SEAM(pb + 1);
        if (IN(pb + 2)) { phase_mixers(F, l, l); } SEAM(pb + 2);
        if (IN(pb + 3)) { pg8::Gemm g{(const GAS bf16*)(F.wsp() + WS_Y), (const GAS bf16*)(F.wsp() + WS_WBR) + (size_t)l * 3 * D * D, (size_t)MTOT * 1024, (size_t)D * D, MTOT / 256, D / 256, 3, D, MERGE_TAIL, WGM_SQ};
            pg8::Order S; S.init(g, F.G, (int)blockIdx.x);
            pg8::EpiMerge E{F.wsp()};
            pg8::gemm_phase(F.lds, g, S, E, F.wave);
            { __syncthreads(); pg8::EpiMergeSlab E2{F.wsp()}; pg8::gemm_phase<pg8::EpiMergeSlab, 1>(F.lds, g, S, E2, F.wave); }
            } SEAM(pb + 3);
        if (IN(pb + 4)) { combine_merge(F); xcd_barrier(bar, F.wave);
            pg8::Gemm g{(const GAS bf16*)(F.wsp() + WS_MERGED), (const GAS bf16*)(F.wsp() + WS_WOUT) + (size_t)l * D * D, 0, 0, MTOT / 256, D / 256, 1, D, 4, WGM_SQ};
            pg8::Order S; S.init(g, F.G, (int)blockIdx.x);
            pg8::EpiOut E{F.wsp(), F.outp(), l == DEPTH - 1 ? 1 : 0, l == 0 ? 1 : 0};
            pg8::gemm_phase(F.lds, g, S, E, F.wave);
            { __syncthreads(); pg8::EpiOutSlab E2{F.wsp()}; pg8::gemm_phase<pg8::EpiOutSlab, 1>(F.lds, g, S, E2, F.wave); }
            xcd_barrier(bar, F.wave); if (l == DEPTH - 1) combine_out(F, 1);
            }
    }
#undef IN
#undef SEAM
}
extern "C" void kernel_launch(void* const* d_in, const int* in_sizes, int n_in, void* d_out, int out_size, void* d_ws, size_t ws_size, hipStream_t stream) {
    static int grid = 0;
    if (grid == 0) {
        if (n_in != 17 || out_size != (int)O_END || ws_size < WS_FAST_END) { fprintf(stderr, "kernel_launch: unexpected sizes (n_in %d, out %d, ws %zu < %zu)\n", n_in, out_size, ws_size, (size_t)WS_FAST_END); grid = -1; return; }
        int dev = 0, cus = 0, per_cu = 0;
        if (hipGetDevice(&dev) != hipSuccess || hipDeviceGetAttribute(&cus, hipDeviceAttributeMultiprocessorCount, dev) != hipSuccess) { grid = -1; return; }
        if (hipFuncSetAttribute((const void*)mega_fwd, hipFuncAttributeMaxDynamicSharedMemorySize, LDS_BYTES) != hipSuccess) { fprintf(stderr, "kernel_launch: hipFuncSetAttribute failed\n"); grid = -1; return; }
        if (hipOccupancyMaxActiveBlocksPerMultiprocessor(&per_cu, (const void*)mega_fwd, 512, LDS_BYTES) != hipSuccess || per_cu < 1) { fprintf(stderr, "kernel_launch: occupancy query says %d blocks per CU\n", per_cu); (void)hipGetLastError(); grid = -1; return; }
        grid = cus;
    }
    if (grid < 0) return;
    (void)hipMemsetAsync((char*)d_ws + WS_CTL, 0, CTL_ZERO_BYTES, stream);
    Params p{};
    for (int i = 0; i < 17; ++i) p.in[i] = (const float*)d_in[i];
    p.out = (float*)d_out; p.ws = (unsigned char*)d_ws;
    p.ph_lo = 0; p.ph_hi = NPHASES;
    hipLaunchKernelGGL(mega_fwd, dim3(grid), dim3(512), LDS_BYTES, stream, p);
}
```

```cpp
#define MK_LAUNCHES 1
#include <hip/hip_runtime.h>
#include <cstdio>
#include <cstdint>
constexpr int D = 1024, BATCH = 8, SEQ = 2048, DEPTH = 2, DBATCH = 32, DSEQ = 64, PAST = 2048, NMETA = 16;
constexpr int LP = NMETA + SEQ;
constexpr int MP = BATCH * LP;
constexpr int MPAD = 16640;
constexpr int MS = DBATCH * DSEQ;
constexpr int MTOT = MPAD + MS;
constexpr int NPROJ = 13 * 1024;
constexpr float EPS = 1e-6f, LB_FLOOR = 1e-30f, SB_SCALE = 0.08838834764831845f;
constexpr size_t O_YP = 0, O_YS = 16777216, O_KP = 18874368, O_VP = 52690944, O_PP = 86507520, O_HP = 86753280,
                 O_KS = 88850432, O_VS = 93044736, O_PS = 97239040, O_HS = 98222080, O_END = 106610688;
#define GAS __attribute__((address_space(1)))
#define LAS __attribute__((address_space(3)))
typedef unsigned short bf16;
typedef unsigned v4u __attribute__((ext_vector_type(4)));
typedef unsigned v2u __attribute__((ext_vector_type(2)));
typedef float f32x4 __attribute__((ext_vector_type(4)));
typedef float f32x2 __attribute__((ext_vector_type(2)));
typedef float f32x16 __attribute__((ext_vector_type(16)));
typedef short bf16x8 __attribute__((ext_vector_type(8)));
typedef short bf16x4 __attribute__((ext_vector_type(4)));
#define LDS_WAIT() asm volatile("s_waitcnt lgkmcnt(0)" ::: "memory")
#define VM_WAIT() asm volatile("s_waitcnt vmcnt(0)" ::: "memory")

typedef __bf16 bf16n2 __attribute__((ext_vector_type(2)));
__device__ __forceinline__ unsigned cvt_pk_bf16(float lo, float hi) { const f32x2 v = {lo, hi}; return __builtin_bit_cast(unsigned, __builtin_convertvector(v, bf16n2)); }
__device__ __forceinline__ float bf_lo(unsigned u) { return __uint_as_float(u << 16); }
__device__ __forceinline__ float bf_hi(unsigned u) { return __uint_as_float(u & 0xffff0000u); }
__device__ __forceinline__ float fexp2(float x) { return __builtin_amdgcn_exp2f(x); }
__device__ __forceinline__ float flog2(float x) { return __builtin_amdgcn_logf(x); }
__device__ __forceinline__ float frcp(float x) { return __builtin_amdgcn_rcpf(x); }
__device__ __forceinline__ float frsq(float x) { return __builtin_amdgcn_rsqf(x); }
__device__ __forceinline__ int lane_id() { unsigned z = 0u; asm volatile("" : "+v"(z)); return (int)__builtin_amdgcn_mbcnt_hi(~0u, __builtin_amdgcn_mbcnt_lo(~0u, z)); }
constexpr float LOG2E = 1.4426950408889634f, LN2 = 0.6931471805599453f;
__device__ __forceinline__ float fexp(float x) { return fexp2(x * LOG2E); }
__device__ __forceinline__ float fsigmoid(float x) { return frcp(1.0f + fexp2(-x * LOG2E)); }
__device__ __forceinline__ float fsilu(float x) { return x * fsigmoid(x); }

constexpr size_t MiB = 1u << 20;
constexpr size_t RB16 = (size_t)MTOT * 1024 * 2, RB32 = (size_t)MTOT * 1024 * 4;
constexpr size_t WS_CTL = 0, CTL_ZERO_BYTES = 64 * 1024;
constexpr size_t WS_RTAB = 1 * MiB + 64 * 1024;
constexpr size_t WS_LB = 1 * MiB;
constexpr size_t WS_WIN = 2 * MiB;
constexpr size_t WS_WBR = WS_WIN + (size_t)2 * NPROJ * 1024 * 2;
constexpr size_t WS_WOUT = WS_WBR + (size_t)6 * 1024 * 1024 * 2;
constexpr size_t WS_WPOOL = WS_WOUT + (size_t)2 * 1024 * 1024 * 2;
constexpr size_t WS_H = WS_WPOOL + 1 * MiB;
constexpr size_t WS_XN = WS_H + RB32;
constexpr size_t WS_UA = WS_XN + RB16, WS_SGA = WS_UA + RB16, WS_Q = WS_SGA + RB16, WS_SGB = WS_Q + RB16, WS_KC = WS_SGB + RB16,
                 WS_QC = WS_KC + RB16, WS_IC = WS_QC + RB16, WS_SGC = WS_IC + RB16, WS_GATE = WS_SGC + RB16  ,
                 WS_LOGF = WS_GATE + 3 * RB16  , WS_Y = WS_LOGF + RB32  , WS_MERGED = WS_Y + 3 * RB16, WS_FAST_END = WS_MERGED + RB16;
constexpr size_t WS_SLAB_M = WS_UA, WS_SLAB_O = WS_Q;
static_assert(108 * 262144 <= 2 * RB16 && 144 * 262144 <= 2 * RB16, "slabs");
constexpr int CW_QUEUE = 64;
constexpr int CW_BAR = 1024;

constexpr int LDS_BYTES = 160 * 1024;
constexpr int LDS_XCH = 128 * 1024;
constexpr int LDS_MISC = 159 * 1024;

#define XB_TMO      128
#define XB_XCNT(j)  (256  + 64 * (j))
#define XB_XSUB(j)  (1280 + 64 * (j))
#define XB_XGEN(j)  (2304 + 64 * (j))
#define XB_TOP      3328
#define XB_TOPGEN   3392
#define XCD_BAR_WORDS 3456
#define XB_SPIN_CAP (1u << 18)
__device__ __forceinline__ unsigned xb_ld(GAS unsigned* p)              { return __hip_atomic_load(p, __ATOMIC_RELAXED, __HIP_MEMORY_SCOPE_AGENT); }
__device__ __forceinline__ unsigned xb_add(GAS unsigned* p, unsigned v) { return __hip_atomic_fetch_add(p, v, __ATOMIC_RELAXED, __HIP_MEMORY_SCOPE_AGENT); }
__device__ __forceinline__ unsigned xb_xcc_id() { return (unsigned)__builtin_amdgcn_s_getreg((3 << 11) | 20) & 0xFu; }
#define XB_SPIN(cond, bar) do { unsigned _sp = 0; while (cond) { __builtin_amdgcn_s_sleep(1); \
    if ((++_sp & 255u) == 0u) { if (xb_ld(&(bar)[XB_TMO])) break; if (_sp > XB_SPIN_CAP) { xb_add(&(bar)[XB_TMO], 1u); break; } } } } while (0)
struct XcdBarrier { GAS unsigned* bar; unsigned x; volatile LAS unsigned* st; bool leader; };
__device__ __forceinline__ XcdBarrier xcd_barrier_post(GAS unsigned* bar, volatile LAS unsigned* st, int wave) {
    XcdBarrier b; b.bar = bar; b.x = xb_xcc_id(); b.st = st; b.leader = false;
    b.leader = (wave == 0) && (lane_id() == 0);
    if (b.leader) (void)xb_add(&bar[XB_XCNT(b.x)], 1u);
    return b;
}
__device__ __forceinline__ void xcd_barrier_complete(GAS unsigned* bar, unsigned x, unsigned& nloc, unsigned& nx) {
    const unsigned G = gridDim.x * gridDim.y * gridDim.z;
    unsigned sum, cnt, mine, sp = 0u;
    for (;;) {
        sum = 0u; cnt = 0u; mine = 0u;
#pragma unroll
        for (unsigned j = 0; j < 16; ++j) { const unsigned c = xb_ld(&bar[XB_XCNT(j)]); sum += c; cnt += (c > 0u) ? 1u : 0u; mine = (j == x) ? c : mine; }
        if (sum == G) break;
        __builtin_amdgcn_s_sleep(1);
        if ((++sp & 255u) == 0u) { if (xb_ld(&bar[XB_TMO])) break; if (sp > XB_SPIN_CAP) { xb_add(&bar[XB_TMO], 1u); break; } }
    }
    nloc = mine > 0u ? mine : 1u; nx = cnt > 0u ? cnt : 1u;
}
__device__ __forceinline__ void xcd_barrier(const XcdBarrier& b, int wave) {
    asm volatile("s_waitcnt vmcnt(0)" ::: "memory");
    __syncthreads();
    if (wave == 0 && lane_id() == 0) {
        GAS unsigned* bar = b.bar;
        __builtin_amdgcn_s_waitcnt(0);
        unsigned nloc = b.st[0], nx = b.st[1];
        if (nloc == 0u) { xcd_barrier_complete(bar, b.x, nloc, nx); b.st[0] = nloc; b.st[1] = nx; }
        const unsigned old = xb_add(&bar[XB_XSUB(b.x)], 1u);
        const unsigned gen = old / nloc;
        if (old + 1u == (gen + 1u) * nloc) {
            __builtin_amdgcn_fence(__ATOMIC_RELEASE, "agent");
            asm volatile("s_waitcnt vmcnt(0)" ::: "memory");
            const unsigned og = xb_add(&bar[XB_TOP], 1u);
            const unsigned tg = og / nx;
            if (og + 1u == (tg + 1u) * nx) xb_add(&bar[XB_TOPGEN], 1u);
            else XB_SPIN(xb_ld(&bar[XB_TOPGEN]) == tg, bar);
            __builtin_amdgcn_fence(__ATOMIC_ACQUIRE, "agent");
            xb_add(&bar[XB_XGEN(b.x)], 1u);
            asm volatile("s_waitcnt vmcnt(0)" ::: "memory");
        } else {
            XB_SPIN(xb_ld(&bar[XB_XGEN(b.x)]) == gen, bar);
            __builtin_amdgcn_fence(__ATOMIC_ACQUIRE, "agent");
            asm volatile("s_waitcnt vmcnt(0)" ::: "memory");
        }
    }
    __syncthreads();
}

struct Params { const float* in[17]; float* out; unsigned char* ws; int ph_lo, ph_hi; };
constexpr int LDS_PARAM = LDS_MISC + 256;
struct Frame {
    LAS unsigned char* lds; volatile LAS unsigned* MISC;
    int wave, G, vcu;
    __device__ __forceinline__ int lane_() const { return lane_id(); }
    __device__ __forceinline__ int tid_() const { return wave * 64 + lane_id(); }
    __device__ __forceinline__ unsigned long long rd(int i) const { const v2u v = *(const LAS v2u*)(lds + LDS_PARAM + 8 * i);
        return ((unsigned long long)(unsigned)__builtin_amdgcn_readfirstlane((int)v.y) << 32) | (unsigned)__builtin_amdgcn_readfirstlane((int)v.x); }
    __device__ __forceinline__ const GAS float* in(int i) const { return (const GAS float*)rd(i); }
    __device__ __forceinline__ GAS float* outp() const { return (GAS float*)rd(17); }
    __device__ __forceinline__ GAS unsigned char* wsp() const { return (GAS unsigned char*)rd(18); }
    __device__ __forceinline__ GAS unsigned* ctl() const { return (GAS unsigned*)(wsp() + WS_CTL); }
};
#define F_xp F.in(0)
#define F_xs F.in(1)
#define F_cache_k F.in(2)
#define F_cache_v F.in(3)
#define F_state_pool F.in(4)
#define F_state_hgrn F.in(5)
#define F_meta F.in(6)
#define F_norm_g F.in(7)
#define F_w_in F.in(8)
#define F_qng F.in(9)
#define F_kng F.in(10)
#define F_w_pool F.in(11)
#define F_pool_scale F.in(12)
#define F_hlb F.in(13)
#define F_hng F.in(14)
#define F_w_branch F.in(15)
#define F_w_out F.in(16)
__device__ __forceinline__ float wave_sum(float v) {
#pragma unroll
    for (int o = 1; o < 64; o <<= 1) v += __shfl_xor(v, o);
    return v;
}

__device__ __forceinline__ void p0_transpose_item(const GAS float* W, int K, int N, GAS bf16* WT, int item, int lane) {
    const int nblk = N / 64, kb = item / nblk, nb = item - kb * nblk, r = lane >> 4, c4 = lane & 15;
    const GAS float* src = W + (size_t)(64 * kb + 16 * r) * N + 64 * nb + 4 * c4;
    f32x4 v[16];
#pragma unroll
    for (int i = 0; i < 16; ++i) v[i] = __builtin_nontemporal_load((const GAS f32x4*)(src + (size_t)i * N));
    GAS bf16* dst = WT + (size_t)(64 * nb + 4 * c4) * K + 64 * kb + 16 * r;
#pragma unroll
    for (int j = 0; j < 4; ++j) { v4u a, b;
        a.x = cvt_pk_bf16(v[0][j], v[1][j]); a.y = cvt_pk_bf16(v[2][j], v[3][j]); a.z = cvt_pk_bf16(v[4][j], v[5][j]); a.w = cvt_pk_bf16(v[6][j], v[7][j]);
        b.x = cvt_pk_bf16(v[8][j], v[9][j]); b.y = cvt_pk_bf16(v[10][j], v[11][j]); b.z = cvt_pk_bf16(v[12][j], v[13][j]); b.w = cvt_pk_bf16(v[14][j], v[15][j]);
        *(GAS v4u*)(dst + (size_t)j * K) = a; *(GAS v4u*)(dst + (size_t)j * K + 8) = b; }
}
__device__ __forceinline__ void xn_row(const GAS float* src, GAS float* hdst, const GAS float* g, GAS bf16* xnrow, int lane) {
    const GAS f32x4* xr = (const GAS f32x4*)src + lane;
    f32x4 v[4]; float s = 0.f;
#pragma unroll
    for (int j = 0; j < 4; ++j) { v[j] = xr[64 * j]; s += (v[j].x * v[j].x + v[j].y * v[j].y) + (v[j].z * v[j].z + v[j].w * v[j].w); }
    if (hdst) { GAS f32x4* ho = (GAS f32x4*)hdst + lane;
#pragma unroll
        for (int j = 0; j < 4; ++j) __builtin_nontemporal_store(v[j], ho + 64 * j); }
    const float rs = frsq(wave_sum(s) * (1.f / D) + EPS);
    GAS v2u* o8 = (GAS v2u*)xnrow + lane;
#pragma unroll
    for (int j = 0; j < 4; ++j) { const f32x4 gg = ((const GAS f32x4*)g)[lane + 64 * j]; v2u o; o.x = cvt_pk_bf16(v[j].x * rs * gg.x, v[j].y * rs * gg.y); o.y = cvt_pk_bf16(v[j].z * rs * gg.z, v[j].w * rs * gg.w); o8[64 * j] = o; }
}
__device__ __forceinline__ void zero_xn_row(GAS bf16* xnrow, int lane) { GAS v2u* o8 = (GAS v2u*)xnrow + lane;
#pragma unroll
    for (int j = 0; j < 4; ++j) o8[64 * j] = (v2u){0u, 0u}; }

__device__ __forceinline__ void phase_prologue(Frame& F) {
    const int gw = F.vcu * 8 + F.wave, NGW = F.G * 8;
    constexpr int I_IN = (D / 64) * (NPROJ / 64), I_SQ = (D / 64) * (D / 64), I_PL = (256 / 64) * (256 / 64);
    constexpr int NITEMS = 2 * I_IN + 6 * I_SQ + 2 * I_SQ + 8 * I_PL;
    GAS bf16* win_t = (GAS bf16*)(F.wsp() + WS_WIN); GAS bf16* wbr_t = (GAS bf16*)(F.wsp() + WS_WBR); GAS bf16* wout_t = (GAS bf16*)(F.wsp() + WS_WOUT); GAS bf16* wpool_t = (GAS bf16*)(F.wsp() + WS_WPOOL);
    for (int it = gw; it < NITEMS; it += NGW) {
        int r = it;
        if (r < 2 * I_IN) { const int l = r / I_IN; p0_transpose_item(F_w_in + (size_t)l * D * NPROJ, D, NPROJ, win_t + (size_t)l * NPROJ * D, r % I_IN, F.lane_()); continue; } r -= 2 * I_IN;
        if (r < 6 * I_SQ) { const int m = r / I_SQ; p0_transpose_item(F_w_branch + (size_t)m * D * D, D, D, wbr_t + (size_t)m * D * D, r % I_SQ, F.lane_()); continue; } r -= 6 * I_SQ;
        if (r < 2 * I_SQ) { const int m = r / I_SQ; p0_transpose_item(F_w_out + (size_t)m * D * D, D, D, wout_t + (size_t)m * D * D, r % I_SQ, F.lane_()); continue; } r -= 2 * I_SQ;
        { const int m = r / I_PL; p0_transpose_item(F_w_pool + (size_t)m * 65536, 256, 256, wpool_t + (size_t)m * 65536, r % I_PL, F.lane_()); }
    }
    GAS float* H = (GAS float*)(F.wsp() + WS_H); GAS bf16* XN = (GAS bf16*)(F.wsp() + WS_XN);
    for (int r = gw; r < MTOT; r += NGW) {
        GAS unsigned long long* rt = (GAS unsigned long long*)(F.wsp() + WS_RTAB) + r;
        if (r >= MP && r < MPAD) { zero_xn_row(XN + (size_t)r * D, F.lane_()); if (F.lane_() == 0) *rt = (unsigned long long)F_meta; continue; }
        const GAS float* src;
        if (r < MP) { const int b = r / LP, t = r - b * LP; src = (t < NMETA) ? F_meta + (size_t)t * D : F_xp + ((size_t)b * SEQ + (t - NMETA)) * D; }
        else src = F_xs + (size_t)(r - MPAD) * D;
        if (F.lane_() == 0) *rt = (unsigned long long)src;
        xn_row(src, nullptr, F_norm_g, XN + (size_t)r * D, F.lane_());
    }
    if (blockIdx.x == 0) { GAS float* lbp = (GAS float*)(F.wsp() + WS_LB);
        for (int i = F.tid_(); i < 1024; i += 512) { const float a = F_hlb[i], b = F_hlb[1024 + i], m = fmaxf(a, b), ea = expf(a - m), eb = expf(b - m), s = ea + eb; const float s0 = ea / s, s1 = eb / s;
            lbp[i] = s0 - s0; lbp[1024 + i] = (s0 + s1) - s0; } }
}
__device__ __forceinline__ void phase_xn(Frame& F, int l) {
    const int gw = F.vcu * 8 + F.wave, NGW = F.G * 8;
    GAS float* H = (GAS float*)(F.wsp() + WS_H); GAS bf16* XN = (GAS bf16*)(F.wsp() + WS_XN);
    for (int r = gw; r < MTOT; r += NGW) {
        if (r >= MP && r < MPAD) { zero_xn_row(XN + (size_t)r * D, F.lane_()); continue; }
        xn_row(H + (size_t)r * D, nullptr, F_norm_g + (size_t)l * D, XN + (size_t)r * D, F.lane_());
    }
}
namespace pg8 {
constexpr int BM = 256, BK = 64, HALF = 128, HTB = HALF * BK * 2, STAGE_BYTES = 8 * HTB, NXCD = 8;
__host__ __device__ __forceinline__ int lds_byte(int r, int c) { const int st = (r >> 4) * 2 + (c >> 5), rr = r & 15, cc = c & 31, ob = rr * 64 + cc * 2; return st * 1024 + (ob ^ (((ob >> 9) & 1) << 5)); }
__host__ __device__ __forceinline__ void stage_rc(int b, int& R, int& C) { const int st = b / 1024, sb = b % 1024, swz = sb ^ (((sb >> 9) & 1) << 5); R = (st >> 1) * 16 + swz / 64; C = (st & 1) * 32 + (swz % 64) / 2; }
__host__ __device__ __forceinline__ int perm32(int rho) { const int n = rho >> 4, i = rho & 15; return 8 * (i >> 2) + 4 * n + (i & 3); }

struct Unit { int pm, pn, seg, k0, nk, slab; };
struct Gemm { const GAS bf16* A; const GAS bf16* Bt; size_t a_seg, b_seg; int nM, nN, nseg, K, tail_parts, wgm; };

struct Order {
    int nM, nN, nwg, G, c, nseg, nt, tail, WGM;
    __device__ void init(const Gemm& g, int G_, int c_) { WGM = g.wgm; nM = g.nM; nN = g.nN; nwg = nM * nN; G = G_; c = c_; nseg = g.nseg; nt = g.K / BK;
        tail = (g.tail_parts > 0 && nwg > G && nwg <= 2 * G && (nwg - G) * g.tail_parts <= G && g.tail_parts % nseg == 0 && (nt % (2 * (g.tail_parts / nseg))) == 0) ? g.tail_parts : 0; }
    __device__ void tile_of(int L, int& pm, int& pn) const {
        int wgid = L; { const int q = nwg / NXCD, r = nwg % NXCD, xcd = wgid % NXCD, off = wgid / NXCD; wgid = (xcd < r ? xcd * (q + 1) : r * (q + 1) + (xcd - r) * q) + off; }
        const int nig = WGM * nN, gid = wgid / nig, fm = gid * WGM, gsz = (nM - fm) < WGM ? (nM - fm) : WGM;
        pm = fm + ((wgid % nig) % gsz); pn = (wgid % nig) / gsz; }
    template <int MODE> __device__ bool next(int i, Unit& u) const {
        u.k0 = 0; u.nk = nt; u.slab = -1;
        if (MODE == 0) {
            if (tail == 0) { const int ti = i / nseg; u.seg = i - ti * nseg; const long L = (long)ti * G + c; if (L >= nwg) return false; tile_of((int)L, u.pm, u.pn); return true; }
            if (i >= nseg) return false; u.seg = i; tile_of(c, u.pm, u.pn); return true; }
        if (tail == 0 || i > 0 || c >= (nwg - G) * tail) return false;
        const int j = c / tail, part = c - j * tail; tile_of(G + j, u.pm, u.pn); u.slab = c;
        { const int ks = tail / nseg; u.seg = part / ks; u.nk = nt / ks; u.k0 = (part - u.seg * ks) * u.nk; }
        return true;
    }
};

typedef f32x4 Acc[2][2][4][2];

template <class Epi, int MODE = 0>
__device__ __forceinline__ void gemm_phase(LAS unsigned char* lds, const Gemm g, const Order& S, const Epi& E, int wave_id) {
    const int wid = wave_id, lane = lane_id(), tid = wid * 64 + lane; const int wr = wid >> 2, wc = wid & 3, fr = lane & 15, fq = lane >> 4;
    const int K = g.K;
    unsigned voffA[2], voffB[2];
#pragma unroll
    for (int i = 0; i < 2; ++i) { int R, C; stage_rc(tid * 16 + i * 8192, R, C); const int Rb = (R & ~31) + perm32(R & 31);
        voffA[i] = (unsigned)(R * K + C) * 2u; voffB[i] = (unsigned)(Rb * K + C) * 2u; }
    const size_t kstep = (size_t)(BK * 2);
    const size_t hstep = (size_t)HALF * K * 2;
    const size_t tstep = 2 * hstep;
    const unsigned ldsw = (unsigned)wid * 1024u;
    const int aoff = lds_byte(wr * 64 + fr, fq * 8), boff = lds_byte(wc * 32 + fr, fq * 8);
#define PG8_SA(b, h) (((b) * 2 + (h)) * HTB)
#define PG8_SB(b, h) ((4 + (b) * 2 + (h)) * HTB)
#define PG8_STAGE(bufoff, gbase, voff) do { _Pragma("unroll") for (int _i = 0; _i < 2; ++_i) \
        __builtin_amdgcn_global_load_lds((const GAS unsigned*)((const GAS char*)(gbase) + (voff)[_i]), (LAS unsigned*)(lds + (bufoff) + ldsw + _i * 8192), 16, 0, 0); } while (0)
#define PG8_LDA(dst, b, h) do { _Pragma("unroll") for (int m = 0; m < 4; ++m) _Pragma("unroll") for (int k = 0; k < 2; ++k) dst[m][k] = *(const LAS bf16x8*)(lds + PG8_SA(b, h) + aoff + m * 2048 + k * 1024); } while (0)
#define PG8_LDB(dst, b, h) do { _Pragma("unroll") for (int n = 0; n < 2; ++n) _Pragma("unroll") for (int k = 0; k < 2; ++k) dst[n][k] = *(const LAS bf16x8*)(lds + PG8_SB(b, h) + boff + n * 2048 + k * 1024); } while (0)
#define PG8_MMA(ai, bj, At, Bt) do { __builtin_amdgcn_s_setprio(1); _Pragma("unroll") for (int m = 0; m < 4; ++m) _Pragma("unroll") for (int n = 0; n < 2; ++n) _Pragma("unroll") for (int k = 0; k < 2; ++k) \
        acc[ai][bj][m][n] = __builtin_amdgcn_mfma_f32_16x16x32_bf16(Bt[n][k], At[m][k], acc[ai][bj][m][n], 0, 0, 0); __builtin_amdgcn_s_setprio(0); } while (0)
#define PG8_WAIT_V(n) asm volatile("s_waitcnt vmcnt(" #n ")" ::: "memory")
#define PG8_WAIT_L(n) asm volatile("s_waitcnt lgkmcnt(" #n ")" ::: "memory")
#define PG8_BAR __builtin_amdgcn_s_barrier()
#define PG8_SCHED __builtin_amdgcn_sched_barrier(0)
    Unit cur, nxt; int ui = 0;
    if (!S.template next<MODE>(0, cur)) return;
    Acc acc;
#pragma unroll
    for (int a = 0; a < 2; ++a)
#pragma unroll
        for (int b = 0; b < 2; ++b)
#pragma unroll
            for (int m = 0; m < 4; ++m)
#pragma unroll
                for (int n = 0; n < 2; ++n) acc[a][b][m][n] = (f32x4){0.f, 0.f, 0.f, 0.f};
    bf16x8 At[4][2], B0[2][2], B1[2][2];
    const GAS char* cA = (const GAS char*)(g.A + (size_t)cur.seg * g.a_seg) + (size_t)cur.pm * tstep + (MODE ? (size_t)cur.k0 * kstep : 0); const GAS char* cB = (const GAS char*)(g.Bt + (size_t)cur.seg * g.b_seg) + (size_t)cur.pn * tstep + (MODE ? (size_t)cur.k0 * kstep : 0);
    PG8_STAGE(PG8_SB(0, 0), cB, voffB); PG8_STAGE(PG8_SB(0, 1), cB + hstep, voffB); PG8_STAGE(PG8_SA(0, 0), cA, voffA); PG8_STAGE(PG8_SA(0, 1), cA + hstep, voffA);
    if (wr == 1) PG8_BAR;
    PG8_WAIT_V(2); PG8_BAR;
    PG8_STAGE(PG8_SB(1, 0), cB + kstep, voffB); PG8_STAGE(PG8_SA(1, 0), cA + kstep, voffA); PG8_STAGE(PG8_SB(1, 1), cB + hstep + kstep, voffB);
    PG8_WAIT_V(6); PG8_BAR;
    for (;;) {
        const bool has_next = S.template next<MODE>(ui + 1, nxt);
        const GAS char* nA = has_next ? (const GAS char*)(g.A + (size_t)nxt.seg * g.a_seg) + (size_t)nxt.pm * tstep + (MODE ? (size_t)nxt.k0 * kstep : 0) : cA; const GAS char* nB = has_next ? (const GAS char*)(g.Bt + (size_t)nxt.seg * g.b_seg) + (size_t)nxt.pn * tstep + (MODE ? (size_t)nxt.k0 * kstep : 0) : cB;
        const int nt = MODE == 0 ? K / BK : cur.nk;
        for (int t = 0; t < nt; t += 2) {
            const bool last = (t == nt - 2);
            const GAS char* a1 = cA + (size_t)(t + 1) * kstep;
            const GAS char* a2 = last ? nA : cA + (size_t)(t + 2) * kstep; const GAS char* b2 = last ? nB : cB + (size_t)(t + 2) * kstep;
            const GAS char* a3 = a2 + kstep; const GAS char* b3 = b2 + kstep;
            PG8_LDB(B0, 0, 0); PG8_LDB(B1, 0, 1); PG8_SCHED; PG8_LDA(At, 0, 0); PG8_STAGE(PG8_SA(1, 1), a1 + hstep, voffA);
            PG8_WAIT_V(8); PG8_WAIT_L(0); PG8_BAR; PG8_MMA(0, 0, At, B0); PG8_MMA(0, 1, At, B1); PG8_BAR; PG8_SCHED;
            PG8_LDA(At, 0, 1); PG8_STAGE(PG8_SB(0, 0), b2, voffB); PG8_STAGE(PG8_SB(0, 1), b2 + hstep, voffB); PG8_STAGE(PG8_SA(0, 0), a2, voffA);
            PG8_WAIT_V(8); PG8_WAIT_L(0); PG8_BAR; PG8_MMA(1, 0, At, B0); PG8_MMA(1, 1, At, B1); PG8_BAR; PG8_SCHED;
            PG8_LDB(B0, 1, 0); PG8_LDB(B1, 1, 1); PG8_SCHED; PG8_LDA(At, 1, 0); PG8_STAGE(PG8_SA(0, 1), a2 + hstep, voffA);
            PG8_WAIT_V(8); PG8_WAIT_L(0); PG8_BAR; PG8_MMA(0, 0, At, B0); PG8_MMA(0, 1, At, B1); PG8_BAR; PG8_SCHED;
            PG8_LDA(At, 1, 1); PG8_STAGE(PG8_SB(1, 0), b3, voffB); PG8_STAGE(PG8_SB(1, 1), b3 + hstep, voffB); PG8_STAGE(PG8_SA(1, 0), a3, voffA);
            PG8_WAIT_V(8); PG8_WAIT_L(0); PG8_BAR; PG8_MMA(1, 0, At, B0); PG8_MMA(1, 1, At, B1); PG8_BAR; PG8_SCHED;
        }
        if (wr == 0) PG8_BAR;
        E(acc, cur, wr, wc, fr, fq, lds);
        if (!has_next) break;
        if (MODE == 1 || cur.seg == g.nseg - 1) {
#pragma unroll
            for (int a = 0; a < 2; ++a)
#pragma unroll
                for (int b = 0; b < 2; ++b)
#pragma unroll
                    for (int m = 0; m < 4; ++m)
#pragma unroll
                        for (int n = 0; n < 2; ++n) acc[a][b][m][n] = (f32x4){0.f, 0.f, 0.f, 0.f};
        }
        cur = nxt; cA = nA; cB = nB; ++ui;
        if (wr == 1) PG8_BAR;
    }
    PG8_WAIT_V(0);
    PG8_BAR;
#undef PG8_SA
#undef PG8_SB
#undef PG8_STAGE
#undef PG8_LDA
#undef PG8_LDB
#undef PG8_MMA
#undef PG8_WAIT_V
#undef PG8_WAIT_L
#undef PG8_BAR
#undef PG8_SCHED
}

typedef _Float16 h16x2 __attribute__((ext_vector_type(2)));
__device__ __forceinline__ unsigned cvt_pk_f16(float a, float b) { const f32x2 t = {a, b}; return __builtin_bit_cast(unsigned, __builtin_convertvector(t, h16x2)); }
__device__ __forceinline__ v4u pack8h(const f32x4 a, const f32x4 b) { v4u w; w.x = cvt_pk_f16(a[0], a[1]); w.y = cvt_pk_f16(a[2], a[3]); w.z = cvt_pk_f16(b[0], b[1]); w.w = cvt_pk_f16(b[2], b[3]); return w; }
#define EPI_FOR_ROWS for (int ai = 0; ai < 2; ++ai) _Pragma("unroll") for (int m = 0; m < 4; ++m)
__device__ __forceinline__ v4u pack8(const f32x4 a, const f32x4 b) { v4u w; w.x = cvt_pk_bf16(a[0], a[1]); w.y = cvt_pk_bf16(a[2], a[3]); w.z = cvt_pk_bf16(b[0], b[1]); w.w = cvt_pk_bf16(b[2], b[3]); return w; }

#define NT_ST(p, v) __builtin_nontemporal_store((v), (p))
struct EpiProj {
    int layer; GAS unsigned char* ws; GAS float* out; const GAS float* qng; const GAS float* kng; const GAS float* lb;
    __device__ __forceinline__ void operator()(Acc& acc, const Unit& u, int wr, int wc, int fr, int fq, LAS unsigned char* lds) const {
        const int grp = u.pn >> 2, ct = u.pn & 3;
        const int row0 = u.pm * BM + wr * 64 + fr;
        const int cg0 = ct * 256 + wc * 32 + 8 * fq;
        const bool sample = u.pm >= MPAD / 256;
        if (grp == 2 || grp == 3) {
            LAS float* X = (LAS float*)(lds + LDS_XCH);
#pragma unroll
            EPI_FOR_ROWS {
#pragma unroll
                for (int bj = 0; bj < 2; ++bj) { const f32x4 a = acc[ai][bj][m][0], b = acc[ai][bj][m][1];
                    float s = (a[0] * a[0] + a[1] * a[1]) + (a[2] * a[2] + a[3] * a[3]) + (b[0] * b[0] + b[1] * b[1]) + (b[2] * b[2] + b[3] * b[3]);
                    s += __shfl_xor(s, 16); s += __shfl_xor(s, 32);
                    if (fq == 0) X[(ai * 128 + wr * 64 + m * 16 + fr) * 8 + bj * 4 + wc] = s; } }
            LDS_WAIT(); __builtin_amdgcn_s_barrier(); asm volatile("" ::: "memory");
            const GAS float* gv = (grp == 2 ? qng : kng) + wc * 32 + 8 * fq; const float qs = (grp == 2) ? SB_SCALE * LOG2E : 1.0f;
            const f32x4 g0 = *(const GAS f32x4*)gv * qs, g1 = *(const GAS f32x4*)(gv + 4) * qs;
            GAS bf16* qdst = (GAS bf16*)(ws + WS_Q);
            GAS float* kdst = sample ? out + O_KS + (size_t)layer * MS * 1024 - (size_t)MPAD * 1024 : out + O_KP + (size_t)layer * MP * 1024;
#pragma unroll
            EPI_FOR_ROWS { const int row = row0 + ai * 128 + m * 16;
#pragma unroll
                for (int bj = 0; bj < 2; ++bj) { const f32x4 p = *(const LAS f32x4*)(X + (ai * 128 + wr * 64 + m * 16 + fr) * 8 + bj * 4);
                    const float rs = frsq(((p[0] + p[1]) + (p[2] + p[3])) * (1.0f / 128.0f) + EPS);
                    const f32x4 a = acc[ai][bj][m][0] * rs * g0, b = acc[ai][bj][m][1] * rs * g1; const int col = cg0 + bj * 128;
                    if (grp == 2) NT_ST((GAS v4u*)(qdst + (size_t)row * 1024 + col), pack8(a, b));
                    else if (sample || row < MP) { GAS float* d = kdst + (size_t)row * 1024 + col; NT_ST((GAS f32x4*)d, a); NT_ST((GAS f32x4*)(d + 4), b); } } }
            return;
        }
        if (grp == 4) {
            GAS float* vdst = sample ? out + O_VS + (size_t)layer * MS * 1024 - (size_t)MPAD * 1024 : out + O_VP + (size_t)layer * MP * 1024;
#pragma unroll
            EPI_FOR_ROWS { const int row = row0 + ai * 128 + m * 16;
                if (sample || row < MP) {
#pragma unroll
                    for (int bj = 0; bj < 2; ++bj) { GAS float* d = vdst + (size_t)row * 1024 + cg0 + bj * 128; NT_ST((GAS f32x4*)d, acc[ai][bj][m][0]); NT_ST((GAS f32x4*)(d + 4), acc[ai][bj][m][1]); } } }
            return;
        }
        if (grp == 6) {
            GAS _Float16* lf = (GAS _Float16*)(ws + WS_LOGF); GAS bf16* kc = (GAS bf16*)(ws + WS_KC);
#pragma unroll
            for (int bj = 0; bj < 2; ++bj) { const int col = cg0 + bj * 128; const f32x4 l0 = *(const GAS f32x4*)(lb + col), l1 = *(const GAS f32x4*)(lb + col + 4);
#pragma unroll
                EPI_FOR_ROWS { const int row = row0 + ai * 128 + m * 16; f32x4 z[2] = {acc[ai][bj][m][0], acc[ai][bj][m][1]}; f32x4 lo[2], ko[2];
#pragma unroll
                    for (int n = 0; n < 2; ++n)
#pragma unroll
                        for (int j = 0; j < 4; ++j) { const float zz = z[n][j], l = n ? l1[j] : l0[j], e = fexp2(-fabsf(zz) * LOG2E), r = frcp(1.0f + e), er = e * r;
                            const float sp = zz >= 0.f ? r : er, sn = zz >= 0.f ? er : r, oml = 1.0f - l;
                            lo[n][j] = flog2(l + oml * sp); ko[n][j] = oml * sn; }
                    NT_ST((GAS v4u*)(lf + (size_t)row * 1024 + col), pack8h(lo[0], lo[1]));
                    NT_ST((GAS v4u*)(kc + (size_t)row * 1024 + col), pack8(ko[0], ko[1])); } }
            return;
        }
        size_t off; int act;
        switch (grp) {
            case 0: off = WS_UA; act = 0; break;   case 1: off = WS_SGA; act = 1; break;  case 5: off = WS_SGB; act = 1; break;
            case 7: off = WS_QC; act = 1; break;   case 8: off = WS_IC; act = 0; break;   case 9: off = WS_SGC; act = 1; break;
            default: off = WS_GATE + (size_t)(grp - 10) * RB16; act = 2; break;
        }
        GAS bf16* dst = (GAS bf16*)(ws + off);
#pragma unroll
        EPI_FOR_ROWS { const int row = row0 + ai * 128 + m * 16;
#pragma unroll
            for (int bj = 0; bj < 2; ++bj) { f32x4 a = acc[ai][bj][m][0], b = acc[ai][bj][m][1];
                if (act) {
#pragma unroll
                    for (int j = 0; j < 4; ++j) { const float sa = fsigmoid(a[j]), sb = fsigmoid(b[j]);
                        a[j] = act == 1 ? a[j] * sa : fmaxf(sa, 1e-30f); b[j] = act == 1 ? b[j] * sb : fmaxf(sb, 1e-30f); } }
                NT_ST((GAS v4u*)(dst + (size_t)row * 1024 + cg0 + bj * 128), pack8(a, b)); } }
        if (grp == 0) {
#pragma unroll
            EPI_FOR_ROWS { const int row = row0 + ai * 128 + m * 16; GAS float* d = nullptr;
                if (sample) { const int rr = row - MPAD, b = rr >> 6, i = rr & 63; if (i >= DSEQ - 15) d = out + O_PS + (((size_t)layer * DBATCH + b) * 15 + (i - (DSEQ - 15))) * 1024; }
                else if (row < MP) { const int b = row / LP, t = row - b * LP; if (t >= LP - 15) d = out + O_PP + (((size_t)layer * BATCH + b) * 15 + (t - (LP - 15))) * 1024; }
                if (d) {
#pragma unroll
                    for (int bj = 0; bj < 2; ++bj) { GAS float* dd = d + cg0 + bj * 128; NT_ST((GAS f32x4*)dd, acc[ai][bj][m][0]); NT_ST((GAS f32x4*)(dd + 4), acc[ai][bj][m][1]); } } }
        }
    }
};

struct EpiMerge {
    GAS unsigned char* ws;
    __device__ __forceinline__ void operator()(Acc& acc, const Unit& u, int wr, int wc, int fr, int fq, LAS unsigned char* lds) const {
        const int row0 = u.pm * BM + wr * 64 + fr, c0 = u.pn * BM + wc * 32 + 8 * fq;
        const GAS bf16* G0 = (const GAS bf16*)(ws + WS_GATE) + (size_t)u.seg * MTOT * 1024; const GAS bf16* G1 = G0 + (size_t)MTOT * 1024; GAS bf16* dst = (GAS bf16*)(ws + WS_MERGED);
        const bool fin = u.seg == 2;
#pragma unroll
        for (int ai = 0; ai < 2; ++ai)
#pragma unroll
        for (int mh = 0; mh < 2; ++mh) {
            v4u ga[2][2], gb[2][2];
#pragma unroll
            for (int mm = 0; mm < 2; ++mm)
#pragma unroll
                for (int bj = 0; bj < 2; ++bj) { const size_t ro = (size_t)(row0 + ai * 128 + (2 * mh + mm) * 16) * 1024 + c0 + bj * 128; ga[mm][bj] = *(const GAS v4u*)(G0 + ro); gb[mm][bj] = fin ? ga[mm][bj] : *(const GAS v4u*)(G1 + ro); }
#pragma unroll
            for (int mm = 0; mm < 2; ++mm)
#pragma unroll
                for (int bj = 0; bj < 2; ++bj) { const int m = 2 * mh + mm; const v4u x = ga[mm][bj], y = gb[mm][bj];
                    f32x4 fa0 = {bf_lo(x.x), bf_hi(x.x), bf_lo(x.y), bf_hi(x.y)}, fa1 = {bf_lo(x.z), bf_hi(x.z), bf_lo(x.w), bf_hi(x.w)};
                    if (!fin) { const f32x4 fb0 = {bf_lo(y.x), bf_hi(y.x), bf_lo(y.y), bf_hi(y.y)}, fb1 = {bf_lo(y.z), bf_hi(y.z), bf_lo(y.w), bf_hi(y.w)};
#pragma unroll
                        for (int j = 0; j < 4; ++j) { fa0[j] *= frcp(fb0[j]); fa1[j] *= frcp(fb1[j]); } }
                    acc[ai][bj][m][0] *= fa0; acc[ai][bj][m][1] *= fa1;
                    if (fin) *(GAS v4u*)(dst + (size_t)(row0 + ai * 128 + m * 16) * 1024 + c0 + bj * 128) = pack8(acc[ai][bj][m][0], acc[ai][bj][m][1]); }
        }
    }
};

struct EpiOut {
    GAS unsigned char* ws; GAS float* out; int last, first;
    __device__ __forceinline__ void operator()(Acc& acc, const Unit& u, int wr, int wc, int fr, int fq, LAS unsigned char* lds) const {
        const int row0 = u.pm * BM + wr * 64 + fr, c0 = u.pn * BM + wc * 32 + 8 * fq; GAS float* H = (GAS float*)(ws + WS_H); const GAS unsigned long long* RT = (const GAS unsigned long long*)(ws + WS_RTAB);
        const bool sample = u.pm >= MPAD / 256;
#pragma unroll
        for (int ai = 0; ai < 2; ++ai) {
            f32x4 hv[4][2][2];
#pragma unroll
            for (int m = 0; m < 4; ++m) { const int rw = row0 + ai * 128 + m * 16; const GAS float* hp = (first ? (const GAS float*)RT[rw] : H + (size_t)rw * 1024) + c0;
#pragma unroll
                for (int bj = 0; bj < 2; ++bj) { hv[m][bj][0] = *(const GAS f32x4*)(hp + bj * 128); hv[m][bj][1] = *(const GAS f32x4*)(hp + bj * 128 + 4); } }
#pragma unroll
            for (int m = 0; m < 4; ++m) { const int row = row0 + ai * 128 + m * 16; GAS float* dp = H + (size_t)row * 1024 + c0; bool ok = true;
                if (last) { if (sample) dp = out + O_YS + (size_t)(row - MPAD) * 1024 + c0;
                    else { const int b = row / LP, t = row - b * LP; ok = row < MP && t >= NMETA; dp = out + O_YP + ((size_t)b * SEQ + (t - NMETA)) * 1024 + c0; } }
                if (ok) {
#pragma unroll
                    for (int bj = 0; bj < 2; ++bj) { *(GAS f32x4*)(dp + bj * 128) = hv[m][bj][0] + acc[ai][bj][m][0]; *(GAS f32x4*)(dp + bj * 128 + 4) = hv[m][bj][1] + acc[ai][bj][m][1]; } } }
        }
    }
};
struct EpiMergeSlab {
    GAS unsigned char* ws;
    __device__ __forceinline__ void operator()(Acc& acc, const Unit& u, int wr, int wc, int fr, int fq, LAS unsigned char* lds) const {
        const int row0 = u.pm * BM + wr * 64 + fr, c0 = u.pn * BM + wc * 32 + 8 * fq;
        const GAS bf16* G0 = (const GAS bf16*)(ws + WS_GATE) + (size_t)u.seg * MTOT * 1024;
        {
            GAS bf16* sl = (GAS bf16*)(ws + WS_SLAB_M) + (size_t)u.slab * 65536 + (size_t)(wr * 64 + fr) * 256 + wc * 32 + 8 * fq;
#pragma unroll
            for (int ai = 0; ai < 2; ++ai) { v4u ga[4][2];
#pragma unroll
                for (int m = 0; m < 4; ++m)
#pragma unroll
                    for (int bj = 0; bj < 2; ++bj) ga[m][bj] = *(const GAS v4u*)(G0 + (size_t)(row0 + ai * 128 + m * 16) * 1024 + c0 + bj * 128);
#pragma unroll
                for (int m = 0; m < 4; ++m)
#pragma unroll
                    for (int bj = 0; bj < 2; ++bj) { const v4u x = ga[m][bj]; const f32x4 f0 = {bf_lo(x.x), bf_hi(x.x), bf_lo(x.y), bf_hi(x.y)}, f1 = {bf_lo(x.z), bf_hi(x.z), bf_lo(x.w), bf_hi(x.w)};
                        *(GAS v4u*)(sl + (size_t)(ai * 128 + m * 16) * 256 + bj * 128) = pack8(acc[ai][bj][m][0] * f0, acc[ai][bj][m][1] * f1); } }
        }
    }
};
struct EpiOutSlab {
    GAS unsigned char* ws;
    __device__ __forceinline__ void operator()(Acc& acc, const Unit& u, int wr, int wc, int fr, int fq, LAS unsigned char* lds) const {
        {
            GAS bf16* sl = (GAS bf16*)(ws + WS_SLAB_O) + (size_t)u.slab * 65536 + (size_t)(wr * 64 + fr) * 256 + wc * 32 + 8 * fq;
#pragma unroll
            for (int ai = 0; ai < 2; ++ai)
#pragma unroll
                for (int m = 0; m < 4; ++m)
#pragma unroll
                    for (int bj = 0; bj < 2; ++bj) *(GAS v4u*)(sl + (size_t)(ai * 128 + m * 16) * 256 + bj * 128) = pack8(acc[ai][bj][m][0], acc[ai][bj][m][1]);
        }
    }
};
}
__device__ __forceinline__ f32x16 mfma32(bf16x8 a, bf16x8 b, f32x16 c) { return __builtin_amdgcn_mfma_f32_32x32x16_bf16(a, b, c, 0, 0, 0); }
__device__ __forceinline__ f32x16 zero16() { f32x16 z;
#pragma unroll
    for (int i = 0; i < 16; ++i) z[i] = 0.f; return z; }
__device__ __forceinline__ bf16x8 cvt8(const f32x4 a, const f32x4 b) { const v4u w = pg8::pack8(a, b); return __builtin_bit_cast(bf16x8, w); }

namespace hg {
constexpr int P136 = 136, P72 = 72;
constexpr int L_QS = 0, L_QT = L_QS + 64 * P136 * 2, L_KT = L_QT + 64 * P136 * 2, L_KTT = L_KT + 64 * P136 * 2, L_VT = L_KTT + 128 * P72 * 2,
              L_ATT = L_VT + 128 * P72 * 2, L_ST = L_ATT + 64 * P72 * 2, L_SEG = L_ST + 128 * P136 * 2, L_EV = L_SEG + 8 * 128 * 4, L_PART = L_EV + 2 * 128 * 4, L_GN = L_PART + 64 * 4 * 4, L_END = L_GN + 128 * 4;
static_assert(L_END <= LDS_MISC, "hgrn LDS");
struct Pre { unsigned lf[8]; unsigned q[8], k[8], v[8]; v2u sg[4]; };
#define HG_BAR() do { asm volatile("s_waitcnt lgkmcnt(0)" ::: "memory"); __builtin_amdgcn_s_barrier(); asm volatile("" ::: "memory"); } while (0)

template <int PART>
__device__ __forceinline__ void prefetch(Pre& P, const GAS unsigned char* ws, size_t row0, int nvalid, int seg, int colb  , int trow  , int sgcol  ) {
    const GAS _Float16* LF = (const GAS _Float16*)(ws + WS_LOGF) + row0 * 1024; const GAS bf16* QC = (const GAS bf16*)(ws + WS_QC) + row0 * 1024; const GAS bf16* KC = (const GAS bf16*)(ws + WS_KC) + row0 * 1024; const GAS bf16* IC = (const GAS bf16*)(ws + WS_IC) + row0 * 1024;
    if (PART & 2) { const GAS bf16* SGC = (const GAS bf16*)(ws + WS_SGC) + row0 * 1024; const unsigned so = (unsigned)((trow < nvalid ? trow : 0) * 1024 + sgcol);
#pragma unroll
      for (int g = 0; g < 4; ++g) P.sg[g] = *(const GAS v2u*)(SGC + so + 8 * g); }
    if (nvalid == 64) {
#pragma unroll
        for (int i = 0; i < 8; ++i) { const unsigned o = (unsigned)((seg * 8 + i) * 1024 + colb);
            if (PART & 1) P.lf[i] = *(const GAS unsigned*)(LF + o);
            if (PART & 2) { P.q[i] = *(const GAS unsigned*)(QC + o); P.k[i] = *(const GAS unsigned*)(KC + o); P.v[i] = *(const GAS unsigned*)(IC + o); } }
    } else {
#pragma unroll
        for (int i = 0; i < 8; ++i) { const int t = seg * 8 + i; const unsigned o = (unsigned)(t * 1024 + colb);
            if (t < nvalid) { if (PART & 1) P.lf[i] = *(const GAS unsigned*)(LF + o); if (PART & 2) { P.q[i] = *(const GAS unsigned*)(QC + o); P.k[i] = *(const GAS unsigned*)(KC + o); P.v[i] = *(const GAS unsigned*)(IC + o); } }
            else { if (PART & 1) P.lf[i] = 0u; if (PART & 2) { P.q[i] = 0u; P.k[i] = 0u; P.v[i] = 0u; } } }
    }
}

__device__ __forceinline__ void chain(Frame& F, int layer, bool sample, int b, int h) {
    LAS unsigned char* lds = F.lds; int tid = F.tid_(); asm volatile("" : "+v"(tid));
    const int lane = tid & 63, wave = F.wave, seg = wave; int kp = tid & 63, l31 = lane & 31, hh = lane >> 5;
    const int L = sample ? DSEQ : LP, nchunks = (L + 63) / 64;
    const size_t rowbase = sample ? (size_t)MPAD + (size_t)b * DSEQ : (size_t)b * LP;
    const int colb = h * 128 + 2 * kp;
    GAS bf16* YC = (GAS bf16*)(F.wsp() + WS_Y) + (size_t)2 * MTOT * 1024;
    const int kb = wave >> 1, vb0 = 2 * (wave & 1);
    f32x16 S[2];
    if (sample) { const GAS float* s0 = F_state_hgrn + (((size_t)layer * DBATCH + b) * 8 + h) * 16384;
#pragma unroll
        for (int vbi = 0; vbi < 2; ++vbi)
#pragma unroll
            for (int r = 0; r < 16; ++r) S[vbi][r] = s0[(size_t)(32 * kb + (r & 3) + 8 * (r >> 2) + 4 * hh) * 128 + 32 * (vb0 + vbi) + l31]; }
    else { S[0] = zero16(); S[1] = zero16(); }
#pragma unroll
    for (int vbi = 0; vbi < 2; ++vbi)
#pragma unroll
        for (int g = 0; g < 4; ++g) { v2u w; w.x = cvt_pk_bf16(S[vbi][4 * g], S[vbi][4 * g + 1]); w.y = cvt_pk_bf16(S[vbi][4 * g + 2], S[vbi][4 * g + 3]);
            *(LAS v2u*)(lds + L_ST + ((32 * (vb0 + vbi) + l31) * P136 + 32 * kb + 8 * g + 4 * hh) * 2) = w; }
    const int ovb = wave & 3, otb = wave >> 2;
    if (tid < 128) *(LAS float*)(lds + L_GN + tid * 4) = F_hng[layer * 128 + tid];
    Pre P; prefetch<3>(P, F.wsp(), rowbase, min(64, L), seg, colb, 32 * otb + l31, h * 128 + 32 * ovb + 4 * hh);
    for (int c = 0; c < nchunks; ++c) {
        asm volatile("" : "+v"(l31), "+v"(hh), "+v"(kp));
        const int nvalid = min(64, L - 64 * c); const size_t row0 = rowbase + (size_t)64 * c;
        float c0[8], c1[8]; { float a0 = 0.f, a1 = 0.f;
#pragma unroll
            for (int i = 0; i < 8; ++i) { const pg8::h16x2 hv = __builtin_bit_cast(pg8::h16x2, P.lf[i]); a0 += (float)hv.x; a1 += (float)hv.y; c0[i] = a0; c1[i] = a1; }
            *(LAS f32x2*)(lds + L_SEG + (seg * 128 + 2 * kp) * 4) = (f32x2){a0, a1}; }
        if (c + 1 < nchunks) prefetch<1>(P, F.wsp(), rowbase + (size_t)64 * (c + 1), min(64, L - 64 * (c + 1)), seg, colb, 32 * otb + l31, h * 128 + 32 * ovb + 4 * hh);
        HG_BAR();
        float off0 = 0.f, off1 = 0.f, m0 = 0.f, m1 = 0.f, la0 = 0.f, la1 = 0.f;
#pragma unroll
        for (int s = 0; s < 8; ++s) { const f32x2 tt = *(const LAS f32x2*)(lds + L_SEG + (s * 128 + 2 * kp) * 4);
            if (s < seg) { off0 += tt.x; off1 += tt.y; } if (s < 4) { m0 += tt.x; m1 += tt.y; } la0 += tt.x; la1 += tt.y; }
        unsigned ktt0[8], ktt1[8], vt0[8], vt1[8]; const float e2m0 = fexp2(m0), e2m1 = fexp2(m1);
#pragma unroll
        for (int i = 0; i < 8; ++i) { const int t = seg * 8 + i; const float cu0 = off0 + c0[i], cu1 = off1 + c1[i];
            const float q0 = bf_lo(P.q[i]), q1 = bf_hi(P.q[i]), k0 = bf_lo(P.k[i]), k1 = bf_hi(P.k[i]);
            const float em0 = fexp2(cu0 - m0), em1 = fexp2(cu1 - m1), ek0 = fexp2(m0 - cu0), ek1 = fexp2(m1 - cu1), eq0 = em0 * e2m0, eq1 = em1 * e2m1;
            *(LAS unsigned*)(lds + L_QS + (t * P136 + 2 * kp) * 2) = cvt_pk_bf16(q0 * eq0, q1 * eq1);
            *(LAS unsigned*)(lds + L_QT + (t * P136 + 2 * kp) * 2) = cvt_pk_bf16(q0 * em0, q1 * em1);
            const unsigned kt = cvt_pk_bf16(k0 * ek0, k1 * ek1);
            *(LAS unsigned*)(lds + L_KT + (t * P136 + 2 * kp) * 2) = kt;
            ktt0[i] = kt & 0xffffu; ktt1[i] = kt >> 16; vt0[i] = P.v[i] & 0xffffu; vt1[i] = P.v[i] >> 16; }
        { v4u w; w.x = ktt0[0] | (ktt0[1] << 16); w.y = ktt0[2] | (ktt0[3] << 16); w.z = ktt0[4] | (ktt0[5] << 16); w.w = ktt0[6] | (ktt0[7] << 16);
          *(LAS v4u*)(lds + L_KTT + ((2 * kp) * P72 + 8 * seg) * 2) = w;
          w.x = ktt1[0] | (ktt1[1] << 16); w.y = ktt1[2] | (ktt1[3] << 16); w.z = ktt1[4] | (ktt1[5] << 16); w.w = ktt1[6] | (ktt1[7] << 16);
          *(LAS v4u*)(lds + L_KTT + ((2 * kp + 1) * P72 + 8 * seg) * 2) = w;
          w.x = vt0[0] | (vt0[1] << 16); w.y = vt0[2] | (vt0[3] << 16); w.z = vt0[4] | (vt0[5] << 16); w.w = vt0[6] | (vt0[7] << 16);
          *(LAS v4u*)(lds + L_VT + ((2 * kp) * P72 + 8 * seg) * 2) = w;
          w.x = vt1[0] | (vt1[1] << 16); w.y = vt1[2] | (vt1[3] << 16); w.z = vt1[4] | (vt1[5] << 16); w.w = vt1[6] | (vt1[7] << 16);
          *(LAS v4u*)(lds + L_VT + ((2 * kp + 1) * P72 + 8 * seg) * 2) = w; }
        if (seg == 0) { *(LAS f32x2*)(lds + L_EV + (2 * kp) * 4) = (f32x2){fexp2(la0), fexp2(la1)}; *(LAS f32x2*)(lds + L_EV + (128 + 2 * kp) * 4) = (f32x2){fexp2(la0 - m0), fexp2(la1 - m1)}; }
        v2u sg[4] = {P.sg[0], P.sg[1], P.sg[2], P.sg[3]};
        if (c + 1 < nchunks) prefetch<2>(P, F.wsp(), rowbase + (size_t)64 * (c + 1), min(64, L - 64 * (c + 1)), seg, colb, 32 * otb + l31, h * 128 + 32 * ovb + 4 * hh);
        HG_BAR();
        if (wave < 3) { const int sb = wave == 2 ? 1 : 0, tb = wave == 0 ? 0 : 1; f32x16 a = zero16();
#pragma unroll
            for (int st = 0; st < 8; ++st) { const bf16x8 ka = *(const LAS bf16x8*)(lds + L_KT + ((32 * sb + l31) * P136 + 16 * st + 8 * hh) * 2);
                const bf16x8 qb = *(const LAS bf16x8*)(lds + L_QT + ((32 * tb + l31) * P136 + 16 * st + 8 * hh) * 2); a = mfma32(ka, qb, a); }
            const int t = 32 * tb + l31;
#pragma unroll
            for (int g = 0; g < 4; ++g) { const int s0 = 32 * sb + 8 * g + 4 * hh; float x[4];
#pragma unroll
                for (int j = 0; j < 4; ++j) x[j] = (s0 + j <= t) ? a[4 * g + j] : 0.f;
                v2u w; w.x = cvt_pk_bf16(x[0], x[1]); w.y = cvt_pk_bf16(x[2], x[3]); *(LAS v2u*)(lds + L_ATT + (t * P72 + s0) * 2) = w; } }
        HG_BAR();
        f32x16 o = zero16();
#pragma unroll
        for (int st = 0; st < 8; ++st) { const bf16x8 sa = *(const LAS bf16x8*)(lds + L_ST + ((32 * ovb + l31) * P136 + 16 * st + 8 * hh) * 2);
            const bf16x8 qb = *(const LAS bf16x8*)(lds + L_QS + ((32 * otb + l31) * P136 + 16 * st + 8 * hh) * 2); o = mfma32(sa, qb, o); }
        for (int st = 0; st < 2 + 2 * otb; ++st) { const bf16x8 va = *(const LAS bf16x8*)(lds + L_VT + ((32 * ovb + l31) * P72 + 16 * st + 8 * hh) * 2);
            const bf16x8 ab = *(const LAS bf16x8*)(lds + L_ATT + ((32 * otb + l31) * P72 + 16 * st + 8 * hh) * 2); o = mfma32(va, ab, o); }
        { float ss = 0.f;
#pragma unroll
            for (int r = 0; r < 16; ++r) ss += o[r] * o[r];
            ss += __shfl_xor(ss, 32);
            if (hh == 0) *(LAS float*)(lds + L_PART + ((32 * otb + l31) * 4 + ovb) * 4) = ss; }
        HG_BAR();
        { const f32x4 p = *(const LAS f32x4*)(lds + L_PART + (32 * otb + l31) * 16); const float rs = frsq(((p[0] + p[1]) + (p[2] + p[3])) * (1.0f / 128.0f) + EPS);
          const int t = 32 * otb + l31;
          if (t < nvalid) { GAS bf16* yp = YC + (row0 + t) * 1024 + h * 128 + 32 * ovb + 4 * hh;
#pragma unroll
              for (int g = 0; g < 4; ++g) { const f32x4 gng = *(const LAS f32x4*)(lds + L_GN + (32 * ovb + 8 * g + 4 * hh) * 4); const float y0 = o[4 * g] * rs * gng[0] * bf_lo(sg[g].x), y1 = o[4 * g + 1] * rs * gng[1] * bf_hi(sg[g].x),
                                                        y2 = o[4 * g + 2] * rs * gng[2] * bf_lo(sg[g].y), y3 = o[4 * g + 3] * rs * gng[3] * bf_hi(sg[g].y);
                  v2u w; w.x = cvt_pk_bf16(y0, y1); w.y = cvt_pk_bf16(y2, y3); *(GAS v2u*)(yp + 8 * g) = w; } } }
        f32x16 Pn[2] = {zero16(), zero16()};
#pragma unroll
        for (int st = 0; st < 4; ++st) { const bf16x8 ka = *(const LAS bf16x8*)(lds + L_KTT + ((32 * kb + l31) * P72 + 16 * st + 8 * hh) * 2);
#pragma unroll
            for (int vbi = 0; vbi < 2; ++vbi) { const bf16x8 vbf = *(const LAS bf16x8*)(lds + L_VT + ((32 * (vb0 + vbi) + l31) * P72 + 16 * st + 8 * hh) * 2); Pn[vbi] = mfma32(ka, vbf, Pn[vbi]); } }
#pragma unroll
        for (int g = 0; g < 4; ++g) { const f32x4 el = *(const LAS f32x4*)(lds + L_EV + (32 * kb + 8 * g + 4 * hh) * 4), elm = *(const LAS f32x4*)(lds + L_EV + (128 + 32 * kb + 8 * g + 4 * hh) * 4);
#pragma unroll
            for (int vbi = 0; vbi < 2; ++vbi) {
#pragma unroll
                for (int j = 0; j < 4; ++j) S[vbi][4 * g + j] = el[j] * S[vbi][4 * g + j] + elm[j] * Pn[vbi][4 * g + j];
                v2u w; w.x = cvt_pk_bf16(S[vbi][4 * g], S[vbi][4 * g + 1]); w.y = cvt_pk_bf16(S[vbi][4 * g + 2], S[vbi][4 * g + 3]);
                *(LAS v2u*)(lds + L_ST + ((32 * (vb0 + vbi) + l31) * P136 + 32 * kb + 8 * g + 4 * hh) * 2) = w; } }
    }
    GAS float* sf = sample ? F.outp() + O_HS + (((size_t)layer * DBATCH + b) * 8 + h) * 16384 : F.outp() + O_HP + (((size_t)layer * BATCH + b) * 8 + h) * 16384;
#pragma unroll
    for (int vbi = 0; vbi < 2; ++vbi)
#pragma unroll
        for (int r = 0; r < 16; ++r) sf[(size_t)(32 * kb + (r & 3) + 8 * (r >> 2) + 4 * hh) * 128 + 32 * (vb0 + vbi) + l31] = S[vbi][r];
    HG_BAR();
}
}

namespace sb {
constexpr float R_STOP = -136.0f;
constexpr int KROW = 272, SLOT = 32 * KROW + 128 * 64;
static_assert(8 * SLOT + 64 <= LDS_MISC, "attention LDS");
constexpr int L_DONE = 8 * SLOT;
struct Grp { const GAS float* k_old; const GAS float* v_old; const GAS float* k_new; const GAS float* v_new; };

struct TileRegs { f32x4 k0, k1, v0, v1; };
__device__ __forceinline__ void tile_issue(TileRegs& t, const Grp& g, int kt, int past, int L, int c, int rp, int sh) {
    const int s0 = 32 * kt - sh; const bool old = s0 + sh < past; const int rl = old ? 31 : (L - 1 - (s0 - past)), lo = s0 < 0 ? -s0 : 0;
    const GAS float* kb = old ? g.k_old + (ptrdiff_t)s0 * 1024 : g.k_new + (ptrdiff_t)(s0 - past) * 1024; const GAS float* vb = old ? g.v_old + (ptrdiff_t)s0 * 1024 : g.v_new + (ptrdiff_t)(s0 - past) * 1024;
    if (rl >= 31 && lo == 0) {
        const unsigned o = (unsigned)(2 * rp * 1024 + 4 * c);
        t.k0 = *(const GAS f32x4*)(kb + o); t.k1 = *(const GAS f32x4*)(kb + o + 1024); t.v0 = *(const GAS f32x4*)(vb + o); t.v1 = *(const GAS f32x4*)(vb + o + 1024);
        return; }
    const int r0 = max(min(2 * rp, rl), lo), r1 = max(min(2 * rp + 1, rl), lo);
    t.k0 = *(const GAS f32x4*)(kb + (ptrdiff_t)r0 * 1024 + 4 * c); t.k1 = *(const GAS f32x4*)(kb + (ptrdiff_t)r1 * 1024 + 4 * c);
    t.v0 = *(const GAS f32x4*)(vb + (ptrdiff_t)r0 * 1024 + 4 * c); t.v1 = *(const GAS f32x4*)(vb + (ptrdiff_t)r1 * 1024 + 4 * c);
}
__device__ __forceinline__ void tile_commit(const TileRegs& t, LAS unsigned char* slot, int c, int rp) {
    v2u a; a.x = cvt_pk_bf16(t.k0[0], t.k0[1]); a.y = cvt_pk_bf16(t.k0[2], t.k0[3]); *(LAS v2u*)(slot + (2 * rp) * KROW + 8 * c) = a;
    a.x = cvt_pk_bf16(t.k1[0], t.k1[1]); a.y = cvt_pk_bf16(t.k1[2], t.k1[3]); *(LAS v2u*)(slot + (2 * rp + 1) * KROW + 8 * c) = a;
    LAS unsigned char* vt = slot + 32 * KROW; const int r7 = rp & 7, f = 2 * (rp >> 3) + ((r7 >> 1) & 1);
    const int u = ((f ^ (c & 3)) * 16) + (r7 >> 2) * 8 + (rp & 1) * 4;
#pragma unroll
    for (int j = 0; j < 4; ++j) *(LAS unsigned*)(vt + (4 * c + j) * 64 + u) = cvt_pk_bf16(t.v0[j], t.v1[j]);
}

template <int NG>
__device__ __forceinline__ void block_unit(Frame& F, int layer, int unit  ) {
    constexpr int W = 8 / NG;
    int tid = F.tid_(); asm volatile("" : "+v"(tid)); const int lane = tid & 63, wave = F.wave, l31 = lane & 31, hh = lane >> 5;
    LAS unsigned char* lds = F.lds;
    const bool sample = NG > 1; constexpr int sh = NG == 1 ? 16 : 0; const int L = sample ? DSEQ : LP, past = sample ? PAST : 0, nqt = (L + sh + 31) / 32;
    const int gi = wave / W, wi = wave - gi * W;
    int bh, qt0; bool wave_on; if (!sample) { const int j = 8 - (unit >> 6); bh = unit & 63; qt0 = j == 0 ? 0 : 8 * j - 7; wave_on = j > 0 || wi == 0; } else { bh = unit * NG + gi; qt0 = 0; wave_on = wi < nqt; }
    const int b = bh >> 3, h = bh & 7; const int qt = qt0 + wi;
    const size_t rowbase = sample ? (size_t)MPAD + (size_t)b * DSEQ : (size_t)b * LP;
    Grp g;
    g.k_new = (sample ? F.outp() + O_KS + (size_t)layer * MS * 1024 + (size_t)b * DSEQ * 1024 : F.outp() + O_KP + (size_t)layer * MP * 1024 + (size_t)b * LP * 1024) + h * 128;
    g.v_new = (sample ? F.outp() + O_VS + (size_t)layer * MS * 1024 + (size_t)b * DSEQ * 1024 : F.outp() + O_VP + (size_t)layer * MP * 1024 + (size_t)b * LP * 1024) + h * 128;
    g.k_old = F_cache_k + ((size_t)layer * DBATCH + b) * PAST * 1024 + h * 128; g.v_old = F_cache_v + ((size_t)layer * DBATCH + b) * PAST * 1024 + h * 128;
    const int dt0 = (past >> 5) + qt0;
    const int tq = 32 * qt - sh + l31; const bool qvalid = wave_on && tq >= 0 && tq < L; const size_t qrow = rowbase + (tq < 0 ? 0 : tq < L ? tq : L - 1);
    const GAS bf16* Q = (const GAS bf16*)(F.wsp() + WS_Q) + qrow * 1024 + h * 128 + 8 * hh;
    bf16x8 qf[8];
#pragma unroll
    for (int st = 0; st < 8; ++st) qf[st] = *(const GAS bf16x8*)(Q + 16 * st);
    f32x16 O[4] = {zero16(), zero16(), zero16(), zero16()};
    const int qpos = past + tq; float R = 0.f; bool done = !wave_on;
    const int sc = tid & 31, srp = NG == 1 ? (tid >> 5) : ((tid & (64 * W - 1)) >> 5);
    if (NG == 1) { for (int j0 = 0; j0 < W; j0 += 4) { TileRegs t[4];
#pragma unroll
            for (int j = 0; j < 4; ++j) tile_issue(t[j], g, dt0 + j0 + j, past, L, sc, srp, sh);
#pragma unroll
            for (int j = 0; j < 4; ++j) tile_commit(t[j], lds + ((dt0 + j0 + j) & (W - 1)) * SLOT, sc, srp); } }
    else { for (int j = 0; j < W; ++j) { TileRegs t[4];
#pragma unroll
            for (int ps = 0; ps < 4; ++ps) tile_issue(t[ps], g, dt0 + j, past, L, sc, srp + 4 * ps, sh);
#pragma unroll
            for (int ps = 0; ps < 4; ++ps) tile_commit(t[ps], lds + (gi * W + ((dt0 + j) & (W - 1))) * SLOT, sc, srp + 4 * ps); } }
    if (lane == 0) *(LAS unsigned*)(lds + L_DONE + 4 * wave) = done ? 1u : 0u;
    TileRegs pre; if (NG == 1 && dt0 - 1 >= 0) tile_issue(pre, g, dt0 - 1, past, L, sc, srp, sh);
    HG_BAR();
    for (int i = 0; ; ++i) {
        const int kt = dt0 + wi - i;
        const int knew = dt0 - i - 1;
        TileRegs pre2; if (NG == 1 && knew - 1 >= 0) tile_issue(pre2, g, knew - 1, past, L, sc, srp, sh);
        if (!done && kt >= 0) {
            const LAS unsigned char* slot = lds + (gi * W + (kt & (W - 1))) * SLOT; const int s0 = 32 * kt - sh;
            f32x16 sa = zero16();
#pragma unroll
            for (int st = 0; st < 8; ++st) sa = mfma32(*(const LAS bf16x8*)(slot + l31 * KROW + (16 * st + 8 * hh) * 2), qf[st], sa);
            const bool diag = i == 0;
            float sg[16], kp[16];
#pragma unroll
            for (int r = 0; r < 16; ++r) { const float e = fexp2(-sa[r]), rc = frcp(1.0f + e); sg[r] = rc; kp[r] = e * rc; }
            if (diag || (sh != 0 && kt == 0)) { const int khi = diag ? qpos : 0x7fffffff;
#pragma unroll
                for (int r = 0; r < 16; ++r) { const int key = s0 + (r & 3) + 8 * (r >> 2) + 4 * hh; const bool ok = key < khi && key >= 0; kp[r] = ok ? kp[r] : 1.0f; sg[r] = ok ? sg[r] : 0.f; } }
            float ex[16], T[4], Tp[4];
#pragma unroll
            for (int gq = 0; gq < 4; ++gq) { ex[4 * gq + 3] = 1.0f; ex[4 * gq + 2] = kp[4 * gq + 3]; ex[4 * gq + 1] = ex[4 * gq + 2] * kp[4 * gq + 2]; ex[4 * gq] = ex[4 * gq + 1] * kp[4 * gq + 1]; T[gq] = ex[4 * gq] * kp[4 * gq]; Tp[gq] = __shfl_xor(T[gq], 32); }
            float carry[4]; { float above = fexp2(R);
#pragma unroll
                for (int gq = 3; gq >= 0; --gq) { carry[gq] = above * (hh == 0 ? Tp[gq] : 1.0f); above *= T[gq] * Tp[gq]; }
                R += flog2(fmaxf(((T[0] * Tp[0]) * (T[1] * Tp[1])) * ((T[2] * Tp[2]) * (T[3] * Tp[3])), 1e-45f)); }
            float w[16];
#pragma unroll
            for (int r = 0; r < 16; ++r) w[r] = sg[r] * (carry[r >> 2] * ex[r]);
            const LAS unsigned char* vt = slot + 32 * KROW;
#pragma unroll
            for (int s = 0; s < 2; ++s) { v4u pw; pw.x = cvt_pk_bf16(w[8 * s], w[8 * s + 1]); pw.y = cvt_pk_bf16(w[8 * s + 2], w[8 * s + 3]); pw.z = cvt_pk_bf16(w[8 * s + 4], w[8 * s + 5]); pw.w = cvt_pk_bf16(w[8 * s + 6], w[8 * s + 7]);
                const bf16x8 pb = __builtin_bit_cast(bf16x8, pw);
#pragma unroll
                for (int db = 0; db < 4; ++db) { const int d = 32 * db + l31;
                    O[db] = mfma32(*(const LAS bf16x8*)(vt + d * 64 + (((2 * s + hh) ^ ((d >> 2) & 3)) * 16)), pb, O[db]); } }
            if (kt == 0 || __all(R < R_STOP)) { done = true; if (lane == 0) *(LAS unsigned*)(lds + L_DONE + 4 * wave) = 1u; }
        } else if (!done && kt < 0) { done = true; if (lane == 0) *(LAS unsigned*)(lds + L_DONE + 4 * wave) = 1u; }
        HG_BAR();
        const v4u d0 = *(const LAS v4u*)(lds + L_DONE), d1 = *(const LAS v4u*)(lds + L_DONE + 16);
        if ((d0.x & d0.y & d0.z & d0.w & d1.x & d1.y & d1.z & d1.w) != 0u) break;
        if (NG == 1) { if (knew >= 0) tile_commit(pre, lds + (knew & (W - 1)) * SLOT, sc, srp); pre = pre2; }
        else if (knew >= 0) { TileRegs t[4];
#pragma unroll
            for (int ps = 0; ps < 4; ++ps) tile_issue(t[ps], g, knew, past, L, sc, srp + 4 * ps, sh);
#pragma unroll
            for (int ps = 0; ps < 4; ++ps) tile_commit(t[ps], lds + (gi * W + (knew & (W - 1))) * SLOT, sc, srp + 4 * ps); }
        HG_BAR();
    }
    if (qvalid) { const GAS bf16* SG = (const GAS bf16*)(F.wsp() + WS_SGB) + qrow * 1024 + h * 128 + 4 * hh; GAS bf16* Y = (GAS bf16*)(F.wsp() + WS_Y) + (size_t)MTOT * 1024 + qrow * 1024 + h * 128 + 4 * hh;
        v2u sgv[4][4];
#pragma unroll
        for (int db = 0; db < 4; ++db)
#pragma unroll
            for (int gq = 0; gq < 4; ++gq) sgv[db][gq] = *(const GAS v2u*)(SG + 32 * db + 8 * gq);
#pragma unroll
        for (int db = 0; db < 4; ++db)
#pragma unroll
            for (int gq = 0; gq < 4; ++gq) { const v2u s = sgv[db][gq]; v2u o;
                o.x = cvt_pk_bf16(O[db][4 * gq] * bf_lo(s.x), O[db][4 * gq + 1] * bf_hi(s.x)); o.y = cvt_pk_bf16(O[db][4 * gq + 2] * bf_lo(s.y), O[db][4 * gq + 3] * bf_hi(s.y));
                *(GAS v2u*)(Y + 32 * db + 8 * gq) = o; } }
    HG_BAR();
}
constexpr int NU_P = BATCH * 8 * 9, NU_S = DBATCH * 8 / 4;
constexpr int NUNITS = NU_P + NU_S;
}

namespace pl {
constexpr int RS = 528;
constexpr int L_UT = 0, L_DF = 143 * RS, L_END = L_DF + 128 * RS;
static_assert(L_END <= LDS_MISC, "pool LDS");
constexpr int NU_P = BATCH * 17 * 4, NU_S = DBATCH * 4, NUNITS = NU_P + NU_S;
__device__ __forceinline__ void unit(Frame& F, int layer, int u) {
    LAS unsigned char* lds = F.lds; int tid = F.tid_(); asm volatile("" : "+v"(tid)); const int lane = tid & 63, wave = F.wave, l31 = lane & 31, hh = lane >> 5;
    const bool sample = u >= NU_P; int b, tile, g;
    if (!sample) { g = u & 3; const int x = u >> 2; b = x / 17; tile = x - b * 17; } else { const int x = u - NU_P; g = x & 3; b = x >> 2; tile = 0; }
    const int L = sample ? DSEQ : LP, t0 = tile * 128, nrows = min(128, L - t0), w = 2 << g;
    const size_t rowbase = sample ? (size_t)MPAD + (size_t)b * DSEQ : (size_t)b * LP;
    const GAS bf16* UA = (const GAS bf16*)(F.wsp() + WS_UA);
    { v4u sv[9];
#pragma unroll
      for (int q = 0; q < 9; ++q) { const int idx = tid + 512 * q, i = idx >> 5, ch = idx & 31, t = t0 - 15 + i; v4u v = {0u, 0u, 0u, 0u};
        if (idx < 143 * 32) { if (t >= 0 && t < L) v = *(const GAS v4u*)(UA + (rowbase + t) * 1024 + 256 * g + 8 * ch);
            else if (t < 0 && sample) { const GAS float* sp = F_state_pool + (((size_t)layer * DBATCH + b) * 15 + (15 + t)) * 1024 + 256 * g + 8 * ch; v = pg8::pack8(*(const GAS f32x4*)sp, *(const GAS f32x4*)(sp + 4)); } }
        sv[q] = v; }
#pragma unroll
      for (int q = 0; q < 9; ++q) { const int idx = tid + 512 * q, i = idx >> 5, ch = idx & 31; if (idx < 143 * 32) *(LAS v4u*)(lds + L_UT + i * RS + ch * 16) = sv[q]; } }
    const GAS bf16* WT = (const GAS bf16*)(F.wsp() + WS_WPOOL) + ((size_t)layer * 4 + g) * 65536 + (size_t)(32 * wave + l31) * 256 + 8 * hh;
    bf16x8 wf[16];
#pragma unroll
    for (int st = 0; st < 16; ++st) wf[st] = *(const GAS bf16x8*)(WT + 16 * st);
    const GAS float* sc = F_pool_scale + layer * 1024 + 256 * g + 32 * wave + 4 * hh; const GAS bf16* SGA = (const GAS bf16*)(F.wsp() + WS_SGA); GAS bf16* YA = (GAS bf16*)(F.wsp() + WS_Y);
    v4u sgq[8]; f32x4 scv[4];
#pragma unroll
    for (int q = 0; q < 8; ++q) { const int cq = tid + 512 * q, row = cq >> 5, ch8 = cq & 31;
        sgq[q] = __builtin_nontemporal_load((const GAS v4u*)(SGA + (rowbase + t0 + (row < nrows ? row : 0)) * 1024 + 256 * g + 8 * ch8)); }
#pragma unroll
    for (int gg = 0; gg < 4; ++gg) scv[gg] = *(const GAS f32x4*)(sc + 8 * gg);
    HG_BAR();
    { const int ch = tid & 31, rs = tid >> 5, r0 = 8 * rs; float sum[8];
#pragma unroll
      for (int j = 0; j < 8; ++j) sum[j] = 0.f;
      for (int j = 1; j < w; ++j) { const v4u v = *(const LAS v4u*)(lds + L_UT + (15 + r0 - j) * RS + ch * 16);
          sum[0] += bf_lo(v.x); sum[1] += bf_hi(v.x); sum[2] += bf_lo(v.y); sum[3] += bf_hi(v.y); sum[4] += bf_lo(v.z); sum[5] += bf_hi(v.z); sum[6] += bf_lo(v.w); sum[7] += bf_hi(v.w); }
#pragma unroll
      for (int i = 0; i < 8; ++i) { const int r = r0 + i; const v4u v = *(const LAS v4u*)(lds + L_UT + (15 + r) * RS + ch * 16);
          float x[8] = {bf_lo(v.x), bf_hi(v.x), bf_lo(v.y), bf_hi(v.y), bf_lo(v.z), bf_hi(v.z), bf_lo(v.w), bf_hi(v.w)};
          const float rc = sample ? 1.0f / (float)w : 1.0f / fminf((float)(t0 + r) + 1.0f, (float)w); float d[8];
#pragma unroll
          for (int j = 0; j < 8; ++j) { sum[j] += x[j]; d[j] = sum[j] * rc - x[j]; }
          *(LAS v4u*)(lds + L_DF + r * RS + ch * 16) = pg8::pack8((f32x4){d[0], d[1], d[2], d[3]}, (f32x4){d[4], d[5], d[6], d[7]});
          const v4u o = *(const LAS v4u*)(lds + L_UT + (15 + r - (w - 1)) * RS + ch * 16);
          sum[0] -= bf_lo(o.x); sum[1] -= bf_hi(o.x); sum[2] -= bf_lo(o.y); sum[3] -= bf_hi(o.y); sum[4] -= bf_lo(o.z); sum[5] -= bf_hi(o.z); sum[6] -= bf_lo(o.w); sum[7] -= bf_hi(o.w); } }
    HG_BAR();
    f32x16 acc[4] = {zero16(), zero16(), zero16(), zero16()};
#pragma unroll
    for (int st = 0; st < 16; ++st) { const bf16x8 a = wf[st];
#pragma unroll
        for (int rb = 0; rb < 4; ++rb) { const bf16x8 bb = *(const LAS bf16x8*)(lds + L_DF + (32 * rb + l31) * RS + (16 * st + 8 * hh) * 2); acc[rb] = mfma32(a, bb, acc[rb]); } }
    HG_BAR();
    constexpr int TS = 1040;
    static_assert(128 * TS <= L_END, "pool output image");
#pragma unroll
    for (int rb = 0; rb < 4; ++rb)
#pragma unroll
        for (int gg = 0; gg < 4; ++gg) { const f32x4 t = {acc[rb][4 * gg] * scv[gg][0], acc[rb][4 * gg + 1] * scv[gg][1], acc[rb][4 * gg + 2] * scv[gg][2], acc[rb][4 * gg + 3] * scv[gg][3]};
            *(LAS f32x4*)(lds + (32 * rb + l31) * TS + (32 * wave + 8 * gg + 4 * hh) * 4) = t; }
    HG_BAR();
#pragma unroll
    for (int q = 0; q < 8; ++q) { const int cq = tid + 512 * q, row = cq >> 5, ch8 = cq & 31;
        if (row < nrows) { const f32x4 a = *(const LAS f32x4*)(lds + row * TS + ch8 * 32), b = *(const LAS f32x4*)(lds + row * TS + ch8 * 32 + 16); const v4u s = sgq[q];
            const f32x4 ga = {bf_lo(s.x), bf_hi(s.x), bf_lo(s.y), bf_hi(s.y)}, gb = {bf_lo(s.z), bf_hi(s.z), bf_lo(s.w), bf_hi(s.w)};
            *(GAS v4u*)(YA + (rowbase + t0 + row) * 1024 + 256 * g + 8 * ch8) = pg8::pack8(a * ga, b * gb); } }
    HG_BAR();
}
}

#ifndef MERGE_TAIL
#define MERGE_TAIL 6
#endif
#ifndef WGM_PROJ
#define WGM_PROJ 4
#endif
#ifndef WGM_SQ
#define WGM_SQ 1
#endif
constexpr int U_HG_P = BATCH * 8, U_HG_S = DBATCH * 8;
constexpr int U0_HGS = U_HG_P, U0_ATT = U0_HGS + U_HG_S, U0_POOL = U0_ATT + sb::NUNITS, U_TOTAL = U0_POOL + pl::NUNITS;
__device__ __forceinline__ void phase_mixers(Frame& F, int layer, int qslot) {
    GAS unsigned* head = F.ctl() + CW_QUEUE + 64 * qslot;
    for (;;) {
        if (F.tid_() == 0) F.MISC[4] = __hip_atomic_fetch_add(head, 1u, __ATOMIC_RELAXED, __HIP_MEMORY_SCOPE_AGENT);
        HG_BAR();
        int u = (int)F.MISC[4];
        HG_BAR();
        if (u >= U_TOTAL) break;
        if (u >= U0_HGS && u < U0_POOL) u = u < U0_HGS + sb::NUNITS ? u + U_HG_S : u - sb::NUNITS;
        if (u < U0_ATT) { const bool smp = u >= U0_HGS; const int x = smp ? u - U0_HGS : u; hg::chain(F, layer, smp, x >> 3, x & 7); }
        else if (u < U0_POOL) { const int x = u - U0_ATT; if (x < sb::NU_P) sb::block_unit<1>(F, layer, x); else sb::block_unit<4>(F, layer, x - sb::NU_P); }
        else pl::unit(F, layer, u - U0_POOL);
    }
}

__device__ __forceinline__ void combine_merge(Frame& F) {
    pg8::Gemm g{nullptr, nullptr, 0, 0, MTOT / 256, D / 256, 3, D, MERGE_TAIL, WGM_SQ}; pg8::Order S; S.init(g, F.G, 0); if (!S.tail) return;
    const int gw = F.vcu * 8 + F.wave, NGW = F.G * 8, lane = F.lane_(), nrows = (S.nwg - S.G) * 256;
    const GAS bf16* sl = (const GAS bf16*)(F.wsp() + WS_SLAB_M); GAS bf16* M = (GAS bf16*)(F.wsp() + WS_MERGED);
    for (int x = gw; x < nrows; x += NGW) { const int j = x >> 8, r = x & 255; int pm, pn; S.tile_of(S.G + j, pm, pn);
        const GAS bf16* p = sl + (size_t)(MERGE_TAIL * j) * 65536 + (size_t)r * 256 + 4 * lane;
        f32x4 v = {0.f, 0.f, 0.f, 0.f};
#pragma unroll
        for (int q = 0; q < MERGE_TAIL; ++q) { const v2u t = *(const GAS v2u*)(p + (size_t)q * 65536); v += (f32x4){bf_lo(t.x), bf_hi(t.x), bf_lo(t.y), bf_hi(t.y)}; }
        v2u o; o.x = cvt_pk_bf16(v[0], v[1]); o.y = cvt_pk_bf16(v[2], v[3]); *(GAS v2u*)(M + (size_t)(256 * pm + r) * 1024 + 256 * pn + 4 * lane) = o; }
}
__device__ __forceinline__ f32x4 slab4_sum(const GAS bf16* p) {
    const v2u a = *(const GAS v2u*)p, b = *(const GAS v2u*)(p + 65536), c = *(const GAS v2u*)(p + 2 * 65536), d = *(const GAS v2u*)(p + 3 * 65536);
    return ((f32x4){bf_lo(a.x), bf_hi(a.x), bf_lo(a.y), bf_hi(a.y)} + (f32x4){bf_lo(b.x), bf_hi(b.x), bf_lo(b.y), bf_hi(b.y)}) + ((f32x4){bf_lo(c.x), bf_hi(c.x), bf_lo(c.y), bf_hi(c.y)} + (f32x4){bf_lo(d.x), bf_hi(d.x), bf_lo(d.y), bf_hi(d.y)}); }
__device__ __forceinline__ void combine_out(Frame& F, int last) {
    pg8::Gemm g{nullptr, nullptr, 0, 0, MTOT / 256, D / 256, 1, D, 4, WGM_SQ}; pg8::Order S; S.init(g, F.G, 0); if (!S.tail) return;
    const int gw = F.vcu * 8 + F.wave, NGW = F.G * 8, lane = F.lane_(), nrows = (S.nwg - S.G) * 256;
    const GAS bf16* sl = (const GAS bf16*)(F.wsp() + WS_SLAB_O); GAS float* H = (GAS float*)(F.wsp() + WS_H); GAS float* out = F.outp();
    for (int x = gw; x < nrows; x += NGW) { const int j = x >> 8, r = x & 255; int pm, pn; S.tile_of(S.G + j, pm, pn);
        const GAS bf16* p = sl + (size_t)(4 * j) * 65536 + (size_t)r * 256 + 4 * lane; const int row = 256 * pm + r, col = 256 * pn + 4 * lane;
        const f32x4 v = *(const GAS f32x4*)(H + (size_t)row * 1024 + col) + slab4_sum(p);
        if (!last) *(GAS f32x4*)(H + (size_t)row * 1024 + col) = v;
        else if (row >= MPAD) *(GAS f32x4*)(out + O_YS + (size_t)(row - MPAD) * 1024 + col) = v;
        else if (row < MP) { const int b = row / LP, t = row - b * LP; if (t >= NMETA) *(GAS f32x4*)(out + O_YP + ((size_t)b * SEQ + (t - NMETA)) * 1024 + col) = v; } }
}
__device__ __forceinline__ void phase_xn_fused(Frame& F, int l) {
    pg8::Gemm g{nullptr, nullptr, 0, 0, MTOT / 256, D / 256, 1, D, 4, WGM_SQ}; pg8::Order S; S.init(g, F.G, 0);
    LAS int* tab = (LAS int*)F.lds; const int tid = F.tid_(), lane = F.lane_();
    for (int i = tid; i < (MTOT / 256) * 4; i += 512) tab[i] = -1;
    __syncthreads();
    if (S.tail && tid < S.nwg - S.G) { int pm, pn; S.tile_of(S.G + tid, pm, pn); tab[4 * pm + pn] = tid; }
    __syncthreads();
    const int gw = F.vcu * 8 + F.wave, NGW = F.G * 8;
    GAS float* H = (GAS float*)(F.wsp() + WS_H); GAS bf16* XN = (GAS bf16*)(F.wsp() + WS_XN); const GAS bf16* sl = (const GAS bf16*)(F.wsp() + WS_SLAB_O); const GAS float* gn = F_norm_g + (size_t)l * D;
    for (int r = gw; r < MTOT; r += NGW) {
        if (r >= MP && r < MPAD) { zero_xn_row(XN + (size_t)r * D, lane); continue; }
        GAS f32x4* xr = (GAS f32x4*)(H + (size_t)r * D) + lane; const int pm = r >> 8, rr = r & 255;
        const GAS f32x4* x0 = l == 1 ? (const GAS f32x4*)(*((const GAS unsigned long long*)(F.wsp() + WS_RTAB) + r)) + lane : xr;
        f32x4 v[4]; float s = 0.f;
#pragma unroll
        for (int j = 0; j < 4; ++j) { const int idx = tab[4 * pm + j]; v[j] = idx >= 0 ? x0[64 * j] : xr[64 * j];
            if (idx >= 0) { v[j] += slab4_sum(sl + (size_t)(4 * idx) * 65536 + (size_t)rr * 256 + 4 * lane); xr[64 * j] = v[j]; }
            s += (v[j].x * v[j].x + v[j].y * v[j].y) + (v[j].z * v[j].z + v[j].w * v[j].w); }
        const float rs = frsq(wave_sum(s) * (1.f / D) + EPS);
        GAS v2u* o8 = (GAS v2u*)(XN + (size_t)r * D) + lane;
#pragma unroll
        for (int j = 0; j < 4; ++j) { const f32x4 gg = ((const GAS f32x4*)gn)[lane + 64 * j]; v2u o; o.x = cvt_pk_bf16(v[j].x * rs * gg.x, v[j].y * rs * gg.y); o.y = cvt_pk_bf16(v[j].z * rs * gg.z, v[j].w * rs * gg.w); o8[64 * j] = o; }
    }
    __syncthreads();
}
constexpr int NPHASES = 1 + 5 * DEPTH;
__global__ void __launch_bounds__(512, 2) mega_fwd(Params p) {
    extern __shared__ __attribute__((aligned(16))) unsigned char lds_raw[];
    Frame F;
    F.lds = (LAS unsigned char*)lds_raw; F.MISC = (volatile LAS unsigned*)(F.lds + LDS_MISC);
    F.wave = __builtin_amdgcn_readfirstlane((int)threadIdx.x >> 6);
    F.G = gridDim.x; { const int bx = blockIdx.x; F.vcu = (F.G % 8 == 0) ? (bx % 8) * (F.G / 8) + bx / 8 : bx; }
    if (threadIdx.x < 64) F.MISC[threadIdx.x] = 0u;
    if (threadIdx.x == 0) { LAS unsigned long long* P = (LAS unsigned long long*)(F.lds + LDS_PARAM);
        P[0] = (unsigned long long)p.in[0]; P[1] = (unsigned long long)p.in[1]; P[2] = (unsigned long long)p.in[2]; P[3] = (unsigned long long)p.in[3]; P[4] = (unsigned long long)p.in[4];
        P[5] = (unsigned long long)p.in[5]; P[6] = (unsigned long long)p.in[6]; P[7] = (unsigned long long)p.in[7]; P[8] = (unsigned long long)p.in[8]; P[9] = (unsigned long long)p.in[9];
        P[10] = (unsigned long long)p.in[10]; P[11] = (unsigned long long)p.in[11]; P[12] = (unsigned long long)p.in[12]; P[13] = (unsigned long long)p.in[13]; P[14] = (unsigned long long)p.in[14];
        P[15] = (unsigned long long)p.in[15]; P[16] = (unsigned long long)p.in[16]; P[17] = (unsigned long long)p.out; P[18] = (unsigned long long)p.ws; }
    __syncthreads();
    const int lo = p.ph_lo, hi = p.ph_hi;
    XcdBarrier bar; bar.bar = F.ctl() + CW_BAR; bar.x = 0; bar.st = nullptr; bar.leader = false;
    if (hi - lo > 1) bar = xcd_barrier_post(F.ctl() + CW_BAR, F.MISC, F.wave);
#define IN(k) (lo <= (k) && (k) < hi)
#define SEAM(k) do { if (IN(k) && IN((k) + 1)) xcd_barrier(bar, F.wave); } while (0)
    if (IN(0)) { phase_prologue(F); } SEAM(0);
    for (int l = 0; l < DEPTH; ++l) {
        const int pb = 1 + 5 * l;
        if (IN(pb)) { if (l > 0) phase_xn_fused(F, l); }
        if (l > 0) SEAM(pb);
        if (IN(pb + 1)) { pg8::Gemm g{(const GAS bf16*)(F.wsp() + WS_XN), (const GAS bf16*)(F.wsp() + WS_WIN) + (size_t)l * NPROJ * D, 0, 0, MTOT / 256, NPROJ / 256, 1, D, 0, WGM_PROJ};
            pg8::Order S; S.init(g, F.G, (int)blockIdx.x);
            pg8::EpiProj E{l, F.wsp(), F.outp(), F_qng + l * 128, F_kng + l * 128, (const GAS float*)(F.wsp() + WS_LB) + l * 1024};
            pg8::gemm_phase(F.lds, g, S, E, F.wave);
            } SEAM(pb + 1);
        if (IN(pb + 2)) { phase_mixers(F, l, l); } SEAM(pb + 2);
        if (IN(pb + 3)) { pg8::Gemm g{(const GAS bf16*)(F.wsp() + WS_Y), (const GAS bf16*)(F.wsp() + WS_WBR) + (size_t)l * 3 * D * D, (size_t)MTOT * 1024, (size_t)D * D, MTOT / 256, D / 256, 3, D, MERGE_TAIL, WGM_SQ};
            pg8::Order S; S.init(g, F.G, (int)blockIdx.x);
            pg8::EpiMerge E{F.wsp()};
            pg8::gemm_phase(F.lds, g, S, E, F.wave);
            { __syncthreads(); pg8::EpiMergeSlab E2{F.wsp()}; pg8::gemm_phase<pg8::EpiMergeSlab, 1>(F.lds, g, S, E2, F.wave); }
            } SEAM(pb + 3);
        if (IN(pb + 4)) { combine_merge(F); xcd_barrier(bar, F.wave);
            pg8::Gemm g{(const GAS bf16*)(F.wsp() + WS_MERGED), (const GAS bf16*)(F.wsp() + WS_WOUT) + (size_t)l * D * D, 0, 0, MTOT / 256, D / 256, 1, D, 4, WGM_SQ};
            pg8::Order S; S.init(g, F.G, (int)blockIdx.x);
            pg8::EpiOut E{F.wsp(), F.outp(), l == DEPTH - 1 ? 1 : 0, l == 0 ? 1 : 0};
            pg8::gemm_phase(F.lds, g, S, E, F.wave);
            { __syncthreads(); pg8::EpiOutSlab E2{F.wsp()}; pg8::gemm_phase<pg8::EpiOutSlab, 1>(F.lds, g, S, E2, F.wave); }
            xcd_barrier(bar, F.wave); if (l == DEPTH - 1) combine_out(F, 1);
            }
    }
#undef IN
#undef SEAM
}
extern "C" void kernel_launch(void* const* d_in, const int* in_sizes, int n_in, void* d_out, int out_size, void* d_ws, size_t ws_size, hipStream_t stream) {
    static int grid = 0;
    if (grid == 0) {
        if (n_in != 17 || out_size != (int)O_END || ws_size < WS_FAST_END) { fprintf(stderr, "kernel_launch: unexpected sizes (n_in %d, out %d, ws %zu < %zu)\n", n_in, out_size, ws_size, (size_t)WS_FAST_END); grid = -1; return; }
        int dev = 0, cus = 0, per_cu = 0;
        if (hipGetDevice(&dev) != hipSuccess || hipDeviceGetAttribute(&cus, hipDeviceAttributeMultiprocessorCount, dev) != hipSuccess) { grid = -1; return; }
        if (hipFuncSetAttribute((const void*)mega_fwd, hipFuncAttributeMaxDynamicSharedMemorySize, LDS_BYTES) != hipSuccess) { fprintf(stderr, "kernel_launch: hipFuncSetAttribute failed\n"); grid = -1; return; }
        if (hipOccupancyMaxActiveBlocksPerMultiprocessor(&per_cu, (const void*)mega_fwd, 512, LDS_BYTES) != hipSuccess || per_cu < 1) { fprintf(stderr, "kernel_launch: occupancy query says %d blocks per CU\n", per_cu); (void)hipGetLastError(); grid = -1; return; }
        grid = cus;
    }
    if (grid < 0) return;
    (void)hipMemsetAsync((char*)d_ws + WS_CTL, 0, CTL_ZERO_BYTES, stream);
    Params p{};
    for (int i = 0; i < 17; ++i) p.in[i] = (const float*)d_in[i];
    p.out = (float*)d_out; p.ws = (unsigned char*)d_ws;
    p.ph_lo = 0; p.ph_hi = NPHASES;
    hipLaunchKernelGGL(mega_fwd, dim3(grid), dim3(512), LDS_BYTES, stream, p);
}
```

```cpp
#define MK_LAUNCHES 1
#include <hip/hip_runtime.h>
#include <cstdio>
#include <cstdint>
constexpr int D = 1024, BATCH = 8, SEQ = 2048, DEPTH = 2, DBATCH = 32, DSEQ = 64, PAST = 2048, NMETA = 16;
constexpr int LP = NMETA + SEQ;
constexpr int MP = BATCH * LP;
constexpr int MPAD = 16640;
constexpr int MS = DBATCH * DSEQ;
constexpr int MTOT = MPAD + MS;
constexpr int NPROJ = 13 * 1024;
constexpr float EPS = 1e-6f, LB_FLOOR = 1e-30f, SB_SCALE = 0.08838834764831845f;
constexpr size_t O_YP = 0, O_YS = 16777216, O_KP = 18874368, O_VP = 52690944, O_PP = 86507520, O_HP = 86753280,
                 O_KS = 88850432, O_VS = 93044736, O_PS = 97239040, O_HS = 98222080, O_END = 106610688;
#define GAS __attribute__((address_space(1)))
#define LAS __attribute__((address_space(3)))
typedef unsigned short bf16;
typedef unsigned v4u __attribute__((ext_vector_type(4)));
typedef unsigned v2u __attribute__((ext_vector_type(2)));
typedef float f32x4 __attribute__((ext_vector_type(4)));
typedef float f32x2 __attribute__((ext_vector_type(2)));
typedef float f32x16 __attribute__((ext_vector_type(16)));
typedef short bf16x8 __attribute__((ext_vector_type(8)));
typedef short bf16x4 __attribute__((ext_vector_type(4)));
#define LDS_WAIT() asm volatile("s_waitcnt lgkmcnt(0)" ::: "memory")
#define VM_WAIT() asm volatile("s_waitcnt vmcnt(0)" ::: "memory")

typedef __bf16 bf16n2 __attribute__((ext_vector_type(2)));
__device__ __forceinline__ unsigned cvt_pk_bf16(float lo, float hi) { const f32x2 v = {lo, hi}; return __builtin_bit_cast(unsigned, __builtin_convertvector(v, bf16n2)); }
__device__ __forceinline__ float bf_lo(unsigned u) { return __uint_as_float(u << 16); }
__device__ __forceinline__ float bf_hi(unsigned u) { return __uint_as_float(u & 0xffff0000u); }
__device__ __forceinline__ float fexp2(float x) { return __builtin_amdgcn_exp2f(x); }
__device__ __forceinline__ float flog2(float x) { return __builtin_amdgcn_logf(x); }
__device__ __forceinline__ float frcp(float x) { return __builtin_amdgcn_rcpf(x); }
__device__ __forceinline__ float frsq(float x) { return __builtin_amdgcn_rsqf(x); }
__device__ __forceinline__ int lane_id() { unsigned z = 0u; asm volatile("" : "+v"(z)); return (int)__builtin_amdgcn_mbcnt_hi(~0u, __builtin_amdgcn_mbcnt_lo(~0u, z)); }
constexpr float LOG2E = 1.4426950408889634f, LN2 = 0.6931471805599453f;
__device__ __forceinline__ float fexp(float x) { return fexp2(x * LOG2E); }
__device__ __forceinline__ float fsigmoid(float x) { return frcp(1.0f + fexp2(-x * LOG2E)); }
__device__ __forceinline__ float fsilu(float x) { return x * fsigmoid(x); }

constexpr size_t MiB = 1u << 20;
constexpr size_t RB16 = (size_t)MTOT * 1024 * 2, RB32 = (size_t)MTOT * 1024 * 4;
constexpr size_t WS_CTL = 0, CTL_ZERO_BYTES = 64 * 1024;
constexpr size_t WS_RTAB = 1 * MiB + 64 * 1024;
constexpr size_t WS_LB = 1 * MiB;
constexpr size_t WS_WIN = 2 * MiB;
constexpr size_t WS_WBR = WS_WIN + (size_t)2 * NPROJ * 1024 * 2;
constexpr size_t WS_WOUT = WS_WBR + (size_t)6 * 1024 * 1024 * 2;
constexpr size_t WS_WPOOL = WS_WOUT + (size_t)2 * 1024 * 1024 * 2;
constexpr size_t WS_H = WS_WPOOL + 1 * MiB;
constexpr size_t WS_XN = WS_H + RB32;
constexpr size_t WS_UA = WS_XN + RB16, WS_SGA = WS_UA + RB16, WS_Q = WS_SGA + RB16, WS_SGB = WS_Q + RB16, WS_KC = WS_SGB + RB16,
                 WS_QC = WS_KC + RB16, WS_IC = WS_QC + RB16, WS_SGC = WS_IC + RB16, WS_GATE = WS_SGC + RB16  ,
                 WS_LOGF = WS_GATE + 3 * RB16  , WS_Y = WS_LOGF + RB32  , WS_MERGED = WS_Y + 3 * RB16, WS_FAST_END = WS_MERGED + RB16;
constexpr size_t WS_SLAB_M = WS_UA, WS_SLAB_O = WS_Q;
static_assert(108 * 262144 <= 2 * RB16 && 144 * 262144 <= 2 * RB16, "slabs");
constexpr int CW_QUEUE = 64;
constexpr int CW_BAR = 1024;

constexpr int LDS_BYTES = 160 * 1024;
constexpr int LDS_XCH = 128 * 1024;
constexpr int LDS_MISC = 159 * 1024;

#define XB_TMO      128
#define XB_XCNT(j)  (256  + 64 * (j))
#define XB_XSUB(j)  (1280 + 64 * (j))
#define XB_XGEN(j)  (2304 + 64 * (j))
#define XB_TOP      3328
#define XB_TOPGEN   3392
#define XCD_BAR_WORDS 3456
#define XB_SPIN_CAP (1u << 18)
__device__ __forceinline__ unsigned xb_ld(GAS unsigned* p)              { return __hip_atomic_load(p, __ATOMIC_RELAXED, __HIP_MEMORY_SCOPE_AGENT); }
__device__ __forceinline__ unsigned xb_add(GAS unsigned* p, unsigned v) { return __hip_atomic_fetch_add(p, v, __ATOMIC_RELAXED, __HIP_MEMORY_SCOPE_AGENT); }
__device__ __forceinline__ unsigned xb_xcc_id() { return (unsigned)__builtin_amdgcn_s_getreg((3 << 11) | 20) & 0xFu; }
#define XB_SPIN(cond, bar) do { unsigned _sp = 0; while (cond) { __builtin_amdgcn_s_sleep(1); \
    if ((++_sp & 255u) == 0u) { if (xb_ld(&(bar)[XB_TMO])) break; if (_sp > XB_SPIN_CAP) { xb_add(&(bar)[XB_TMO], 1u); break; } } } } while (0)
struct XcdBarrier { GAS unsigned* bar; unsigned x; volatile LAS unsigned* st; bool leader; };
__device__ __forceinline__ XcdBarrier xcd_barrier_post(GAS unsigned* bar, volatile LAS unsigned* st, int wave) {
    XcdBarrier b; b.bar = bar; b.x = xb_xcc_id(); b.st = st; b.leader = false;
    b.leader = (wave == 0) && (lane_id() == 0);
    if (b.leader) (void)xb_add(&bar[XB_XCNT(b.x)], 1u);
    return b;
}
__device__ __forceinline__ void xcd_barrier_complete(GAS unsigned* bar, unsigned x, unsigned& nloc, unsigned& nx) {
    const unsigned G = gridDim.x * gridDim.y * gridDim.z;
    unsigned sum, cnt, mine, sp = 0u;
    for (;;) {
        sum = 0u; cnt = 0u; mine = 0u;
#pragma unroll
        for (unsigned j = 0; j < 16; ++j) { const unsigned c = xb_ld(&bar[XB_XCNT(j)]); sum += c; cnt += (c > 0u) ? 1u : 0u; mine = (j == x) ? c : mine; }
        if (sum == G) break;
        __builtin_amdgcn_s_sleep(1);
        if ((++sp & 255u) == 0u) { if (xb_ld(&bar[XB_TMO])) break; if (sp > XB_SPIN_CAP) { xb_add(&bar[XB_TMO], 1u); break; } }
    }
    nloc = mine > 0u ? mine : 1u; nx = cnt > 0u ? cnt : 1u;
}
__device__ __forceinline__ void xcd_barrier(const XcdBarrier& b, int wave) {
    asm volatile("s_waitcnt vmcnt(0)" ::: "memory");
    __syncthreads();
    if (wave == 0 && lane_id() == 0) {
        GAS unsigned* bar = b.bar;
        __builtin_amdgcn_s_waitcnt(0);
        unsigned nloc = b.st[0], nx = b.st[1];
        if (nloc == 0u) { xcd_barrier_complete(bar, b.x, nloc, nx); b.st[0] = nloc; b.st[1] = nx; }
        const unsigned old = xb_add(&bar[XB_XSUB(b.x)], 1u);
        const unsigned gen = old / nloc;
        if (old + 1u == (gen + 1u) * nloc) {
            __builtin_amdgcn_fence(__ATOMIC_RELEASE, "agent");
            asm volatile("s_waitcnt vmcnt(0)" ::: "memory");
            const unsigned og = xb_add(&bar[XB_TOP], 1u);
            const unsigned tg = og / nx;
            if (og + 1u == (tg + 1u) * nx) xb_add(&bar[XB_TOPGEN], 1u);
            else XB_SPIN(xb_ld(&bar[XB_TOPGEN]) == tg, bar);
            __builtin_amdgcn_fence(__ATOMIC_ACQUIRE, "agent");
            xb_add(&bar[XB_XGEN(b.x)], 1u);
            asm volatile("s_waitcnt vmcnt(0)" ::: "memory");
        } else {
            XB_SPIN(xb_ld(&bar[XB_XGEN(b.x)]) == gen, bar);
            __builtin_amdgcn_fence(__ATOMIC_ACQUIRE, "agent");
            asm volatile("s_waitcnt vmcnt(0)" ::: "memory");
        }
    }
    __syncthreads();
}

struct Params { const float* in[17]; float* out; unsigned char* ws; int ph_lo, ph_hi; };
constexpr int LDS_PARAM = LDS_MISC + 256;
struct Frame {
    LAS unsigned char* lds; volatile LAS unsigned* MISC;
    int wave, G, vcu;
    __device__ __forceinline__ int lane_() const { return lane_id(); }
    __device__ __forceinline__ int tid_() const { return wave * 64 + lane_id(); }
    __device__ __forceinline__ unsigned long long rd(int i) const { const v2u v = *(const LAS v2u*)(lds + LDS_PARAM + 8 * i);
        return ((unsigned long long)(unsigned)__builtin_amdgcn_readfirstlane((int)v.y) << 32) | (unsigned)__builtin_amdgcn_readfirstlane((int)v.x); }
    __device__ __forceinline__ const GAS float* in(int i) const { return (const GAS float*)rd(i); }
    __device__ __forceinline__ GAS float* outp() const { return (GAS float*)rd(17); }
    __device__ __forceinline__ GAS unsigned char* wsp() const { return (GAS unsigned char*)rd(18); }
    __device__ __forceinline__ GAS unsigned* ctl() const { return (GAS unsigned*)(wsp() + WS_CTL); }
};
#define F_xp F.in(0)
#define F_xs F.in(1)
#define F_cache_k F.in(2)
#define F_cache_v F.in(3)
#define F_state_pool F.in(4)
#define F_state_hgrn F.in(5)
#define F_meta F.in(6)
#define F_norm_g F.in(7)
#define F_w_in F.in(8)
#define F_qng F.in(9)
#define F_kng F.in(10)
#define F_w_pool F.in(11)
#define F_pool_scale F.in(12)
#define F_hlb F.in(13)
#define F_hng F.in(14)
#define F_w_branch F.in(15)
#define F_w_out F.in(16)
__device__ __forceinline__ float wave_sum(float v) {
#pragma unroll
    for (int o = 1; o < 64; o <<= 1) v += __shfl_xor(v, o);
    return v;
}

__device__ __forceinline__ void p0_transpose_item(const GAS float* W, int K, int N, GAS bf16* WT, int item, int lane) {
    const int nblk = N / 64, kb = item / nblk, nb = item - kb * nblk, r = lane >> 4, c4 = lane & 15;
    const GAS float* src = W + (size_t)(64 * kb + 16 * r) * N + 64 * nb + 4 * c4;
    f32x4 v[16];
#pragma unroll
    for (int i = 0; i < 16; ++i) v[i] = __builtin_nontemporal_load((const GAS f32x4*)(src + (size_t)i * N));
    GAS bf16* dst = WT + (size_t)(64 * nb + 4 * c4) * K + 64 * kb + 16 * r;
#pragma unroll
    for (int j = 0; j < 4; ++j) { v4u a, b;
        a.x = cvt_pk_bf16(v[0][j], v[1][j]); a.y = cvt_pk_bf16(v[2][j], v[3][j]); a.z = cvt_pk_bf16(v[4][j], v[5][j]); a.w = cvt_pk_bf16(v[6][j], v[7][j]);
        b.x = cvt_pk_bf16(v[8][j], v[9][j]); b.y = cvt_pk_bf16(v[10][j], v[11][j]); b.z = cvt_pk_bf16(v[12][j], v[13][j]); b.w = cvt_pk_bf16(v[14][j], v[15][j]);
        *(GAS v4u*)(dst + (size_t)j * K) = a; *(GAS v4u*)(dst + (size_t)j * K + 8) = b; }
}
__device__ __forceinline__ void xn_row(const GAS float* src, GAS float* hdst, const GAS float* g, GAS bf16* xnrow, int lane) {
    const GAS f32x4* xr = (const GAS f32x4*)src + lane;
    f32x4 v[4]; float s = 0.f;
#pragma unroll
    for (int j = 0; j < 4; ++j) { v[j] = xr[64 * j]; s += (v[j].x * v[j].x + v[j].y * v[j].y) + (v[j].z * v[j].z + v[j].w * v[j].w); }
    if (hdst) { GAS v2u* ho = (GAS v2u*)hdst + lane;
#pragma unroll
        for (int j = 0; j < 4; ++j) { v2u o; o.x = cvt_pk_bf16(v[j].x, v[j].y); o.y = cvt_pk_bf16(v[j].z, v[j].w); ho[64 * j] = o; } }
    const float rs = frsq(wave_sum(s) * (1.f / D) + EPS);
    GAS v2u* o8 = (GAS v2u*)xnrow + lane;
#pragma unroll
    for (int j = 0; j < 4; ++j) { const f32x4 gg = ((const GAS f32x4*)g)[lane + 64 * j]; v2u o; o.x = cvt_pk_bf16(v[j].x * rs * gg.x, v[j].y * rs * gg.y); o.y = cvt_pk_bf16(v[j].z * rs * gg.z, v[j].w * rs * gg.w); o8[64 * j] = o; }
}
__device__ __forceinline__ void zero_xn_row(GAS bf16* xnrow, int lane) { GAS v2u* o8 = (GAS v2u*)xnrow + lane;
#pragma unroll
    for (int j = 0; j < 4; ++j) o8[64 * j] = (v2u){0u, 0u}; }

__device__ __forceinline__ void phase_prologue(Frame& F) {
    const int gw = F.vcu * 8 + F.wave, NGW = F.G * 8;
    constexpr int I_IN = (D / 64) * (NPROJ / 64), I_SQ = (D / 64) * (D / 64), I_PL = (256 / 64) * (256 / 64);
    constexpr int NITEMS = 2 * I_IN + 6 * I_SQ + 2 * I_SQ + 8 * I_PL;
    GAS bf16* win_t = (GAS bf16*)(F.wsp() + WS_WIN); GAS bf16* wbr_t = (GAS bf16*)(F.wsp() + WS_WBR); GAS bf16* wout_t = (GAS bf16*)(F.wsp() + WS_WOUT); GAS bf16* wpool_t = (GAS bf16*)(F.wsp() + WS_WPOOL);
    for (int it = gw; it < NITEMS; it += NGW) {
        int r = it;
        if (r < 2 * I_IN) { const int l = r / I_IN; p0_transpose_item(F_w_in + (size_t)l * D * NPROJ, D, NPROJ, win_t + (size_t)l * NPROJ * D, r % I_IN, F.lane_()); continue; } r -= 2 * I_IN;
        if (r < 6 * I_SQ) { const int m = r / I_SQ; p0_transpose_item(F_w_branch + (size_t)m * D * D, D, D, wbr_t + (size_t)m * D * D, r % I_SQ, F.lane_()); continue; } r -= 6 * I_SQ;
        if (r < 2 * I_SQ) { const int m = r / I_SQ; p0_transpose_item(F_w_out + (size_t)m * D * D, D, D, wout_t + (size_t)m * D * D, r % I_SQ, F.lane_()); continue; } r -= 2 * I_SQ;
        { const int m = r / I_PL; p0_transpose_item(F_w_pool + (size_t)m * 65536, 256, 256, wpool_t + (size_t)m * 65536, r % I_PL, F.lane_()); }
    }
    GAS float* H = (GAS float*)(F.wsp() + WS_H); GAS bf16* XN = (GAS bf16*)(F.wsp() + WS_XN);
    for (int r = gw; r < MTOT; r += NGW) {
        if (r >= MP && r < MPAD) { zero_xn_row(XN + (size_t)r * D, F.lane_()); zero_xn_row((GAS bf16*)(F.wsp() + WS_H) + (size_t)r * D, F.lane_()); continue; }
        const GAS float* src;
        if (r < MP) { const int b = r / LP, t = r - b * LP; src = (t < NMETA) ? F_meta + (size_t)t * D : F_xp + ((size_t)b * SEQ + (t - NMETA)) * D; }
        else src = F_xs + (size_t)(r - MPAD) * D;
        xn_row(src, (GAS float*)((GAS bf16*)(F.wsp() + WS_H) + (size_t)r * D), F_norm_g, XN + (size_t)r * D, F.lane_());
    }
    if (blockIdx.x == 0) { GAS float* lbp = (GAS float*)(F.wsp() + WS_LB);
        for (int i = F.tid_(); i < 1024; i += 512) { const float a = F_hlb[i], b = F_hlb[1024 + i], m = fmaxf(a, b), ea = expf(a - m), eb = expf(b - m), s = ea + eb; const float s0 = ea / s, s1 = eb / s;
            lbp[i] = s0 - s0; lbp[1024 + i] = (s0 + s1) - s0; } }
}
__device__ __forceinline__ void phase_xn(Frame& F, int l) {
    const int gw = F.vcu * 8 + F.wave, NGW = F.G * 8;
    GAS float* H = (GAS float*)(F.wsp() + WS_H); GAS bf16* XN = (GAS bf16*)(F.wsp() + WS_XN);
    for (int r = gw; r < MTOT; r += NGW) {
        if (r >= MP && r < MPAD) { zero_xn_row(XN + (size_t)r * D, F.lane_()); continue; }
        xn_row(H + (size_t)r * D, nullptr, F_norm_g + (size_t)l * D, XN + (size_t)r * D, F.lane_());
    }
}
namespace pg8 {
constexpr int BM = 256, BK = 64, HALF = 128, HTB = HALF * BK * 2, STAGE_BYTES = 8 * HTB, NXCD = 8;
__host__ __device__ __forceinline__ int lds_byte(int r, int c) { const int st = (r >> 4) * 2 + (c >> 5), rr = r & 15, cc = c & 31, ob = rr * 64 + cc * 2; return st * 1024 + (ob ^ (((ob >> 9) & 1) << 5)); }
__host__ __device__ __forceinline__ void stage_rc(int b, int& R, int& C) { const int st = b / 1024, sb = b % 1024, swz = sb ^ (((sb >> 9) & 1) << 5); R = (st >> 1) * 16 + swz / 64; C = (st & 1) * 32 + (swz % 64) / 2; }
__host__ __device__ __forceinline__ int perm32(int rho) { const int n = rho >> 4, i = rho & 15; return 8 * (i >> 2) + 4 * n + (i & 3); }

struct Unit { int pm, pn, seg, k0, nk, slab; };
struct Gemm { const GAS bf16* A; const GAS bf16* Bt; size_t a_seg, b_seg; int nM, nN, nseg, K, tail_parts, wgm; };

struct Order {
    int nM, nN, nwg, G, c, nseg, nt, tail, WGM;
    __device__ void init(const Gemm& g, int G_, int c_) { WGM = g.wgm; nM = g.nM; nN = g.nN; nwg = nM * nN; G = G_; c = c_; nseg = g.nseg; nt = g.K / BK;
        tail = (g.tail_parts > 0 && nwg > G && nwg <= 2 * G && (nwg - G) * g.tail_parts <= G && g.tail_parts % nseg == 0 && (nt % (2 * (g.tail_parts / nseg))) == 0) ? g.tail_parts : 0; }
    __device__ void tile_of(int L, int& pm, int& pn) const {
        int wgid = L; { const int q = nwg / NXCD, r = nwg % NXCD, xcd = wgid % NXCD, off = wgid / NXCD; wgid = (xcd < r ? xcd * (q + 1) : r * (q + 1) + (xcd - r) * q) + off; }
        const int nig = WGM * nN, gid = wgid / nig, fm = gid * WGM, gsz = (nM - fm) < WGM ? (nM - fm) : WGM;
        pm = fm + ((wgid % nig) % gsz); pn = (wgid % nig) / gsz; }
    template <int MODE> __device__ bool next(int i, Unit& u) const {
        u.k0 = 0; u.nk = nt; u.slab = -1;
        if (MODE == 0) {
            if (tail == 0) { const int ti = i / nseg; u.seg = i - ti * nseg; const long L = (long)ti * G + c; if (L >= nwg) return false; tile_of((int)L, u.pm, u.pn); return true; }
            if (i >= nseg) return false; u.seg = i; tile_of(c, u.pm, u.pn); return true; }
        if (tail == 0 || i > 0 || c >= (nwg - G) * tail) return false;
        const int j = c / tail, part = c - j * tail; tile_of(G + j, u.pm, u.pn); u.slab = c;
        { const int ks = tail / nseg; u.seg = part / ks; u.nk = nt / ks; u.k0 = (part - u.seg * ks) * u.nk; }
        return true;
    }
};

typedef f32x4 Acc[2][2][4][2];

template <class Epi, int MODE = 0>
__device__ __forceinline__ void gemm_phase(LAS unsigned char* lds, const Gemm g, const Order& S, const Epi& E, int wave_id) {
    const int wid = wave_id, lane = lane_id(), tid = wid * 64 + lane; const int wr = wid >> 2, wc = wid & 3, fr = lane & 15, fq = lane >> 4;
    const int K = g.K;
    unsigned voffA[2], voffB[2];
#pragma unroll
    for (int i = 0; i < 2; ++i) { int R, C; stage_rc(tid * 16 + i * 8192, R, C); const int Rb = (R & ~31) + perm32(R & 31);
        voffA[i] = (unsigned)(R * K + C) * 2u; voffB[i] = (unsigned)(Rb * K + C) * 2u; }
    const size_t kstep = (size_t)(BK * 2);
    const size_t hstep = (size_t)HALF * K * 2;
    const size_t tstep = 2 * hstep;
    const unsigned ldsw = (unsigned)wid * 1024u;
    const int aoff = lds_byte(wr * 64 + fr, fq * 8), boff = lds_byte(wc * 32 + fr, fq * 8);
#define PG8_SA(b, h) (((b) * 2 + (h)) * HTB)
#define PG8_SB(b, h) ((4 + (b) * 2 + (h)) * HTB)
#define PG8_STAGE(bufoff, gbase, voff) do { _Pragma("unroll") for (int _i = 0; _i < 2; ++_i) \
        __builtin_amdgcn_global_load_lds((const GAS unsigned*)((const GAS char*)(gbase) + (voff)[_i]), (LAS unsigned*)(lds + (bufoff) + ldsw + _i * 8192), 16, 0, 0); } while (0)
#define PG8_LDA(dst, b, h) do { _Pragma("unroll") for (int m = 0; m < 4; ++m) _Pragma("unroll") for (int k = 0; k < 2; ++k) dst[m][k] = *(const LAS bf16x8*)(lds + PG8_SA(b, h) + aoff + m * 2048 + k * 1024); } while (0)
#define PG8_LDB(dst, b, h) do { _Pragma("unroll") for (int n = 0; n < 2; ++n) _Pragma("unroll") for (int k = 0; k < 2; ++k) dst[n][k] = *(const LAS bf16x8*)(lds + PG8_SB(b, h) + boff + n * 2048 + k * 1024); } while (0)
#define PG8_MMA(ai, bj, At, Bt) do { __builtin_amdgcn_s_setprio(1); _Pragma("unroll") for (int m = 0; m < 4; ++m) _Pragma("unroll") for (int n = 0; n < 2; ++n) _Pragma("unroll") for (int k = 0; k < 2; ++k) \
        acc[ai][bj][m][n] = __builtin_amdgcn_mfma_f32_16x16x32_bf16(Bt[n][k], At[m][k], acc[ai][bj][m][n], 0, 0, 0); __builtin_amdgcn_s_setprio(0); } while (0)
#define PG8_WAIT_V(n) asm volatile("s_waitcnt vmcnt(" #n ")" ::: "memory")
#define PG8_WAIT_L(n) asm volatile("s_waitcnt lgkmcnt(" #n ")" ::: "memory")
#define PG8_BAR __builtin_amdgcn_s_barrier()
#define PG8_SCHED __builtin_amdgcn_sched_barrier(0)
    Unit cur, nxt; int ui = 0;
    if (!S.template next<MODE>(0, cur)) return;
    Acc acc;
#pragma unroll
    for (int a = 0; a < 2; ++a)
#pragma unroll
        for (int b = 0; b < 2; ++b)
#pragma unroll
            for (int m = 0; m < 4; ++m)
#pragma unroll
                for (int n = 0; n < 2; ++n) acc[a][b][m][n] = (f32x4){0.f, 0.f, 0.f, 0.f};
    bf16x8 At[4][2], B0[2][2], B1[2][2];
    const GAS char* cA = (const GAS char*)(g.A + (size_t)cur.seg * g.a_seg) + (size_t)cur.pm * tstep + (MODE ? (size_t)cur.k0 * kstep : 0); const GAS char* cB = (const GAS char*)(g.Bt + (size_t)cur.seg * g.b_seg) + (size_t)cur.pn * tstep + (MODE ? (size_t)cur.k0 * kstep : 0);
    PG8_STAGE(PG8_SB(0, 0), cB, voffB); PG8_STAGE(PG8_SB(0, 1), cB + hstep, voffB); PG8_STAGE(PG8_SA(0, 0), cA, voffA); PG8_STAGE(PG8_SA(0, 1), cA + hstep, voffA);
    if (wr == 1) PG8_BAR;
    PG8_WAIT_V(2); PG8_BAR;
    PG8_STAGE(PG8_SB(1, 0), cB + kstep, voffB); PG8_STAGE(PG8_SA(1, 0), cA + kstep, voffA); PG8_STAGE(PG8_SB(1, 1), cB + hstep + kstep, voffB);
    PG8_WAIT_V(6); PG8_BAR;
    for (;;) {
        const bool has_next = S.template next<MODE>(ui + 1, nxt);
        const GAS char* nA = has_next ? (const GAS char*)(g.A + (size_t)nxt.seg * g.a_seg) + (size_t)nxt.pm * tstep + (MODE ? (size_t)nxt.k0 * kstep : 0) : cA; const GAS char* nB = has_next ? (const GAS char*)(g.Bt + (size_t)nxt.seg * g.b_seg) + (size_t)nxt.pn * tstep + (MODE ? (size_t)nxt.k0 * kstep : 0) : cB;
        const int nt = MODE == 0 ? K / BK : cur.nk;
        for (int t = 0; t < nt; t += 2) {
            const bool last = (t == nt - 2);
            const GAS char* a1 = cA + (size_t)(t + 1) * kstep;
            const GAS char* a2 = last ? nA : cA + (size_t)(t + 2) * kstep; const GAS char* b2 = last ? nB : cB + (size_t)(t + 2) * kstep;
            const GAS char* a3 = a2 + kstep; const GAS char* b3 = b2 + kstep;
            PG8_LDB(B0, 0, 0); PG8_LDB(B1, 0, 1); PG8_SCHED; PG8_LDA(At, 0, 0); PG8_STAGE(PG8_SA(1, 1), a1 + hstep, voffA);
            PG8_WAIT_V(8); PG8_WAIT_L(0); PG8_BAR; PG8_MMA(0, 0, At, B0); PG8_MMA(0, 1, At, B1); PG8_BAR; PG8_SCHED;
            PG8_LDA(At, 0, 1); PG8_STAGE(PG8_SB(0, 0), b2, voffB); PG8_STAGE(PG8_SB(0, 1), b2 + hstep, voffB); PG8_STAGE(PG8_SA(0, 0), a2, voffA);
            PG8_WAIT_V(8); PG8_WAIT_L(0); PG8_BAR; PG8_MMA(1, 0, At, B0); PG8_MMA(1, 1, At, B1); PG8_BAR; PG8_SCHED;
            PG8_LDB(B0, 1, 0); PG8_LDB(B1, 1, 1); PG8_SCHED; PG8_LDA(At, 1, 0); PG8_STAGE(PG8_SA(0, 1), a2 + hstep, voffA);
            PG8_WAIT_V(8); PG8_WAIT_L(0); PG8_BAR; PG8_MMA(0, 0, At, B0); PG8_MMA(0, 1, At, B1); PG8_BAR; PG8_SCHED;
            PG8_LDA(At, 1, 1); PG8_STAGE(PG8_SB(1, 0), b3, voffB); PG8_STAGE(PG8_SB(1, 1), b3 + hstep, voffB); PG8_STAGE(PG8_SA(1, 0), a3, voffA);
            PG8_WAIT_V(8); PG8_WAIT_L(0); PG8_BAR; PG8_MMA(1, 0, At, B0); PG8_MMA(1, 1, At, B1); PG8_BAR; PG8_SCHED;
        }
        if (wr == 0) PG8_BAR;
        E(acc, cur, wr, wc, fr, fq, lds);
        if (!has_next) break;
        if (MODE == 1 || cur.seg == g.nseg - 1) {
#pragma unroll
            for (int a = 0; a < 2; ++a)
#pragma unroll
                for (int b = 0; b < 2; ++b)
#pragma unroll
                    for (int m = 0; m < 4; ++m)
#pragma unroll
                        for (int n = 0; n < 2; ++n) acc[a][b][m][n] = (f32x4){0.f, 0.f, 0.f, 0.f};
        }
        cur = nxt; cA = nA; cB = nB; ++ui;
        if (wr == 1) PG8_BAR;
    }
    PG8_WAIT_V(0);
    PG8_BAR;
#undef PG8_SA
#undef PG8_SB
#undef PG8_STAGE
#undef PG8_LDA
#undef PG8_LDB
#undef PG8_MMA
#undef PG8_WAIT_V
#undef PG8_WAIT_L
#undef PG8_BAR
#undef PG8_SCHED
}

typedef _Float16 h16x2 __attribute__((ext_vector_type(2)));
__device__ __forceinline__ unsigned cvt_pk_f16(float a, float b) { const f32x2 t = {a, b}; return __builtin_bit_cast(unsigned, __builtin_convertvector(t, h16x2)); }
__device__ __forceinline__ v4u pack8h(const f32x4 a, const f32x4 b) { v4u w; w.x = cvt_pk_f16(a[0], a[1]); w.y = cvt_pk_f16(a[2], a[3]); w.z = cvt_pk_f16(b[0], b[1]); w.w = cvt_pk_f16(b[2], b[3]); return w; }
#define EPI_FOR_ROWS for (int ai = 0; ai < 2; ++ai) _Pragma("unroll") for (int m = 0; m < 4; ++m)
__device__ __forceinline__ v4u pack8(const f32x4 a, const f32x4 b) { v4u w; w.x = cvt_pk_bf16(a[0], a[1]); w.y = cvt_pk_bf16(a[2], a[3]); w.z = cvt_pk_bf16(b[0], b[1]); w.w = cvt_pk_bf16(b[2], b[3]); return w; }

#define NT_ST(p, v) __builtin_nontemporal_store((v), (p))
struct EpiProj {
    int layer; GAS unsigned char* ws; GAS float* out; const GAS float* qng; const GAS float* kng; const GAS float* lb;
    __device__ __forceinline__ void operator()(Acc& acc, const Unit& u, int wr, int wc, int fr, int fq, LAS unsigned char* lds) const {
        const int grp = u.pn >> 2, ct = u.pn & 3;
        const int row0 = u.pm * BM + wr * 64 + fr;
        const int cg0 = ct * 256 + wc * 32 + 8 * fq;
        const bool sample = u.pm >= MPAD / 256;
        if (grp == 2 || grp == 3) {
            LAS float* X = (LAS float*)(lds + LDS_XCH);
#pragma unroll
            EPI_FOR_ROWS {
#pragma unroll
                for (int bj = 0; bj < 2; ++bj) { const f32x4 a = acc[ai][bj][m][0], b = acc[ai][bj][m][1];
                    float s = (a[0] * a[0] + a[1] * a[1]) + (a[2] * a[2] + a[3] * a[3]) + (b[0] * b[0] + b[1] * b[1]) + (b[2] * b[2] + b[3] * b[3]);
                    s += __shfl_xor(s, 16); s += __shfl_xor(s, 32);
                    if (fq == 0) X[(ai * 128 + wr * 64 + m * 16 + fr) * 8 + bj * 4 + wc] = s; } }
            LDS_WAIT(); __builtin_amdgcn_s_barrier(); asm volatile("" ::: "memory");
            const GAS float* gv = (grp == 2 ? qng : kng) + wc * 32 + 8 * fq; const float qs = (grp == 2) ? SB_SCALE * LOG2E : 1.0f;
            const f32x4 g0 = *(const GAS f32x4*)gv * qs, g1 = *(const GAS f32x4*)(gv + 4) * qs;
            GAS bf16* qdst = (GAS bf16*)(ws + WS_Q);
            GAS float* kdst = sample ? out + O_KS + (size_t)layer * MS * 1024 - (size_t)MPAD * 1024 : out + O_KP + (size_t)layer * MP * 1024;
#pragma unroll
            EPI_FOR_ROWS { const int row = row0 + ai * 128 + m * 16;
#pragma unroll
                for (int bj = 0; bj < 2; ++bj) { const f32x4 p = *(const LAS f32x4*)(X + (ai * 128 + wr * 64 + m * 16 + fr) * 8 + bj * 4);
                    const float rs = frsq(((p[0] + p[1]) + (p[2] + p[3])) * (1.0f / 128.0f) + EPS);
                    const f32x4 a = acc[ai][bj][m][0] * rs * g0, b = acc[ai][bj][m][1] * rs * g1; const int col = cg0 + bj * 128;
                    if (grp == 2) NT_ST((GAS v4u*)(qdst + (size_t)row * 1024 + col), pack8(a, b));
                    else if (sample || row < MP) { GAS float* d = kdst + (size_t)row * 1024 + col; NT_ST((GAS f32x4*)d, a); NT_ST((GAS f32x4*)(d + 4), b); } } }
            return;
        }
        if (grp == 4) {
            GAS float* vdst = sample ? out + O_VS + (size_t)layer * MS * 1024 - (size_t)MPAD * 1024 : out + O_VP + (size_t)layer * MP * 1024;
#pragma unroll
            EPI_FOR_ROWS { const int row = row0 + ai * 128 + m * 16;
                if (sample || row < MP) {
#pragma unroll
                    for (int bj = 0; bj < 2; ++bj) { GAS float* d = vdst + (size_t)row * 1024 + cg0 + bj * 128; NT_ST((GAS f32x4*)d, acc[ai][bj][m][0]); NT_ST((GAS f32x4*)(d + 4), acc[ai][bj][m][1]); } } }
            return;
        }
        if (grp == 6) {
            GAS _Float16* lf = (GAS _Float16*)(ws + WS_LOGF); GAS bf16* kc = (GAS bf16*)(ws + WS_KC);
#pragma unroll
            for (int bj = 0; bj < 2; ++bj) { const int col = cg0 + bj * 128; const f32x4 l0 = *(const GAS f32x4*)(lb + col), l1 = *(const GAS f32x4*)(lb + col + 4);
#pragma unroll
                EPI_FOR_ROWS { const int row = row0 + ai * 128 + m * 16; f32x4 z[2] = {acc[ai][bj][m][0], acc[ai][bj][m][1]}; f32x4 lo[2], ko[2];
#pragma unroll
                    for (int n = 0; n < 2; ++n)
#pragma unroll
                        for (int j = 0; j < 4; ++j) { const float zz = z[n][j], l = n ? l1[j] : l0[j], e = fexp2(-fabsf(zz) * LOG2E), r = frcp(1.0f + e), er = e * r;
                            const float sp = zz >= 0.f ? r : er, sn = zz >= 0.f ? er : r, oml = 1.0f - l;
                            lo[n][j] = flog2(l + oml * sp); ko[n][j] = oml * sn; }
                    NT_ST((GAS v4u*)(lf + (size_t)row * 1024 + col), pack8h(lo[0], lo[1]));
                    NT_ST((GAS v4u*)(kc + (size_t)row * 1024 + col), pack8(ko[0], ko[1])); } }
            return;
        }
        size_t off; int act;
        switch (grp) {
            case 0: off = WS_UA; act = 0; break;   case 1: off = WS_SGA; act = 1; break;  case 5: off = WS_SGB; act = 1; break;
            case 7: off = WS_QC; act = 1; break;   case 8: off = WS_IC; act = 0; break;   case 9: off = WS_SGC; act = 1; break;
            default: off = WS_GATE + (size_t)(grp - 10) * RB16; act = 2; break;
        }
        GAS bf16* dst = (GAS bf16*)(ws + off);
#pragma unroll
        EPI_FOR_ROWS { const int row = row0 + ai * 128 + m * 16;
#pragma unroll
            for (int bj = 0; bj < 2; ++bj) { f32x4 a = acc[ai][bj][m][0], b = acc[ai][bj][m][1];
                if (act) {
#pragma unroll
                    for (int j = 0; j < 4; ++j) { const float sa = fsigmoid(a[j]), sb = fsigmoid(b[j]);
                        a[j] = act == 1 ? a[j] * sa : fmaxf(sa, 1e-30f); b[j] = act == 1 ? b[j] * sb : fmaxf(sb, 1e-30f); } }
                NT_ST((GAS v4u*)(dst + (size_t)row * 1024 + cg0 + bj * 128), pack8(a, b)); } }
        if (grp == 0) {
#pragma unroll
            EPI_FOR_ROWS { const int row = row0 + ai * 128 + m * 16; GAS float* d = nullptr;
                if (sample) { const int rr = row - MPAD, b = rr >> 6, i = rr & 63; if (i >= DSEQ - 15) d = out + O_PS + (((size_t)layer * DBATCH + b) * 15 + (i - (DSEQ - 15))) * 1024; }
                else if (row < MP) { const int b = row / LP, t = row - b * LP; if (t >= LP - 15) d = out + O_PP + (((size_t)layer * BATCH + b) * 15 + (t - (LP - 15))) * 1024; }
                if (d) {
#pragma unroll
                    for (int bj = 0; bj < 2; ++bj) { GAS float* dd = d + cg0 + bj * 128; NT_ST((GAS f32x4*)dd, acc[ai][bj][m][0]); NT_ST((GAS f32x4*)(dd + 4), acc[ai][bj][m][1]); } } }
        }
    }
};

struct EpiMerge {
    GAS unsigned char* ws;
    __device__ __forceinline__ void operator()(Acc& acc, const Unit& u, int wr, int wc, int fr, int fq, LAS unsigned char* lds) const {
        const int row0 = u.pm * BM + wr * 64 + fr, c0 = u.pn * BM + wc * 32 + 8 * fq;
        const GAS bf16* G0 = (const GAS bf16*)(ws + WS_GATE) + (size_t)u.seg * MTOT * 1024; const GAS bf16* G1 = G0 + (size_t)MTOT * 1024; GAS bf16* dst = (GAS bf16*)(ws + WS_MERGED);
        const bool fin = u.seg == 2;
#pragma unroll
        for (int ai = 0; ai < 2; ++ai)
#pragma unroll
        for (int mh = 0; mh < 2; ++mh) {
            v4u ga[2][2], gb[2][2];
#pragma unroll
            for (int mm = 0; mm < 2; ++mm)
#pragma unroll
                for (int bj = 0; bj < 2; ++bj) { const size_t ro = (size_t)(row0 + ai * 128 + (2 * mh + mm) * 16) * 1024 + c0 + bj * 128; ga[mm][bj] = *(const GAS v4u*)(G0 + ro); gb[mm][bj] = fin ? ga[mm][bj] : *(const GAS v4u*)(G1 + ro); }
#pragma unroll
            for (int mm = 0; mm < 2; ++mm)
#pragma unroll
                for (int bj = 0; bj < 2; ++bj) { const int m = 2 * mh + mm; const v4u x = ga[mm][bj], y = gb[mm][bj];
                    f32x4 fa0 = {bf_lo(x.x), bf_hi(x.x), bf_lo(x.y), bf_hi(x.y)}, fa1 = {bf_lo(x.z), bf_hi(x.z), bf_lo(x.w), bf_hi(x.w)};
                    if (!fin) { const f32x4 fb0 = {bf_lo(y.x), bf_hi(y.x), bf_lo(y.y), bf_hi(y.y)}, fb1 = {bf_lo(y.z), bf_hi(y.z), bf_lo(y.w), bf_hi(y.w)};
#pragma unroll
                        for (int j = 0; j < 4; ++j) { fa0[j] *= frcp(fb0[j]); fa1[j] *= frcp(fb1[j]); } }
                    acc[ai][bj][m][0] *= fa0; acc[ai][bj][m][1] *= fa1;
                    if (fin) *(GAS v4u*)(dst + (size_t)(row0 + ai * 128 + m * 16) * 1024 + c0 + bj * 128) = pack8(acc[ai][bj][m][0], acc[ai][bj][m][1]); }
        }
    }
};

struct EpiOut {
    GAS unsigned char* ws; GAS float* out; int last;
    __device__ __forceinline__ void operator()(Acc& acc, const Unit& u, int wr, int wc, int fr, int fq, LAS unsigned char* lds) const {
        const int row0 = u.pm * BM + wr * 64 + fr, c0 = u.pn * BM + wc * 32 + 8 * fq; GAS bf16* HB = (GAS bf16*)(ws + WS_H);
        const bool sample = u.pm >= MPAD / 256;
#pragma unroll
        for (int ai = 0; ai < 2; ++ai) {
            v4u hb[4][2];
#pragma unroll
            for (int m = 0; m < 4; ++m)
#pragma unroll
                for (int bj = 0; bj < 2; ++bj) hb[m][bj] = *(const GAS v4u*)(HB + (size_t)(row0 + ai * 128 + m * 16) * 1024 + c0 + bj * 128);
#pragma unroll
            for (int m = 0; m < 4; ++m) { const int row = row0 + ai * 128 + m * 16;
                if (last) { GAS float* dp; bool ok = true;
                    if (sample) dp = out + O_YS + (size_t)(row - MPAD) * 1024 + c0;
                    else { const int b = row / LP, t = row - b * LP; ok = row < MP && t >= NMETA; dp = out + O_YP + ((size_t)b * SEQ + (t - NMETA)) * 1024 + c0; }
                    if (ok) {
#pragma unroll
                        for (int bj = 0; bj < 2; ++bj) { const v4u t = hb[m][bj];
                            *(GAS f32x4*)(dp + bj * 128) = (f32x4){bf_lo(t.x), bf_hi(t.x), bf_lo(t.y), bf_hi(t.y)} + acc[ai][bj][m][0]; *(GAS f32x4*)(dp + bj * 128 + 4) = (f32x4){bf_lo(t.z), bf_hi(t.z), bf_lo(t.w), bf_hi(t.w)} + acc[ai][bj][m][1]; } }
                } else {
#pragma unroll
                    for (int bj = 0; bj < 2; ++bj) { const v4u t = hb[m][bj];
                        *(GAS v4u*)(HB + (size_t)row * 1024 + c0 + bj * 128) = pack8((f32x4){bf_lo(t.x), bf_hi(t.x), bf_lo(t.y), bf_hi(t.y)} + acc[ai][bj][m][0], (f32x4){bf_lo(t.z), bf_hi(t.z), bf_lo(t.w), bf_hi(t.w)} + acc[ai][bj][m][1]); } } }
        }
    }
};
struct EpiMergeSlab {
    GAS unsigned char* ws;
    __device__ __forceinline__ void operator()(Acc& acc, const Unit& u, int wr, int wc, int fr, int fq, LAS unsigned char* lds) const {
        const int row0 = u.pm * BM + wr * 64 + fr, c0 = u.pn * BM + wc * 32 + 8 * fq;
        const GAS bf16* G0 = (const GAS bf16*)(ws + WS_GATE) + (size_t)u.seg * MTOT * 1024;
        {
            GAS bf16* sl = (GAS bf16*)(ws + WS_SLAB_M) + (size_t)u.slab * 65536 + (size_t)(wr * 64 + fr) * 256 + wc * 32 + 8 * fq;
#pragma unroll
            for (int ai = 0; ai < 2; ++ai) { v4u ga[4][2];
#pragma unroll
                for (int m = 0; m < 4; ++m)
#pragma unroll
                    for (int bj = 0; bj < 2; ++bj) ga[m][bj] = *(const GAS v4u*)(G0 + (size_t)(row0 + ai * 128 + m * 16) * 1024 + c0 + bj * 128);
#pragma unroll
                for (int m = 0; m < 4; ++m)
#pragma unroll
                    for (int bj = 0; bj < 2; ++bj) { const v4u x = ga[m][bj]; const f32x4 f0 = {bf_lo(x.x), bf_hi(x.x), bf_lo(x.y), bf_hi(x.y)}, f1 = {bf_lo(x.z), bf_hi(x.z), bf_lo(x.w), bf_hi(x.w)};
                        *(GAS v4u*)(sl + (size_t)(ai * 128 + m * 16) * 256 + bj * 128) = pack8(acc[ai][bj][m][0] * f0, acc[ai][bj][m][1] * f1); } }
        }
    }
};
struct EpiOutSlab {
    GAS unsigned char* ws;
    __device__ __forceinline__ void operator()(Acc& acc, const Unit& u, int wr, int wc, int fr, int fq, LAS unsigned char* lds) const {
        {
            GAS bf16* sl = (GAS bf16*)(ws + WS_SLAB_O) + (size_t)u.slab * 65536 + (size_t)(wr * 64 + fr) * 256 + wc * 32 + 8 * fq;
#pragma unroll
            for (int ai = 0; ai < 2; ++ai)
#pragma unroll
                for (int m = 0; m < 4; ++m)
#pragma unroll
                    for (int bj = 0; bj < 2; ++bj) *(GAS v4u*)(sl + (size_t)(ai * 128 + m * 16) * 256 + bj * 128) = pack8(acc[ai][bj][m][0], acc[ai][bj][m][1]);
        }
    }
};
}
__device__ __forceinline__ f32x16 mfma32(bf16x8 a, bf16x8 b, f32x16 c) { return __builtin_amdgcn_mfma_f32_32x32x16_bf16(a, b, c, 0, 0, 0); }
__device__ __forceinline__ f32x16 zero16() { f32x16 z;
#pragma unroll
    for (int i = 0; i < 16; ++i) z[i] = 0.f; return z; }
__device__ __forceinline__ bf16x8 cvt8(const f32x4 a, const f32x4 b) { const v4u w = pg8::pack8(a, b); return __builtin_bit_cast(bf16x8, w); }

namespace hg {
constexpr int P136 = 136, P72 = 72;
constexpr int L_QS = 0, L_QT = L_QS + 64 * P136 * 2, L_KT = L_QT + 64 * P136 * 2, L_KTT = L_KT + 64 * P136 * 2, L_VT = L_KTT + 128 * P72 * 2,
              L_ATT = L_VT + 128 * P72 * 2, L_ST = L_ATT + 64 * P72 * 2, L_SEG = L_ST + 128 * P136 * 2, L_EV = L_SEG + 8 * 128 * 4, L_PART = L_EV + 2 * 128 * 4, L_GN = L_PART + 64 * 4 * 4, L_END = L_GN + 128 * 4;
static_assert(L_END <= LDS_MISC, "hgrn LDS");
struct Pre { unsigned lf[8]; unsigned q[8], k[8], v[8]; v2u sg[4]; };
#define HG_BAR() do { asm volatile("s_waitcnt lgkmcnt(0)" ::: "memory"); __builtin_amdgcn_s_barrier(); asm volatile("" ::: "memory"); } while (0)

template <int PART>
__device__ __forceinline__ void prefetch(Pre& P, const GAS unsigned char* ws, size_t row0, int nvalid, int seg, int colb  , int trow  , int sgcol  ) {
    const GAS _Float16* LF = (const GAS _Float16*)(ws + WS_LOGF) + row0 * 1024; const GAS bf16* QC = (const GAS bf16*)(ws + WS_QC) + row0 * 1024; const GAS bf16* KC = (const GAS bf16*)(ws + WS_KC) + row0 * 1024; const GAS bf16* IC = (const GAS bf16*)(ws + WS_IC) + row0 * 1024;
    if (PART & 2) { const GAS bf16* SGC = (const GAS bf16*)(ws + WS_SGC) + row0 * 1024; const unsigned so = (unsigned)((trow < nvalid ? trow : 0) * 1024 + sgcol);
#pragma unroll
      for (int g = 0; g < 4; ++g) P.sg[g] = *(const GAS v2u*)(SGC + so + 8 * g); }
    if (nvalid == 64) {
#pragma unroll
        for (int i = 0; i < 8; ++i) { const unsigned o = (unsigned)((seg * 8 + i) * 1024 + colb);
            if (PART & 1) P.lf[i] = *(const GAS unsigned*)(LF + o);
            if (PART & 2) { P.q[i] = *(const GAS unsigned*)(QC + o); P.k[i] = *(const GAS unsigned*)(KC + o); P.v[i] = *(const GAS unsigned*)(IC + o); } }
    } else {
#pragma unroll
        for (int i = 0; i < 8; ++i) { const int t = seg * 8 + i; const unsigned o = (unsigned)(t * 1024 + colb);
            if (t < nvalid) { if (PART & 1) P.lf[i] = *(const GAS unsigned*)(LF + o); if (PART & 2) { P.q[i] = *(const GAS unsigned*)(QC + o); P.k[i] = *(const GAS unsigned*)(KC + o); P.v[i] = *(const GAS unsigned*)(IC + o); } }
            else { if (PART & 1) P.lf[i] = 0u; if (PART & 2) { P.q[i] = 0u; P.k[i] = 0u; P.v[i] = 0u; } } }
    }
}

__device__ __forceinline__ void chain(Frame& F, int layer, bool sample, int b, int h) {
    LAS unsigned char* lds = F.lds; int tid = F.tid_(); asm volatile("" : "+v"(tid));
    const int lane = tid & 63, wave = F.wave, seg = wave; int kp = tid & 63, l31 = lane & 31, hh = lane >> 5;
    const int L = sample ? DSEQ : LP, nchunks = (L + 63) / 64;
    const size_t rowbase = sample ? (size_t)MPAD + (size_t)b * DSEQ : (size_t)b * LP;
    const int colb = h * 128 + 2 * kp;
    GAS bf16* YC = (GAS bf16*)(F.wsp() + WS_Y) + (size_t)2 * MTOT * 1024;
    const int kb = wave >> 1, vb0 = 2 * (wave & 1);
    f32x16 S[2];
    if (sample) { const GAS float* s0 = F_state_hgrn + (((size_t)layer * DBATCH + b) * 8 + h) * 16384;
#pragma unroll
        for (int vbi = 0; vbi < 2; ++vbi)
#pragma unroll
            for (int r = 0; r < 16; ++r) S[vbi][r] = s0[(size_t)(32 * kb + (r & 3) + 8 * (r >> 2) + 4 * hh) * 128 + 32 * (vb0 + vbi) + l31]; }
    else { S[0] = zero16(); S[1] = zero16(); }
#pragma unroll
    for (int vbi = 0; vbi < 2; ++vbi)
#pragma unroll
        for (int g = 0; g < 4; ++g) { v2u w; w.x = cvt_pk_bf16(S[vbi][4 * g], S[vbi][4 * g + 1]); w.y = cvt_pk_bf16(S[vbi][4 * g + 2], S[vbi][4 * g + 3]);
            *(LAS v2u*)(lds + L_ST + ((32 * (vb0 + vbi) + l31) * P136 + 32 * kb + 8 * g + 4 * hh) * 2) = w; }
    const int ovb = wave & 3, otb = wave >> 2;
    if (tid < 128) *(LAS float*)(lds + L_GN + tid * 4) = F_hng[layer * 128 + tid];
    Pre P; prefetch<3>(P, F.wsp(), rowbase, min(64, L), seg, colb, 32 * otb + l31, h * 128 + 32 * ovb + 4 * hh);
    for (int c = 0; c < nchunks; ++c) {
        asm volatile("" : "+v"(l31), "+v"(hh), "+v"(kp));
        const int nvalid = min(64, L - 64 * c); const size_t row0 = rowbase + (size_t)64 * c;
        float c0[8], c1[8]; { float a0 = 0.f, a1 = 0.f;
#pragma unroll
            for (int i = 0; i < 8; ++i) { const pg8::h16x2 hv = __builtin_bit_cast(pg8::h16x2, P.lf[i]); a0 += (float)hv.x; a1 += (float)hv.y; c0[i] = a0; c1[i] = a1; }
            *(LAS f32x2*)(lds + L_SEG + (seg * 128 + 2 * kp) * 4) = (f32x2){a0, a1}; }
        if (c + 1 < nchunks) prefetch<1>(P, F.wsp(), rowbase + (size_t)64 * (c + 1), min(64, L - 64 * (c + 1)), seg, colb, 32 * otb + l31, h * 128 + 32 * ovb + 4 * hh);
        HG_BAR();
        float off0 = 0.f, off1 = 0.f, m0 = 0.f, m1 = 0.f, la0 = 0.f, la1 = 0.f;
#pragma unroll
        for (int s = 0; s < 8; ++s) { const f32x2 tt = *(const LAS f32x2*)(lds + L_SEG + (s * 128 + 2 * kp) * 4);
            if (s < seg) { off0 += tt.x; off1 += tt.y; } if (s < 4) { m0 += tt.x; m1 += tt.y; } la0 += tt.x; la1 += tt.y; }
        unsigned ktt0[8], ktt1[8], vt0[8], vt1[8]; const float e2m0 = fexp2(m0), e2m1 = fexp2(m1);
#pragma unroll
        for (int i = 0; i < 8; ++i) { const int t = seg * 8 + i; const float cu0 = off0 + c0[i], cu1 = off1 + c1[i];
            const float q0 = bf_lo(P.q[i]), q1 = bf_hi(P.q[i]), k0 = bf_lo(P.k[i]), k1 = bf_hi(P.k[i]);
            const float em0 = fexp2(cu0 - m0), em1 = fexp2(cu1 - m1), ek0 = fexp2(m0 - cu0), ek1 = fexp2(m1 - cu1), eq0 = em0 * e2m0, eq1 = em1 * e2m1;
            *(LAS unsigned*)(lds + L_QS + (t * P136 + 2 * kp) * 2) = cvt_pk_bf16(q0 * eq0, q1 * eq1);
            *(LAS unsigned*)(lds + L_QT + (t * P136 + 2 * kp) * 2) = cvt_pk_bf16(q0 * em0, q1 * em1);
            const unsigned kt = cvt_pk_bf16(k0 * ek0, k1 * ek1);
            *(LAS unsigned*)(lds + L_KT + (t * P136 + 2 * kp) * 2) = kt;
            ktt0[i] = kt & 0xffffu; ktt1[i] = kt >> 16; vt0[i] = P.v[i] & 0xffffu; vt1[i] = P.v[i] >> 16; }
        { v4u w; w.x = ktt0[0] | (ktt0[1] << 16); w.y = ktt0[2] | (ktt0[3] << 16); w.z = ktt0[4] | (ktt0[5] << 16); w.w = ktt0[6] | (ktt0[7] << 16);
          *(LAS v4u*)(lds + L_KTT + ((2 * kp) * P72 + 8 * seg) * 2) = w;
          w.x = ktt1[0] | (ktt1[1] << 16); w.y = ktt1[2] | (ktt1[3] << 16); w.z = ktt1[4] | (ktt1[5] << 16); w.w = ktt1[6] | (ktt1[7] << 16);
          *(LAS v4u*)(lds + L_KTT + ((2 * kp + 1) * P72 + 8 * seg) * 2) = w;
          w.x = vt0[0] | (vt0[1] << 16); w.y = vt0[2] | (vt0[3] << 16); w.z = vt0[4] | (vt0[5] << 16); w.w = vt0[6] | (vt0[7] << 16);
          *(LAS v4u*)(lds + L_VT + ((2 * kp) * P72 + 8 * seg) * 2) = w;
          w.x = vt1[0] | (vt1[1] << 16); w.y = vt1[2] | (vt1[3] << 16); w.z = vt1[4] | (vt1[5] << 16); w.w = vt1[6] | (vt1[7] << 16);
          *(LAS v4u*)(lds + L_VT + ((2 * kp + 1) * P72 + 8 * seg) * 2) = w; }
        if (seg == 0) { *(LAS f32x2*)(lds + L_EV + (2 * kp) * 4) = (f32x2){fexp2(la0), fexp2(la1)}; *(LAS f32x2*)(lds + L_EV + (128 + 2 * kp) * 4) = (f32x2){fexp2(la0 - m0), fexp2(la1 - m1)}; }
        v2u sg[4] = {P.sg[0], P.sg[1], P.sg[2], P.sg[3]};
        if (c + 1 < nchunks) prefetch<2>(P, F.wsp(), rowbase + (size_t)64 * (c + 1), min(64, L - 64 * (c + 1)), seg, colb, 32 * otb + l31, h * 128 + 32 * ovb + 4 * hh);
        HG_BAR();
        if (wave < 3) { const int sb = wave == 2 ? 1 : 0, tb = wave == 0 ? 0 : 1; f32x16 a = zero16();
#pragma unroll
            for (int st = 0; st < 8; ++st) { const bf16x8 ka = *(const LAS bf16x8*)(lds + L_KT + ((32 * sb + l31) * P136 + 16 * st + 8 * hh) * 2);
                const bf16x8 qb = *(const LAS bf16x8*)(lds + L_QT + ((32 * tb + l31) * P136 + 16 * st + 8 * hh) * 2); a = mfma32(ka, qb, a); }
            const int t = 32 * tb + l31;
#pragma unroll
            for (int g = 0; g < 4; ++g) { const int s0 = 32 * sb + 8 * g + 4 * hh; float x[4];
#pragma unroll
                for (int j = 0; j < 4; ++j) x[j] = (s0 + j <= t) ? a[4 * g + j] : 0.f;
                v2u w; w.x = cvt_pk_bf16(x[0], x[1]); w.y = cvt_pk_bf16(x[2], x[3]); *(LAS v2u*)(lds + L_ATT + (t * P72 + s0) * 2) = w; } }
        HG_BAR();
        f32x16 o = zero16();
#pragma unroll
        for (int st = 0; st < 8; ++st) { const bf16x8 sa = *(const LAS bf16x8*)(lds + L_ST + ((32 * ovb + l31) * P136 + 16 * st + 8 * hh) * 2);
            const bf16x8 qb = *(const LAS bf16x8*)(lds + L_QS + ((32 * otb + l31) * P136 + 16 * st + 8 * hh) * 2); o = mfma32(sa, qb, o); }
        for (int st = 0; st < 2 + 2 * otb; ++st) { const bf16x8 va = *(const LAS bf16x8*)(lds + L_VT + ((32 * ovb + l31) * P72 + 16 * st + 8 * hh) * 2);
            const bf16x8 ab = *(const LAS bf16x8*)(lds + L_ATT + ((32 * otb + l31) * P72 + 16 * st + 8 * hh) * 2); o = mfma32(va, ab, o); }
        { float ss = 0.f;
#pragma unroll
            for (int r = 0; r < 16; ++r) ss += o[r] * o[r];
            ss += __shfl_xor(ss, 32);
            if (hh == 0) *(LAS float*)(lds + L_PART + ((32 * otb + l31) * 4 + ovb) * 4) = ss; }
        HG_BAR();
        { const f32x4 p = *(const LAS f32x4*)(lds + L_PART + (32 * otb + l31) * 16); const float rs = frsq(((p[0] + p[1]) + (p[2] + p[3])) * (1.0f / 128.0f) + EPS);
          const int t = 32 * otb + l31;
          if (t < nvalid) { GAS bf16* yp = YC + (row0 + t) * 1024 + h * 128 + 32 * ovb + 4 * hh;
#pragma unroll
              for (int g = 0; g < 4; ++g) { const f32x4 gng = *(const LAS f32x4*)(lds + L_GN + (32 * ovb + 8 * g + 4 * hh) * 4); const float y0 = o[4 * g] * rs * gng[0] * bf_lo(sg[g].x), y1 = o[4 * g + 1] * rs * gng[1] * bf_hi(sg[g].x),
                                                        y2 = o[4 * g + 2] * rs * gng[2] * bf_lo(sg[g].y), y3 = o[4 * g + 3] * rs * gng[3] * bf_hi(sg[g].y);
                  v2u w; w.x = cvt_pk_bf16(y0, y1); w.y = cvt_pk_bf16(y2, y3); *(GAS v2u*)(yp + 8 * g) = w; } } }
        f32x16 Pn[2] = {zero16(), zero16()};
#pragma unroll
        for (int st = 0; st < 4; ++st) { const bf16x8 ka = *(const LAS bf16x8*)(lds + L_KTT + ((32 * kb + l31) * P72 + 16 * st + 8 * hh) * 2);
#pragma unroll
            for (int vbi = 0; vbi < 2; ++vbi) { const bf16x8 vbf = *(const LAS bf16x8*)(lds + L_VT + ((32 * (vb0 + vbi) + l31) * P72 + 16 * st + 8 * hh) * 2); Pn[vbi] = mfma32(ka, vbf, Pn[vbi]); } }
#pragma unroll
        for (int g = 0; g < 4; ++g) { const f32x4 el = *(const LAS f32x4*)(lds + L_EV + (32 * kb + 8 * g + 4 * hh) * 4), elm = *(const LAS f32x4*)(lds + L_EV + (128 + 32 * kb + 8 * g + 4 * hh) * 4);
#pragma unroll
            for (int vbi = 0; vbi < 2; ++vbi) {
#pragma unroll
                for (int j = 0; j < 4; ++j) S[vbi][4 * g + j] = el[j] * S[vbi][4 * g + j] + elm[j] * Pn[vbi][4 * g + j];
                v2u w; w.x = cvt_pk_bf16(S[vbi][4 * g], S[vbi][4 * g + 1]); w.y = cvt_pk_bf16(S[vbi][4 * g + 2], S[vbi][4 * g + 3]);
                *(LAS v2u*)(lds + L_ST + ((32 * (vb0 + vbi) + l31) * P136 + 32 * kb + 8 * g + 4 * hh) * 2) = w; } }
    }
    GAS float* sf = sample ? F.outp() + O_HS + (((size_t)layer * DBATCH + b) * 8 + h) * 16384 : F.outp() + O_HP + (((size_t)layer * BATCH + b) * 8 + h) * 16384;
#pragma unroll
    for (int vbi = 0; vbi < 2; ++vbi)
#pragma unroll
        for (int r = 0; r < 16; ++r) sf[(size_t)(32 * kb + (r & 3) + 8 * (r >> 2) + 4 * hh) * 128 + 32 * (vb0 + vbi) + l31] = S[vbi][r];
    HG_BAR();
}
}

namespace sb {
constexpr float R_STOP = -136.0f;
constexpr int KROW = 272, SLOT = 32 * KROW + 128 * 64;
static_assert(8 * SLOT + 64 <= LDS_MISC, "attention LDS");
constexpr int L_DONE = 8 * SLOT;
struct Grp { const GAS float* k_old; const GAS float* v_old; const GAS float* k_new; const GAS float* v_new; };

struct TileRegs { f32x4 k0, k1, v0, v1; };
__device__ __forceinline__ void tile_issue(TileRegs& t, const Grp& g, int kt, int past, int L, int c, int rp, int sh) {
    const int s0 = 32 * kt - sh; const bool old = s0 + sh < past; const int rl = old ? 31 : (L - 1 - (s0 - past)), lo = s0 < 0 ? -s0 : 0;
    const GAS float* kb = old ? g.k_old + (ptrdiff_t)s0 * 1024 : g.k_new + (ptrdiff_t)(s0 - past) * 1024; const GAS float* vb = old ? g.v_old + (ptrdiff_t)s0 * 1024 : g.v_new + (ptrdiff_t)(s0 - past) * 1024;
    if (rl >= 31 && lo == 0) {
        const unsigned o = (unsigned)(2 * rp * 1024 + 4 * c);
        t.k0 = *(const GAS f32x4*)(kb + o); t.k1 = *(const GAS f32x4*)(kb + o + 1024); t.v0 = *(const GAS f32x4*)(vb + o); t.v1 = *(const GAS f32x4*)(vb + o + 1024);
        return; }
    const int r0 = max(min(2 * rp, rl), lo), r1 = max(min(2 * rp + 1, rl), lo);
    t.k0 = *(const GAS f32x4*)(kb + (ptrdiff_t)r0 * 1024 + 4 * c); t.k1 = *(const GAS f32x4*)(kb + (ptrdiff_t)r1 * 1024 + 4 * c);
    t.v0 = *(const GAS f32x4*)(vb + (ptrdiff_t)r0 * 1024 + 4 * c); t.v1 = *(const GAS f32x4*)(vb + (ptrdiff_t)r1 * 1024 + 4 * c);
}
__device__ __forceinline__ void tile_commit(const TileRegs& t, LAS unsigned char* slot, int c, int rp) {
    v2u a; a.x = cvt_pk_bf16(t.k0[0], t.k0[1]); a.y = cvt_pk_bf16(t.k0[2], t.k0[3]); *(LAS v2u*)(slot + (2 * rp) * KROW + 8 * c) = a;
    a.x = cvt_pk_bf16(t.k1[0], t.k1[1]); a.y = cvt_pk_bf16(t.k1[2], t.k1[3]); *(LAS v2u*)(slot + (2 * rp + 1) * KROW + 8 * c) = a;
    LAS unsigned char* vt = slot + 32 * KROW; const int r7 = rp & 7, f = 2 * (rp >> 3) + ((r7 >> 1) & 1);
    const int u = ((f ^ (c & 3)) * 16) + (r7 >> 2) * 8 + (rp & 1) * 4;
#pragma unroll
    for (int j = 0; j < 4; ++j) *(LAS unsigned*)(vt + (4 * c + j) * 64 + u) = cvt_pk_bf16(t.v0[j], t.v1[j]);
}

template <int NG>
__device__ __forceinline__ void block_unit(Frame& F, int layer, int unit  ) {
    constexpr int W = 8 / NG;
    int tid = F.tid_(); asm volatile("" : "+v"(tid)); const int lane = tid & 63, wave = F.wave, l31 = lane & 31, hh = lane >> 5;
    LAS unsigned char* lds = F.lds;
    const bool sample = NG > 1; constexpr int sh = NG == 1 ? 16 : 0; const int L = sample ? DSEQ : LP, past = sample ? PAST : 0, nqt = (L + sh + 31) / 32;
    const int gi = wave / W, wi = wave - gi * W;
    int bh, qt0; bool wave_on; if (!sample) { const int j = 8 - (unit >> 6); bh = unit & 63; qt0 = j == 0 ? 0 : 8 * j - 7; wave_on = j > 0 || wi == 0; } else { bh = unit * NG + gi; qt0 = 0; wave_on = wi < nqt; }
    const int b = bh >> 3, h = bh & 7; const int qt = qt0 + wi;
    const size_t rowbase = sample ? (size_t)MPAD + (size_t)b * DSEQ : (size_t)b * LP;
    Grp g;
    g.k_new = (sample ? F.outp() + O_KS + (size_t)layer * MS * 1024 + (size_t)b * DSEQ * 1024 : F.outp() + O_KP + (size_t)layer * MP * 1024 + (size_t)b * LP * 1024) + h * 128;
    g.v_new = (sample ? F.outp() + O_VS + (size_t)layer * MS * 1024 + (size_t)b * DSEQ * 1024 : F.outp() + O_VP + (size_t)layer * MP * 1024 + (size_t)b * LP * 1024) + h * 128;
    g.k_old = F_cache_k + ((size_t)layer * DBATCH + b) * PAST * 1024 + h * 128; g.v_old = F_cache_v + ((size_t)layer * DBATCH + b) * PAST * 1024 + h * 128;
    const int dt0 = (past >> 5) + qt0;
    const int tq = 32 * qt - sh + l31; const bool qvalid = wave_on && tq >= 0 && tq < L; const size_t qrow = rowbase + (tq < 0 ? 0 : tq < L ? tq : L - 1);
    const GAS bf16* Q = (const GAS bf16*)(F.wsp() + WS_Q) + qrow * 1024 + h * 128 + 8 * hh;
    bf16x8 qf[8];
#pragma unroll
    for (int st = 0; st < 8; ++st) qf[st] = *(const GAS bf16x8*)(Q + 16 * st);
    f32x16 O[4] = {zero16(), zero16(), zero16(), zero16()};
    const int qpos = past + tq; float R = 0.f; bool done = !wave_on;
    const int sc = tid & 31, srp = NG == 1 ? (tid >> 5) : ((tid & (64 * W - 1)) >> 5);
    if (NG == 1) { for (int j0 = 0; j0 < W; j0 += 4) { TileRegs t[4];
#pragma unroll
            for (int j = 0; j < 4; ++j) tile_issue(t[j], g, dt0 + j0 + j, past, L, sc, srp, sh);
#pragma unroll
            for (int j = 0; j < 4; ++j) tile_commit(t[j], lds + ((dt0 + j0 + j) & (W - 1)) * SLOT, sc, srp); } }
    else { for (int j = 0; j < W; ++j) { TileRegs t[4];
#pragma unroll
            for (int ps = 0; ps < 4; ++ps) tile_issue(t[ps], g, dt0 + j, past, L, sc, srp + 4 * ps, sh);
#pragma unroll
            for (int ps = 0; ps < 4; ++ps) tile_commit(t[ps], lds + (gi * W + ((dt0 + j) & (W - 1))) * SLOT, sc, srp + 4 * ps); } }
    if (lane == 0) *(LAS unsigned*)(lds + L_DONE + 4 * wave) = done ? 1u : 0u;
    TileRegs pre; if (NG == 1 && dt0 - 1 >= 0) tile_issue(pre, g, dt0 - 1, past, L, sc, srp, sh);
    HG_BAR();
    for (int i = 0; ; ++i) {
        const int kt = dt0 + wi - i;
        const int knew = dt0 - i - 1;
        TileRegs pre2; if (NG == 1 && knew - 1 >= 0) tile_issue(pre2, g, knew - 1, past, L, sc, srp, sh);
        if (!done && kt >= 0) {
            const LAS unsigned char* slot = lds + (gi * W + (kt & (W - 1))) * SLOT; const int s0 = 32 * kt - sh;
            f32x16 sa = zero16();
#pragma unroll
            for (int st = 0; st < 8; ++st) sa = mfma32(*(const LAS bf16x8*)(slot + l31 * KROW + (16 * st + 8 * hh) * 2), qf[st], sa);
            const bool diag = i == 0;
            float sg[16], kp[16];
#pragma unroll
            for (int r = 0; r < 16; ++r) { const float e = fexp2(-sa[r]), rc = frcp(1.0f + e); sg[r] = rc; kp[r] = e * rc; }
            if (diag || (sh != 0 && kt == 0)) { const int khi = diag ? qpos : 0x7fffffff;
#pragma unroll
                for (int r = 0; r < 16; ++r) { const int key = s0 + (r & 3) + 8 * (r >> 2) + 4 * hh; const bool ok = key < khi && key >= 0; kp[r] = ok ? kp[r] : 1.0f; sg[r] = ok ? sg[r] : 0.f; } }
            float ex[16], T[4], Tp[4];
#pragma unroll
            for (int gq = 0; gq < 4; ++gq) { ex[4 * gq + 3] = 1.0f; ex[4 * gq + 2] = kp[4 * gq + 3]; ex[4 * gq + 1] = ex[4 * gq + 2] * kp[4 * gq + 2]; ex[4 * gq] = ex[4 * gq + 1] * kp[4 * gq + 1]; T[gq] = ex[4 * gq] * kp[4 * gq]; Tp[gq] = __shfl_xor(T[gq], 32); }
            float carry[4]; { float above = fexp2(R);
#pragma unroll
                for (int gq = 3; gq >= 0; --gq) { carry[gq] = above * (hh == 0 ? Tp[gq] : 1.0f); above *= T[gq] * Tp[gq]; }
                R += flog2(fmaxf(((T[0] * Tp[0]) * (T[1] * Tp[1])) * ((T[2] * Tp[2]) * (T[3] * Tp[3])), 1e-45f)); }
            float w[16];
#pragma unroll
            for (int r = 0; r < 16; ++r) w[r] = sg[r] * (carry[r >> 2] * ex[r]);
            const LAS unsigned char* vt = slot + 32 * KROW;
#pragma unroll
            for (int s = 0; s < 2; ++s) { v4u pw; pw.x = cvt_pk_bf16(w[8 * s], w[8 * s + 1]); pw.y = cvt_pk_bf16(w[8 * s + 2], w[8 * s + 3]); pw.z = cvt_pk_bf16(w[8 * s + 4], w[8 * s + 5]); pw.w = cvt_pk_bf16(w[8 * s + 6], w[8 * s + 7]);
                const bf16x8 pb = __builtin_bit_cast(bf16x8, pw);
#pragma unroll
                for (int db = 0; db < 4; ++db) { const int d = 32 * db + l31;
                    O[db] = mfma32(*(const LAS bf16x8*)(vt + d * 64 + (((2 * s + hh) ^ ((d >> 2) & 3)) * 16)), pb, O[db]); } }
            if (kt == 0 || __all(R < R_STOP)) { done = true; if (lane == 0) *(LAS unsigned*)(lds + L_DONE + 4 * wave) = 1u; }
        } else if (!done && kt < 0) { done = true; if (lane == 0) *(LAS unsigned*)(lds + L_DONE + 4 * wave) = 1u; }
        HG_BAR();
        const v4u d0 = *(const LAS v4u*)(lds + L_DONE), d1 = *(const LAS v4u*)(lds + L_DONE + 16);
        if ((d0.x & d0.y & d0.z & d0.w & d1.x & d1.y & d1.z & d1.w) != 0u) break;
        if (NG == 1) { if (knew >= 0) tile_commit(pre, lds + (knew & (W - 1)) * SLOT, sc, srp); pre = pre2; }
        else if (knew >= 0) { TileRegs t[4];
#pragma unroll
            for (int ps = 0; ps < 4; ++ps) tile_issue(t[ps], g, knew, past, L, sc, srp + 4 * ps, sh);
#pragma unroll
            for (int ps = 0; ps < 4; ++ps) tile_commit(t[ps], lds + (gi * W + (knew & (W - 1))) * SLOT, sc, srp + 4 * ps); }
        HG_BAR();
    }
    if (qvalid) { const GAS bf16* SG = (const GAS bf16*)(F.wsp() + WS_SGB) + qrow * 1024 + h * 128 + 4 * hh; GAS bf16* Y = (GAS bf16*)(F.wsp() + WS_Y) + (size_t)MTOT * 1024 + qrow * 1024 + h * 128 + 4 * hh;
        v2u sgv[4][4];
#pragma unroll
        for (int db = 0; db < 4; ++db)
#pragma unroll
            for (int gq = 0; gq < 4; ++gq) sgv[db][gq] = *(const GAS v2u*)(SG + 32 * db + 8 * gq);
#pragma unroll
        for (int db = 0; db < 4; ++db)
#pragma unroll
            for (int gq = 0; gq < 4; ++gq) { const v2u s = sgv[db][gq]; v2u o;
                o.x = cvt_pk_bf16(O[db][4 * gq] * bf_lo(s.x), O[db][4 * gq + 1] * bf_hi(s.x)); o.y = cvt_pk_bf16(O[db][4 * gq + 2] * bf_lo(s.y), O[db][4 * gq + 3] * bf_hi(s.y));
                *(GAS v2u*)(Y + 32 * db + 8 * gq) = o; } }
    HG_BAR();
}
constexpr int NU_P = BATCH * 8 * 9, NU_S = DBATCH * 8 / 4;
constexpr int NUNITS = NU_P + NU_S;
}

namespace pl {
constexpr int RS = 528;
constexpr int L_UT = 0, L_DF = 143 * RS, L_END = L_DF + 128 * RS;
static_assert(L_END <= LDS_MISC, "pool LDS");
constexpr int NU_P = BATCH * 17 * 4, NU_S = DBATCH * 4, NUNITS = NU_P + NU_S;
__device__ __forceinline__ void unit(Frame& F, int layer, int u) {
    LAS unsigned char* lds = F.lds; int tid = F.tid_(); asm volatile("" : "+v"(tid)); const int lane = tid & 63, wave = F.wave, l31 = lane & 31, hh = lane >> 5;
    const bool sample = u >= NU_P; int b, tile, g;
    if (!sample) { g = u & 3; const int x = u >> 2; b = x / 17; tile = x - b * 17; } else { const int x = u - NU_P; g = x & 3; b = x >> 2; tile = 0; }
    const int L = sample ? DSEQ : LP, t0 = tile * 128, nrows = min(128, L - t0), w = 2 << g;
    const size_t rowbase = sample ? (size_t)MPAD + (size_t)b * DSEQ : (size_t)b * LP;
    const GAS bf16* UA = (const GAS bf16*)(F.wsp() + WS_UA);
    { v4u sv[9];
#pragma unroll
      for (int q = 0; q < 9; ++q) { const int idx = tid + 512 * q, i = idx >> 5, ch = idx & 31, t = t0 - 15 + i; v4u v = {0u, 0u, 0u, 0u};
        if (idx < 143 * 32) { if (t >= 0 && t < L) v = *(const GAS v4u*)(UA + (rowbase + t) * 1024 + 256 * g + 8 * ch);
            else if (t < 0 && sample) { const GAS float* sp = F_state_pool + (((size_t)layer * DBATCH + b) * 15 + (15 + t)) * 1024 + 256 * g + 8 * ch; v = pg8::pack8(*(const GAS f32x4*)sp, *(const GAS f32x4*)(sp + 4)); } }
        sv[q] = v; }
#pragma unroll
      for (int q = 0; q < 9; ++q) { const int idx = tid + 512 * q, i = idx >> 5, ch = idx & 31; if (idx < 143 * 32) *(LAS v4u*)(lds + L_UT + i * RS + ch * 16) = sv[q]; } }
    const GAS bf16* WT = (const GAS bf16*)(F.wsp() + WS_WPOOL) + ((size_t)layer * 4 + g) * 65536 + (size_t)(32 * wave + l31) * 256 + 8 * hh;
    bf16x8 wf[16];
#pragma unroll
    for (int st = 0; st < 16; ++st) wf[st] = *(const GAS bf16x8*)(WT + 16 * st);
    const GAS float* sc = F_pool_scale + layer * 1024 + 256 * g + 32 * wave + 4 * hh; const GAS bf16* SGA = (const GAS bf16*)(F.wsp() + WS_SGA); GAS bf16* YA = (GAS bf16*)(F.wsp() + WS_Y);
    v4u sgq[8]; f32x4 scv[4];
#pragma unroll
    for (int q = 0; q < 8; ++q) { const int cq = tid + 512 * q, row = cq >> 5, ch8 = cq & 31;
        sgq[q] = __builtin_nontemporal_load((const GAS v4u*)(SGA + (rowbase + t0 + (row < nrows ? row : 0)) * 1024 + 256 * g + 8 * ch8)); }
#pragma unroll
    for (int gg = 0; gg < 4; ++gg) scv[gg] = *(const GAS f32x4*)(sc + 8 * gg);
    HG_BAR();
    { const int ch = tid & 31, rs = tid >> 5, r0 = 8 * rs; float sum[8];
#pragma unroll
      for (int j = 0; j < 8; ++j) sum[j] = 0.f;
      for (int j = 1; j < w; ++j) { const v4u v = *(const LAS v4u*)(lds + L_UT + (15 + r0 - j) * RS + ch * 16);
          sum[0] += bf_lo(v.x); sum[1] += bf_hi(v.x); sum[2] += bf_lo(v.y); sum[3] += bf_hi(v.y); sum[4] += bf_lo(v.z); sum[5] += bf_hi(v.z); sum[6] += bf_lo(v.w); sum[7] += bf_hi(v.w); }
#pragma unroll
      for (int i = 0; i < 8; ++i) { const int r = r0 + i; const v4u v = *(const LAS v4u*)(lds + L_UT + (15 + r) * RS + ch * 16);
          float x[8] = {bf_lo(v.x), bf_hi(v.x), bf_lo(v.y), bf_hi(v.y), bf_lo(v.z), bf_hi(v.z), bf_lo(v.w), bf_hi(v.w)};
          const float rc = sample ? 1.0f / (float)w : 1.0f / fminf((float)(t0 + r) + 1.0f, (float)w); float d[8];
#pragma unroll
          for (int j = 0; j < 8; ++j) { sum[j] += x[j]; d[j] = sum[j] * rc - x[j]; }
          *(LAS v4u*)(lds + L_DF + r * RS + ch * 16) = pg8::pack8((f32x4){d[0], d[1], d[2], d[3]}, (f32x4){d[4], d[5], d[6], d[7]});
          const v4u o = *(const LAS v4u*)(lds + L_UT + (15 + r - (w - 1)) * RS + ch * 16);
          sum[0] -= bf_lo(o.x); sum[1] -= bf_hi(o.x); sum[2] -= bf_lo(o.y); sum[3] -= bf_hi(o.y); sum[4] -= bf_lo(o.z); sum[5] -= bf_hi(o.z); sum[6] -= bf_lo(o.w); sum[7] -= bf_hi(o.w); } }
    HG_BAR();
    f32x16 acc[4] = {zero16(), zero16(), zero16(), zero16()};
#pragma unroll
    for (int st = 0; st < 16; ++st) { const bf16x8 a = wf[st];
#pragma unroll
        for (int rb = 0; rb < 4; ++rb) { const bf16x8 bb = *(const LAS bf16x8*)(lds + L_DF + (32 * rb + l31) * RS + (16 * st + 8 * hh) * 2); acc[rb] = mfma32(a, bb, acc[rb]); } }
    HG_BAR();
    constexpr int TS = 1040;
    static_assert(128 * TS <= L_END, "pool output image");
#pragma unroll
    for (int rb = 0; rb < 4; ++rb)
#pragma unroll
        for (int gg = 0; gg < 4; ++gg) { const f32x4 t = {acc[rb][4 * gg] * scv[gg][0], acc[rb][4 * gg + 1] * scv[gg][1], acc[rb][4 * gg + 2] * scv[gg][2], acc[rb][4 * gg + 3] * scv[gg][3]};
            *(LAS f32x4*)(lds + (32 * rb + l31) * TS + (32 * wave + 8 * gg + 4 * hh) * 4) = t; }
    HG_BAR();
#pragma unroll
    for (int q = 0; q < 8; ++q) { const int cq = tid + 512 * q, row = cq >> 5, ch8 = cq & 31;
        if (row < nrows) { const f32x4 a = *(const LAS f32x4*)(lds + row * TS + ch8 * 32), b = *(const LAS f32x4*)(lds + row * TS + ch8 * 32 + 16); const v4u s = sgq[q];
            const f32x4 ga = {bf_lo(s.x), bf_hi(s.x), bf_lo(s.y), bf_hi(s.y)}, gb = {bf_lo(s.z), bf_hi(s.z), bf_lo(s.w), bf_hi(s.w)};
            *(GAS v4u*)(YA + (rowbase + t0 + row) * 1024 + 256 * g + 8 * ch8) = pg8::pack8(a * ga, b * gb); } }
    HG_BAR();
}
}

#ifndef MERGE_TAIL
#define MERGE_TAIL 6
#endif
#ifndef WGM_PROJ
#define WGM_PROJ 4
#endif
#ifndef WGM_SQ
#define WGM_SQ 1
#endif
constexpr int U_HG_P = BATCH * 8, U_HG_S = DBATCH * 8;
constexpr int U0_HGS = U_HG_P, U0_ATT = U0_HGS + U_HG_S, U0_POOL = U0_ATT + sb::NUNITS, U_TOTAL = U0_POOL + pl::NUNITS;
__device__ __forceinline__ void phase_mixers(Frame& F, int layer, int qslot) {
    GAS unsigned* head = F.ctl() + CW_QUEUE + 64 * qslot;
    for (;;) {
        if (F.tid_() == 0) F.MISC[4] = __hip_atomic_fetch_add(head, 1u, __ATOMIC_RELAXED, __HIP_MEMORY_SCOPE_AGENT);
        HG_BAR();
        int u = (int)F.MISC[4];
        HG_BAR();
        if (u >= U_TOTAL) break;
        if (u >= U0_HGS && u < U0_POOL) u = u < U0_HGS + sb::NUNITS ? u + U_HG_S : u - sb::NUNITS;
        if (u < U0_ATT) { const bool smp = u >= U0_HGS; const int x = smp ? u - U0_HGS : u; hg::chain(F, layer, smp, x >> 3, x & 7); }
        else if (u < U0_POOL) { const int x = u - U0_ATT; if (x < sb::NU_P) sb::block_unit<1>(F, layer, x); else sb::block_unit<4>(F, layer, x - sb::NU_P); }
        else pl::unit(F, layer, u - U0_POOL);
    }
}

__device__ __forceinline__ void combine_merge(Frame& F) {
    pg8::Gemm g{nullptr, nullptr, 0, 0, MTOT / 256, D / 256, 3, D, MERGE_TAIL, WGM_SQ}; pg8::Order S; S.init(g, F.G, 0); if (!S.tail) return;
    const int gw = F.vcu * 8 + F.wave, NGW = F.G * 8, lane = F.lane_(), nrows = (S.nwg - S.G) * 256;
    const GAS bf16* sl = (const GAS bf16*)(F.wsp() + WS_SLAB_M); GAS bf16* M = (GAS bf16*)(F.wsp() + WS_MERGED);
    for (int x = gw; x < nrows; x += NGW) { const int j = x >> 8, r = x & 255; int pm, pn; S.tile_of(S.G + j, pm, pn);
        const GAS bf16* p = sl + (size_t)(MERGE_TAIL * j) * 65536 + (size_t)r * 256 + 4 * lane;
        f32x4 v = {0.f, 0.f, 0.f, 0.f};
#pragma unroll
        for (int q = 0; q < MERGE_TAIL; ++q) { const v2u t = *(const GAS v2u*)(p + (size_t)q * 65536); v += (f32x4){bf_lo(t.x), bf_hi(t.x), bf_lo(t.y), bf_hi(t.y)}; }
        v2u o; o.x = cvt_pk_bf16(v[0], v[1]); o.y = cvt_pk_bf16(v[2], v[3]); *(GAS v2u*)(M + (size_t)(256 * pm + r) * 1024 + 256 * pn + 4 * lane) = o; }
}
__device__ __forceinline__ f32x4 slab4_sum(const GAS bf16* p) {
    const v2u a = *(const GAS v2u*)p, b = *(const GAS v2u*)(p + 65536), c = *(const GAS v2u*)(p + 2 * 65536), d = *(const GAS v2u*)(p + 3 * 65536);
    return ((f32x4){bf_lo(a.x), bf_hi(a.x), bf_lo(a.y), bf_hi(a.y)} + (f32x4){bf_lo(b.x), bf_hi(b.x), bf_lo(b.y), bf_hi(b.y)}) + ((f32x4){bf_lo(c.x), bf_hi(c.x), bf_lo(c.y), bf_hi(c.y)} + (f32x4){bf_lo(d.x), bf_hi(d.x), bf_lo(d.y), bf_hi(d.y)}); }
__device__ __forceinline__ void combine_out(Frame& F, int last) {
    pg8::Gemm g{nullptr, nullptr, 0, 0, MTOT / 256, D / 256, 1, D, 4, WGM_SQ}; pg8::Order S; S.init(g, F.G, 0); if (!S.tail) return;
    const int gw = F.vcu * 8 + F.wave, NGW = F.G * 8, lane = F.lane_(), nrows = (S.nwg - S.G) * 256;
    const GAS bf16* sl = (const GAS bf16*)(F.wsp() + WS_SLAB_O); GAS bf16* HB = (GAS bf16*)(F.wsp() + WS_H); GAS float* out = F.outp();
    for (int x = gw; x < nrows; x += NGW) { const int j = x >> 8, r = x & 255; int pm, pn; S.tile_of(S.G + j, pm, pn);
        const GAS bf16* p = sl + (size_t)(4 * j) * 65536 + (size_t)r * 256 + 4 * lane; const int row = 256 * pm + r, col = 256 * pn + 4 * lane;
        const v2u hb = *(const GAS v2u*)(HB + (size_t)row * 1024 + col);
        const f32x4 v = (f32x4){bf_lo(hb.x), bf_hi(hb.x), bf_lo(hb.y), bf_hi(hb.y)} + slab4_sum(p);
        if (!last) { v2u o; o.x = cvt_pk_bf16(v[0], v[1]); o.y = cvt_pk_bf16(v[2], v[3]); *(GAS v2u*)(HB + (size_t)row * 1024 + col) = o; }
        else if (row >= MPAD) *(GAS f32x4*)(out + O_YS + (size_t)(row - MPAD) * 1024 + col) = v;
        else if (row < MP) { const int b = row / LP, t = row - b * LP; if (t >= NMETA) *(GAS f32x4*)(out + O_YP + ((size_t)b * SEQ + (t - NMETA)) * 1024 + col) = v; } }
}
__device__ __forceinline__ void phase_xn_fused(Frame& F, int l) {
    pg8::Gemm g{nullptr, nullptr, 0, 0, MTOT / 256, D / 256, 1, D, 4, WGM_SQ}; pg8::Order S; S.init(g, F.G, 0);
    LAS int* tab = (LAS int*)F.lds; const int tid = F.tid_(), lane = F.lane_();
    for (int i = tid; i < (MTOT / 256) * 4; i += 512) tab[i] = -1;
    __syncthreads();
    if (S.tail && tid < S.nwg - S.G) { int pm, pn; S.tile_of(S.G + tid, pm, pn); tab[4 * pm + pn] = tid; }
    __syncthreads();
    const int gw = F.vcu * 8 + F.wave, NGW = F.G * 8;
    GAS bf16* HB = (GAS bf16*)(F.wsp() + WS_H); GAS bf16* XN = (GAS bf16*)(F.wsp() + WS_XN); const GAS bf16* sl = (const GAS bf16*)(F.wsp() + WS_SLAB_O); const GAS float* gn = F_norm_g + (size_t)l * D;
    for (int r = gw; r < MTOT; r += NGW) {
        if (r >= MP && r < MPAD) { zero_xn_row(XN + (size_t)r * D, lane); continue; }
        GAS v2u* xb = (GAS v2u*)(HB + (size_t)r * D) + lane; const int pm = r >> 8, rr = r & 255;
        f32x4 v[4]; float s = 0.f;
#pragma unroll
        for (int j = 0; j < 4; ++j) { const int idx = tab[4 * pm + j]; const v2u t = xb[64 * j]; v[j] = (f32x4){bf_lo(t.x), bf_hi(t.x), bf_lo(t.y), bf_hi(t.y)};
            if (idx >= 0) { v[j] += slab4_sum(sl + (size_t)(4 * idx) * 65536 + (size_t)rr * 256 + 4 * lane); v2u o; o.x = cvt_pk_bf16(v[j][0], v[j][1]); o.y = cvt_pk_bf16(v[j][2], v[j][3]); xb[64 * j] = o; }
            s += (v[j].x * v[j].x + v[j].y * v[j].y) + (v[j].z * v[j].z + v[j].w * v[j].w); }
        const float rs = frsq(wave_sum(s) * (1.f / D) + EPS);
        GAS v2u* o8 = (GAS v2u*)(XN + (size_t)r * D) + lane;
#pragma unroll
        for (int j = 0; j < 4; ++j) { const f32x4 gg = ((const GAS f32x4*)gn)[lane + 64 * j]; v2u o; o.x = cvt_pk_bf16(v[j].x * rs * gg.x, v[j].y * rs * gg.y); o.y = cvt_pk_bf16(v[j].z * rs * gg.z, v[j].w * rs * gg.w); o8[64 * j] = o; }
    }
    __syncthreads();
}
constexpr int NPHASES = 1 + 5 * DEPTH;
__global__ void __launch_bounds__(512, 2) mega_fwd(Params p) {
    extern __shared__ __attribute__((aligned(16))) unsigned char lds_raw[];
    Frame F;
    F.lds = (LAS unsigned char*)lds_raw; F.MISC = (volatile LAS unsigned*)(F.lds + LDS_MISC);
    F.wave = __builtin_amdgcn_readfirstlane((int)threadIdx.x >> 6);
    F.G = gridDim.x; { const int bx = blockIdx.x; F.vcu = (F.G % 8 == 0) ? (bx % 8) * (F.G / 8) + bx / 8 : bx; }
    if (threadIdx.x < 64) F.MISC[threadIdx.x] = 0u;
    if (threadIdx.x == 0) { LAS unsigned long long* P = (LAS unsigned long long*)(F.lds + LDS_PARAM);
        P[0] = (unsigned long long)p.in[0]; P[1] = (unsigned long long)p.in[1]; P[2] = (unsigned long long)p.in[2]; P[3] = (unsigned long long)p.in[3]; P[4] = (unsigned long long)p.in[4];
        P[5] = (unsigned long long)p.in[5]; P[6] = (unsigned long long)p.in[6]; P[7] = (unsigned long long)p.in[7]; P[8] = (unsigned long long)p.in[8]; P[9] = (unsigned long long)p.in[9];
        P[10] = (unsigned long long)p.in[10]; P[11] = (unsigned long long)p.in[11]; P[12] = (unsigned long long)p.in[12]; P[13] = (unsigned long long)p.in[13]; P[14] = (unsigned long long)p.in[14];
        P[15] = (unsigned long long)p.in[15]; P[16] = (unsigned long long)p.in[16]; P[17] = (unsigned long long)p.out; P[18] = (unsigned long long)p.ws; }
    __syncthreads();
    const int lo = p.ph_lo, hi = p.ph_hi;
    XcdBarrier bar; bar.bar = F.ctl() + CW_BAR; bar.x = 0; bar.st = nullptr; bar.leader = false;
    if (hi - lo > 1) bar = xcd_barrier_post(F.ctl() + CW_BAR, F.MISC, F.wave);
#define IN(k) (lo <= (k) && (k) < hi)
#define SEAM(k) do { if (IN(k) && IN((k) + 1)) xcd_barrier(bar, F.wave); } while (0)
    if (IN(0)) { phase_prologue(F); } SEAM(0);
    for (int l = 0; l < DEPTH; ++l) {
        const int pb = 1 + 5 * l;
        if (IN(pb)) { if (l > 0) phase_xn_fused(F, l); }
        if (l > 0) SEAM(pb);
        if (IN(pb + 1)) { pg8::Gemm g{(const GAS bf16*)(F.wsp() + WS_XN), (const GAS bf16*)(F.wsp() + WS_WIN) + (size_t)l * NPROJ * D, 0, 0, MTOT / 256, NPROJ / 256, 1, D, 0, WGM_PROJ};
            pg8::Order S; S.init(g, F.G, (int)blockIdx.x);
            pg8::EpiProj E{l, F.wsp(), F.outp(), F_qng + l * 128, F_kng + l * 128, (const GAS float*)(F.wsp() + WS_LB) + l * 1024};
            pg8::gemm_phase(F.lds, g, S, E, F.wave);
            } SEAM(pb + 1);
        if (IN(pb + 2)) { phase_mixers(F, l, l); } SEAM(pb + 2);
        if (IN(pb + 3)) { pg8::Gemm g{(const GAS bf16*)(F.wsp() + WS_Y), (const GAS bf16*)(F.wsp() + WS_WBR) + (size_t)l * 3 * D * D, (size_t)MTOT * 1024, (size_t)D * D, MTOT / 256, D / 256, 3, D, MERGE_TAIL, WGM_SQ};
            pg8::Order S; S.init(g, F.G, (int)blockIdx.x);
            pg8::EpiMerge E{F.wsp()};
            pg8::gemm_phase(F.lds, g, S, E, F.wave);
            { __syncthreads(); pg8::EpiMergeSlab E2{F.wsp()}; pg8::gemm_phase<pg8::EpiMergeSlab, 1>(F.lds, g, S, E2, F.wave); }
            } SEAM(pb + 3);
        if (IN(pb + 4)) { combine_merge(F); xcd_barrier(bar, F.wave);
            pg8::Gemm g{(const GAS bf16*)(F.wsp() + WS_MERGED), (const GAS bf16*)(F.wsp() + WS_WOUT) + (size_t)l * D * D, 0, 0, MTOT / 256, D / 256, 1, D, 4, WGM_SQ};
            pg8::Order S; S.init(g, F.G, (int)blockIdx.x);
            pg8::EpiOut E{F.wsp(), F.outp(), l == DEPTH - 1 ? 1 : 0};
            pg8::gemm_phase(F.lds, g, S, E, F.wave);
            { __syncthreads(); pg8::EpiOutSlab E2{F.wsp()}; pg8::gemm_phase<pg8::EpiOutSlab, 1>(F.lds, g, S, E2, F.wave); }
            xcd_barrier(bar, F.wave); if (l == DEPTH - 1) combine_out(F, 1);
            }
    }
#undef IN
#undef SEAM
}
extern "C" void kernel_launch(void* const* d_in, const int* in_sizes, int n_in, void* d_out, int out_size, void* d_ws, size_t ws_size, hipStream_t stream) {
    static int grid = 0;
    if (grid == 0) {
        if (n_in != 17 || out_size != (int)O_END || ws_size < WS_FAST_END) { fprintf(stderr, "kernel_launch: unexpected sizes (n_in %d, out %d, ws %zu < %zu)\n", n_in, out_size, ws_size, (size_t)WS_FAST_END); grid = -1; return; }
        int dev = 0, cus = 0, per_cu = 0;
        if (hipGetDevice(&dev) != hipSuccess || hipDeviceGetAttribute(&cus, hipDeviceAttributeMultiprocessorCount, dev) != hipSuccess) { grid = -1; return; }
        if (hipFuncSetAttribute((const void*)mega_fwd, hipFuncAttributeMaxDynamicSharedMemorySize, LDS_BYTES) != hipSuccess) { fprintf(stderr, "kernel_launch: hipFuncSetAttribute failed\n"); grid = -1; return; }
        if (hipOccupancyMaxActiveBlocksPerMultiprocessor(&per_cu, (const void*)mega_fwd, 512, LDS_BYTES) != hipSuccess || per_cu < 1) { fprintf(stderr, "kernel_launch: occupancy query says %d blocks per CU\n", per_cu); (void)hipGetLastError(); grid = -1; return; }
        grid = cus;
    }
    if (grid < 0) return;
    (void)hipMemsetAsync((char*)d_ws + WS_CTL, 0, CTL_ZERO_BYTES, stream);
    Params p{};
    for (int i = 0; i < 17; ++i) p.in[i] = (const float*)d_in[i];
    p.out = (float*)d_out; p.ws = (unsigned char*)d_ws;
    p.ph_lo = 0; p.ph_hi = NPHASES;
    hipLaunchKernelGGL(mega_fwd, dim3(grid), dim3(512), LDS_BYTES, stream, p);
}
```

```cpp
#define MK_LAUNCHES 1
#include <hip/hip_runtime.h>
#include <cstdio>
#include <cstdint>
constexpr int D = 1024, BATCH = 8, SEQ = 2048, DEPTH = 2, DBATCH = 32, DSEQ = 64, PAST = 2048, NMETA = 16;
constexpr int LP = NMETA + SEQ;
constexpr int MP = BATCH * LP;
constexpr int MPAD = 16640;
constexpr int MS = DBATCH * DSEQ;
constexpr int MTOT = MPAD + MS;
constexpr int NPROJ = 13 * 1024;
constexpr float EPS = 1e-6f, LB_FLOOR = 1e-30f, SB_SCALE = 0.08838834764831845f;
constexpr size_t O_YP = 0, O_YS = 16777216, O_KP = 18874368, O_VP = 52690944, O_PP = 86507520, O_HP = 86753280,
                 O_KS = 88850432, O_VS = 93044736, O_PS = 97239040, O_HS = 98222080, O_END = 106610688;
#define GAS __attribute__((address_space(1)))
#define LAS __attribute__((address_space(3)))
typedef unsigned short bf16;
typedef unsigned v4u __attribute__((ext_vector_type(4)));
typedef unsigned v2u __attribute__((ext_vector_type(2)));
typedef float f32x4 __attribute__((ext_vector_type(4)));
typedef float f32x2 __attribute__((ext_vector_type(2)));
typedef float f32x16 __attribute__((ext_vector_type(16)));
typedef short bf16x8 __attribute__((ext_vector_type(8)));
typedef short bf16x4 __attribute__((ext_vector_type(4)));
#define LDS_WAIT() asm volatile("s_waitcnt lgkmcnt(0)" ::: "memory")
#define VM_WAIT() asm volatile("s_waitcnt vmcnt(0)" ::: "memory")

typedef __bf16 bf16n2 __attribute__((ext_vector_type(2)));
__device__ __forceinline__ unsigned cvt_pk_bf16(float lo, float hi) { const f32x2 v = {lo, hi}; return __builtin_bit_cast(unsigned, __builtin_convertvector(v, bf16n2)); }
__device__ __forceinline__ float bf_lo(unsigned u) { return __uint_as_float(u << 16); }
__device__ __forceinline__ float bf_hi(unsigned u) { return __uint_as_float(u & 0xffff0000u); }
__device__ __forceinline__ float fexp2(float x) { return __builtin_amdgcn_exp2f(x); }
__device__ __forceinline__ float flog2(float x) { return __builtin_amdgcn_logf(x); }
__device__ __forceinline__ float frcp(float x) { return __builtin_amdgcn_rcpf(x); }
__device__ __forceinline__ float frsq(float x) { return __builtin_amdgcn_rsqf(x); }
__device__ __forceinline__ int lane_id() { unsigned z = 0u; asm volatile("" : "+v"(z)); return (int)__builtin_amdgcn_mbcnt_hi(~0u, __builtin_amdgcn_mbcnt_lo(~0u, z)); }
constexpr float LOG2E = 1.4426950408889634f, LN2 = 0.6931471805599453f;
__device__ __forceinline__ float fexp(float x) { return fexp2(x * LOG2E); }
__device__ __forceinline__ float fsigmoid(float x) { return frcp(1.0f + fexp2(-x * LOG2E)); }
__device__ __forceinline__ float fsilu(float x) { return x * fsigmoid(x); }

constexpr size_t MiB = 1u << 20;
constexpr size_t RB16 = (size_t)MTOT * 1024 * 2, RB32 = (size_t)MTOT * 1024 * 4;
constexpr size_t WS_CTL = 0, CTL_ZERO_BYTES = 64 * 1024;
constexpr size_t WS_RTAB = 1 * MiB + 64 * 1024;
constexpr size_t WS_LB = 1 * MiB;
constexpr size_t WS_WIN = 2 * MiB;
constexpr size_t WS_WBR = WS_WIN + (size_t)2 * NPROJ * 1024 * 2;
constexpr size_t WS_WOUT = WS_WBR + (size_t)6 * 1024 * 1024 * 2;
constexpr size_t WS_WPOOL = WS_WOUT + (size_t)2 * 1024 * 1024 * 2;
constexpr size_t WS_H = WS_WPOOL + 1 * MiB;
constexpr size_t WS_XN = WS_H + RB32;
constexpr size_t WS_UA = WS_XN + RB16, WS_SGA = WS_UA + RB16, WS_Q = WS_SGA + RB16, WS_SGB = WS_Q + RB16, WS_KC = WS_SGB + RB16,
                 WS_QC = WS_KC + RB16, WS_IC = WS_QC + RB16, WS_SGC = WS_IC + RB16, WS_GATE = WS_SGC + RB16  ,
                 WS_LOGF = WS_GATE + 3 * RB16  , WS_Y = WS_LOGF + RB32  , WS_MERGED = WS_Y + 3 * RB16, WS_FAST_END = WS_MERGED + RB16;
constexpr size_t WS_SLAB_M = WS_UA, WS_SLAB_O = WS_Q;
static_assert(108 * 262144 <= 2 * RB16 && 144 * 262144 <= 2 * RB16, "slabs");
constexpr int CW_QUEUE = 64;
constexpr int CW_BAR = 1024;

constexpr int LDS_BYTES = 160 * 1024;
constexpr int LDS_XCH = 128 * 1024;
constexpr int LDS_MISC = 159 * 1024;

#define XB_TMO      128
#define XB_XCNT(j)  (256  + 64 * (j))
#define XB_XSUB(j)  (1280 + 64 * (j))
#define XB_XGEN(j)  (2304 + 64 * (j))
#define XB_TOP      3328
#define XB_TOPGEN   3392
#define XCD_BAR_WORDS 3456
#define XB_SPIN_CAP (1u << 18)
__device__ __forceinline__ unsigned xb_ld(GAS unsigned* p)              { return __hip_atomic_load(p, __ATOMIC_RELAXED, __HIP_MEMORY_SCOPE_AGENT); }
__device__ __forceinline__ unsigned xb_add(GAS unsigned* p, unsigned v) { return __hip_atomic_fetch_add(p, v, __ATOMIC_RELAXED, __HIP_MEMORY_SCOPE_AGENT); }
__device__ __forceinline__ unsigned xb_xcc_id() { return (unsigned)__builtin_amdgcn_s_getreg((3 << 11) | 20) & 0xFu; }
#define XB_SPIN(cond, bar) do { unsigned _sp = 0; while (cond) { __builtin_amdgcn_s_sleep(1); \
    if ((++_sp & 255u) == 0u) { if (xb_ld(&(bar)[XB_TMO])) break; if (_sp > XB_SPIN_CAP) { xb_add(&(bar)[XB_TMO], 1u); break; } } } } while (0)
struct XcdBarrier { GAS unsigned* bar; unsigned x; volatile LAS unsigned* st; bool leader; };
__device__ __forceinline__ XcdBarrier xcd_barrier_post(GAS unsigned* bar, volatile LAS unsigned* st, int wave) {
    XcdBarrier b; b.bar = bar; b.x = xb_xcc_id(); b.st = st; b.leader = false;
    b.leader = (wave == 0) && (lane_id() == 0);
    if (b.leader) (void)xb_add(&bar[XB_XCNT(b.x)], 1u);
    return b;
}
__device__ __forceinline__ void xcd_barrier_complete(GAS unsigned* bar, unsigned x, unsigned& nloc, unsigned& nx) {
    const unsigned G = gridDim.x * gridDim.y * gridDim.z;
    unsigned sum, cnt, mine, sp = 0u;
    for (;;) {
        sum = 0u; cnt = 0u; mine = 0u;
#pragma unroll
        for (unsigned j = 0; j < 16; ++j) { const unsigned c = xb_ld(&bar[XB_XCNT(j)]); sum += c; cnt += (c > 0u) ? 1u : 0u; mine = (j == x) ? c : mine; }
        if (sum == G) break;
        __builtin_amdgcn_s_sleep(1);
        if ((++sp & 255u) == 0u) { if (xb_ld(&bar[XB_TMO])) break; if (sp > XB_SPIN_CAP) { xb_add(&bar[XB_TMO], 1u); break; } }
    }
    nloc = mine > 0u ? mine : 1u; nx = cnt > 0u ? cnt : 1u;
}
__device__ __forceinline__ void xcd_barrier(const XcdBarrier& b, int wave) {
    asm volatile("s_waitcnt vmcnt(0)" ::: "memory");
    __syncthreads();
    if (wave == 0 && lane_id() == 0) {
        GAS unsigned* bar = b.bar;
        __builtin_amdgcn_s_waitcnt(0);
        unsigned nloc = b.st[0], nx = b.st[1];
        if (nloc == 0u) { xcd_barrier_complete(bar, b.x, nloc, nx); b.st[0] = nloc; b.st[1] = nx; }
        const unsigned old = xb_add(&bar[XB_XSUB(b.x)], 1u);
        const unsigned gen = old / nloc;
        if (old + 1u == (gen + 1u) * nloc) {
            __builtin_amdgcn_fence(__ATOMIC_RELEASE, "agent");
            asm volatile("s_waitcnt vmcnt(0)" ::: "memory");
            const unsigned og = xb_add(&bar[XB_TOP], 1u);
            const unsigned tg = og / nx;
            if (og + 1u == (tg + 1u) * nx) xb_add(&bar[XB_TOPGEN], 1u);
            else XB_SPIN(xb_ld(&bar[XB_TOPGEN]) == tg, bar);
            __builtin_amdgcn_fence(__ATOMIC_ACQUIRE, "agent");
            xb_add(&bar[XB_XGEN(b.x)], 1u);
            asm volatile("s_waitcnt vmcnt(0)" ::: "memory");
        } else {
            XB_SPIN(xb_ld(&bar[XB_XGEN(b.x)]) == gen, bar);
            __builtin_amdgcn_fence(__ATOMIC_ACQUIRE, "agent");
            asm volatile("s_waitcnt vmcnt(0)" ::: "memory");
        }
    }
    __syncthreads();
}

struct Params { const float* in[17]; float* out; unsigned char* ws; int ph_lo, ph_hi; };
constexpr int LDS_PARAM = LDS_MISC + 256;
struct Frame {
    LAS unsigned char* lds; volatile LAS unsigned* MISC;
    int wave, G, vcu;
    __device__ __forceinline__ int lane_() const { return lane_id(); }
    __device__ __forceinline__ int tid_() const { return wave * 64 + lane_id(); }
    __device__ __forceinline__ unsigned long long rd(int i) const { const v2u v = *(const LAS v2u*)(lds + LDS_PARAM + 8 * i);
        return ((unsigned long long)(unsigned)__builtin_amdgcn_readfirstlane((int)v.y) << 32) | (unsigned)__builtin_amdgcn_readfirstlane((int)v.x); }
    __device__ __forceinline__ const GAS float* in(int i) const { return (const GAS float*)rd(i); }
    __device__ __forceinline__ GAS float* outp() const { return (GAS float*)rd(17); }
    __device__ __forceinline__ GAS unsigned char* wsp() const { return (GAS unsigned char*)rd(18); }
    __device__ __forceinline__ GAS unsigned* ctl() const { return (GAS unsigned*)(wsp() + WS_CTL); }
};
#define F_xp F.in(0)
#define F_xs F.in(1)
#define F_cache_k F.in(2)
#define F_cache_v F.in(3)
#define F_state_pool F.in(4)
#define F_state_hgrn F.in(5)
#define F_meta F.in(6)
#define F_norm_g F.in(7)
#define F_w_in F.in(8)
#define F_qng F.in(9)
#define F_kng F.in(10)
#define F_w_pool F.in(11)
#define F_pool_scale F.in(12)
#define F_hlb F.in(13)
#define F_hng F.in(14)
#define F_w_branch F.in(15)
#define F_w_out F.in(16)
__device__ __forceinline__ float wave_sum(float v) {
#pragma unroll
    for (int o = 1; o < 64; o <<= 1) v += __shfl_xor(v, o);
    return v;
}

__device__ __forceinline__ void p0_transpose_item(const GAS float* W, int K, int N, GAS bf16* WT, int item, int lane) {
    const int nblk = N / 64, kb = item / nblk, nb = item - kb * nblk, r = lane >> 4, c4 = lane & 15;
    const GAS float* src = W + (size_t)(64 * kb + 16 * r) * N + 64 * nb + 4 * c4;
    f32x4 v[16];
#pragma unroll
    for (int i = 0; i < 16; ++i) v[i] = __builtin_nontemporal_load((const GAS f32x4*)(src + (size_t)i * N));
    GAS bf16* dst = WT + (size_t)(64 * nb + 4 * c4) * K + 64 * kb + 16 * r;
#pragma unroll
    for (int j = 0; j < 4; ++j) { v4u a, b;
        a.x = cvt_pk_bf16(v[0][j], v[1][j]); a.y = cvt_pk_bf16(v[2][j], v[3][j]); a.z = cvt_pk_bf16(v[4][j], v[5][j]); a.w = cvt_pk_bf16(v[6][j], v[7][j]);
        b.x = cvt_pk_bf16(v[8][j], v[9][j]); b.y = cvt_pk_bf16(v[10][j], v[11][j]); b.z = cvt_pk_bf16(v[12][j], v[13][j]); b.w = cvt_pk_bf16(v[14][j], v[15][j]);
        *(GAS v4u*)(dst + (size_t)j * K) = a; *(GAS v4u*)(dst + (size_t)j * K + 8) = b; }
}
__device__ __forceinline__ void xn_row(const GAS float* src, GAS float* hdst, const GAS float* g, GAS bf16* xnrow, int lane) {
    const GAS f32x4* xr = (const GAS f32x4*)src + lane;
    f32x4 v[4]; float s = 0.f;
#pragma unroll
    for (int j = 0; j < 4; ++j) { v[j] = xr[64 * j]; s += (v[j].x * v[j].x + v[j].y * v[j].y) + (v[j].z * v[j].z + v[j].w * v[j].w); }
    if (hdst) { GAS v2u* ho = (GAS v2u*)hdst + lane;
#pragma unroll
        for (int j = 0; j < 4; ++j) { v2u o; o.x = cvt_pk_bf16(v[j].x, v[j].y); o.y = cvt_pk_bf16(v[j].z, v[j].w); ho[64 * j] = o; } }
    const float rs = frsq(wave_sum(s) * (1.f / D) + EPS);
    GAS v2u* o8 = (GAS v2u*)xnrow + lane;
#pragma unroll
    for (int j = 0; j < 4; ++j) { const f32x4 gg = ((const GAS f32x4*)g)[lane + 64 * j]; v2u o; o.x = cvt_pk_bf16(v[j].x * rs * gg.x, v[j].y * rs * gg.y); o.y = cvt_pk_bf16(v[j].z * rs * gg.z, v[j].w * rs * gg.w); o8[64 * j] = o; }
}
__device__ __forceinline__ void xn_row_regs(const f32x4 (&v)[4], GAS bf16* hdst, const GAS float* g, GAS bf16* xnrow, int lane) {
    float s = 0.f;
#pragma unroll
    for (int j = 0; j < 4; ++j) s += (v[j].x * v[j].x + v[j].y * v[j].y) + (v[j].z * v[j].z + v[j].w * v[j].w);
    { GAS v2u* ho = (GAS v2u*)hdst + lane;
#pragma unroll
      for (int j = 0; j < 4; ++j) { v2u o; o.x = cvt_pk_bf16(v[j].x, v[j].y); o.y = cvt_pk_bf16(v[j].z, v[j].w); ho[64 * j] = o; } }
    const float rs = frsq(wave_sum(s) * (1.f / D) + EPS);
    GAS v2u* o8 = (GAS v2u*)xnrow + lane;
#pragma unroll
    for (int j = 0; j < 4; ++j) { const f32x4 gg = ((const GAS f32x4*)g)[lane + 64 * j]; v2u o; o.x = cvt_pk_bf16(v[j].x * rs * gg.x, v[j].y * rs * gg.y); o.y = cvt_pk_bf16(v[j].z * rs * gg.z, v[j].w * rs * gg.w); o8[64 * j] = o; }
}
__device__ __forceinline__ void zero_xn_row(GAS bf16* xnrow, int lane) { GAS v2u* o8 = (GAS v2u*)xnrow + lane;
#pragma unroll
    for (int j = 0; j < 4; ++j) o8[64 * j] = (v2u){0u, 0u}; }

__device__ __forceinline__ void phase_prologue(Frame& F) {
    const int gw = F.vcu * 8 + F.wave, NGW = F.G * 8;
    constexpr int I_IN = (D / 64) * (NPROJ / 64), I_SQ = (D / 64) * (D / 64), I_PL = (256 / 64) * (256 / 64);
    constexpr int NITEMS = 2 * I_IN + 6 * I_SQ + 2 * I_SQ + 8 * I_PL;
    GAS bf16* win_t = (GAS bf16*)(F.wsp() + WS_WIN); GAS bf16* wbr_t = (GAS bf16*)(F.wsp() + WS_WBR); GAS bf16* wout_t = (GAS bf16*)(F.wsp() + WS_WOUT); GAS bf16* wpool_t = (GAS bf16*)(F.wsp() + WS_WPOOL);
    for (int it = gw; it < NITEMS; it += NGW) {
        int r = it;
        if (r < 2 * I_IN) { const int l = r / I_IN; p0_transpose_item(F_w_in + (size_t)l * D * NPROJ, D, NPROJ, win_t + (size_t)l * NPROJ * D, r % I_IN, F.lane_()); continue; } r -= 2 * I_IN;
        if (r < 6 * I_SQ) { const int m = r / I_SQ; p0_transpose_item(F_w_branch + (size_t)m * D * D, D, D, wbr_t + (size_t)m * D * D, r % I_SQ, F.lane_()); continue; } r -= 6 * I_SQ;
        if (r < 2 * I_SQ) { const int m = r / I_SQ; p0_transpose_item(F_w_out + (size_t)m * D * D, D, D, wout_t + (size_t)m * D * D, r % I_SQ, F.lane_()); continue; } r -= 2 * I_SQ;
        { const int m = r / I_PL; p0_transpose_item(F_w_pool + (size_t)m * 65536, 256, 256, wpool_t + (size_t)m * 65536, r % I_PL, F.lane_()); }
    }
    GAS float* H = (GAS float*)(F.wsp() + WS_H); GAS bf16* XN = (GAS bf16*)(F.wsp() + WS_XN);
#define P0_SRC(x, dst) do { if ((x) >= MP && (x) < MPAD) dst = F_meta;   \
        else if ((x) < MP) { const int b_ = (x) / LP, t_ = (x) - b_ * LP; dst = (t_ < NMETA) ? F_meta + (size_t)t_ * D : F_xp + ((size_t)b_ * SEQ + (t_ - NMETA)) * D; } \
        else dst = F_xs + (size_t)((x) - MPAD) * D; } while (0)
    f32x4 nx[4];
    if (gw < MTOT) { const GAS float* s0; P0_SRC(gw, s0); const GAS f32x4* p0 = (const GAS f32x4*)s0 + F.lane_();
#pragma unroll
        for (int j = 0; j < 4; ++j) nx[j] = p0[64 * j]; }
    for (int r = gw; r < MTOT; r += NGW) {
        const f32x4 cur[4] = {nx[0], nx[1], nx[2], nx[3]};
        if (r + NGW < MTOT) { const GAS float* s1; P0_SRC(r + NGW, s1); const GAS f32x4* p1 = (const GAS f32x4*)s1 + F.lane_();
#pragma unroll
            for (int j = 0; j < 4; ++j) nx[j] = p1[64 * j]; }
        GAS bf16* hrow = (GAS bf16*)(F.wsp() + WS_H) + (size_t)r * D;
        if (r >= MP && r < MPAD) { zero_xn_row(XN + (size_t)r * D, F.lane_()); zero_xn_row(hrow, F.lane_()); continue; }
        xn_row_regs(cur, hrow, F_norm_g, XN + (size_t)r * D, F.lane_());
    }
#undef P0_SRC
    if (blockIdx.x == 0) { GAS float* lbp = (GAS float*)(F.wsp() + WS_LB);
        for (int i = F.tid_(); i < 1024; i += 512) { const float a = F_hlb[i], b = F_hlb[1024 + i], m = fmaxf(a, b), ea = expf(a - m), eb = expf(b - m), s = ea + eb; const float s0 = ea / s, s1 = eb / s;
            lbp[i] = s0 - s0; lbp[1024 + i] = (s0 + s1) - s0; } }
}
__device__ __forceinline__ void phase_xn(Frame& F, int l) {
    const int gw = F.vcu * 8 + F.wave, NGW = F.G * 8;
    GAS float* H = (GAS float*)(F.wsp() + WS_H); GAS bf16* XN = (GAS bf16*)(F.wsp() + WS_XN);
    for (int r = gw; r < MTOT; r += NGW) {
        if (r >= MP && r < MPAD) { zero_xn_row(XN + (size_t)r * D, F.lane_()); continue; }
        xn_row(H + (size_t)r * D, nullptr, F_norm_g + (size_t)l * D, XN + (size_t)r * D, F.lane_());
    }
}
namespace pg8 {
constexpr int BM = 256, BK = 64, HALF = 128, HTB = HALF * BK * 2, STAGE_BYTES = 8 * HTB, NXCD = 8;
__host__ __device__ __forceinline__ int lds_byte(int r, int c) { const int st = (r >> 4) * 2 + (c >> 5), rr = r & 15, cc = c & 31, ob = rr * 64 + cc * 2; return st * 1024 + (ob ^ (((ob >> 9) & 1) << 5)); }
__host__ __device__ __forceinline__ void stage_rc(int b, int& R, int& C) { const int st = b / 1024, sb = b % 1024, swz = sb ^ (((sb >> 9) & 1) << 5); R = (st >> 1) * 16 + swz / 64; C = (st & 1) * 32 + (swz % 64) / 2; }
__host__ __device__ __forceinline__ int perm32(int rho) { const int n = rho >> 4, i = rho & 15; return 8 * (i >> 2) + 4 * n + (i & 3); }

struct Unit { int pm, pn, seg, k0, nk, slab; };
struct Gemm { const GAS bf16* A; const GAS bf16* Bt; size_t a_seg, b_seg; int nM, nN, nseg, K, tail_parts, wgm; };

struct Order {
    int nM, nN, nwg, G, c, nseg, nt, tail, WGM;
    __device__ void init(const Gemm& g, int G_, int c_) { WGM = g.wgm; nM = g.nM; nN = g.nN; nwg = nM * nN; G = G_; c = c_; nseg = g.nseg; nt = g.K / BK;
        tail = (g.tail_parts > 0 && nwg > G && nwg <= 2 * G && (nwg - G) * g.tail_parts <= G && g.tail_parts % nseg == 0 && (nt % (2 * (g.tail_parts / nseg))) == 0) ? g.tail_parts : 0; }
    __device__ void tile_of(int L, int& pm, int& pn) const {
        int wgid = L; { const int q = nwg / NXCD, r = nwg % NXCD, xcd = wgid % NXCD, off = wgid / NXCD; wgid = (xcd < r ? xcd * (q + 1) : r * (q + 1) + (xcd - r) * q) + off; }
        const int nig = WGM * nN, gid = wgid / nig, fm = gid * WGM, gsz = (nM - fm) < WGM ? (nM - fm) : WGM;
        pm = fm + ((wgid % nig) % gsz); pn = (wgid % nig) / gsz; }
    template <int MODE> __device__ bool next(int i, Unit& u) const {
        u.k0 = 0; u.nk = nt; u.slab = -1;
        if (MODE == 0) {
            if (tail == 0) { const int ti = i / nseg; u.seg = i - ti * nseg; const long L = (long)ti * G + c; if (L >= nwg) return false; tile_of((int)L, u.pm, u.pn); return true; }
            if (i >= nseg) return false; u.seg = i; tile_of(c, u.pm, u.pn); return true; }
        if (tail == 0 || i > 0 || c >= (nwg - G) * tail) return false;
        const int j = c / tail, part = c - j * tail; tile_of(G + j, u.pm, u.pn); u.slab = c;
        { const int ks = tail / nseg; u.seg = part / ks; u.nk = nt / ks; u.k0 = (part - u.seg * ks) * u.nk; }
        return true;
    }
};

typedef f32x4 Acc[2][2][4][2];

template <class Epi, int MODE = 0>
__device__ __forceinline__ void gemm_phase(LAS unsigned char* lds, const Gemm g, const Order& S, const Epi& E, int wave_id) {
    const int wid = wave_id, lane = lane_id(), tid = wid * 64 + lane; const int wr = wid >> 2, wc = wid & 3, fr = lane & 15, fq = lane >> 4;
    const int K = g.K;
    unsigned voffA[2], voffB[2];
#pragma unroll
    for (int i = 0; i < 2; ++i) { int R, C; stage_rc(tid * 16 + i * 8192, R, C); const int Rb = (R & ~31) + perm32(R & 31);
        voffA[i] = (unsigned)(R * K + C) * 2u; voffB[i] = (unsigned)(Rb * K + C) * 2u; }
    const size_t kstep = (size_t)(BK * 2);
    const size_t hstep = (size_t)HALF * K * 2;
    const size_t tstep = 2 * hstep;
    const unsigned ldsw = (unsigned)wid * 1024u;
    const int aoff = lds_byte(wr * 64 + fr, fq * 8), boff = lds_byte(wc * 32 + fr, fq * 8);
#define PG8_SA(b, h) (((b) * 2 + (h)) * HTB)
#define PG8_SB(b, h) ((4 + (b) * 2 + (h)) * HTB)
#define PG8_STAGE(bufoff, gbase, voff) do { _Pragma("unroll") for (int _i = 0; _i < 2; ++_i) \
        __builtin_amdgcn_global_load_lds((const GAS unsigned*)((const GAS char*)(gbase) + (voff)[_i]), (LAS unsigned*)(lds + (bufoff) + ldsw + _i * 8192), 16, 0, 0); } while (0)
#define PG8_LDA(dst, b, h) do { _Pragma("unroll") for (int m = 0; m < 4; ++m) _Pragma("unroll") for (int k = 0; k < 2; ++k) dst[m][k] = *(const LAS bf16x8*)(lds + PG8_SA(b, h) + aoff + m * 2048 + k * 1024); } while (0)
#define PG8_LDB(dst, b, h) do { _Pragma("unroll") for (int n = 0; n < 2; ++n) _Pragma("unroll") for (int k = 0; k < 2; ++k) dst[n][k] = *(const LAS bf16x8*)(lds + PG8_SB(b, h) + boff + n * 2048 + k * 1024); } while (0)
#define PG8_MMA(ai, bj, At, Bt) do { __builtin_amdgcn_s_setprio(1); _Pragma("unroll") for (int m = 0; m < 4; ++m) _Pragma("unroll") for (int n = 0; n < 2; ++n) _Pragma("unroll") for (int k = 0; k < 2; ++k) \
        acc[ai][bj][m][n] = __builtin_amdgcn_mfma_f32_16x16x32_bf16(Bt[n][k], At[m][k], acc[ai][bj][m][n], 0, 0, 0); __builtin_amdgcn_s_setprio(0); } while (0)
#define PG8_WAIT_V(n) asm volatile("s_waitcnt vmcnt(" #n ")" ::: "memory")
#define PG8_WAIT_L(n) asm volatile("s_waitcnt lgkmcnt(" #n ")" ::: "memory")
#define PG8_BAR __builtin_amdgcn_s_barrier()
#define PG8_SCHED __builtin_amdgcn_sched_barrier(0)
    Unit cur, nxt; int ui = 0;
    if (!S.template next<MODE>(0, cur)) return;
    Acc acc;
#pragma unroll
    for (int a = 0; a < 2; ++a)
#pragma unroll
        for (int b = 0; b < 2; ++b)
#pragma unroll
            for (int m = 0; m < 4; ++m)
#pragma unroll
                for (int n = 0; n < 2; ++n) acc[a][b][m][n] = (f32x4){0.f, 0.f, 0.f, 0.f};
    bf16x8 At[4][2], B0[2][2], B1[2][2];
    const GAS char* cA = (const GAS char*)(g.A + (size_t)cur.seg * g.a_seg) + (size_t)cur.pm * tstep + (MODE ? (size_t)cur.k0 * kstep : 0); const GAS char* cB = (const GAS char*)(g.Bt + (size_t)cur.seg * g.b_seg) + (size_t)cur.pn * tstep + (MODE ? (size_t)cur.k0 * kstep : 0);
    PG8_STAGE(PG8_SB(0, 0), cB, voffB); PG8_STAGE(PG8_SB(0, 1), cB + hstep, voffB); PG8_STAGE(PG8_SA(0, 0), cA, voffA); PG8_STAGE(PG8_SA(0, 1), cA + hstep, voffA);
    if (wr == 1) PG8_BAR;
    PG8_WAIT_V(2); PG8_BAR;
    PG8_STAGE(PG8_SB(1, 0), cB + kstep, voffB); PG8_STAGE(PG8_SA(1, 0), cA + kstep, voffA); PG8_STAGE(PG8_SB(1, 1), cB + hstep + kstep, voffB);
    PG8_WAIT_V(6); PG8_BAR;
    for (;;) {
        const bool has_next = S.template next<MODE>(ui + 1, nxt);
        const GAS char* nA = has_next ? (const GAS char*)(g.A + (size_t)nxt.seg * g.a_seg) + (size_t)nxt.pm * tstep + (MODE ? (size_t)nxt.k0 * kstep : 0) : cA; const GAS char* nB = has_next ? (const GAS char*)(g.Bt + (size_t)nxt.seg * g.b_seg) + (size_t)nxt.pn * tstep + (MODE ? (size_t)nxt.k0 * kstep : 0) : cB;
        const int nt = MODE == 0 ? K / BK : cur.nk;
        for (int t = 0; t < nt; t += 2) {
            const bool last = (t == nt - 2);
            const GAS char* a1 = cA + (size_t)(t + 1) * kstep;
            const GAS char* a2 = last ? nA : cA + (size_t)(t + 2) * kstep; const GAS char* b2 = last ? nB : cB + (size_t)(t + 2) * kstep;
            const GAS char* a3 = a2 + kstep; const GAS char* b3 = b2 + kstep;
            PG8_LDB(B0, 0, 0); PG8_LDB(B1, 0, 1); PG8_SCHED; PG8_LDA(At, 0, 0); PG8_STAGE(PG8_SA(1, 1), a1 + hstep, voffA);
            PG8_WAIT_V(8); PG8_WAIT_L(0); PG8_BAR; PG8_MMA(0, 0, At, B0); PG8_MMA(0, 1, At, B1); PG8_BAR; PG8_SCHED;
            PG8_LDA(At, 0, 1); PG8_STAGE(PG8_SB(0, 0), b2, voffB); PG8_STAGE(PG8_SB(0, 1), b2 + hstep, voffB); PG8_STAGE(PG8_SA(0, 0), a2, voffA);
            PG8_WAIT_V(8); PG8_WAIT_L(0); PG8_BAR; PG8_MMA(1, 0, At, B0); PG8_MMA(1, 1, At, B1); PG8_BAR; PG8_SCHED;
            PG8_LDB(B0, 1, 0); PG8_LDB(B1, 1, 1); PG8_SCHED; PG8_LDA(At, 1, 0); PG8_STAGE(PG8_SA(0, 1), a2 + hstep, voffA);
            PG8_WAIT_V(8); PG8_WAIT_L(0); PG8_BAR; PG8_MMA(0, 0, At, B0); PG8_MMA(0, 1, At, B1); PG8_BAR; PG8_SCHED;
            PG8_LDA(At, 1, 1); PG8_STAGE(PG8_SB(1, 0), b3, voffB); PG8_STAGE(PG8_SB(1, 1), b3 + hstep, voffB); PG8_STAGE(PG8_SA(1, 0), a3, voffA);
            PG8_WAIT_V(8); PG8_WAIT_L(0); PG8_BAR; PG8_MMA(1, 0, At, B0); PG8_MMA(1, 1, At, B1); PG8_BAR; PG8_SCHED;
        }
        if (wr == 0) PG8_BAR;
        E(acc, cur, wr, wc, fr, fq, lds);
        if (!has_next) break;
        if (MODE == 1 || cur.seg == g.nseg - 1) {
#pragma unroll
            for (int a = 0; a < 2; ++a)
#pragma unroll
                for (int b = 0; b < 2; ++b)
#pragma unroll
                    for (int m = 0; m < 4; ++m)
#pragma unroll
                        for (int n = 0; n < 2; ++n) acc[a][b][m][n] = (f32x4){0.f, 0.f, 0.f, 0.f};
        }
        cur = nxt; cA = nA; cB = nB; ++ui;
        if (wr == 1) PG8_BAR;
    }
    PG8_WAIT_V(0);
    PG8_BAR;
#undef PG8_SA
#undef PG8_SB
#undef PG8_STAGE
#undef PG8_LDA
#undef PG8_LDB
#undef PG8_MMA
#undef PG8_WAIT_V
#undef PG8_WAIT_L
#undef PG8_BAR
#undef PG8_SCHED
}

typedef _Float16 h16x2 __attribute__((ext_vector_type(2)));
__device__ __forceinline__ unsigned cvt_pk_f16(float a, float b) { const f32x2 t = {a, b}; return __builtin_bit_cast(unsigned, __builtin_convertvector(t, h16x2)); }
__device__ __forceinline__ v4u pack8h(const f32x4 a, const f32x4 b) { v4u w; w.x = cvt_pk_f16(a[0], a[1]); w.y = cvt_pk_f16(a[2], a[3]); w.z = cvt_pk_f16(b[0], b[1]); w.w = cvt_pk_f16(b[2], b[3]); return w; }
#define EPI_FOR_ROWS for (int ai = 0; ai < 2; ++ai) _Pragma("unroll") for (int m = 0; m < 4; ++m)
__device__ __forceinline__ v4u pack8(const f32x4 a, const f32x4 b) { v4u w; w.x = cvt_pk_bf16(a[0], a[1]); w.y = cvt_pk_bf16(a[2], a[3]); w.z = cvt_pk_bf16(b[0], b[1]); w.w = cvt_pk_bf16(b[2], b[3]); return w; }

#define NT_ST(p, v) __builtin_nontemporal_store((v), (p))
struct EpiProj {
    int layer; GAS unsigned char* ws; GAS float* out; const GAS float* qng; const GAS float* kng; const GAS float* lb;
    __device__ __forceinline__ void operator()(Acc& acc, const Unit& u, int wr, int wc, int fr, int fq, LAS unsigned char* lds) const {
        const int grp = u.pn >> 2, ct = u.pn & 3;
        const int row0 = u.pm * BM + wr * 64 + fr;
        const int cg0 = ct * 256 + wc * 32 + 8 * fq;
        const bool sample = u.pm >= MPAD / 256;
        if (grp == 2 || grp == 3) {
            LAS float* X = (LAS float*)(lds + LDS_XCH);
#pragma unroll
            EPI_FOR_ROWS {
#pragma unroll
                for (int bj = 0; bj < 2; ++bj) { const f32x4 a = acc[ai][bj][m][0], b = acc[ai][bj][m][1];
                    float s = (a[0] * a[0] + a[1] * a[1]) + (a[2] * a[2] + a[3] * a[3]) + (b[0] * b[0] + b[1] * b[1]) + (b[2] * b[2] + b[3] * b[3]);
                    s += __shfl_xor(s, 16); s += __shfl_xor(s, 32);
                    if (fq == 0) X[(ai * 128 + wr * 64 + m * 16 + fr) * 8 + bj * 4 + wc] = s; } }
            LDS_WAIT(); __builtin_amdgcn_s_barrier(); asm volatile("" ::: "memory");
            const GAS float* gv = (grp == 2 ? qng : kng) + wc * 32 + 8 * fq; const float qs = (grp == 2) ? SB_SCALE * LOG2E : 1.0f;
            const f32x4 g0 = *(const GAS f32x4*)gv * qs, g1 = *(const GAS f32x4*)(gv + 4) * qs;
            GAS bf16* qdst = (GAS bf16*)(ws + WS_Q);
            GAS float* kdst = sample ? out + O_KS + (size_t)layer * MS * 1024 - (size_t)MPAD * 1024 : out + O_KP + (size_t)layer * MP * 1024;
#pragma unroll
            EPI_FOR_ROWS { const int row = row0 + ai * 128 + m * 16;
#pragma unroll
                for (int bj = 0; bj < 2; ++bj) { const f32x4 p = *(const LAS f32x4*)(X + (ai * 128 + wr * 64 + m * 16 + fr) * 8 + bj * 4);
                    const float rs = frsq(((p[0] + p[1]) + (p[2] + p[3])) * (1.0f / 128.0f) + EPS);
                    const f32x4 a = acc[ai][bj][m][0] * rs * g0, b = acc[ai][bj][m][1] * rs * g1; const int col = cg0 + bj * 128;
                    if (grp == 2) NT_ST((GAS v4u*)(qdst + (size_t)row * 1024 + col), pack8(a, b));
                    else if (sample || row < MP) { GAS float* d = kdst + (size_t)row * 1024 + col; NT_ST((GAS f32x4*)d, a); NT_ST((GAS f32x4*)(d + 4), b); } } }
            return;
        }
        if (grp == 4) {
            GAS float* vdst = sample ? out + O_VS + (size_t)layer * MS * 1024 - (size_t)MPAD * 1024 : out + O_VP + (size_t)layer * MP * 1024;
#pragma unroll
            EPI_FOR_ROWS { const int row = row0 + ai * 128 + m * 16;
                if (sample || row < MP) {
#pragma unroll
                    for (int bj = 0; bj < 2; ++bj) { GAS float* d = vdst + (size_t)row * 1024 + cg0 + bj * 128; NT_ST((GAS f32x4*)d, acc[ai][bj][m][0]); NT_ST((GAS f32x4*)(d + 4), acc[ai][bj][m][1]); } } }
            return;
        }
        if (grp == 6) {
            GAS _Float16* lf = (GAS _Float16*)(ws + WS_LOGF); GAS bf16* kc = (GAS bf16*)(ws + WS_KC);
#pragma unroll
            for (int bj = 0; bj < 2; ++bj) { const int col = cg0 + bj * 128; const f32x4 l0 = *(const GAS f32x4*)(lb + col), l1 = *(const GAS f32x4*)(lb + col + 4);
#pragma unroll
                EPI_FOR_ROWS { const int row = row0 + ai * 128 + m * 16; f32x4 z[2] = {acc[ai][bj][m][0], acc[ai][bj][m][1]}; f32x4 lo[2], ko[2];
#pragma unroll
                    for (int n = 0; n < 2; ++n)
#pragma unroll
                        for (int j = 0; j < 4; ++j) { const float zz = z[n][j], l = n ? l1[j] : l0[j], e = fexp2(-fabsf(zz) * LOG2E), r = frcp(1.0f + e), er = e * r;
                            const float sp = zz >= 0.f ? r : er, sn = zz >= 0.f ? er : r, oml = 1.0f - l;
                            lo[n][j] = flog2(l + oml * sp); ko[n][j] = oml * sn; }
                    NT_ST((GAS v4u*)(lf + (size_t)row * 1024 + col), pack8h(lo[0], lo[1]));
                    NT_ST((GAS v4u*)(kc + (size_t)row * 1024 + col), pack8(ko[0], ko[1])); } }
            return;
        }
        size_t off; int act;
        switch (grp) {
            case 0: off = WS_UA; act = 0; break;   case 1: off = WS_SGA; act = 1; break;  case 5: off = WS_SGB; act = 1; break;
            case 7: off = WS_QC; act = 1; break;   case 8: off = WS_IC; act = 0; break;   case 9: off = WS_SGC; act = 1; break;
            default: off = WS_GATE + (size_t)(grp - 10) * RB16; act = 2; break;
        }
        GAS bf16* dst = (GAS bf16*)(ws + off);
#pragma unroll
        EPI_FOR_ROWS { const int row = row0 + ai * 128 + m * 16;
#pragma unroll
            for (int bj = 0; bj < 2; ++bj) { f32x4 a = acc[ai][bj][m][0], b = acc[ai][bj][m][1];
                if (act) {
#pragma unroll
                    for (int j = 0; j < 4; ++j) { const float sa = fsigmoid(a[j]), sb = fsigmoid(b[j]);
                        a[j] = act == 1 ? a[j] * sa : fmaxf(sa, 1e-30f); b[j] = act == 1 ? b[j] * sb : fmaxf(sb, 1e-30f); } }
                NT_ST((GAS v4u*)(dst + (size_t)row * 1024 + cg0 + bj * 128), pack8(a, b)); } }
        if (grp == 0) {
#pragma unroll
            EPI_FOR_ROWS { const int row = row0 + ai * 128 + m * 16; GAS float* d = nullptr;
                if (sample) { const int rr = row - MPAD, b = rr >> 6, i = rr & 63; if (i >= DSEQ - 15) d = out + O_PS + (((size_t)layer * DBATCH + b) * 15 + (i - (DSEQ - 15))) * 1024; }
                else if (row < MP) { const int b = row / LP, t = row - b * LP; if (t >= LP - 15) d = out + O_PP + (((size_t)layer * BATCH + b) * 15 + (t - (LP - 15))) * 1024; }
                if (d) {
#pragma unroll
                    for (int bj = 0; bj < 2; ++bj) { GAS float* dd = d + cg0 + bj * 128; NT_ST((GAS f32x4*)dd, acc[ai][bj][m][0]); NT_ST((GAS f32x4*)(dd + 4), acc[ai][bj][m][1]); } } }
        }
    }
};

struct EpiMerge {
    GAS unsigned char* ws;
    __device__ __forceinline__ void operator()(Acc& acc, const Unit& u, int wr, int wc, int fr, int fq, LAS unsigned char* lds) const {
        const int row0 = u.pm * BM + wr * 64 + fr, c0 = u.pn * BM + wc * 32 + 8 * fq;
        const GAS bf16* G0 = (const GAS bf16*)(ws + WS_GATE) + (size_t)u.seg * MTOT * 1024; const GAS bf16* G1 = G0 + (size_t)MTOT * 1024; GAS bf16* dst = (GAS bf16*)(ws + WS_MERGED);
        const bool fin = u.seg == 2;
#pragma unroll
        for (int ai = 0; ai < 2; ++ai)
#pragma unroll
        for (int mh = 0; mh < 2; ++mh) {
            v4u ga[2][2], gb[2][2];
#pragma unroll
            for (int mm = 0; mm < 2; ++mm)
#pragma unroll
                for (int bj = 0; bj < 2; ++bj) { const size_t ro = (size_t)(row0 + ai * 128 + (2 * mh + mm) * 16) * 1024 + c0 + bj * 128; ga[mm][bj] = *(const GAS v4u*)(G0 + ro); gb[mm][bj] = fin ? ga[mm][bj] : *(const GAS v4u*)(G1 + ro); }
#pragma unroll
            for (int mm = 0; mm < 2; ++mm)
#pragma unroll
                for (int bj = 0; bj < 2; ++bj) { const int m = 2 * mh + mm; const v4u x = ga[mm][bj], y = gb[mm][bj];
                    f32x4 fa0 = {bf_lo(x.x), bf_hi(x.x), bf_lo(x.y), bf_hi(x.y)}, fa1 = {bf_lo(x.z), bf_hi(x.z), bf_lo(x.w), bf_hi(x.w)};
                    if (!fin) { const f32x4 fb0 = {bf_lo(y.x), bf_hi(y.x), bf_lo(y.y), bf_hi(y.y)}, fb1 = {bf_lo(y.z), bf_hi(y.z), bf_lo(y.w), bf_hi(y.w)};
#pragma unroll
                        for (int j = 0; j < 4; ++j) { fa0[j] *= frcp(fb0[j]); fa1[j] *= frcp(fb1[j]); } }
                    acc[ai][bj][m][0] *= fa0; acc[ai][bj][m][1] *= fa1;
                    if (fin) *(GAS v4u*)(dst + (size_t)(row0 + ai * 128 + m * 16) * 1024 + c0 + bj * 128) = pack8(acc[ai][bj][m][0], acc[ai][bj][m][1]); }
        }
    }
};

struct EpiOut {
    GAS unsigned char* ws; GAS float* out; int last;
    __device__ __forceinline__ void operator()(Acc& acc, const Unit& u, int wr, int wc, int fr, int fq, LAS unsigned char* lds) const {
        const int row0 = u.pm * BM + wr * 64 + fr, c0 = u.pn * BM + wc * 32 + 8 * fq; GAS bf16* HB = (GAS bf16*)(ws + WS_H);
        const bool sample = u.pm >= MPAD / 256;
#pragma unroll
        for (int ai = 0; ai < 2; ++ai) {
            v4u hb[4][2];
#pragma unroll
            for (int m = 0; m < 4; ++m)
#pragma unroll
                for (int bj = 0; bj < 2; ++bj) hb[m][bj] = *(const GAS v4u*)(HB + (size_t)(row0 + ai * 128 + m * 16) * 1024 + c0 + bj * 128);
#pragma unroll
            for (int m = 0; m < 4; ++m) { const int row = row0 + ai * 128 + m * 16;
                if (last) { GAS float* dp; bool ok = true;
                    if (sample) dp = out + O_YS + (size_t)(row - MPAD) * 1024 + c0;
                    else { const int b = row / LP, t = row - b * LP; ok = row < MP && t >= NMETA; dp = out + O_YP + ((size_t)b * SEQ + (t - NMETA)) * 1024 + c0; }
                    if (ok) {
#pragma unroll
                        for (int bj = 0; bj < 2; ++bj) { const v4u t = hb[m][bj];
                            *(GAS f32x4*)(dp + bj * 128) = (f32x4){bf_lo(t.x), bf_hi(t.x), bf_lo(t.y), bf_hi(t.y)} + acc[ai][bj][m][0]; *(GAS f32x4*)(dp + bj * 128 + 4) = (f32x4){bf_lo(t.z), bf_hi(t.z), bf_lo(t.w), bf_hi(t.w)} + acc[ai][bj][m][1]; } }
                } else {
#pragma unroll
                    for (int bj = 0; bj < 2; ++bj) { const v4u t = hb[m][bj];
                        *(GAS v4u*)(HB + (size_t)row * 1024 + c0 + bj * 128) = pack8((f32x4){bf_lo(t.x), bf_hi(t.x), bf_lo(t.y), bf_hi(t.y)} + acc[ai][bj][m][0], (f32x4){bf_lo(t.z), bf_hi(t.z), bf_lo(t.w), bf_hi(t.w)} + acc[ai][bj][m][1]); } } }
        }
    }
};
struct EpiMergeSlab {
    GAS unsigned char* ws;
    __device__ __forceinline__ void operator()(Acc& acc, const Unit& u, int wr, int wc, int fr, int fq, LAS unsigned char* lds) const {
        const int row0 = u.pm * BM + wr * 64 + fr, c0 = u.pn * BM + wc * 32 + 8 * fq;
        const GAS bf16* G0 = (const GAS bf16*)(ws + WS_GATE) + (size_t)u.seg * MTOT * 1024;
        {
            GAS bf16* sl = (GAS bf16*)(ws + WS_SLAB_M) + (size_t)u.slab * 65536 + (size_t)(wr * 64 + fr) * 256 + wc * 32 + 8 * fq;
#pragma unroll
            for (int ai = 0; ai < 2; ++ai) { v4u ga[4][2];
#pragma unroll
                for (int m = 0; m < 4; ++m)
#pragma unroll
                    for (int bj = 0; bj < 2; ++bj) ga[m][bj] = *(const GAS v4u*)(G0 + (size_t)(row0 + ai * 128 + m * 16) * 1024 + c0 + bj * 128);
#pragma unroll
                for (int m = 0; m < 4; ++m)
#pragma unroll
                    for (int bj = 0; bj < 2; ++bj) { const v4u x = ga[m][bj]; const f32x4 f0 = {bf_lo(x.x), bf_hi(x.x), bf_lo(x.y), bf_hi(x.y)}, f1 = {bf_lo(x.z), bf_hi(x.z), bf_lo(x.w), bf_hi(x.w)};
                        *(GAS v4u*)(sl + (size_t)(ai * 128 + m * 16) * 256 + bj * 128) = pack8(acc[ai][bj][m][0] * f0, acc[ai][bj][m][1] * f1); } }
        }
    }
};
struct EpiOutSlab {
    GAS unsigned char* ws;
    __device__ __forceinline__ void operator()(Acc& acc, const Unit& u, int wr, int wc, int fr, int fq, LAS unsigned char* lds) const {
        {
            GAS bf16* sl = (GAS bf16*)(ws + WS_SLAB_O) + (size_t)u.slab * 65536 + (size_t)(wr * 64 + fr) * 256 + wc * 32 + 8 * fq;
#pragma unroll
            for (int ai = 0; ai < 2; ++ai)
#pragma unroll
                for (int m = 0; m < 4; ++m)
#pragma unroll
                    for (int bj = 0; bj < 2; ++bj) *(GAS v4u*)(sl + (size_t)(ai * 128 + m * 16) * 256 + bj * 128) = pack8(acc[ai][bj][m][0], acc[ai][bj][m][1]);
        }
    }
};
}
__device__ __forceinline__ f32x16 mfma32(bf16x8 a, bf16x8 b, f32x16 c) { return __builtin_amdgcn_mfma_f32_32x32x16_bf16(a, b, c, 0, 0, 0); }
__device__ __forceinline__ f32x16 zero16() { f32x16 z;
#pragma unroll
    for (int i = 0; i < 16; ++i) z[i] = 0.f; return z; }
__device__ __forceinline__ bf16x8 cvt8(const f32x4 a, const f32x4 b) { const v4u w = pg8::pack8(a, b); return __builtin_bit_cast(bf16x8, w); }

namespace hg {
constexpr int P136 = 136, P72 = 72;
constexpr int L_QS = 0, L_QT = L_QS + 64 * P136 * 2, L_KT = L_QT + 64 * P136 * 2, L_KTT = L_KT + 64 * P136 * 2, L_VT = L_KTT + 128 * P72 * 2,
              L_ATT = L_VT + 128 * P72 * 2, L_ST = L_ATT + 64 * P72 * 2, L_SEG = L_ST + 128 * P136 * 2, L_EV = L_SEG + 8 * 128 * 4, L_PART = L_EV + 2 * 128 * 4, L_GN = L_PART + 64 * 4 * 4, L_END = L_GN + 128 * 4;
static_assert(L_END <= LDS_MISC, "hgrn LDS");
struct Pre { unsigned lf[8]; unsigned q[8], k[8], v[8]; v2u sg[4]; };
#define HG_BAR() do { asm volatile("s_waitcnt lgkmcnt(0)" ::: "memory"); __builtin_amdgcn_s_barrier(); asm volatile("" ::: "memory"); } while (0)

template <int PART>
__device__ __forceinline__ void prefetch(Pre& P, const GAS unsigned char* ws, size_t row0, int nvalid, int seg, int colb  , int trow  , int sgcol  ) {
    const GAS _Float16* LF = (const GAS _Float16*)(ws + WS_LOGF) + row0 * 1024; const GAS bf16* QC = (const GAS bf16*)(ws + WS_QC) + row0 * 1024; const GAS bf16* KC = (const GAS bf16*)(ws + WS_KC) + row0 * 1024; const GAS bf16* IC = (const GAS bf16*)(ws + WS_IC) + row0 * 1024;
    if (PART & 2) { const GAS bf16* SGC = (const GAS bf16*)(ws + WS_SGC) + row0 * 1024; const unsigned so = (unsigned)((trow < nvalid ? trow : 0) * 1024 + sgcol);
#pragma unroll
      for (int g = 0; g < 4; ++g) P.sg[g] = *(const GAS v2u*)(SGC + so + 8 * g); }
    if (nvalid == 64) {
#pragma unroll
        for (int i = 0; i < 8; ++i) { const unsigned o = (unsigned)((seg * 8 + i) * 1024 + colb);
            if (PART & 1) P.lf[i] = *(const GAS unsigned*)(LF + o);
            if (PART & 2) { P.q[i] = *(const GAS unsigned*)(QC + o); P.k[i] = *(const GAS unsigned*)(KC + o); P.v[i] = *(const GAS unsigned*)(IC + o); } }
    } else {
#pragma unroll
        for (int i = 0; i < 8; ++i) { const int t = seg * 8 + i; const unsigned o = (unsigned)(t * 1024 + colb);
            if (t < nvalid) { if (PART & 1) P.lf[i] = *(const GAS unsigned*)(LF + o); if (PART & 2) { P.q[i] = *(const GAS unsigned*)(QC + o); P.k[i] = *(const GAS unsigned*)(KC + o); P.v[i] = *(const GAS unsigned*)(IC + o); } }
            else { if (PART & 1) P.lf[i] = 0u; if (PART & 2) { P.q[i] = 0u; P.k[i] = 0u; P.v[i] = 0u; } } }
    }
}

__device__ __forceinline__ void chain(Frame& F, int layer, bool sample, int b, int h) {
    LAS unsigned char* lds = F.lds; int tid = F.tid_(); asm volatile("" : "+v"(tid));
    const int lane = tid & 63, wave = F.wave, seg = wave; int kp = tid & 63, l31 = lane & 31, hh = lane >> 5;
    const int L = sample ? DSEQ : LP, nchunks = (L + 63) / 64;
    const size_t rowbase = sample ? (size_t)MPAD + (size_t)b * DSEQ : (size_t)b * LP;
    const int colb = h * 128 + 2 * kp;
    GAS bf16* YC = (GAS bf16*)(F.wsp() + WS_Y) + (size_t)2 * MTOT * 1024;
    const int kb = wave >> 1, vb0 = 2 * (wave & 1);
    f32x16 S[2];
    if (sample) { const GAS float* s0 = F_state_hgrn + (((size_t)layer * DBATCH + b) * 8 + h) * 16384;
#pragma unroll
        for (int vbi = 0; vbi < 2; ++vbi)
#pragma unroll
            for (int r = 0; r < 16; ++r) S[vbi][r] = s0[(size_t)(32 * kb + (r & 3) + 8 * (r >> 2) + 4 * hh) * 128 + 32 * (vb0 + vbi) + l31]; }
    else { S[0] = zero16(); S[1] = zero16(); }
#pragma unroll
    for (int vbi = 0; vbi < 2; ++vbi)
#pragma unroll
        for (int g = 0; g < 4; ++g) { v2u w; w.x = cvt_pk_bf16(S[vbi][4 * g], S[vbi][4 * g + 1]); w.y = cvt_pk_bf16(S[vbi][4 * g + 2], S[vbi][4 * g + 3]);
            *(LAS v2u*)(lds + L_ST + ((32 * (vb0 + vbi) + l31) * P136 + 32 * kb + 8 * g + 4 * hh) * 2) = w; }
    const int ovb = wave & 3, otb = wave >> 2;
    if (tid < 128) *(LAS float*)(lds + L_GN + tid * 4) = F_hng[layer * 128 + tid];
    Pre P; prefetch<3>(P, F.wsp(), rowbase, min(64, L), seg, colb, 32 * otb + l31, h * 128 + 32 * ovb + 4 * hh);
    for (int c = 0; c < nchunks; ++c) {
        asm volatile("" : "+v"(l31), "+v"(hh), "+v"(kp));
        const int nvalid = min(64, L - 64 * c); const size_t row0 = rowbase + (size_t)64 * c;
        float c0[8], c1[8]; { float a0 = 0.f, a1 = 0.f;
#pragma unroll
            for (int i = 0; i < 8; ++i) { const pg8::h16x2 hv = __builtin_bit_cast(pg8::h16x2, P.lf[i]); a0 += (float)hv.x; a1 += (float)hv.y; c0[i] = a0; c1[i] = a1; }
            *(LAS f32x2*)(lds + L_SEG + (seg * 128 + 2 * kp) * 4) = (f32x2){a0, a1}; }
        if (c + 1 < nchunks) prefetch<1>(P, F.wsp(), rowbase + (size_t)64 * (c + 1), min(64, L - 64 * (c + 1)), seg, colb, 32 * otb + l31, h * 128 + 32 * ovb + 4 * hh);
        HG_BAR();
        float off0 = 0.f, off1 = 0.f, m0 = 0.f, m1 = 0.f, la0 = 0.f, la1 = 0.f;
#pragma unroll
        for (int s = 0; s < 8; ++s) { const f32x2 tt = *(const LAS f32x2*)(lds + L_SEG + (s * 128 + 2 * kp) * 4);
            if (s < seg) { off0 += tt.x; off1 += tt.y; } if (s < 4) { m0 += tt.x; m1 += tt.y; } la0 += tt.x; la1 += tt.y; }
        unsigned ktt0[8], ktt1[8], vt0[8], vt1[8]; const float e2m0 = fexp2(m0), e2m1 = fexp2(m1);
#pragma unroll
        for (int i = 0; i < 8; ++i) { const int t = seg * 8 + i; const float cu0 = off0 + c0[i], cu1 = off1 + c1[i];
            const float q0 = bf_lo(P.q[i]), q1 = bf_hi(P.q[i]), k0 = bf_lo(P.k[i]), k1 = bf_hi(P.k[i]);
            const float em0 = fexp2(cu0 - m0), em1 = fexp2(cu1 - m1), ek0 = fexp2(m0 - cu0), ek1 = fexp2(m1 - cu1), eq0 = em0 * e2m0, eq1 = em1 * e2m1;
            *(LAS unsigned*)(lds + L_QS + (t * P136 + 2 * kp) * 2) = cvt_pk_bf16(q0 * eq0, q1 * eq1);
            *(LAS unsigned*)(lds + L_QT + (t * P136 + 2 * kp) * 2) = cvt_pk_bf16(q0 * em0, q1 * em1);
            const unsigned kt = cvt_pk_bf16(k0 * ek0, k1 * ek1);
            *(LAS unsigned*)(lds + L_KT + (t * P136 + 2 * kp) * 2) = kt;
            ktt0[i] = kt & 0xffffu; ktt1[i] = kt >> 16; vt0[i] = P.v[i] & 0xffffu; vt1[i] = P.v[i] >> 16; }
        { v4u w; w.x = ktt0[0] | (ktt0[1] << 16); w.y = ktt0[2] | (ktt0[3] << 16); w.z = ktt0[4] | (ktt0[5] << 16); w.w = ktt0[6] | (ktt0[7] << 16);
          *(LAS v4u*)(lds + L_KTT + ((2 * kp) * P72 + 8 * seg) * 2) = w;
          w.x = ktt1[0] | (ktt1[1] << 16); w.y = ktt1[2] | (ktt1[3] << 16); w.z = ktt1[4] | (ktt1[5] << 16); w.w = ktt1[6] | (ktt1[7] << 16);
          *(LAS v4u*)(lds + L_KTT + ((2 * kp + 1) * P72 + 8 * seg) * 2) = w;
          w.x = vt0[0] | (vt0[1] << 16); w.y = vt0[2] | (vt0[3] << 16); w.z = vt0[4] | (vt0[5] << 16); w.w = vt0[6] | (vt0[7] << 16);
          *(LAS v4u*)(lds + L_VT + ((2 * kp) * P72 + 8 * seg) * 2) = w;
          w.x = vt1[0] | (vt1[1] << 16); w.y = vt1[2] | (vt1[3] << 16); w.z = vt1[4] | (vt1[5] << 16); w.w = vt1[6] | (vt1[7] << 16);
          *(LAS v4u*)(lds + L_VT + ((2 * kp + 1) * P72 + 8 * seg) * 2) = w; }
        if (seg == 0) { *(LAS f32x2*)(lds + L_EV + (2 * kp) * 4) = (f32x2){fexp2(la0), fexp2(la1)}; *(LAS f32x2*)(lds + L_EV + (128 + 2 * kp) * 4) = (f32x2){fexp2(la0 - m0), fexp2(la1 - m1)}; }
        v2u sg[4] = {P.sg[0], P.sg[1], P.sg[2], P.sg[3]};
        if (c + 1 < nchunks) prefetch<2>(P, F.wsp(), rowbase + (size_t)64 * (c + 1), min(64, L - 64 * (c + 1)), seg, colb, 32 * otb + l31, h * 128 + 32 * ovb + 4 * hh);
        HG_BAR();
        if (wave < 3) { const int sb = wave == 2 ? 1 : 0, tb = wave == 0 ? 0 : 1; f32x16 a = zero16();
#pragma unroll
            for (int st = 0; st < 8; ++st) { const bf16x8 ka = *(const LAS bf16x8*)(lds + L_KT + ((32 * sb + l31) * P136 + 16 * st + 8 * hh) * 2);
                const bf16x8 qb = *(const LAS bf16x8*)(lds + L_QT + ((32 * tb + l31) * P136 + 16 * st + 8 * hh) * 2); a = mfma32(ka, qb, a); }
            const int t = 32 * tb + l31;
#pragma unroll
            for (int g = 0; g < 4; ++g) { const int s0 = 32 * sb + 8 * g + 4 * hh; float x[4];
#pragma unroll
                for (int j = 0; j < 4; ++j) x[j] = (s0 + j <= t) ? a[4 * g + j] : 0.f;
                v2u w; w.x = cvt_pk_bf16(x[0], x[1]); w.y = cvt_pk_bf16(x[2], x[3]); *(LAS v2u*)(lds + L_ATT + (t * P72 + s0) * 2) = w; } }
        HG_BAR();
        f32x16 o = zero16();
#pragma unroll
        for (int st = 0; st < 8; ++st) { const bf16x8 sa = *(const LAS bf16x8*)(lds + L_ST + ((32 * ovb + l31) * P136 + 16 * st + 8 * hh) * 2);
            const bf16x8 qb = *(const LAS bf16x8*)(lds + L_QS + ((32 * otb + l31) * P136 + 16 * st + 8 * hh) * 2); o = mfma32(sa, qb, o); }
        for (int st = 0; st < 2 + 2 * otb; ++st) { const bf16x8 va = *(const LAS bf16x8*)(lds + L_VT + ((32 * ovb + l31) * P72 + 16 * st + 8 * hh) * 2);
            const bf16x8 ab = *(const LAS bf16x8*)(lds + L_ATT + ((32 * otb + l31) * P72 + 16 * st + 8 * hh) * 2); o = mfma32(va, ab, o); }
        { float ss = 0.f;
#pragma unroll
            for (int r = 0; r < 16; ++r) ss += o[r] * o[r];
            ss += __shfl_xor(ss, 32);
            if (hh == 0) *(LAS float*)(lds + L_PART + ((32 * otb + l31) * 4 + ovb) * 4) = ss; }
        HG_BAR();
        { const f32x4 p = *(const LAS f32x4*)(lds + L_PART + (32 * otb + l31) * 16); const float rs = frsq(((p[0] + p[1]) + (p[2] + p[3])) * (1.0f / 128.0f) + EPS);
          const int t = 32 * otb + l31;
          if (t < nvalid) { GAS bf16* yp = YC + (row0 + t) * 1024 + h * 128 + 32 * ovb + 4 * hh;
#pragma unroll
              for (int g = 0; g < 4; ++g) { const f32x4 gng = *(const LAS f32x4*)(lds + L_GN + (32 * ovb + 8 * g + 4 * hh) * 4); const float y0 = o[4 * g] * rs * gng[0] * bf_lo(sg[g].x), y1 = o[4 * g + 1] * rs * gng[1] * bf_hi(sg[g].x),
                                                        y2 = o[4 * g + 2] * rs * gng[2] * bf_lo(sg[g].y), y3 = o[4 * g + 3] * rs * gng[3] * bf_hi(sg[g].y);
                  v2u w; w.x = cvt_pk_bf16(y0, y1); w.y = cvt_pk_bf16(y2, y3); *(GAS v2u*)(yp + 8 * g) = w; } } }
        f32x16 Pn[2] = {zero16(), zero16()};
#pragma unroll
        for (int st = 0; st < 4; ++st) { const bf16x8 ka = *(const LAS bf16x8*)(lds + L_KTT + ((32 * kb + l31) * P72 + 16 * st + 8 * hh) * 2);
#pragma unroll
            for (int vbi = 0; vbi < 2; ++vbi) { const bf16x8 vbf = *(const LAS bf16x8*)(lds + L_VT + ((32 * (vb0 + vbi) + l31) * P72 + 16 * st + 8 * hh) * 2); Pn[vbi] = mfma32(ka, vbf, Pn[vbi]); } }
#pragma unroll
        for (int g = 0; g < 4; ++g) { const f32x4 el = *(const LAS f32x4*)(lds + L_EV + (32 * kb + 8 * g + 4 * hh) * 4), elm = *(const LAS f32x4*)(lds + L_EV + (128 + 32 * kb + 8 * g + 4 * hh) * 4);
#pragma unroll
            for (int vbi = 0; vbi < 2; ++vbi) {
#pragma unroll
                for (int j = 0; j < 4; ++j) S[vbi][4 * g + j] = el[j] * S[vbi][4 * g + j] + elm[j] * Pn[vbi][4 * g + j];
                v2u w; w.x = cvt_pk_bf16(S[vbi][4 * g], S[vbi][4 * g + 1]); w.y = cvt_pk_bf16(S[vbi][4 * g + 2], S[vbi][4 * g + 3]);
                *(LAS v2u*)(lds + L_ST + ((32 * (vb0 + vbi) + l31) * P136 + 32 * kb + 8 * g + 4 * hh) * 2) = w; } }
    }
    GAS float* sf = sample ? F.outp() + O_HS + (((size_t)layer * DBATCH + b) * 8 + h) * 16384 : F.outp() + O_HP + (((size_t)layer * BATCH + b) * 8 + h) * 16384;
#pragma unroll
    for (int vbi = 0; vbi < 2; ++vbi)
#pragma unroll
        for (int r = 0; r < 16; ++r) sf[(size_t)(32 * kb + (r & 3) + 8 * (r >> 2) + 4 * hh) * 128 + 32 * (vb0 + vbi) + l31] = S[vbi][r];
    HG_BAR();
}
}

namespace sb {
constexpr float R_STOP = -136.0f;
constexpr int KROW = 272, SLOT = 32 * KROW + 128 * 64;
static_assert(8 * SLOT + 64 <= LDS_MISC, "attention LDS");
constexpr int L_DONE = 8 * SLOT;
struct Grp { const GAS float* k_old; const GAS float* v_old; const GAS float* k_new; const GAS float* v_new; };

struct TileRegs { f32x4 k0, k1, v0, v1; };
__device__ __forceinline__ void tile_issue(TileRegs& t, const Grp& g, int kt, int past, int L, int c, int rp, int sh) {
    const int s0 = 32 * kt - sh; const bool old = s0 + sh < past; const int rl = old ? 31 : (L - 1 - (s0 - past)), lo = s0 < 0 ? -s0 : 0;
    const GAS float* kb = old ? g.k_old + (ptrdiff_t)s0 * 1024 : g.k_new + (ptrdiff_t)(s0 - past) * 1024; const GAS float* vb = old ? g.v_old + (ptrdiff_t)s0 * 1024 : g.v_new + (ptrdiff_t)(s0 - past) * 1024;
    if (rl >= 31 && lo == 0) {
        const unsigned o = (unsigned)(2 * rp * 1024 + 4 * c);
        t.k0 = *(const GAS f32x4*)(kb + o); t.k1 = *(const GAS f32x4*)(kb + o + 1024); t.v0 = *(const GAS f32x4*)(vb + o); t.v1 = *(const GAS f32x4*)(vb + o + 1024);
        return; }
    const int r0 = max(min(2 * rp, rl), lo), r1 = max(min(2 * rp + 1, rl), lo);
    t.k0 = *(const GAS f32x4*)(kb + (ptrdiff_t)r0 * 1024 + 4 * c); t.k1 = *(const GAS f32x4*)(kb + (ptrdiff_t)r1 * 1024 + 4 * c);
    t.v0 = *(const GAS f32x4*)(vb + (ptrdiff_t)r0 * 1024 + 4 * c); t.v1 = *(const GAS f32x4*)(vb + (ptrdiff_t)r1 * 1024 + 4 * c);
}
__device__ __forceinline__ void tile_commit(const TileRegs& t, LAS unsigned char* slot, int c, int rp) {
    v2u a; a.x = cvt_pk_bf16(t.k0[0], t.k0[1]); a.y = cvt_pk_bf16(t.k0[2], t.k0[3]); *(LAS v2u*)(slot + (2 * rp) * KROW + 8 * c) = a;
    a.x = cvt_pk_bf16(t.k1[0], t.k1[1]); a.y = cvt_pk_bf16(t.k1[2], t.k1[3]); *(LAS v2u*)(slot + (2 * rp + 1) * KROW + 8 * c) = a;
    LAS unsigned char* vt = slot + 32 * KROW; const int r7 = rp & 7, f = 2 * (rp >> 3) + ((r7 >> 1) & 1);
    const int u = ((f ^ (c & 3)) * 16) + (r7 >> 2) * 8 + (rp & 1) * 4;
#pragma unroll
    for (int j = 0; j < 4; ++j) *(LAS unsigned*)(vt + (4 * c + j) * 64 + u) = cvt_pk_bf16(t.v0[j], t.v1[j]);
}

template <int NG>
__device__ __forceinline__ void block_unit(Frame& F, int layer, int unit  ) {
    constexpr int W = 8 / NG;
    int tid = F.tid_(); asm volatile("" : "+v"(tid)); const int lane = tid & 63, wave = F.wave, l31 = lane & 31, hh = lane >> 5;
    LAS unsigned char* lds = F.lds;
    const bool sample = NG > 1; constexpr int sh = NG == 1 ? 16 : 0; const int L = sample ? DSEQ : LP, past = sample ? PAST : 0, nqt = (L + sh + 31) / 32;
    const int gi = wave / W, wi = wave - gi * W;
    int bh, qt0; bool wave_on; if (!sample) { const int j = 8 - (unit >> 6); bh = unit & 63; qt0 = j == 0 ? 0 : 8 * j - 7; wave_on = j > 0 || wi == 0; } else { bh = unit * NG + gi; qt0 = 0; wave_on = wi < nqt; }
    const int b = bh >> 3, h = bh & 7; const int qt = qt0 + wi;
    const size_t rowbase = sample ? (size_t)MPAD + (size_t)b * DSEQ : (size_t)b * LP;
    Grp g;
    g.k_new = (sample ? F.outp() + O_KS + (size_t)layer * MS * 1024 + (size_t)b * DSEQ * 1024 : F.outp() + O_KP + (size_t)layer * MP * 1024 + (size_t)b * LP * 1024) + h * 128;
    g.v_new = (sample ? F.outp() + O_VS + (size_t)layer * MS * 1024 + (size_t)b * DSEQ * 1024 : F.outp() + O_VP + (size_t)layer * MP * 1024 + (size_t)b * LP * 1024) + h * 128;
    g.k_old = F_cache_k + ((size_t)layer * DBATCH + b) * PAST * 1024 + h * 128; g.v_old = F_cache_v + ((size_t)layer * DBATCH + b) * PAST * 1024 + h * 128;
    const int dt0 = (past >> 5) + qt0;
    const int tq = 32 * qt - sh + l31; const bool qvalid = wave_on && tq >= 0 && tq < L; const size_t qrow = rowbase + (tq < 0 ? 0 : tq < L ? tq : L - 1);
    const GAS bf16* Q = (const GAS bf16*)(F.wsp() + WS_Q) + qrow * 1024 + h * 128 + 8 * hh;
    bf16x8 qf[8];
#pragma unroll
    for (int st = 0; st < 8; ++st) qf[st] = *(const GAS bf16x8*)(Q + 16 * st);
    f32x16 O[4] = {zero16(), zero16(), zero16(), zero16()};
    const int qpos = past + tq; float R = 0.f; bool done = !wave_on;
    const int sc = tid & 31, srp = NG == 1 ? (tid >> 5) : ((tid & (64 * W - 1)) >> 5);
    if (NG == 1) { for (int j0 = 0; j0 < W; j0 += 4) { TileRegs t[4];
#pragma unroll
            for (int j = 0; j < 4; ++j) tile_issue(t[j], g, dt0 + j0 + j, past, L, sc, srp, sh);
#pragma unroll
            for (int j = 0; j < 4; ++j) tile_commit(t[j], lds + ((dt0 + j0 + j) & (W - 1)) * SLOT, sc, srp); } }
    else { for (int j = 0; j < W; ++j) { TileRegs t[4];
#pragma unroll
            for (int ps = 0; ps < 4; ++ps) tile_issue(t[ps], g, dt0 + j, past, L, sc, srp + 4 * ps, sh);
#pragma unroll
            for (int ps = 0; ps < 4; ++ps) tile_commit(t[ps], lds + (gi * W + ((dt0 + j) & (W - 1))) * SLOT, sc, srp + 4 * ps); } }
    if (lane == 0) *(LAS unsigned*)(lds + L_DONE + 4 * wave) = done ? 1u : 0u;
    TileRegs pre; if (NG == 1 && dt0 - 1 >= 0) tile_issue(pre, g, dt0 - 1, past, L, sc, srp, sh);
    HG_BAR();
    for (int i = 0; ; ++i) {
        const int kt = dt0 + wi - i;
        const int knew = dt0 - i - 1;
        TileRegs pre2; if (NG == 1 && knew - 1 >= 0) tile_issue(pre2, g, knew - 1, past, L, sc, srp, sh);
        if (!done && kt >= 0) {
            const LAS unsigned char* slot = lds + (gi * W + (kt & (W - 1))) * SLOT; const int s0 = 32 * kt - sh;
            f32x16 sa = zero16();
#pragma unroll
            for (int st = 0; st < 8; ++st) sa = mfma32(*(const LAS bf16x8*)(slot + l31 * KROW + (16 * st + 8 * hh) * 2), qf[st], sa);
            const bool diag = i == 0;
            float sg[16], kp[16];
#pragma unroll
            for (int r = 0; r < 16; ++r) { const float e = fexp2(-sa[r]), rc = frcp(1.0f + e); sg[r] = rc; kp[r] = e * rc; }
            if (diag || (sh != 0 && kt == 0)) { const int khi = diag ? qpos : 0x7fffffff;
#pragma unroll
                for (int r = 0; r < 16; ++r) { const int key = s0 + (r & 3) + 8 * (r >> 2) + 4 * hh; const bool ok = key < khi && key >= 0; kp[r] = ok ? kp[r] : 1.0f; sg[r] = ok ? sg[r] : 0.f; } }
            float ex[16], T[4], Tp[4];
#pragma unroll
            for (int gq = 0; gq < 4; ++gq) { ex[4 * gq + 3] = 1.0f; ex[4 * gq + 2] = kp[4 * gq + 3]; ex[4 * gq + 1] = ex[4 * gq + 2] * kp[4 * gq + 2]; ex[4 * gq] = ex[4 * gq + 1] * kp[4 * gq + 1]; T[gq] = ex[4 * gq] * kp[4 * gq]; Tp[gq] = __shfl_xor(T[gq], 32); }
            float carry[4]; { float above = fexp2(R);
#pragma unroll
                for (int gq = 3; gq >= 0; --gq) { carry[gq] = above * (hh == 0 ? Tp[gq] : 1.0f); above *= T[gq] * Tp[gq]; }
                R += flog2(fmaxf(((T[0] * Tp[0]) * (T[1] * Tp[1])) * ((T[2] * Tp[2]) * (T[3] * Tp[3])), 1e-45f)); }
            float w[16];
#pragma unroll
            for (int r = 0; r < 16; ++r) w[r] = sg[r] * (carry[r >> 2] * ex[r]);
            const LAS unsigned char* vt = slot + 32 * KROW;
#pragma unroll
            for (int s = 0; s < 2; ++s) { v4u pw; pw.x = cvt_pk_bf16(w[8 * s], w[8 * s + 1]); pw.y = cvt_pk_bf16(w[8 * s + 2], w[8 * s + 3]); pw.z = cvt_pk_bf16(w[8 * s + 4], w[8 * s + 5]); pw.w = cvt_pk_bf16(w[8 * s + 6], w[8 * s + 7]);
                const bf16x8 pb = __builtin_bit_cast(bf16x8, pw);
#pragma unroll
                for (int db = 0; db < 4; ++db) { const int d = 32 * db + l31;
                    O[db] = mfma32(*(const LAS bf16x8*)(vt + d * 64 + (((2 * s + hh) ^ ((d >> 2) & 3)) * 16)), pb, O[db]); } }
            if (kt == 0 || __all(R < R_STOP)) { done = true; if (lane == 0) *(LAS unsigned*)(lds + L_DONE + 4 * wave) = 1u; }
        } else if (!done && kt < 0) { done = true; if (lane == 0) *(LAS unsigned*)(lds + L_DONE + 4 * wave) = 1u; }
        HG_BAR();
        const v4u d0 = *(const LAS v4u*)(lds + L_DONE), d1 = *(const LAS v4u*)(lds + L_DONE + 16);
        if ((d0.x & d0.y & d0.z & d0.w & d1.x & d1.y & d1.z & d1.w) != 0u) break;
        if (NG == 1) { if (knew >= 0) tile_commit(pre, lds + (knew & (W - 1)) * SLOT, sc, srp); pre = pre2; }
        else if (knew >= 0) { TileRegs t[4];
#pragma unroll
            for (int ps = 0; ps < 4; ++ps) tile_issue(t[ps], g, knew, past, L, sc, srp + 4 * ps, sh);
#pragma unroll
            for (int ps = 0; ps < 4; ++ps) tile_commit(t[ps], lds + (gi * W + (knew & (W - 1))) * SLOT, sc, srp + 4 * ps); }
        HG_BAR();
    }
    if (qvalid) { const GAS bf16* SG = (const GAS bf16*)(F.wsp() + WS_SGB) + qrow * 1024 + h * 128 + 4 * hh; GAS bf16* Y = (GAS bf16*)(F.wsp() + WS_Y) + (size_t)MTOT * 1024 + qrow * 1024 + h * 128 + 4 * hh;
        v2u sgv[4][4];
#pragma unroll
        for (int db = 0; db < 4; ++db)
#pragma unroll
            for (int gq = 0; gq < 4; ++gq) sgv[db][gq] = *(const GAS v2u*)(SG + 32 * db + 8 * gq);
#pragma unroll
        for (int db = 0; db < 4; ++db)
#pragma unroll
            for (int gq = 0; gq < 4; ++gq) { const v2u s = sgv[db][gq]; v2u o;
                o.x = cvt_pk_bf16(O[db][4 * gq] * bf_lo(s.x), O[db][4 * gq + 1] * bf_hi(s.x)); o.y = cvt_pk_bf16(O[db][4 * gq + 2] * bf_lo(s.y), O[db][4 * gq + 3] * bf_hi(s.y));
                *(GAS v2u*)(Y + 32 * db + 8 * gq) = o; } }
    HG_BAR();
}
constexpr int NU_P = BATCH * 8 * 9, NU_S = DBATCH * 8 / 4;
constexpr int NUNITS = NU_P + NU_S;
}

namespace pl {
constexpr int RS = 528;
constexpr int L_UT = 0, L_DF = 143 * RS, L_END = L_DF + 128 * RS;
static_assert(L_END <= LDS_MISC, "pool LDS");
constexpr int NU_P = BATCH * 17 * 4, NU_S = DBATCH * 4, NUNITS = NU_P + NU_S;
__device__ __forceinline__ void unit(Frame& F, int layer, int u) {
    LAS unsigned char* lds = F.lds; int tid = F.tid_(); asm volatile("" : "+v"(tid)); const int lane = tid & 63, wave = F.wave, l31 = lane & 31, hh = lane >> 5;
    const bool sample = u >= NU_P; int b, tile, g;
    if (!sample) { g = u & 3; const int x = u >> 2; b = x / 17; tile = x - b * 17; } else { const int x = u - NU_P; g = x & 3; b = x >> 2; tile = 0; }
    const int L = sample ? DSEQ : LP, t0 = tile * 128, nrows = min(128, L - t0), w = 2 << g;
    const size_t rowbase = sample ? (size_t)MPAD + (size_t)b * DSEQ : (size_t)b * LP;
    const GAS bf16* UA = (const GAS bf16*)(F.wsp() + WS_UA);
    { v4u sv[9];
#pragma unroll
      for (int q = 0; q < 9; ++q) { const int idx = tid + 512 * q, i = idx >> 5, ch = idx & 31, t = t0 - 15 + i; v4u v = {0u, 0u, 0u, 0u};
        if (idx < 143 * 32) { if (t >= 0 && t < L) v = *(const GAS v4u*)(UA + (rowbase + t) * 1024 + 256 * g + 8 * ch);
            else if (t < 0 && sample) { const GAS float* sp = F_state_pool + (((size_t)layer * DBATCH + b) * 15 + (15 + t)) * 1024 + 256 * g + 8 * ch; v = pg8::pack8(*(const GAS f32x4*)sp, *(const GAS f32x4*)(sp + 4)); } }
        sv[q] = v; }
#pragma unroll
      for (int q = 0; q < 9; ++q) { const int idx = tid + 512 * q, i = idx >> 5, ch = idx & 31; if (idx < 143 * 32) *(LAS v4u*)(lds + L_UT + i * RS + ch * 16) = sv[q]; } }
    const GAS bf16* WT = (const GAS bf16*)(F.wsp() + WS_WPOOL) + ((size_t)layer * 4 + g) * 65536 + (size_t)(32 * wave + l31) * 256 + 8 * hh;
    bf16x8 wf[16];
#pragma unroll
    for (int st = 0; st < 16; ++st) wf[st] = *(const GAS bf16x8*)(WT + 16 * st);
    const GAS float* sc = F_pool_scale + layer * 1024 + 256 * g + 32 * wave + 4 * hh; const GAS bf16* SGA = (const GAS bf16*)(F.wsp() + WS_SGA); GAS bf16* YA = (GAS bf16*)(F.wsp() + WS_Y);
    v4u sgq[8]; f32x4 scv[4];
#pragma unroll
    for (int q = 0; q < 8; ++q) { const int cq = tid + 512 * q, row = cq >> 5, ch8 = cq & 31;
        sgq[q] = __builtin_nontemporal_load((const GAS v4u*)(SGA + (rowbase + t0 + (row < nrows ? row : 0)) * 1024 + 256 * g + 8 * ch8)); }
#pragma unroll
    for (int gg = 0; gg < 4; ++gg) scv[gg] = *(const GAS f32x4*)(sc + 8 * gg);
    HG_BAR();
    { const int ch = tid & 31, rs = tid >> 5, r0 = 8 * rs; float sum[8];
#pragma unroll
      for (int j = 0; j < 8; ++j) sum[j] = 0.f;
      for (int j = 1; j < w; ++j) { const v4u v = *(const LAS v4u*)(lds + L_UT + (15 + r0 - j) * RS + ch * 16);
          sum[0] += bf_lo(v.x); sum[1] += bf_hi(v.x); sum[2] += bf_lo(v.y); sum[3] += bf_hi(v.y); sum[4] += bf_lo(v.z); sum[5] += bf_hi(v.z); sum[6] += bf_lo(v.w); sum[7] += bf_hi(v.w); }
#pragma unroll
      for (int i = 0; i < 8; ++i) { const int r = r0 + i; const v4u v = *(const LAS v4u*)(lds + L_UT + (15 + r) * RS + ch * 16);
          float x[8] = {bf_lo(v.x), bf_hi(v.x), bf_lo(v.y), bf_hi(v.y), bf_lo(v.z), bf_hi(v.z), bf_lo(v.w), bf_hi(v.w)};
          const float rc = sample ? 1.0f / (float)w : 1.0f / fminf((float)(t0 + r) + 1.0f, (float)w); float d[8];
#pragma unroll
          for (int j = 0; j < 8; ++j) { sum[j] += x[j]; d[j] = sum[j] * rc - x[j]; }
          *(LAS v4u*)(lds + L_DF + r * RS + ch * 16) = pg8::pack8((f32x4){d[0], d[1], d[2], d[3]}, (f32x4){d[4], d[5], d[6], d[7]});
          const v4u o = *(const LAS v4u*)(lds + L_UT + (15 + r - (w - 1)) * RS + ch * 16);
          sum[0] -= bf_lo(o.x); sum[1] -= bf_hi(o.x); sum[2] -= bf_lo(o.y); sum[3] -= bf_hi(o.y); sum[4] -= bf_lo(o.z); sum[5] -= bf_hi(o.z); sum[6] -= bf_lo(o.w); sum[7] -= bf_hi(o.w); } }
    HG_BAR();
    f32x16 acc[4] = {zero16(), zero16(), zero16(), zero16()};
#pragma unroll
    for (int st = 0; st < 16; ++st) { const bf16x8 a = wf[st];
#pragma unroll
        for (int rb = 0; rb < 4; ++rb) { const bf16x8 bb = *(const LAS bf16x8*)(lds + L_DF + (32 * rb + l31) * RS + (16 * st + 8 * hh) * 2); acc[rb] = mfma32(a, bb, acc[rb]); } }
    HG_BAR();
    constexpr int TS = 1040;
    static_assert(128 * TS <= L_END, "pool output image");
#pragma unroll
    for (int rb = 0; rb < 4; ++rb)
#pragma unroll
        for (int gg = 0; gg < 4; ++gg) { const f32x4 t = {acc[rb][4 * gg] * scv[gg][0], acc[rb][4 * gg + 1] * scv[gg][1], acc[rb][4 * gg + 2] * scv[gg][2], acc[rb][4 * gg + 3] * scv[gg][3]};
            *(LAS f32x4*)(lds + (32 * rb + l31) * TS + (32 * wave + 8 * gg + 4 * hh) * 4) = t; }
    HG_BAR();
#pragma unroll
    for (int q = 0; q < 8; ++q) { const int cq = tid + 512 * q, row = cq >> 5, ch8 = cq & 31;
        if (row < nrows) { const f32x4 a = *(const LAS f32x4*)(lds + row * TS + ch8 * 32), b = *(const LAS f32x4*)(lds + row * TS + ch8 * 32 + 16); const v4u s = sgq[q];
            const f32x4 ga = {bf_lo(s.x), bf_hi(s.x), bf_lo(s.y), bf_hi(s.y)}, gb = {bf_lo(s.z), bf_hi(s.z), bf_lo(s.w), bf_hi(s.w)};
            *(GAS v4u*)(YA + (rowbase + t0 + row) * 1024 + 256 * g + 8 * ch8) = pg8::pack8(a * ga, b * gb); } }
    HG_BAR();
}
}

#ifndef MERGE_TAIL
#define MERGE_TAIL 6
#endif
#ifndef WGM_PROJ
#define WGM_PROJ 4
#endif
#ifndef WGM_SQ
#define WGM_SQ 1
#endif
constexpr int U_HG_P = BATCH * 8, U_HG_S = DBATCH * 8;
constexpr int U0_HGS = U_HG_P, U0_ATT = U0_HGS + U_HG_S, U0_POOL = U0_ATT + sb::NUNITS, U_TOTAL = U0_POOL + pl::NUNITS;
__device__ __forceinline__ void phase_mixers(Frame& F, int layer, int qslot) {
    GAS unsigned* head = F.ctl() + CW_QUEUE + 64 * qslot;
    for (;;) {
        if (F.tid_() == 0) F.MISC[4] = __hip_atomic_fetch_add(head, 1u, __ATOMIC_RELAXED, __HIP_MEMORY_SCOPE_AGENT);
        HG_BAR();
        int u = (int)F.MISC[4];
        HG_BAR();
        if (u >= U_TOTAL) break;
        if (u >= U0_HGS && u < U0_POOL) u = u < U0_HGS + sb::NUNITS ? u + U_HG_S : u - sb::NUNITS;
        if (u < U0_ATT) { const bool smp = u >= U0_HGS; const int x = smp ? u - U0_HGS : u; hg::chain(F, layer, smp, x >> 3, x & 7); }
        else if (u < U0_POOL) { const int x = u - U0_ATT; if (x < sb::NU_P) sb::block_unit<1>(F, layer, x); else sb::block_unit<4>(F, layer, x - sb::NU_P); }
        else pl::unit(F, layer, u - U0_POOL);
    }
}

__device__ __forceinline__ void combine_merge(Frame& F) {
    pg8::Gemm g{nullptr, nullptr, 0, 0, MTOT / 256, D / 256, 3, D, MERGE_TAIL, WGM_SQ}; pg8::Order S; S.init(g, F.G, 0); if (!S.tail) return;
    const int gw = F.vcu * 8 + F.wave, NGW = F.G * 8, lane = F.lane_(), nrows = (S.nwg - S.G) * 256;
    const GAS bf16* sl = (const GAS bf16*)(F.wsp() + WS_SLAB_M); GAS bf16* M = (GAS bf16*)(F.wsp() + WS_MERGED);
    for (int x = gw; x < nrows; x += NGW) { const int j = x >> 8, r = x & 255; int pm, pn; S.tile_of(S.G + j, pm, pn);
        const GAS bf16* p = sl + (size_t)(MERGE_TAIL * j) * 65536 + (size_t)r * 256 + 4 * lane;
        f32x4 v = {0.f, 0.f, 0.f, 0.f};
#pragma unroll
        for (int q = 0; q < MERGE_TAIL; ++q) { const v2u t = *(const GAS v2u*)(p + (size_t)q * 65536); v += (f32x4){bf_lo(t.x), bf_hi(t.x), bf_lo(t.y), bf_hi(t.y)}; }
        v2u o; o.x = cvt_pk_bf16(v[0], v[1]); o.y = cvt_pk_bf16(v[2], v[3]); *(GAS v2u*)(M + (size_t)(256 * pm + r) * 1024 + 256 * pn + 4 * lane) = o; }
}
__device__ __forceinline__ f32x4 slab4_sum(const GAS bf16* p) {
    const v2u a = *(const GAS v2u*)p, b = *(const GAS v2u*)(p + 65536), c = *(const GAS v2u*)(p + 2 * 65536), d = *(const GAS v2u*)(p + 3 * 65536);
    return ((f32x4){bf_lo(a.x), bf_hi(a.x), bf_lo(a.y), bf_hi(a.y)} + (f32x4){bf_lo(b.x), bf_hi(b.x), bf_lo(b.y), bf_hi(b.y)}) + ((f32x4){bf_lo(c.x), bf_hi(c.x), bf_lo(c.y), bf_hi(c.y)} + (f32x4){bf_lo(d.x), bf_hi(d.x), bf_lo(d.y), bf_hi(d.y)}); }
__device__ __forceinline__ void combine_out(Frame& F, int last) {
    pg8::Gemm g{nullptr, nullptr, 0, 0, MTOT / 256, D / 256, 1, D, 4, WGM_SQ}; pg8::Order S; S.init(g, F.G, 0); if (!S.tail) return;
    const int gw = F.vcu * 8 + F.wave, NGW = F.G * 8, lane = F.lane_(), nrows = (S.nwg - S.G) * 256;
    const GAS bf16* sl = (const GAS bf16*)(F.wsp() + WS_SLAB_O); GAS bf16* HB = (GAS bf16*)(F.wsp() + WS_H); GAS float* out = F.outp();
    for (int x = gw; x < nrows; x += NGW) { const int j = x >> 8, r = x & 255; int pm, pn; S.tile_of(S.G + j, pm, pn);
        const GAS bf16* p = sl + (size_t)(4 * j) * 65536 + (size_t)r * 256 + 4 * lane; const int row = 256 * pm + r, col = 256 * pn + 4 * lane;
        const v2u hb = *(const GAS v2u*)(HB + (size_t)row * 1024 + col);
        const f32x4 v = (f32x4){bf_lo(hb.x), bf_hi(hb.x), bf_lo(hb.y), bf_hi(hb.y)} + slab4_sum(p);
        if (!last) { v2u o; o.x = cvt_pk_bf16(v[0], v[1]); o.y = cvt_pk_bf16(v[2], v[3]); *(GAS v2u*)(HB + (size_t)row * 1024 + col) = o; }
        else if (row >= MPAD) *(GAS f32x4*)(out + O_YS + (size_t)(row - MPAD) * 1024 + col) = v;
        else if (row < MP) { const int b = row / LP, t = row - b * LP; if (t >= NMETA) *(GAS f32x4*)(out + O_YP + ((size_t)b * SEQ + (t - NMETA)) * 1024 + col) = v; } }
}
__device__ __forceinline__ void phase_xn_fused(Frame& F, int l) {
    pg8::Gemm g{nullptr, nullptr, 0, 0, MTOT / 256, D / 256, 1, D, 4, WGM_SQ}; pg8::Order S; S.init(g, F.G, 0);
    LAS int* tab = (LAS int*)F.lds; const int tid = F.tid_(), lane = F.lane_();
    for (int i = tid; i < (MTOT / 256) * 4; i += 512) tab[i] = -1;
    __syncthreads();
    if (S.tail && tid < S.nwg - S.G) { int pm, pn; S.tile_of(S.G + tid, pm, pn); tab[4 * pm + pn] = tid; }
    __syncthreads();
    const int gw = F.vcu * 8 + F.wave, NGW = F.G * 8;
    GAS bf16* HB = (GAS bf16*)(F.wsp() + WS_H); GAS bf16* XN = (GAS bf16*)(F.wsp() + WS_XN); const GAS bf16* sl = (const GAS bf16*)(F.wsp() + WS_SLAB_O); const GAS float* gn = F_norm_g + (size_t)l * D;
    v2u nx[4];
    if (gw < MTOT) { const GAS v2u* p0 = (const GAS v2u*)(HB + (size_t)gw * D) + lane;
#pragma unroll
        for (int j = 0; j < 4; ++j) nx[j] = p0[64 * j]; }
    for (int r = gw; r < MTOT; r += NGW) {
        const v2u cur[4] = {nx[0], nx[1], nx[2], nx[3]};
        if (r + NGW < MTOT) { const GAS v2u* p1 = (const GAS v2u*)(HB + (size_t)(r + NGW) * D) + lane;
#pragma unroll
            for (int j = 0; j < 4; ++j) nx[j] = p1[64 * j]; }
        if (r >= MP && r < MPAD) { zero_xn_row(XN + (size_t)r * D, lane); continue; }
        GAS v2u* xb = (GAS v2u*)(HB + (size_t)r * D) + lane; const int pm = r >> 8, rr = r & 255;
        f32x4 v[4]; float s = 0.f;
#pragma unroll
        for (int j = 0; j < 4; ++j) { const int idx = tab[4 * pm + j]; const v2u t = cur[j]; v[j] = (f32x4){bf_lo(t.x), bf_hi(t.x), bf_lo(t.y), bf_hi(t.y)};
            if (idx >= 0) { v[j] += slab4_sum(sl + (size_t)(4 * idx) * 65536 + (size_t)rr * 256 + 4 * lane); v2u o; o.x = cvt_pk_bf16(v[j][0], v[j][1]); o.y = cvt_pk_bf16(v[j][2], v[j][3]); xb[64 * j] = o; }
            s += (v[j].x * v[j].x + v[j].y * v[j].y) + (v[j].z * v[j].z + v[j].w * v[j].w); }
        const float rs = frsq(wave_sum(s) * (1.f / D) + EPS);
        GAS v2u* o8 = (GAS v2u*)(XN + (size_t)r * D) + lane;
#pragma unroll
        for (int j = 0; j < 4; ++j) { const f32x4 gg = ((const GAS f32x4*)gn)[lane + 64 * j]; v2u o; o.x = cvt_pk_bf16(v[j].x * rs * gg.x, v[j].y * rs * gg.y); o.y = cvt_pk_bf16(v[j].z * rs * gg.z, v[j].w * rs * gg.w); o8[64 * j] = o; }
    }
    __syncthreads();
}
constexpr int NPHASES = 1 + 5 * DEPTH;
__global__ void __launch_bounds__(512, 2) mega_fwd(Params p) {
    extern __shared__ __attribute__((aligned(16))) unsigned char lds_raw[];
    Frame F;
    F.lds = (LAS unsigned char*)lds_raw; F.MISC = (volatile LAS unsigned*)(F.lds + LDS_MISC);
    F.wave = __builtin_amdgcn_readfirstlane((int)threadIdx.x >> 6);
    F.G = gridDim.x; { const int bx = blockIdx.x; F.vcu = (F.G % 8 == 0) ? (bx % 8) * (F.G / 8) + bx / 8 : bx; }
    if (threadIdx.x < 64) F.MISC[threadIdx.x] = 0u;
    if (threadIdx.x == 0) { LAS unsigned long long* P = (LAS unsigned long long*)(F.lds + LDS_PARAM);
        P[0] = (unsigned long long)p.in[0]; P[1] = (unsigned long long)p.in[1]; P[2] = (unsigned long long)p.in[2]; P[3] = (unsigned long long)p.in[3]; P[4] = (unsigned long long)p.in[4];
        P[5] = (unsigned long long)p.in[5]; P[6] = (unsigned long long)p.in[6]; P[7] = (unsigned long long)p.in[7]; P[8] = (unsigned long long)p.in[8]; P[9] = (unsigned long long)p.in[9];
        P[10] = (unsigned long long)p.in[10]; P[11] = (unsigned long long)p.in[11]; P[12] = (unsigned long long)p.in[12]; P[13] = (unsigned long long)p.in[13]; P[14] = (unsigned long long)p.in[14];
        P[15] = (unsigned long long)p.in[15]; P[16] = (unsigned long long)p.in[16]; P[17] = (unsigned long long)p.out; P[18] = (unsigned long long)p.ws; }
    __syncthreads();
    const int lo = p.ph_lo, hi = p.ph_hi;
    XcdBarrier bar; bar.bar = F.ctl() + CW_BAR; bar.x = 0; bar.st = nullptr; bar.leader = false;
    if (hi - lo > 1) bar = xcd_barrier_post(F.ctl() + CW_BAR, F.MISC, F.wave);
#define IN(k) (lo <= (k) && (k) < hi)
#define SEAM(k) do { if (IN(k) && IN((k) + 1)) xcd_barrier(bar, F.wave); } while (0)
    if (IN(0)) { phase_prologue(F); } SEAM(0);
    for (int l = 0; l < DEPTH; ++l) {
        const int pb = 1 + 5 * l;
        if (IN(pb)) { if (l > 0) phase_xn_fused(F, l); }
        if (l > 0) SEAM(pb);
        if (IN(pb + 1)) { pg8::Gemm g{(const GAS bf16*)(F.wsp() + WS_XN), (const GAS bf16*)(F.wsp() + WS_WIN) + (size_t)l * NPROJ * D, 0, 0, MTOT / 256, NPROJ / 256, 1, D, 0, WGM_PROJ};
            pg8::Order S; S.init(g, F.G, (int)blockIdx.x);
            pg8::EpiProj E{l, F.wsp(), F.outp(), F_qng + l * 128, F_kng + l * 128, (const GAS float*)(F.wsp() + WS_LB) + l * 1024};
            pg8::gemm_phase(F.lds, g, S, E, F.wave);
            } SEAM(pb + 1);
        if (IN(pb + 2)) { phase_mixers(F, l, l); } SEAM(pb + 2);
        if (IN(pb + 3)) { pg8::Gemm g{(const GAS bf16*)(F.wsp() + WS_Y), (const GAS bf16*)(F.wsp() + WS_WBR) + (size_t)l * 3 * D * D, (size_t)MTOT * 1024, (size_t)D * D, MTOT / 256, D / 256, 3, D, MERGE_TAIL, WGM_SQ};
            pg8::Order S; S.init(g, F.G, (int)blockIdx.x);
            pg8::EpiMerge E{F.wsp()};
            pg8::gemm_phase(F.lds, g, S, E, F.wave);
            { __syncthreads(); pg8::EpiMergeSlab E2{F.wsp()}; pg8::gemm_phase<pg8::EpiMergeSlab, 1>(F.lds, g, S, E2, F.wave); }
            } SEAM(pb + 3);
        if (IN(pb + 4)) { combine_merge(F); xcd_barrier(bar, F.wave);
            pg8::Gemm g{(const GAS bf16*)(F.wsp() + WS_MERGED), (const GAS bf16*)(F.wsp() + WS_WOUT) + (size_t)l * D * D, 0, 0, MTOT / 256, D / 256, 1, D, 4, WGM_SQ};
            pg8::Order S; S.init(g, F.G, (int)blockIdx.x);
            pg8::EpiOut E{F.wsp(), F.outp(), l == DEPTH - 1 ? 1 : 0};
            pg8::gemm_phase(F.lds, g, S, E, F.wave);
            { __syncthreads(); pg8::EpiOutSlab E2{F.wsp()}; pg8::gemm_phase<pg8::EpiOutSlab, 1>(F.lds, g, S, E2, F.wave); }
            xcd_barrier(bar, F.wave); if (l == DEPTH - 1) combine_out(F, 1);
            }
    }
#undef IN
#undef SEAM
}
extern "C" void kernel_launch(void* const* d_in, const int* in_sizes, int n_in, void* d_out, int out_size, void* d_ws, size_t ws_size, hipStream_t stream) {
    static int grid = 0;
    if (grid == 0) {
        if (n_in != 17 || out_size != (int)O_END || ws_size < WS_FAST_END) { fprintf(stderr, "kernel_launch: unexpected sizes (n_in %d, out %d, ws %zu < %zu)\n", n_in, out_size, ws_size, (size_t)WS_FAST_END); grid = -1; return; }
        int dev = 0, cus = 0, per_cu = 0;
        if (hipGetDevice(&dev) != hipSuccess || hipDeviceGetAttribute(&cus, hipDeviceAttributeMultiprocessorCount, dev) != hipSuccess) { grid = -1; return; }
        if (hipFuncSetAttribute((const void*)mega_fwd, hipFuncAttributeMaxDynamicSharedMemorySize, LDS_BYTES) != hipSuccess) { fprintf(stderr, "kernel_launch: hipFuncSetAttribute failed\n"); grid = -1; return; }
        if (hipOccupancyMaxActiveBlocksPerMultiprocessor(&per_cu, (const void*)mega_fwd, 512, LDS_BYTES) != hipSuccess || per_cu < 1) { fprintf(stderr, "kernel_launch: occupancy query says %d blocks per CU\n", per_cu); (void)hipGetLastError(); grid = -1; return; }
        grid = cus;
    }
    if (grid < 0) return;
    (void)hipMemsetAsync((char*)d_ws + WS_CTL, 0, CTL_ZERO_BYTES, stream);
    Params p{};
    for (int i = 0; i < 17; ++i) p.in[i] = (const float*)d_in[i];
    p.out = (float*)d_out; p.ws = (unsigned char*)d_ws;
    p.ph_lo = 0; p.ph_hi = NPHASES;
    hipLaunchKernelGGL(mega_fwd, dim3(grid), dim3(512), LDS_BYTES, stream, p);
}
```

```cpp
#define MK_LAUNCHES 1
#include <hip/hip_runtime.h>
#include <cstdio>
#include <cstdint>
constexpr int D = 1024, BATCH = 8, SEQ = 2048, DEPTH = 2, DBATCH = 32, DSEQ = 64, PAST = 2048, NMETA = 16;
constexpr int LP = NMETA + SEQ;
constexpr int MP = BATCH * LP;
constexpr int MPAD = 16640;
constexpr int MS = DBATCH * DSEQ;
constexpr int MTOT = MPAD + MS;
constexpr int NPROJ = 13 * 1024;
constexpr float EPS = 1e-6f, LB_FLOOR = 1e-30f, SB_SCALE = 0.08838834764831845f;
constexpr size_t O_YP = 0, O_YS = 16777216, O_KP = 18874368, O_VP = 52690944, O_PP = 86507520, O_HP = 86753280,
                 O_KS = 88850432, O_VS = 93044736, O_PS = 97239040, O_HS = 98222080, O_END = 106610688;
#define GAS __attribute__((address_space(1)))
#define LAS __attribute__((address_space(3)))
typedef unsigned short bf16;
typedef unsigned v4u __attribute__((ext_vector_type(4)));
typedef unsigned v2u __attribute__((ext_vector_type(2)));
typedef float f32x4 __attribute__((ext_vector_type(4)));
typedef float f32x2 __attribute__((ext_vector_type(2)));
typedef float f32x16 __attribute__((ext_vector_type(16)));
typedef short bf16x8 __attribute__((ext_vector_type(8)));
typedef short bf16x4 __attribute__((ext_vector_type(4)));
#define LDS_WAIT() asm volatile("s_waitcnt lgkmcnt(0)" ::: "memory")
#define VM_WAIT() asm volatile("s_waitcnt vmcnt(0)" ::: "memory")

typedef __bf16 bf16n2 __attribute__((ext_vector_type(2)));
__device__ __forceinline__ unsigned cvt_pk_bf16(float lo, float hi) { const f32x2 v = {lo, hi}; return __builtin_bit_cast(unsigned, __builtin_convertvector(v, bf16n2)); }
__device__ __forceinline__ float bf_lo(unsigned u) { return __uint_as_float(u << 16); }
__device__ __forceinline__ float bf_hi(unsigned u) { return __uint_as_float(u & 0xffff0000u); }
__device__ __forceinline__ float fexp2(float x) { return __builtin_amdgcn_exp2f(x); }
__device__ __forceinline__ float flog2(float x) { return __builtin_amdgcn_logf(x); }
__device__ __forceinline__ float frcp(float x) { return __builtin_amdgcn_rcpf(x); }
__device__ __forceinline__ float frsq(float x) { return __builtin_amdgcn_rsqf(x); }
__device__ __forceinline__ int lane_id() { unsigned z = 0u; asm volatile("" : "+v"(z)); return (int)__builtin_amdgcn_mbcnt_hi(~0u, __builtin_amdgcn_mbcnt_lo(~0u, z)); }
constexpr float LOG2E = 1.4426950408889634f, LN2 = 0.6931471805599453f;
__device__ __forceinline__ float fexp(float x) { return fexp2(x * LOG2E); }
__device__ __forceinline__ float fsigmoid(float x) { return frcp(1.0f + fexp2(-x * LOG2E)); }
__device__ __forceinline__ float fsilu(float x) { return x * fsigmoid(x); }

constexpr size_t MiB = 1u << 20;
constexpr size_t RB16 = (size_t)MTOT * 1024 * 2, RB32 = (size_t)MTOT * 1024 * 4;
constexpr size_t WS_CTL = 0, CTL_ZERO_BYTES = 64 * 1024;
constexpr size_t WS_RTAB = 1 * MiB + 64 * 1024;
constexpr size_t WS_LB = 1 * MiB;
constexpr size_t WS_WIN = 2 * MiB;
constexpr size_t WS_WBR = WS_WIN + (size_t)2 * NPROJ * 1024 * 2;
constexpr size_t WS_WOUT = WS_WBR + (size_t)6 * 1024 * 1024 * 2;
constexpr size_t WS_WPOOL = WS_WOUT + (size_t)2 * 1024 * 1024 * 2;
constexpr size_t WS_H = WS_WPOOL + 1 * MiB;
constexpr size_t WS_XN = WS_H + RB32;
constexpr size_t WS_UA = WS_XN + RB16, WS_SGA = WS_UA + RB16, WS_Q = WS_SGA + RB16, WS_SGB = WS_Q + RB16, WS_KC = WS_SGB + RB16,
                 WS_QC = WS_KC + RB16, WS_IC = WS_QC + RB16, WS_SGC = WS_IC + RB16, WS_GATE = WS_SGC + RB16  ,
                 WS_LOGF = WS_GATE + 3 * RB16  , WS_Y = WS_LOGF + RB32  , WS_MERGED = WS_Y + 3 * RB16, WS_FAST_END = WS_MERGED + RB16;
constexpr size_t WS_SLAB_M = WS_UA, WS_SLAB_O = WS_Q;
static_assert(108 * 262144 <= 2 * RB16 && 144 * 262144 <= 2 * RB16, "slabs");
constexpr int CW_QUEUE = 64;
constexpr int CW_BAR = 1024;

constexpr int LDS_BYTES = 160 * 1024;
constexpr int LDS_XCH = 128 * 1024;
constexpr int LDS_MISC = 159 * 1024;

#define XB_TMO      128
#define XB_XCNT(j)  (256  + 64 * (j))
#define XB_XSUB(j)  (1280 + 64 * (j))
#define XB_XGEN(j)  (2304 + 64 * (j))
#define XB_TOP      3328
#define XB_TOPGEN   3392
#define XCD_BAR_WORDS 3456
#define XB_SPIN_CAP (1u << 18)
__device__ __forceinline__ unsigned xb_ld(GAS unsigned* p)              { return __hip_atomic_load(p, __ATOMIC_RELAXED, __HIP_MEMORY_SCOPE_AGENT); }
__device__ __forceinline__ unsigned xb_add(GAS unsigned* p, unsigned v) { return __hip_atomic_fetch_add(p, v, __ATOMIC_RELAXED, __HIP_MEMORY_SCOPE_AGENT); }
__device__ __forceinline__ unsigned xb_xcc_id() { return (unsigned)__builtin_amdgcn_s_getreg((3 << 11) | 20) & 0xFu; }
#define XB_SPIN(cond, bar) do { unsigned _sp = 0; while (cond) { __builtin_amdgcn_s_sleep(1); \
    if ((++_sp & 255u) == 0u) { if (xb_ld(&(bar)[XB_TMO])) break; if (_sp > XB_SPIN_CAP) { xb_add(&(bar)[XB_TMO], 1u); break; } } } } while (0)
struct XcdBarrier { GAS unsigned* bar; unsigned x; volatile LAS unsigned* st; bool leader; };
__device__ __forceinline__ XcdBarrier xcd_barrier_post(GAS unsigned* bar, volatile LAS unsigned* st, int wave) {
    XcdBarrier b; b.bar = bar; b.x = xb_xcc_id(); b.st = st; b.leader = false;
    b.leader = (wave == 0) && (lane_id() == 0);
    if (b.leader) (void)xb_add(&bar[XB_XCNT(b.x)], 1u);
    return b;
}
__device__ __forceinline__ void xcd_barrier_complete(GAS unsigned* bar, unsigned x, unsigned& nloc, unsigned& nx) {
    const unsigned G = gridDim.x * gridDim.y * gridDim.z;
    unsigned sum, cnt, mine, sp = 0u;
    for (;;) {
        sum = 0u; cnt = 0u; mine = 0u;
#pragma unroll
        for (unsigned j = 0; j < 16; ++j) { const unsigned c = xb_ld(&bar[XB_XCNT(j)]); sum += c; cnt += (c > 0u) ? 1u : 0u; mine = (j == x) ? c : mine; }
        if (sum == G) break;
        __builtin_amdgcn_s_sleep(1);
        if ((++sp & 255u) == 0u) { if (xb_ld(&bar[XB_TMO])) break; if (sp > XB_SPIN_CAP) { xb_add(&bar[XB_TMO], 1u); break; } }
    }
    nloc = mine > 0u ? mine : 1u; nx = cnt > 0u ? cnt : 1u;
}
__device__ __forceinline__ void xcd_barrier(const XcdBarrier& b, int wave) {
    asm volatile("s_waitcnt vmcnt(0)" ::: "memory");
    __syncthreads();
    if (wave == 0 && lane_id() == 0) {
        GAS unsigned* bar = b.bar;
        __builtin_amdgcn_s_waitcnt(0);
        unsigned nloc = b.st[0], nx = b.st[1];
        if (nloc == 0u) { xcd_barrier_complete(bar, b.x, nloc, nx); b.st[0] = nloc; b.st[1] = nx; }
        const unsigned old = xb_add(&bar[XB_XSUB(b.x)], 1u);
        const unsigned gen = old / nloc;
        if (old + 1u == (gen + 1u) * nloc) {
            __builtin_amdgcn_fence(__ATOMIC_RELEASE, "agent");
            asm volatile("s_waitcnt vmcnt(0)" ::: "memory");
            const unsigned og = xb_add(&bar[XB_TOP], 1u);
            const unsigned tg = og / nx;
            if (og + 1u == (tg + 1u) * nx) xb_add(&bar[XB_TOPGEN], 1u);
            else XB_SPIN(xb_ld(&bar[XB_TOPGEN]) == tg, bar);
            __builtin_amdgcn_fence(__ATOMIC_ACQUIRE, "agent");
            xb_add(&bar[XB_XGEN(b.x)], 1u);
            asm volatile("s_waitcnt vmcnt(0)" ::: "memory");
        } else {
            XB_SPIN(xb_ld(&bar[XB_XGEN(b.x)]) == gen, bar);
            __builtin_amdgcn_fence(__ATOMIC_ACQUIRE, "agent");
            asm volatile("s_waitcnt vmcnt(0)" ::: "memory");
        }
    }
    __syncthreads();
}

struct Params { const float* in[17]; float* out; unsigned char* ws; int ph_lo, ph_hi; };
constexpr int LDS_PARAM = LDS_MISC + 256;
struct Frame {
    LAS unsigned char* lds; volatile LAS unsigned* MISC;
    int wave, G, vcu;
    __device__ __forceinline__ int lane_() const { return lane_id(); }
    __device__ __forceinline__ int tid_() const { return wave * 64 + lane_id(); }
    __device__ __forceinline__ unsigned long long rd(int i) const { const v2u v = *(const LAS v2u*)(lds + LDS_PARAM + 8 * i);
        return ((unsigned long long)(unsigned)__builtin_amdgcn_readfirstlane((int)v.y) << 32) | (unsigned)__builtin_amdgcn_readfirstlane((int)v.x); }
    __device__ __forceinline__ const GAS float* in(int i) const { return (const GAS float*)rd(i); }
    __device__ __forceinline__ GAS float* outp() const { return (GAS float*)rd(17); }
    __device__ __forceinline__ GAS unsigned char* wsp() const { return (GAS unsigned char*)rd(18); }
    __device__ __forceinline__ GAS unsigned* ctl() const { return (GAS unsigned*)(wsp() + WS_CTL); }
};
#define F_xp F.in(0)
#define F_xs F.in(1)
#define F_cache_k F.in(2)
#define F_cache_v F.in(3)
#define F_state_pool F.in(4)
#define F_state_hgrn F.in(5)
#define F_meta F.in(6)
#define F_norm_g F.in(7)
#define F_w_in F.in(8)
#define F_qng F.in(9)
#define F_kng F.in(10)
#define F_w_pool F.in(11)
#define F_pool_scale F.in(12)
#define F_hlb F.in(13)
#define F_hng F.in(14)
#define F_w_branch F.in(15)
#define F_w_out F.in(16)
__device__ __forceinline__ float wave_sum(float v) {
#pragma unroll
    for (int o = 1; o < 64; o <<= 1) v += __shfl_xor(v, o);
    return v;
}

__device__ __forceinline__ void p0_transpose_item(const GAS float* W, int K, int N, GAS bf16* WT, int item, int lane) {
    const int nblk = N / 64, kb = item / nblk, nb = item - kb * nblk, r = lane >> 4, c4 = lane & 15;
    const GAS float* src = W + (size_t)(64 * kb + 16 * r) * N + 64 * nb + 4 * c4;
    f32x4 v[16];
#pragma unroll
    for (int i = 0; i < 16; ++i) v[i] = __builtin_nontemporal_load((const GAS f32x4*)(src + (size_t)i * N));
    GAS bf16* dst = WT + (size_t)(64 * nb + 4 * c4) * K + 64 * kb + 16 * r;
#pragma unroll
    for (int j = 0; j < 4; ++j) { v4u a, b;
        a.x = cvt_pk_bf16(v[0][j], v[1][j]); a.y = cvt_pk_bf16(v[2][j], v[3][j]); a.z = cvt_pk_bf16(v[4][j], v[5][j]); a.w = cvt_pk_bf16(v[6][j], v[7][j]);
        b.x = cvt_pk_bf16(v[8][j], v[9][j]); b.y = cvt_pk_bf16(v[10][j], v[11][j]); b.z = cvt_pk_bf16(v[12][j], v[13][j]); b.w = cvt_pk_bf16(v[14][j], v[15][j]);
        *(GAS v4u*)(dst + (size_t)j * K) = a; *(GAS v4u*)(dst + (size_t)j * K + 8) = b; }
}
__device__ __forceinline__ void xn_row(const GAS float* src, GAS float* hdst, const GAS float* g, GAS bf16* xnrow, int lane) {
    const GAS f32x4* xr = (const GAS f32x4*)src + lane;
    f32x4 v[4]; float s = 0.f;
#pragma unroll
    for (int j = 0; j < 4; ++j) { v[j] = xr[64 * j]; s += (v[j].x * v[j].x + v[j].y * v[j].y) + (v[j].z * v[j].z + v[j].w * v[j].w); }
    if (hdst) { GAS v2u* ho = (GAS v2u*)hdst + lane;
#pragma unroll
        for (int j = 0; j < 4; ++j) { v2u o; o.x = cvt_pk_bf16(v[j].x, v[j].y); o.y = cvt_pk_bf16(v[j].z, v[j].w); ho[64 * j] = o; } }
    const float rs = frsq(wave_sum(s) * (1.f / D) + EPS);
    GAS v2u* o8 = (GAS v2u*)xnrow + lane;
#pragma unroll
    for (int j = 0; j < 4; ++j) { const f32x4 gg = ((const GAS f32x4*)g)[lane + 64 * j]; v2u o; o.x = cvt_pk_bf16(v[j].x * rs * gg.x, v[j].y * rs * gg.y); o.y = cvt_pk_bf16(v[j].z * rs * gg.z, v[j].w * rs * gg.w); o8[64 * j] = o; }
}
__device__ __forceinline__ void xn_row_regs(const f32x4 (&v)[4], GAS bf16* hdst, const GAS float* g, GAS bf16* xnrow, int lane) {
    float s = 0.f;
#pragma unroll
    for (int j = 0; j < 4; ++j) s += (v[j].x * v[j].x + v[j].y * v[j].y) + (v[j].z * v[j].z + v[j].w * v[j].w);
    { GAS v2u* ho = (GAS v2u*)hdst + lane;
#pragma unroll
      for (int j = 0; j < 4; ++j) { v2u o; o.x = cvt_pk_bf16(v[j].x, v[j].y); o.y = cvt_pk_bf16(v[j].z, v[j].w); ho[64 * j] = o; } }
    const float rs = frsq(wave_sum(s) * (1.f / D) + EPS);
    GAS v2u* o8 = (GAS v2u*)xnrow + lane;
#pragma unroll
    for (int j = 0; j < 4; ++j) { const f32x4 gg = ((const GAS f32x4*)g)[lane + 64 * j]; v2u o; o.x = cvt_pk_bf16(v[j].x * rs * gg.x, v[j].y * rs * gg.y); o.y = cvt_pk_bf16(v[j].z * rs * gg.z, v[j].w * rs * gg.w); o8[64 * j] = o; }
}
__device__ __forceinline__ void zero_xn_row(GAS bf16* xnrow, int lane) { GAS v2u* o8 = (GAS v2u*)xnrow + lane;
#pragma unroll
    for (int j = 0; j < 4; ++j) o8[64 * j] = (v2u){0u, 0u}; }

__device__ __forceinline__ void phase_prologue(Frame& F) {
    const int gw = F.vcu * 8 + F.wave, NGW = F.G * 8;
    constexpr int I_IN = (D / 64) * (NPROJ / 64), I_SQ = (D / 64) * (D / 64), I_PL = (256 / 64) * (256 / 64);
    constexpr int NITEMS = 2 * I_IN + 6 * I_SQ + 2 * I_SQ + 8 * I_PL;
    GAS bf16* win_t = (GAS bf16*)(F.wsp() + WS_WIN); GAS bf16* wbr_t = (GAS bf16*)(F.wsp() + WS_WBR); GAS bf16* wout_t = (GAS bf16*)(F.wsp() + WS_WOUT); GAS bf16* wpool_t = (GAS bf16*)(F.wsp() + WS_WPOOL);
    { constexpr int NB = NPROJ / 64, IPL = (D / 32) * NB, NIT = 2 * IPL;
      const int lr = F.lane_() >> 4, c4 = F.lane_() & 15;
      f32x4 nxw[8]; unsigned ndo = 0u;
      if (gw < NIT) { const int l = gw / IPL, item = gw - l * IPL, kb = item / NB, nb = item - kb * NB;
          const GAS float* s = F_w_in + (size_t)l * D * NPROJ + (size_t)(32 * kb + 8 * lr) * NPROJ + 64 * nb + 4 * c4; ndo = (unsigned)(l * NPROJ * D + (64 * nb + 4 * c4) * D + 32 * kb + 8 * lr);
#pragma unroll
          for (int i = 0; i < 8; ++i) nxw[i] = __builtin_nontemporal_load((const GAS f32x4*)(s + (size_t)i * NPROJ)); }
      for (int it = gw; it < NIT; it += NGW) {
          f32x4 v[8]; const unsigned dof = ndo;
#pragma unroll
          for (int i = 0; i < 8; ++i) v[i] = nxw[i];
          if (it + NGW < NIT) { const int x = it + NGW, l = x / IPL, item = x - l * IPL, kb = item / NB, nb = item - kb * NB;
              const GAS float* s = F_w_in + (size_t)l * D * NPROJ + (size_t)(32 * kb + 8 * lr) * NPROJ + 64 * nb + 4 * c4; ndo = (unsigned)(l * NPROJ * D + (64 * nb + 4 * c4) * D + 32 * kb + 8 * lr);
#pragma unroll
              for (int i = 0; i < 8; ++i) nxw[i] = __builtin_nontemporal_load((const GAS f32x4*)(s + (size_t)i * NPROJ)); }
#pragma unroll
          for (int jj = 0; jj < 4; ++jj) { v4u o; o.x = cvt_pk_bf16(v[0][jj], v[1][jj]); o.y = cvt_pk_bf16(v[2][jj], v[3][jj]); o.z = cvt_pk_bf16(v[4][jj], v[5][jj]); o.w = cvt_pk_bf16(v[6][jj], v[7][jj]);
              *(GAS v4u*)(win_t + dof + (size_t)jj * D) = o; }
      } }
    for (int it = 2 * I_IN + gw; it < NITEMS; it += NGW) {
        int r = it - 2 * I_IN;
        if (r < 6 * I_SQ) { const int m = r / I_SQ; p0_transpose_item(F_w_branch + (size_t)m * D * D, D, D, wbr_t + (size_t)m * D * D, r % I_SQ, F.lane_()); continue; } r -= 6 * I_SQ;
        if (r < 2 * I_SQ) { const int m = r / I_SQ; p0_transpose_item(F_w_out + (size_t)m * D * D, D, D, wout_t + (size_t)m * D * D, r % I_SQ, F.lane_()); continue; } r -= 2 * I_SQ;
        { const int m = r / I_PL; p0_transpose_item(F_w_pool + (size_t)m * 65536, 256, 256, wpool_t + (size_t)m * 65536, r % I_PL, F.lane_()); }
    }
    GAS float* H = (GAS float*)(F.wsp() + WS_H); GAS bf16* XN = (GAS bf16*)(F.wsp() + WS_XN);
#define P0_SRC(x, dst) do { if ((x) >= MP && (x) < MPAD) dst = F_meta;   \
        else if ((x) < MP) { const int b_ = (x) / LP, t_ = (x) - b_ * LP; dst = (t_ < NMETA) ? F_meta + (size_t)t_ * D : F_xp + ((size_t)b_ * SEQ + (t_ - NMETA)) * D; } \
        else dst = F_xs + (size_t)((x) - MPAD) * D; } while (0)
    f32x4 nx[4];
    if (gw < MTOT) { const GAS float* s0; P0_SRC(gw, s0); const GAS f32x4* p0 = (const GAS f32x4*)s0 + F.lane_();
#pragma unroll
        for (int j = 0; j < 4; ++j) nx[j] = p0[64 * j]; }
    for (int r = gw; r < MTOT; r += NGW) {
        const f32x4 cur[4] = {nx[0], nx[1], nx[2], nx[3]};
        if (r + NGW < MTOT) { const GAS float* s1; P0_SRC(r + NGW, s1); const GAS f32x4* p1 = (const GAS f32x4*)s1 + F.lane_();
#pragma unroll
            for (int j = 0; j < 4; ++j) nx[j] = p1[64 * j]; }
        GAS bf16* hrow = (GAS bf16*)(F.wsp() + WS_H) + (size_t)r * D;
        if (r >= MP && r < MPAD) { zero_xn_row(XN + (size_t)r * D, F.lane_()); zero_xn_row(hrow, F.lane_()); continue; }
        xn_row_regs(cur, hrow, F_norm_g, XN + (size_t)r * D, F.lane_());
    }
#undef P0_SRC
    if (blockIdx.x == 0) { GAS float* lbp = (GAS float*)(F.wsp() + WS_LB);
        for (int i = F.tid_(); i < 1024; i += 512) { const float a = F_hlb[i], b = F_hlb[1024 + i], m = fmaxf(a, b), ea = expf(a - m), eb = expf(b - m), s = ea + eb; const float s0 = ea / s, s1 = eb / s;
            lbp[i] = s0 - s0; lbp[1024 + i] = (s0 + s1) - s0; } }
}
__device__ __forceinline__ void phase_xn(Frame& F, int l) {
    const int gw = F.vcu * 8 + F.wave, NGW = F.G * 8;
    GAS float* H = (GAS float*)(F.wsp() + WS_H); GAS bf16* XN = (GAS bf16*)(F.wsp() + WS_XN);
    for (int r = gw; r < MTOT; r += NGW) {
        if (r >= MP && r < MPAD) { zero_xn_row(XN + (size_t)r * D, F.lane_()); continue; }
        xn_row(H + (size_t)r * D, nullptr, F_norm_g + (size_t)l * D, XN + (size_t)r * D, F.lane_());
    }
}
namespace pg8 {
constexpr int BM = 256, BK = 64, HALF = 128, HTB = HALF * BK * 2, STAGE_BYTES = 8 * HTB, NXCD = 8;
__host__ __device__ __forceinline__ int lds_byte(int r, int c) { const int st = (r >> 4) * 2 + (c >> 5), rr = r & 15, cc = c & 31, ob = rr * 64 + cc * 2; return st * 1024 + (ob ^ (((ob >> 9) & 1) << 5)); }
__host__ __device__ __forceinline__ void stage_rc(int b, int& R, int& C) { const int st = b / 1024, sb = b % 1024, swz = sb ^ (((sb >> 9) & 1) << 5); R = (st >> 1) * 16 + swz / 64; C = (st & 1) * 32 + (swz % 64) / 2; }
__host__ __device__ __forceinline__ int perm32(int rho) { const int n = rho >> 4, i = rho & 15; return 8 * (i >> 2) + 4 * n + (i & 3); }

struct Unit { int pm, pn, seg, k0, nk, slab; };
struct Gemm { const GAS bf16* A; const GAS bf16* Bt; size_t a_seg, b_seg; int nM, nN, nseg, K, tail_parts, wgm; };

struct Order {
    int nM, nN, nwg, G, c, nseg, nt, tail, WGM;
    __device__ void init(const Gemm& g, int G_, int c_) { WGM = g.wgm; nM = g.nM; nN = g.nN; nwg = nM * nN; G = G_; c = c_; nseg = g.nseg; nt = g.K / BK;
        tail = (g.tail_parts > 0 && nwg > G && nwg <= 2 * G && (nwg - G) * g.tail_parts <= G && g.tail_parts % nseg == 0 && (nt % (2 * (g.tail_parts / nseg))) == 0) ? g.tail_parts : 0; }
    __device__ void tile_of(int L, int& pm, int& pn) const {
        int wgid = L; { const int q = nwg / NXCD, r = nwg % NXCD, xcd = wgid % NXCD, off = wgid / NXCD; wgid = (xcd < r ? xcd * (q + 1) : r * (q + 1) + (xcd - r) * q) + off; }
        const int nig = WGM * nN, gid = wgid / nig, fm = gid * WGM, gsz = (nM - fm) < WGM ? (nM - fm) : WGM;
        pm = fm + ((wgid % nig) % gsz); pn = (wgid % nig) / gsz; }
    template <int MODE> __device__ bool next(int i, Unit& u) const {
        u.k0 = 0; u.nk = nt; u.slab = -1;
        if (MODE == 0) {
            if (tail == 0) { const int ti = i / nseg; u.seg = i - ti * nseg; const long L = (long)ti * G + c; if (L >= nwg) return false; tile_of((int)L, u.pm, u.pn); return true; }
            if (i >= nseg) return false; u.seg = i; tile_of(c, u.pm, u.pn); return true; }
        if (tail == 0 || i > 0 || c >= (nwg - G) * tail) return false;
        const int j = c / tail, part = c - j * tail; tile_of(G + j, u.pm, u.pn); u.slab = c;
        { const int ks = tail / nseg; u.seg = part / ks; u.nk = nt / ks; u.k0 = (part - u.seg * ks) * u.nk; }
        return true;
    }
};

typedef f32x4 Acc[2][2][4][2];

template <class Epi, int MODE = 0>
__device__ __forceinline__ void gemm_phase(LAS unsigned char* lds, const Gemm g, const Order& S, const Epi& E, int wave_id) {
    const int wid = wave_id, lane = lane_id(), tid = wid * 64 + lane; const int wr = wid >> 2, wc = wid & 3, fr = lane & 15, fq = lane >> 4;
    const int K = g.K;
    unsigned voffA[2], voffB[2];
#pragma unroll
    for (int i = 0; i < 2; ++i) { int R, C; stage_rc(tid * 16 + i * 8192, R, C); const int Rb = (R & ~31) + perm32(R & 31);
        voffA[i] = (unsigned)(R * K + C) * 2u; voffB[i] = (unsigned)(Rb * K + C) * 2u; }
    const size_t kstep = (size_t)(BK * 2);
    const size_t hstep = (size_t)HALF * K * 2;
    const size_t tstep = 2 * hstep;
    const unsigned ldsw = (unsigned)wid * 1024u;
    const int aoff = lds_byte(wr * 64 + fr, fq * 8), boff = lds_byte(wc * 32 + fr, fq * 8);
#define PG8_SA(b, h) (((b) * 2 + (h)) * HTB)
#define PG8_SB(b, h) ((4 + (b) * 2 + (h)) * HTB)
#define PG8_STAGE(bufoff, gbase, voff) do { _Pragma("unroll") for (int _i = 0; _i < 2; ++_i) \
        __builtin_amdgcn_global_load_lds((const GAS unsigned*)((const GAS char*)(gbase) + (voff)[_i]), (LAS unsigned*)(lds + (bufoff) + ldsw + _i * 8192), 16, 0, 0); } while (0)
#define PG8_LDA(dst, b, h) do { _Pragma("unroll") for (int m = 0; m < 4; ++m) _Pragma("unroll") for (int k = 0; k < 2; ++k) dst[m][k] = *(const LAS bf16x8*)(lds + PG8_SA(b, h) + aoff + m * 2048 + k * 1024); } while (0)
#define PG8_LDB(dst, b, h) do { _Pragma("unroll") for (int n = 0; n < 2; ++n) _Pragma("unroll") for (int k = 0; k < 2; ++k) dst[n][k] = *(const LAS bf16x8*)(lds + PG8_SB(b, h) + boff + n * 2048 + k * 1024); } while (0)
#define PG8_MMA(ai, bj, At, Bt) do { __builtin_amdgcn_s_setprio(1); _Pragma("unroll") for (int m = 0; m < 4; ++m) _Pragma("unroll") for (int n = 0; n < 2; ++n) _Pragma("unroll") for (int k = 0; k < 2; ++k) \
        acc[ai][bj][m][n] = __builtin_amdgcn_mfma_f32_16x16x32_bf16(Bt[n][k], At[m][k], acc[ai][bj][m][n], 0, 0, 0); __builtin_amdgcn_s_setprio(0); } while (0)
#define PG8_WAIT_V(n) asm volatile("s_waitcnt vmcnt(" #n ")" ::: "memory")
#define PG8_WAIT_L(n) asm volatile("s_waitcnt lgkmcnt(" #n ")" ::: "memory")
#define PG8_BAR __builtin_amdgcn_s_barrier()
#define PG8_SCHED __builtin_amdgcn_sched_barrier(0)
    Unit cur, nxt; int ui = 0;
    if (!S.template next<MODE>(0, cur)) return;
    Acc acc;
#pragma unroll
    for (int a = 0; a < 2; ++a)
#pragma unroll
        for (int b = 0; b < 2; ++b)
#pragma unroll
            for (int m = 0; m < 4; ++m)
#pragma unroll
                for (int n = 0; n < 2; ++n) acc[a][b][m][n] = (f32x4){0.f, 0.f, 0.f, 0.f};
    bf16x8 At[4][2], B0[2][2], B1[2][2];
    const GAS char* cA = (const GAS char*)(g.A + (size_t)cur.seg * g.a_seg) + (size_t)cur.pm * tstep + (MODE ? (size_t)cur.k0 * kstep : 0); const GAS char* cB = (const GAS char*)(g.Bt + (size_t)cur.seg * g.b_seg) + (size_t)cur.pn * tstep + (MODE ? (size_t)cur.k0 * kstep : 0);
    PG8_STAGE(PG8_SB(0, 0), cB, voffB); PG8_STAGE(PG8_SB(0, 1), cB + hstep, voffB); PG8_STAGE(PG8_SA(0, 0), cA, voffA); PG8_STAGE(PG8_SA(0, 1), cA + hstep, voffA);
    if (wr == 1) PG8_BAR;
    PG8_WAIT_V(2); PG8_BAR;
    PG8_STAGE(PG8_SB(1, 0), cB + kstep, voffB); PG8_STAGE(PG8_SA(1, 0), cA + kstep, voffA); PG8_STAGE(PG8_SB(1, 1), cB + hstep + kstep, voffB);
    PG8_WAIT_V(6); PG8_BAR;
    for (;;) {
        const bool has_next = S.template next<MODE>(ui + 1, nxt);
        const GAS char* nA = has_next ? (const GAS char*)(g.A + (size_t)nxt.seg * g.a_seg) + (size_t)nxt.pm * tstep + (MODE ? (size_t)nxt.k0 * kstep : 0) : cA; const GAS char* nB = has_next ? (const GAS char*)(g.Bt + (size_t)nxt.seg * g.b_seg) + (size_t)nxt.pn * tstep + (MODE ? (size_t)nxt.k0 * kstep : 0) : cB;
        const int nt = MODE == 0 ? K / BK : cur.nk;
        for (int t = 0; t < nt; t += 2) {
            const bool last = (t == nt - 2);
            const GAS char* a1 = cA + (size_t)(t + 1) * kstep;
            const GAS char* a2 = last ? nA : cA + (size_t)(t + 2) * kstep; const GAS char* b2 = last ? nB : cB + (size_t)(t + 2) * kstep;
            const GAS char* a3 = a2 + kstep; const GAS char* b3 = b2 + kstep;
            PG8_LDB(B0, 0, 0); PG8_LDB(B1, 0, 1); PG8_SCHED; PG8_LDA(At, 0, 0); PG8_STAGE(PG8_SA(1, 1), a1 + hstep, voffA);
            PG8_WAIT_V(8); PG8_WAIT_L(0); PG8_BAR; PG8_MMA(0, 0, At, B0); PG8_MMA(0, 1, At, B1); PG8_BAR; PG8_SCHED;
            PG8_LDA(At, 0, 1); PG8_STAGE(PG8_SB(0, 0), b2, voffB); PG8_STAGE(PG8_SB(0, 1), b2 + hstep, voffB); PG8_STAGE(PG8_SA(0, 0), a2, voffA);
            PG8_WAIT_V(8); PG8_WAIT_L(0); PG8_BAR; PG8_MMA(1, 0, At, B0); PG8_MMA(1, 1, At, B1); PG8_BAR; PG8_SCHED;
            PG8_LDB(B0, 1, 0); PG8_LDB(B1, 1, 1); PG8_SCHED; PG8_LDA(At, 1, 0); PG8_STAGE(PG8_SA(0, 1), a2 + hstep, voffA);
            PG8_WAIT_V(8); PG8_WAIT_L(0); PG8_BAR; PG8_MMA(0, 0, At, B0); PG8_MMA(0, 1, At, B1); PG8_BAR; PG8_SCHED;
            PG8_LDA(At, 1, 1); PG8_STAGE(PG8_SB(1, 0), b3, voffB); PG8_STAGE(PG8_SB(1, 1), b3 + hstep, voffB); PG8_STAGE(PG8_SA(1, 0), a3, voffA);
            PG8_WAIT_V(8); PG8_WAIT_L(0); PG8_BAR; PG8_MMA(1, 0, At, B0); PG8_MMA(1, 1, At, B1); PG8_BAR; PG8_SCHED;
        }
        if (wr == 0) PG8_BAR;
        E(acc, cur, wr, wc, fr, fq, lds);
        if (!has_next) break;
        if (MODE == 1 || cur.seg == g.nseg - 1) {
#pragma unroll
            for (int a = 0; a < 2; ++a)
#pragma unroll
                for (int b = 0; b < 2; ++b)
#pragma unroll
                    for (int m = 0; m < 4; ++m)
#pragma unroll
                        for (int n = 0; n < 2; ++n) acc[a][b][m][n] = (f32x4){0.f, 0.f, 0.f, 0.f};
        }
        cur = nxt; cA = nA; cB = nB; ++ui;
        if (wr == 1) PG8_BAR;
    }
    PG8_WAIT_V(0);
    PG8_BAR;
#undef PG8_SA
#undef PG8_SB
#undef PG8_STAGE
#undef PG8_LDA
#undef PG8_LDB
#undef PG8_MMA
#undef PG8_WAIT_V
#undef PG8_WAIT_L
#undef PG8_BAR
#undef PG8_SCHED
}

typedef _Float16 h16x2 __attribute__((ext_vector_type(2)));
__device__ __forceinline__ unsigned cvt_pk_f16(float a, float b) { const f32x2 t = {a, b}; return __builtin_bit_cast(unsigned, __builtin_convertvector(t, h16x2)); }
__device__ __forceinline__ v4u pack8h(const f32x4 a, const f32x4 b) { v4u w; w.x = cvt_pk_f16(a[0], a[1]); w.y = cvt_pk_f16(a[2], a[3]); w.z = cvt_pk_f16(b[0], b[1]); w.w = cvt_pk_f16(b[2], b[3]); return w; }
#define EPI_FOR_ROWS for (int ai = 0; ai < 2; ++ai) _Pragma("unroll") for (int m = 0; m < 4; ++m)
__device__ __forceinline__ v4u pack8(const f32x4 a, const f32x4 b) { v4u w; w.x = cvt_pk_bf16(a[0], a[1]); w.y = cvt_pk_bf16(a[2], a[3]); w.z = cvt_pk_bf16(b[0], b[1]); w.w = cvt_pk_bf16(b[2], b[3]); return w; }

#define NT_ST(p, v) __builtin_nontemporal_store((v), (p))
struct EpiProj {
    int layer; GAS unsigned char* ws; GAS float* out; const GAS float* qng; const GAS float* kng; const GAS float* lb;
    __device__ __forceinline__ void operator()(Acc& acc, const Unit& u, int wr, int wc, int fr, int fq, LAS unsigned char* lds) const {
        const int grp = u.pn >> 2, ct = u.pn & 3;
        const int row0 = u.pm * BM + wr * 64 + fr;
        const int cg0 = ct * 256 + wc * 32 + 8 * fq;
        const bool sample = u.pm >= MPAD / 256;
        if (grp == 2 || grp == 3) {
            LAS float* X = (LAS float*)(lds + LDS_XCH);
#pragma unroll
            EPI_FOR_ROWS {
#pragma unroll
                for (int bj = 0; bj < 2; ++bj) { const f32x4 a = acc[ai][bj][m][0], b = acc[ai][bj][m][1];
                    float s = (a[0] * a[0] + a[1] * a[1]) + (a[2] * a[2] + a[3] * a[3]) + (b[0] * b[0] + b[1] * b[1]) + (b[2] * b[2] + b[3] * b[3]);
                    s += __shfl_xor(s, 16); s += __shfl_xor(s, 32);
                    if (fq == 0) X[(ai * 128 + wr * 64 + m * 16 + fr) * 8 + bj * 4 + wc] = s; } }
            LDS_WAIT(); __builtin_amdgcn_s_barrier(); asm volatile("" ::: "memory");
            const GAS float* gv = (grp == 2 ? qng : kng) + wc * 32 + 8 * fq; const float qs = (grp == 2) ? SB_SCALE * LOG2E : 1.0f;
            const f32x4 g0 = *(const GAS f32x4*)gv * qs, g1 = *(const GAS f32x4*)(gv + 4) * qs;
            GAS bf16* qdst = (GAS bf16*)(ws + WS_Q);
            GAS float* kdst = sample ? out + O_KS + (size_t)layer * MS * 1024 - (size_t)MPAD * 1024 : out + O_KP + (size_t)layer * MP * 1024;
#pragma unroll
            EPI_FOR_ROWS { const int row = row0 + ai * 128 + m * 16;
#pragma unroll
                for (int bj = 0; bj < 2; ++bj) { const f32x4 p = *(const LAS f32x4*)(X + (ai * 128 + wr * 64 + m * 16 + fr) * 8 + bj * 4);
                    const float rs = frsq(((p[0] + p[1]) + (p[2] + p[3])) * (1.0f / 128.0f) + EPS);
                    const f32x4 a = acc[ai][bj][m][0] * rs * g0, b = acc[ai][bj][m][1] * rs * g1; const int col = cg0 + bj * 128;
                    if (grp == 2) NT_ST((GAS v4u*)(qdst + (size_t)row * 1024 + col), pack8(a, b));
                    else if (sample || row < MP) { GAS float* d = kdst + (size_t)row * 1024 + col; NT_ST((GAS f32x4*)d, a); NT_ST((GAS f32x4*)(d + 4), b); } } }
            return;
        }
        if (grp == 4) {
            GAS float* vdst = sample ? out + O_VS + (size_t)layer * MS * 1024 - (size_t)MPAD * 1024 : out + O_VP + (size_t)layer * MP * 1024;
#pragma unroll
            EPI_FOR_ROWS { const int row = row0 + ai * 128 + m * 16;
                if (sample || row < MP) {
#pragma unroll
                    for (int bj = 0; bj < 2; ++bj) { GAS float* d = vdst + (size_t)row * 1024 + cg0 + bj * 128; NT_ST((GAS f32x4*)d, acc[ai][bj][m][0]); NT_ST((GAS f32x4*)(d + 4), acc[ai][bj][m][1]); } } }
            return;
        }
        if (grp == 6) {
            GAS _Float16* lf = (GAS _Float16*)(ws + WS_LOGF); GAS bf16* kc = (GAS bf16*)(ws + WS_KC);
#pragma unroll
            for (int bj = 0; bj < 2; ++bj) { const int col = cg0 + bj * 128; const f32x4 l0 = *(const GAS f32x4*)(lb + col), l1 = *(const GAS f32x4*)(lb + col + 4);
#pragma unroll
                EPI_FOR_ROWS { const int row = row0 + ai * 128 + m * 16; f32x4 z[2] = {acc[ai][bj][m][0], acc[ai][bj][m][1]}; f32x4 lo[2], ko[2];
#pragma unroll
                    for (int n = 0; n < 2; ++n)
#pragma unroll
                        for (int j = 0; j < 4; ++j) { const float zz = z[n][j], l = n ? l1[j] : l0[j], e = fexp2(-fabsf(zz) * LOG2E), r = frcp(1.0f + e), er = e * r;
                            const float sp = zz >= 0.f ? r : er, sn = zz >= 0.f ? er : r, oml = 1.0f - l;
                            lo[n][j] = flog2(l + oml * sp); ko[n][j] = oml * sn; }
                    NT_ST((GAS v4u*)(lf + (size_t)row * 1024 + col), pack8h(lo[0], lo[1]));
                    NT_ST((GAS v4u*)(kc + (size_t)row * 1024 + col), pack8(ko[0], ko[1])); } }
            return;
        }
        size_t off; int act;
        switch (grp) {
            case 0: off = WS_UA; act = 0; break;   case 1: off = WS_SGA; act = 1; break;  case 5: off = WS_SGB; act = 1; break;
            case 7: off = WS_QC; act = 1; break;   case 8: off = WS_IC; act = 0; break;   case 9: off = WS_SGC; act = 1; break;
            default: off = WS_GATE + (size_t)(grp - 10) * RB16; act = 2; break;
        }
        GAS bf16* dst = (GAS bf16*)(ws + off);
#pragma unroll
        EPI_FOR_ROWS { const int row = row0 + ai * 128 + m * 16;
#pragma unroll
            for (int bj = 0; bj < 2; ++bj) { f32x4 a = acc[ai][bj][m][0], b = acc[ai][bj][m][1];
                if (act) {
#pragma unroll
                    for (int j = 0; j < 4; ++j) { const float sa = fsigmoid(a[j]), sb = fsigmoid(b[j]);
                        a[j] = act == 1 ? a[j] * sa : fmaxf(sa, 1e-30f); b[j] = act == 1 ? b[j] * sb : fmaxf(sb, 1e-30f); } }
                NT_ST((GAS v4u*)(dst + (size_t)row * 1024 + cg0 + bj * 128), pack8(a, b)); } }
        if (grp == 0) {
#pragma unroll
            EPI_FOR_ROWS { const int row = row0 + ai * 128 + m * 16; GAS float* d = nullptr;
                if (sample) { const int rr = row - MPAD, b = rr >> 6, i = rr & 63; if (i >= DSEQ - 15) d = out + O_PS + (((size_t)layer * DBATCH + b) * 15 + (i - (DSEQ - 15))) * 1024; }
                else if (row < MP) { const int b = row / LP, t = row - b * LP; if (t >= LP - 15) d = out + O_PP + (((size_t)layer * BATCH + b) * 15 + (t - (LP - 15))) * 1024; }
                if (d) {
#pragma unroll
                    for (int bj = 0; bj < 2; ++bj) { GAS float* dd = d + cg0 + bj * 128; NT_ST((GAS f32x4*)dd, acc[ai][bj][m][0]); NT_ST((GAS f32x4*)(dd + 4), acc[ai][bj][m][1]); } } }
        }
    }
};

struct EpiMerge {
    GAS unsigned char* ws;
    __device__ __forceinline__ void operator()(Acc& acc, const Unit& u, int wr, int wc, int fr, int fq, LAS unsigned char* lds) const {
        const int row0 = u.pm * BM + wr * 64 + fr, c0 = u.pn * BM + wc * 32 + 8 * fq;
        const GAS bf16* G0 = (const GAS bf16*)(ws + WS_GATE) + (size_t)u.seg * MTOT * 1024; const GAS bf16* G1 = G0 + (size_t)MTOT * 1024; GAS bf16* dst = (GAS bf16*)(ws + WS_MERGED);
        const bool fin = u.seg == 2;
#pragma unroll
        for (int ai = 0; ai < 2; ++ai)
#pragma unroll
        for (int mh = 0; mh < 2; ++mh) {
            v4u ga[2][2], gb[2][2];
#pragma unroll
            for (int mm = 0; mm < 2; ++mm)
#pragma unroll
                for (int bj = 0; bj < 2; ++bj) { const size_t ro = (size_t)(row0 + ai * 128 + (2 * mh + mm) * 16) * 1024 + c0 + bj * 128; ga[mm][bj] = *(const GAS v4u*)(G0 + ro); gb[mm][bj] = fin ? ga[mm][bj] : *(const GAS v4u*)(G1 + ro); }
#pragma unroll
            for (int mm = 0; mm < 2; ++mm)
#pragma unroll
                for (int bj = 0; bj < 2; ++bj) { const int m = 2 * mh + mm; const v4u x = ga[mm][bj], y = gb[mm][bj];
                    f32x4 fa0 = {bf_lo(x.x), bf_hi(x.x), bf_lo(x.y), bf_hi(x.y)}, fa1 = {bf_lo(x.z), bf_hi(x.z), bf_lo(x.w), bf_hi(x.w)};
                    if (!fin) { const f32x4 fb0 = {bf_lo(y.x), bf_hi(y.x), bf_lo(y.y), bf_hi(y.y)}, fb1 = {bf_lo(y.z), bf_hi(y.z), bf_lo(y.w), bf_hi(y.w)};
#pragma unroll
                        for (int j = 0; j < 4; ++j) { fa0[j] *= frcp(fb0[j]); fa1[j] *= frcp(fb1[j]); } }
                    acc[ai][bj][m][0] *= fa0; acc[ai][bj][m][1] *= fa1;
                    if (fin) *(GAS v4u*)(dst + (size_t)(row0 + ai * 128 + m * 16) * 1024 + c0 + bj * 128) = pack8(acc[ai][bj][m][0], acc[ai][bj][m][1]); }
        }
    }
};

struct EpiOut {
    GAS unsigned char* ws; GAS float* out; int last;
    __device__ __forceinline__ void operator()(Acc& acc, const Unit& u, int wr, int wc, int fr, int fq, LAS unsigned char* lds) const {
        const int row0 = u.pm * BM + wr * 64 + fr, c0 = u.pn * BM + wc * 32 + 8 * fq; GAS bf16* HB = (GAS bf16*)(ws + WS_H);
        const bool sample = u.pm >= MPAD / 256;
#pragma unroll
        for (int ai = 0; ai < 2; ++ai) {
            v4u hb[4][2];
#pragma unroll
            for (int m = 0; m < 4; ++m)
#pragma unroll
                for (int bj = 0; bj < 2; ++bj) hb[m][bj] = *(const GAS v4u*)(HB + (size_t)(row0 + ai * 128 + m * 16) * 1024 + c0 + bj * 128);
#pragma unroll
            for (int m = 0; m < 4; ++m) { const int row = row0 + ai * 128 + m * 16;
                if (last) { GAS float* dp; bool ok = true;
                    if (sample) dp = out + O_YS + (size_t)(row - MPAD) * 1024 + c0;
                    else { const int b = row / LP, t = row - b * LP; ok = row < MP && t >= NMETA; dp = out + O_YP + ((size_t)b * SEQ + (t - NMETA)) * 1024 + c0; }
                    if (ok) {
#pragma unroll
                        for (int bj = 0; bj < 2; ++bj) { const v4u t = hb[m][bj];
                            *(GAS f32x4*)(dp + bj * 128) = (f32x4){bf_lo(t.x), bf_hi(t.x), bf_lo(t.y), bf_hi(t.y)} + acc[ai][bj][m][0]; *(GAS f32x4*)(dp + bj * 128 + 4) = (f32x4){bf_lo(t.z), bf_hi(t.z), bf_lo(t.w), bf_hi(t.w)} + acc[ai][bj][m][1]; } }
                } else {
#pragma unroll
                    for (int bj = 0; bj < 2; ++bj) { const v4u t = hb[m][bj];
                        *(GAS v4u*)(HB + (size_t)row * 1024 + c0 + bj * 128) = pack8((f32x4){bf_lo(t.x), bf_hi(t.x), bf_lo(t.y), bf_hi(t.y)} + acc[ai][bj][m][0], (f32x4){bf_lo(t.z), bf_hi(t.z), bf_lo(t.w), bf_hi(t.w)} + acc[ai][bj][m][1]); } } }
        }
    }
};
struct EpiMergeSlab {
    GAS unsigned char* ws;
    __device__ __forceinline__ void operator()(Acc& acc, const Unit& u, int wr, int wc, int fr, int fq, LAS unsigned char* lds) const {
        const int row0 = u.pm * BM + wr * 64 + fr, c0 = u.pn * BM + wc * 32 + 8 * fq;
        const GAS bf16* G0 = (const GAS bf16*)(ws + WS_GATE) + (size_t)u.seg * MTOT * 1024;
        {
            GAS bf16* sl = (GAS bf16*)(ws + WS_SLAB_M) + (size_t)u.slab * 65536 + (size_t)(wr * 64 + fr) * 256 + wc * 32 + 8 * fq;
#pragma unroll
            for (int ai = 0; ai < 2; ++ai) { v4u ga[4][2];
#pragma unroll
                for (int m = 0; m < 4; ++m)
#pragma unroll
                    for (int bj = 0; bj < 2; ++bj) ga[m][bj] = *(const GAS v4u*)(G0 + (size_t)(row0 + ai * 128 + m * 16) * 1024 + c0 + bj * 128);
#pragma unroll
                for (int m = 0; m < 4; ++m)
#pragma unroll
                    for (int bj = 0; bj < 2; ++bj) { const v4u x = ga[m][bj]; const f32x4 f0 = {bf_lo(x.x), bf_hi(x.x), bf_lo(x.y), bf_hi(x.y)}, f1 = {bf_lo(x.z), bf_hi(x.z), bf_lo(x.w), bf_hi(x.w)};
                        *(GAS v4u*)(sl + (size_t)(ai * 128 + m * 16) * 256 + bj * 128) = pack8(acc[ai][bj][m][0] * f0, acc[ai][bj][m][1] * f1); } }
        }
    }
};
struct EpiOutSlab {
    GAS unsigned char* ws;
    __device__ __forceinline__ void operator()(Acc& acc, const Unit& u, int wr, int wc, int fr, int fq, LAS unsigned char* lds) const {
        {
            GAS bf16* sl = (GAS bf16*)(ws + WS_SLAB_O) + (size_t)u.slab * 65536 + (size_t)(wr * 64 + fr) * 256 + wc * 32 + 8 * fq;
#pragma unroll
            for (int ai = 0; ai < 2; ++ai)
#pragma unroll
                for (int m = 0; m < 4; ++m)
#pragma unroll
                    for (int bj = 0; bj < 2; ++bj) *(GAS v4u*)(sl + (size_t)(ai * 128 + m * 16) * 256 + bj * 128) = pack8(acc[ai][bj][m][0], acc[ai][bj][m][1]);
        }
    }
};
}
__device__ __forceinline__ f32x16 mfma32(bf16x8 a, bf16x8 b, f32x16 c) { return __builtin_amdgcn_mfma_f32_32x32x16_bf16(a, b, c, 0, 0, 0); }
__device__ __forceinline__ f32x16 zero16() { f32x16 z;
#pragma unroll
    for (int i = 0; i < 16; ++i) z[i] = 0.f; return z; }
__device__ __forceinline__ bf16x8 cvt8(const f32x4 a, const f32x4 b) { const v4u w = pg8::pack8(a, b); return __builtin_bit_cast(bf16x8, w); }

namespace hg {
constexpr int P136 = 136, P72 = 72;
constexpr int L_QS = 0, L_QT = L_QS + 64 * P136 * 2, L_KT = L_QT + 64 * P136 * 2, L_KTT = L_KT + 64 * P136 * 2, L_VT = L_KTT + 128 * P72 * 2,
              L_ATT = L_VT + 128 * P72 * 2, L_ST = L_ATT + 64 * P72 * 2, L_SEG = L_ST + 128 * P136 * 2, L_EV = L_SEG + 8 * 128 * 4, L_PART = L_EV + 2 * 128 * 4, L_GN = L_PART + 64 * 4 * 4, L_END = L_GN + 128 * 4;
static_assert(L_END <= LDS_MISC, "hgrn LDS");
struct Pre { unsigned lf[8]; unsigned q[8], k[8], v[8]; v2u sg[4]; };
#define HG_BAR() do { asm volatile("s_waitcnt lgkmcnt(0)" ::: "memory"); __builtin_amdgcn_s_barrier(); asm volatile("" ::: "memory"); } while (0)

template <int PART>
__device__ __forceinline__ void prefetch(Pre& P, const GAS unsigned char* ws, size_t row0, int nvalid, int seg, int colb  , int trow  , int sgcol  ) {
    const GAS _Float16* LF = (const GAS _Float16*)(ws + WS_LOGF) + row0 * 1024; const GAS bf16* QC = (const GAS bf16*)(ws + WS_QC) + row0 * 1024; const GAS bf16* KC = (const GAS bf16*)(ws + WS_KC) + row0 * 1024; const GAS bf16* IC = (const GAS bf16*)(ws + WS_IC) + row0 * 1024;
    if (PART & 2) { const GAS bf16* SGC = (const GAS bf16*)(ws + WS_SGC) + row0 * 1024; const unsigned so = (unsigned)((trow < nvalid ? trow : 0) * 1024 + sgcol);
#pragma unroll
      for (int g = 0; g < 4; ++g) P.sg[g] = *(const GAS v2u*)(SGC + so + 8 * g); }
    if (nvalid == 64) {
#pragma unroll
        for (int i = 0; i < 8; ++i) { const unsigned o = (unsigned)((seg * 8 + i) * 1024 + colb);
            if (PART & 1) P.lf[i] = *(const GAS unsigned*)(LF + o);
            if (PART & 2) { P.q[i] = *(const GAS unsigned*)(QC + o); P.k[i] = *(const GAS unsigned*)(KC + o); P.v[i] = *(const GAS unsigned*)(IC + o); } }
    } else {
#pragma unroll
        for (int i = 0; i < 8; ++i) { const int t = seg * 8 + i; const unsigned o = (unsigned)(t * 1024 + colb);
            if (t < nvalid) { if (PART & 1) P.lf[i] = *(const GAS unsigned*)(LF + o); if (PART & 2) { P.q[i] = *(const GAS unsigned*)(QC + o); P.k[i] = *(const GAS unsigned*)(KC + o); P.v[i] = *(const GAS unsigned*)(IC + o); } }
            else { if (PART & 1) P.lf[i] = 0u; if (PART & 2) { P.q[i] = 0u; P.k[i] = 0u; P.v[i] = 0u; } } }
    }
}

__device__ __forceinline__ void chain(Frame& F, int layer, bool sample, int b, int h) {
    LAS unsigned char* lds = F.lds; int tid = F.tid_(); asm volatile("" : "+v"(tid));
    const int lane = tid & 63, wave = F.wave, seg = wave; int kp = tid & 63, l31 = lane & 31, hh = lane >> 5;
    const int L = sample ? DSEQ : LP, nchunks = (L + 63) / 64;
    const size_t rowbase = sample ? (size_t)MPAD + (size_t)b * DSEQ : (size_t)b * LP;
    const int colb = h * 128 + 2 * kp;
    GAS bf16* YC = (GAS bf16*)(F.wsp() + WS_Y) + (size_t)2 * MTOT * 1024;
    const int kb = wave >> 1, vb0 = 2 * (wave & 1);
    f32x16 S[2];
    if (sample) { const GAS float* s0 = F_state_hgrn + (((size_t)layer * DBATCH + b) * 8 + h) * 16384;
#pragma unroll
        for (int vbi = 0; vbi < 2; ++vbi)
#pragma unroll
            for (int r = 0; r < 16; ++r) S[vbi][r] = s0[(size_t)(32 * kb + (r & 3) + 8 * (r >> 2) + 4 * hh) * 128 + 32 * (vb0 + vbi) + l31]; }
    else { S[0] = zero16(); S[1] = zero16(); }
#pragma unroll
    for (int vbi = 0; vbi < 2; ++vbi)
#pragma unroll
        for (int g = 0; g < 4; ++g) { v2u w; w.x = cvt_pk_bf16(S[vbi][4 * g], S[vbi][4 * g + 1]); w.y = cvt_pk_bf16(S[vbi][4 * g + 2], S[vbi][4 * g + 3]);
            *(LAS v2u*)(lds + L_ST + ((32 * (vb0 + vbi) + l31) * P136 + 32 * kb + 8 * g + 4 * hh) * 2) = w; }
    const int ovb = wave & 3, otb = wave >> 2;
    if (tid < 128) *(LAS float*)(lds + L_GN + tid * 4) = F_hng[layer * 128 + tid];
    Pre P; prefetch<3>(P, F.wsp(), rowbase, min(64, L), seg, colb, 32 * otb + l31, h * 128 + 32 * ovb + 4 * hh);
    for (int c = 0; c < nchunks; ++c) {
        asm volatile("" : "+v"(l31), "+v"(hh), "+v"(kp));
        const int nvalid = min(64, L - 64 * c); const size_t row0 = rowbase + (size_t)64 * c;
        float c0[8], c1[8]; { float a0 = 0.f, a1 = 0.f;
#pragma unroll
            for (int i = 0; i < 8; ++i) { const pg8::h16x2 hv = __builtin_bit_cast(pg8::h16x2, P.lf[i]); a0 += (float)hv.x; a1 += (float)hv.y; c0[i] = a0; c1[i] = a1; }
            *(LAS f32x2*)(lds + L_SEG + (seg * 128 + 2 * kp) * 4) = (f32x2){a0, a1}; }
        if (c + 1 < nchunks) prefetch<1>(P, F.wsp(), rowbase + (size_t)64 * (c + 1), min(64, L - 64 * (c + 1)), seg, colb, 32 * otb + l31, h * 128 + 32 * ovb + 4 * hh);
        HG_BAR();
        float off0 = 0.f, off1 = 0.f, m0 = 0.f, m1 = 0.f, la0 = 0.f, la1 = 0.f;
#pragma unroll
        for (int s = 0; s < 8; ++s) { const f32x2 tt = *(const LAS f32x2*)(lds + L_SEG + (s * 128 + 2 * kp) * 4);
            if (s < seg) { off0 += tt.x; off1 += tt.y; } if (s < 4) { m0 += tt.x; m1 += tt.y; } la0 += tt.x; la1 += tt.y; }
        unsigned ktt0[8], ktt1[8], vt0[8], vt1[8]; const float e2m0 = fexp2(m0), e2m1 = fexp2(m1);
#pragma unroll
        for (int i = 0; i < 8; ++i) { const int t = seg * 8 + i; const float cu0 = off0 + c0[i], cu1 = off1 + c1[i];
            const float q0 = bf_lo(P.q[i]), q1 = bf_hi(P.q[i]), k0 = bf_lo(P.k[i]), k1 = bf_hi(P.k[i]);
            const float em0 = fexp2(cu0 - m0), em1 = fexp2(cu1 - m1), ek0 = fexp2(m0 - cu0), ek1 = fexp2(m1 - cu1), eq0 = em0 * e2m0, eq1 = em1 * e2m1;
            *(LAS unsigned*)(lds + L_QS + (t * P136 + 2 * kp) * 2) = cvt_pk_bf16(q0 * eq0, q1 * eq1);
            *(LAS unsigned*)(lds + L_QT + (t * P136 + 2 * kp) * 2) = cvt_pk_bf16(q0 * em0, q1 * em1);
            const unsigned kt = cvt_pk_bf16(k0 * ek0, k1 * ek1);
            *(LAS unsigned*)(lds + L_KT + (t * P136 + 2 * kp) * 2) = kt;
            ktt0[i] = kt & 0xffffu; ktt1[i] = kt >> 16; vt0[i] = P.v[i] & 0xffffu; vt1[i] = P.v[i] >> 16; }
        { v4u w; w.x = ktt0[0] | (ktt0[1] << 16); w.y = ktt0[2] | (ktt0[3] << 16); w.z = ktt0[4] | (ktt0[5] << 16); w.w = ktt0[6] | (ktt0[7] << 16);
          *(LAS v4u*)(lds + L_KTT + ((2 * kp) * P72 + 8 * seg) * 2) = w;
          w.x = ktt1[0] | (ktt1[1] << 16); w.y = ktt1[2] | (ktt1[3] << 16); w.z = ktt1[4] | (ktt1[5] << 16); w.w = ktt1[6] | (ktt1[7] << 16);
          *(LAS v4u*)(lds + L_KTT + ((2 * kp + 1) * P72 + 8 * seg) * 2) = w;
          w.x = vt0[0] | (vt0[1] << 16); w.y = vt0[2] | (vt0[3] << 16); w.z = vt0[4] | (vt0[5] << 16); w.w = vt0[6] | (vt0[7] << 16);
          *(LAS v4u*)(lds + L_VT + ((2 * kp) * P72 + 8 * seg) * 2) = w;
          w.x = vt1[0] | (vt1[1] << 16); w.y = vt1[2] | (vt1[3] << 16); w.z = vt1[4] | (vt1[5] << 16); w.w = vt1[6] | (vt1[7] << 16);
          *(LAS v4u*)(lds + L_VT + ((2 * kp + 1) * P72 + 8 * seg) * 2) = w; }
        if (seg == 0) { *(LAS f32x2*)(lds + L_EV + (2 * kp) * 4) = (f32x2){fexp2(la0), fexp2(la1)}; *(LAS f32x2*)(lds + L_EV + (128 + 2 * kp) * 4) = (f32x2){fexp2(la0 - m0), fexp2(la1 - m1)}; }
        v2u sg[4] = {P.sg[0], P.sg[1], P.sg[2], P.sg[3]};
        if (c + 1 < nchunks) prefetch<2>(P, F.wsp(), rowbase + (size_t)64 * (c + 1), min(64, L - 64 * (c + 1)), seg, colb, 32 * otb + l31, h * 128 + 32 * ovb + 4 * hh);
        HG_BAR();
        if (wave < 3) { const int sb = wave == 2 ? 1 : 0, tb = wave == 0 ? 0 : 1; f32x16 a = zero16();
#pragma unroll
            for (int st = 0; st < 8; ++st) { const bf16x8 ka = *(const LAS bf16x8*)(lds + L_KT + ((32 * sb + l31) * P136 + 16 * st + 8 * hh) * 2);
                const bf16x8 qb = *(const LAS bf16x8*)(lds + L_QT + ((32 * tb + l31) * P136 + 16 * st + 8 * hh) * 2); a = mfma32(ka, qb, a); }
            const int t = 32 * tb + l31;
#pragma unroll
            for (int g = 0; g < 4; ++g) { const int s0 = 32 * sb + 8 * g + 4 * hh; float x[4];
#pragma unroll
                for (int j = 0; j < 4; ++j) x[j] = (s0 + j <= t) ? a[4 * g + j] : 0.f;
                v2u w; w.x = cvt_pk_bf16(x[0], x[1]); w.y = cvt_pk_bf16(x[2], x[3]); *(LAS v2u*)(lds + L_ATT + (t * P72 + s0) * 2) = w; } }
        HG_BAR();
        f32x16 o = zero16();
#pragma unroll
        for (int st = 0; st < 8; ++st) { const bf16x8 sa = *(const LAS bf16x8*)(lds + L_ST + ((32 * ovb + l31) * P136 + 16 * st + 8 * hh) * 2);
            const bf16x8 qb = *(const LAS bf16x8*)(lds + L_QS + ((32 * otb + l31) * P136 + 16 * st + 8 * hh) * 2); o = mfma32(sa, qb, o); }
        for (int st = 0; st < 2 + 2 * otb; ++st) { const bf16x8 va = *(const LAS bf16x8*)(lds + L_VT + ((32 * ovb + l31) * P72 + 16 * st + 8 * hh) * 2);
            const bf16x8 ab = *(const LAS bf16x8*)(lds + L_ATT + ((32 * otb + l31) * P72 + 16 * st + 8 * hh) * 2); o = mfma32(va, ab, o); }
        { float ss = 0.f;
#pragma unroll
            for (int r = 0; r < 16; ++r) ss += o[r] * o[r];
            ss += __shfl_xor(ss, 32);
            if (hh == 0) *(LAS float*)(lds + L_PART + ((32 * otb + l31) * 4 + ovb) * 4) = ss; }
        HG_BAR();
        { const f32x4 p = *(const LAS f32x4*)(lds + L_PART + (32 * otb + l31) * 16); const float rs = frsq(((p[0] + p[1]) + (p[2] + p[3])) * (1.0f / 128.0f) + EPS);
          const int t = 32 * otb + l31;
          if (t < nvalid) { GAS bf16* yp = YC + (row0 + t) * 1024 + h * 128 + 32 * ovb + 4 * hh;
#pragma unroll
              for (int g = 0; g < 4; ++g) { const f32x4 gng = *(const LAS f32x4*)(lds + L_GN + (32 * ovb + 8 * g + 4 * hh) * 4); const float y0 = o[4 * g] * rs * gng[0] * bf_lo(sg[g].x), y1 = o[4 * g + 1] * rs * gng[1] * bf_hi(sg[g].x),
                                                        y2 = o[4 * g + 2] * rs * gng[2] * bf_lo(sg[g].y), y3 = o[4 * g + 3] * rs * gng[3] * bf_hi(sg[g].y);
                  v2u w; w.x = cvt_pk_bf16(y0, y1); w.y = cvt_pk_bf16(y2, y3); *(GAS v2u*)(yp + 8 * g) = w; } } }
        f32x16 Pn[2] = {zero16(), zero16()};
#pragma unroll
        for (int st = 0; st < 4; ++st) { const bf16x8 ka = *(const LAS bf16x8*)(lds + L_KTT + ((32 * kb + l31) * P72 + 16 * st + 8 * hh) * 2);
#pragma unroll
            for (int vbi = 0; vbi < 2; ++vbi) { const bf16x8 vbf = *(const LAS bf16x8*)(lds + L_VT + ((32 * (vb0 + vbi) + l31) * P72 + 16 * st + 8 * hh) * 2); Pn[vbi] = mfma32(ka, vbf, Pn[vbi]); } }
#pragma unroll
        for (int g = 0; g < 4; ++g) { const f32x4 el = *(const LAS f32x4*)(lds + L_EV + (32 * kb + 8 * g + 4 * hh) * 4), elm = *(const LAS f32x4*)(lds + L_EV + (128 + 32 * kb + 8 * g + 4 * hh) * 4);
#pragma unroll
            for (int vbi = 0; vbi < 2; ++vbi) {
#pragma unroll
                for (int j = 0; j < 4; ++j) S[vbi][4 * g + j] = el[j] * S[vbi][4 * g + j] + elm[j] * Pn[vbi][4 * g + j];
                v2u w; w.x = cvt_pk_bf16(S[vbi][4 * g], S[vbi][4 * g + 1]); w.y = cvt_pk_bf16(S[vbi][4 * g + 2], S[vbi][4 * g + 3]);
                *(LAS v2u*)(lds + L_ST + ((32 * (vb0 + vbi) + l31) * P136 + 32 * kb + 8 * g + 4 * hh) * 2) = w; } }
    }
    GAS float* sf = sample ? F.outp() + O_HS + (((size_t)layer * DBATCH + b) * 8 + h) * 16384 : F.outp() + O_HP + (((size_t)layer * BATCH + b) * 8 + h) * 16384;
#pragma unroll
    for (int vbi = 0; vbi < 2; ++vbi)
#pragma unroll
        for (int r = 0; r < 16; ++r) sf[(size_t)(32 * kb + (r & 3) + 8 * (r >> 2) + 4 * hh) * 128 + 32 * (vb0 + vbi) + l31] = S[vbi][r];
    HG_BAR();
}
}

namespace sb {
constexpr float R_STOP = -136.0f;
constexpr int KROW = 272, SLOT = 32 * KROW + 128 * 64;
static_assert(8 * SLOT + 64 <= LDS_MISC, "attention LDS");
constexpr int L_DONE = 8 * SLOT;
struct Grp { const GAS float* k_old; const GAS float* v_old; const GAS float* k_new; const GAS float* v_new; };

struct TileRegs { f32x4 k0, k1, v0, v1; };
__device__ __forceinline__ void tile_issue(TileRegs& t, const Grp& g, int kt, int past, int L, int c, int rp, int sh) {
    const int s0 = 32 * kt - sh; const bool old = s0 + sh < past; const int rl = old ? 31 : (L - 1 - (s0 - past)), lo = s0 < 0 ? -s0 : 0;
    const GAS float* kb = old ? g.k_old + (ptrdiff_t)s0 * 1024 : g.k_new + (ptrdiff_t)(s0 - past) * 1024; const GAS float* vb = old ? g.v_old + (ptrdiff_t)s0 * 1024 : g.v_new + (ptrdiff_t)(s0 - past) * 1024;
    if (rl >= 31 && lo == 0) {
        const unsigned o = (unsigned)(2 * rp * 1024 + 4 * c);
        t.k0 = *(const GAS f32x4*)(kb + o); t.k1 = *(const GAS f32x4*)(kb + o + 1024); t.v0 = *(const GAS f32x4*)(vb + o); t.v1 = *(const GAS f32x4*)(vb + o + 1024);
        return; }
    const int r0 = max(min(2 * rp, rl), lo), r1 = max(min(2 * rp + 1, rl), lo);
    t.k0 = *(const GAS f32x4*)(kb + (ptrdiff_t)r0 * 1024 + 4 * c); t.k1 = *(const GAS f32x4*)(kb + (ptrdiff_t)r1 * 1024 + 4 * c);
    t.v0 = *(const GAS f32x4*)(vb + (ptrdiff_t)r0 * 1024 + 4 * c); t.v1 = *(const GAS f32x4*)(vb + (ptrdiff_t)r1 * 1024 + 4 * c);
}
__device__ __forceinline__ void tile_commit(const TileRegs& t, LAS unsigned char* slot, int c, int rp) {
    v2u a; a.x = cvt_pk_bf16(t.k0[0], t.k0[1]); a.y = cvt_pk_bf16(t.k0[2], t.k0[3]); *(LAS v2u*)(slot + (2 * rp) * KROW + 8 * c) = a;
    a.x = cvt_pk_bf16(t.k1[0], t.k1[1]); a.y = cvt_pk_bf16(t.k1[2], t.k1[3]); *(LAS v2u*)(slot + (2 * rp + 1) * KROW + 8 * c) = a;
    LAS unsigned char* vt = slot + 32 * KROW; const int r7 = rp & 7, f = 2 * (rp >> 3) + ((r7 >> 1) & 1);
    const int u = ((f ^ (c & 3)) * 16) + (r7 >> 2) * 8 + (rp & 1) * 4;
#pragma unroll
    for (int j = 0; j < 4; ++j) *(LAS unsigned*)(vt + (4 * c + j) * 64 + u) = cvt_pk_bf16(t.v0[j], t.v1[j]);
}

template <int NG>
__device__ __forceinline__ void block_unit(Frame& F, int layer, int unit  ) {
    constexpr int W = 8 / NG;
    int tid = F.tid_(); asm volatile("" : "+v"(tid)); const int lane = tid & 63, wave = F.wave, l31 = lane & 31, hh = lane >> 5;
    LAS unsigned char* lds = F.lds;
    const bool sample = NG > 1; constexpr int sh = NG == 1 ? 16 : 0; const int L = sample ? DSEQ : LP, past = sample ? PAST : 0, nqt = (L + sh + 31) / 32;
    const int gi = wave / W, wi = wave - gi * W;
    int bh, qt0; bool wave_on; if (!sample) { const int j = 8 - (unit >> 6); bh = unit & 63; qt0 = j == 0 ? 0 : 8 * j - 7; wave_on = j > 0 || wi == 0; } else { bh = unit * NG + gi; qt0 = 0; wave_on = wi < nqt; }
    const int b = bh >> 3, h = bh & 7; const int qt = qt0 + wi;
    const size_t rowbase = sample ? (size_t)MPAD + (size_t)b * DSEQ : (size_t)b * LP;
    Grp g;
    g.k_new = (sample ? F.outp() + O_KS + (size_t)layer * MS * 1024 + (size_t)b * DSEQ * 1024 : F.outp() + O_KP + (size_t)layer * MP * 1024 + (size_t)b * LP * 1024) + h * 128;
    g.v_new = (sample ? F.outp() + O_VS + (size_t)layer * MS * 1024 + (size_t)b * DSEQ * 1024 : F.outp() + O_VP + (size_t)layer * MP * 1024 + (size_t)b * LP * 1024) + h * 128;
    g.k_old = F_cache_k + ((size_t)layer * DBATCH + b) * PAST * 1024 + h * 128; g.v_old = F_cache_v + ((size_t)layer * DBATCH + b) * PAST * 1024 + h * 128;
    const int dt0 = (past >> 5) + qt0;
    const int tq = 32 * qt - sh + l31; const bool qvalid = wave_on && tq >= 0 && tq < L; const size_t qrow = rowbase + (tq < 0 ? 0 : tq < L ? tq : L - 1);
    const GAS bf16* Q = (const GAS bf16*)(F.wsp() + WS_Q) + qrow * 1024 + h * 128 + 8 * hh;
    bf16x8 qf[8];
#pragma unroll
    for (int st = 0; st < 8; ++st) qf[st] = *(const GAS bf16x8*)(Q + 16 * st);
    f32x16 O[4] = {zero16(), zero16(), zero16(), zero16()};
    const int qpos = past + tq; float R = 0.f; bool done = !wave_on;
    const int sc = tid & 31, srp = NG == 1 ? (tid >> 5) : ((tid & (64 * W - 1)) >> 5);
    if (NG == 1) { for (int j0 = 0; j0 < W; j0 += 4) { TileRegs t[4];
#pragma unroll
            for (int j = 0; j < 4; ++j) tile_issue(t[j], g, dt0 + j0 + j, past, L, sc, srp, sh);
#pragma unroll
            for (int j = 0; j < 4; ++j) tile_commit(t[j], lds + ((dt0 + j0 + j) & (W - 1)) * SLOT, sc, srp); } }
    else { for (int j = 0; j < W; ++j) { TileRegs t[4];
#pragma unroll
            for (int ps = 0; ps < 4; ++ps) tile_issue(t[ps], g, dt0 + j, past, L, sc, srp + 4 * ps, sh);
#pragma unroll
            for (int ps = 0; ps < 4; ++ps) tile_commit(t[ps], lds + (gi * W + ((dt0 + j) & (W - 1))) * SLOT, sc, srp + 4 * ps); } }
    if (lane == 0) *(LAS unsigned*)(lds + L_DONE + 4 * wave) = done ? 1u : 0u;
    TileRegs pre; if (NG == 1 && dt0 - 1 >= 0) tile_issue(pre, g, dt0 - 1, past, L, sc, srp, sh);
    HG_BAR();
    for (int i = 0; ; ++i) {
        const int kt = dt0 + wi - i;
        const int knew = dt0 - i - 1;
        TileRegs pre2; if (NG == 1 && knew - 1 >= 0) tile_issue(pre2, g, knew - 1, past, L, sc, srp, sh);
        if (!done && kt >= 0) {
            const LAS unsigned char* slot = lds + (gi * W + (kt & (W - 1))) * SLOT; const int s0 = 32 * kt - sh;
            f32x16 sa = zero16();
#pragma unroll
            for (int st = 0; st < 8; ++st) sa = mfma32(*(const LAS bf16x8*)(slot + l31 * KROW + (16 * st + 8 * hh) * 2), qf[st], sa);
            const bool diag = i == 0;
            float sg[16], kp[16];
#pragma unroll
            for (int r = 0; r < 16; ++r) { const float e = fexp2(-sa[r]), rc = frcp(1.0f + e); sg[r] = rc; kp[r] = e * rc; }
            if (diag || (sh != 0 && kt == 0)) { const int khi = diag ? qpos : 0x7fffffff;
#pragma unroll
                for (int r = 0; r < 16; ++r) { const int key = s0 + (r & 3) + 8 * (r >> 2) + 4 * hh; const bool ok = key < khi && key >= 0; kp[r] = ok ? kp[r] : 1.0f; sg[r] = ok ? sg[r] : 0.f; } }
            float ex[16], T[4], Tp[4];
#pragma unroll
            for (int gq = 0; gq < 4; ++gq) { ex[4 * gq + 3] = 1.0f; ex[4 * gq + 2] = kp[4 * gq + 3]; ex[4 * gq + 1] = ex[4 * gq + 2] * kp[4 * gq + 2]; ex[4 * gq] = ex[4 * gq + 1] * kp[4 * gq + 1]; T[gq] = ex[4 * gq] * kp[4 * gq]; Tp[gq] = __shfl_xor(T[gq], 32); }
            float carry[4]; { float above = fexp2(R);
#pragma unroll
                for (int gq = 3; gq >= 0; --gq) { carry[gq] = above * (hh == 0 ? Tp[gq] : 1.0f); above *= T[gq] * Tp[gq]; }
                R += flog2(fmaxf(((T[0] * Tp[0]) * (T[1] * Tp[1])) * ((T[2] * Tp[2]) * (T[3] * Tp[3])), 1e-45f)); }
            float w[16];
#pragma unroll
            for (int r = 0; r < 16; ++r) w[r] = sg[r] * (carry[r >> 2] * ex[r]);
            const LAS unsigned char* vt = slot + 32 * KROW;
#pragma unroll
            for (int s = 0; s < 2; ++s) { v4u pw; pw.x = cvt_pk_bf16(w[8 * s], w[8 * s + 1]); pw.y = cvt_pk_bf16(w[8 * s + 2], w[8 * s + 3]); pw.z = cvt_pk_bf16(w[8 * s + 4], w[8 * s + 5]); pw.w = cvt_pk_bf16(w[8 * s + 6], w[8 * s + 7]);
                const bf16x8 pb = __builtin_bit_cast(bf16x8, pw);
#pragma unroll
                for (int db = 0; db < 4; ++db) { const int d = 32 * db + l31;
                    O[db] = mfma32(*(const LAS bf16x8*)(vt + d * 64 + (((2 * s + hh) ^ ((d >> 2) & 3)) * 16)), pb, O[db]); } }
            if (kt == 0 || __all(R < R_STOP)) { done = true; if (lane == 0) *(LAS unsigned*)(lds + L_DONE + 4 * wave) = 1u; }
        } else if (!done && kt < 0) { done = true; if (lane == 0) *(LAS unsigned*)(lds + L_DONE + 4 * wave) = 1u; }
        HG_BAR();
        const v4u d0 = *(const LAS v4u*)(lds + L_DONE), d1 = *(const LAS v4u*)(lds + L_DONE + 16);
        if ((d0.x & d0.y & d0.z & d0.w & d1.x & d1.y & d1.z & d1.w) != 0u) break;
        if (NG == 1) { if (knew >= 0) tile_commit(pre, lds + (knew & (W - 1)) * SLOT, sc, srp); pre = pre2; }
        else if (knew >= 0) { TileRegs t[4];
#pragma unroll
            for (int ps = 0; ps < 4; ++ps) tile_issue(t[ps], g, knew, past, L, sc, srp + 4 * ps, sh);
#pragma unroll
            for (int ps = 0; ps < 4; ++ps) tile_commit(t[ps], lds + (gi * W + (knew & (W - 1))) * SLOT, sc, srp + 4 * ps); }
        HG_BAR();
    }
    if (qvalid) { const GAS bf16* SG = (const GAS bf16*)(F.wsp() + WS_SGB) + qrow * 1024 + h * 128 + 4 * hh; GAS bf16* Y = (GAS bf16*)(F.wsp() + WS_Y) + (size_t)MTOT * 1024 + qrow * 1024 + h * 128 + 4 * hh;
        v2u sgv[4][4];
#pragma unroll
        for (int db = 0; db < 4; ++db)
#pragma unroll
            for (int gq = 0; gq < 4; ++gq) sgv[db][gq] = *(const GAS v2u*)(SG + 32 * db + 8 * gq);
#pragma unroll
        for (int db = 0; db < 4; ++db)
#pragma unroll
            for (int gq = 0; gq < 4; ++gq) { const v2u s = sgv[db][gq]; v2u o;
                o.x = cvt_pk_bf16(O[db][4 * gq] * bf_lo(s.x), O[db][4 * gq + 1] * bf_hi(s.x)); o.y = cvt_pk_bf16(O[db][4 * gq + 2] * bf_lo(s.y), O[db][4 * gq + 3] * bf_hi(s.y));
                *(GAS v2u*)(Y + 32 * db + 8 * gq) = o; } }
    HG_BAR();
}
constexpr int NU_P = BATCH * 8 * 9, NU_S = DBATCH * 8 / 4;
constexpr int NUNITS = NU_P + NU_S;
}

namespace pl {
constexpr int RS = 528;
constexpr int L_UT = 0, L_DF = 143 * RS, L_END = L_DF + 128 * RS;
static_assert(L_END <= LDS_MISC, "pool LDS");
constexpr int NU_P = BATCH * 17 * 4, NU_S = DBATCH * 4, NUNITS = NU_P + NU_S;
__device__ __forceinline__ void unit(Frame& F, int layer, int u) {
    LAS unsigned char* lds = F.lds; int tid = F.tid_(); asm volatile("" : "+v"(tid)); const int lane = tid & 63, wave = F.wave, l31 = lane & 31, hh = lane >> 5;
    const bool sample = u >= NU_P; int b, tile, g;
    if (!sample) { g = u & 3; const int x = u >> 2; b = x / 17; tile = x - b * 17; } else { const int x = u - NU_P; g = x & 3; b = x >> 2; tile = 0; }
    const int L = sample ? DSEQ : LP, t0 = tile * 128, nrows = min(128, L - t0), w = 2 << g;
    const size_t rowbase = sample ? (size_t)MPAD + (size_t)b * DSEQ : (size_t)b * LP;
    const GAS bf16* UA = (const GAS bf16*)(F.wsp() + WS_UA);
    { v4u sv[9];
#pragma unroll
      for (int q = 0; q < 9; ++q) { const int idx = tid + 512 * q, i = idx >> 5, ch = idx & 31, t = t0 - 15 + i; v4u v = {0u, 0u, 0u, 0u};
        if (idx < 143 * 32) { if (t >= 0 && t < L) v = *(const GAS v4u*)(UA + (rowbase + t) * 1024 + 256 * g + 8 * ch);
            else if (t < 0 && sample) { const GAS float* sp = F_state_pool + (((size_t)layer * DBATCH + b) * 15 + (15 + t)) * 1024 + 256 * g + 8 * ch; v = pg8::pack8(*(const GAS f32x4*)sp, *(const GAS f32x4*)(sp + 4)); } }
        sv[q] = v; }
#pragma unroll
      for (int q = 0; q < 9; ++q) { const int idx = tid + 512 * q, i = idx >> 5, ch = idx & 31; if (idx < 143 * 32) *(LAS v4u*)(lds + L_UT + i * RS + ch * 16) = sv[q]; } }
    const GAS bf16* WT = (const GAS bf16*)(F.wsp() + WS_WPOOL) + ((size_t)layer * 4 + g) * 65536 + (size_t)(32 * wave + l31) * 256 + 8 * hh;
    bf16x8 wf[16];
#pragma unroll
    for (int st = 0; st < 16; ++st) wf[st] = *(const GAS bf16x8*)(WT + 16 * st);
    const GAS float* sc = F_pool_scale + layer * 1024 + 256 * g + 32 * wave + 4 * hh; const GAS bf16* SGA = (const GAS bf16*)(F.wsp() + WS_SGA); GAS bf16* YA = (GAS bf16*)(F.wsp() + WS_Y);
    v4u sgq[8]; f32x4 scv[4];
#pragma unroll
    for (int q = 0; q < 8; ++q) { const int cq = tid + 512 * q, row = cq >> 5, ch8 = cq & 31;
        sgq[q] = __builtin_nontemporal_load((const GAS v4u*)(SGA + (rowbase + t0 + (row < nrows ? row : 0)) * 1024 + 256 * g + 8 * ch8)); }
#pragma unroll
    for (int gg = 0; gg < 4; ++gg) scv[gg] = *(const GAS f32x4*)(sc + 8 * gg);
    HG_BAR();
    { const int ch = tid & 31, rs = tid >> 5, r0 = 8 * rs; float sum[8];
#pragma unroll
      for (int j = 0; j < 8; ++j) sum[j] = 0.f;
      for (int j = 1; j < w; ++j) { const v4u v = *(const LAS v4u*)(lds + L_UT + (15 + r0 - j) * RS + ch * 16);
          sum[0] += bf_lo(v.x); sum[1] += bf_hi(v.x); sum[2] += bf_lo(v.y); sum[3] += bf_hi(v.y); sum[4] += bf_lo(v.z); sum[5] += bf_hi(v.z); sum[6] += bf_lo(v.w); sum[7] += bf_hi(v.w); }
#pragma unroll
      for (int i = 0; i < 8; ++i) { const int r = r0 + i; const v4u v = *(const LAS v4u*)(lds + L_UT + (15 + r) * RS + ch * 16);
          float x[8] = {bf_lo(v.x), bf_hi(v.x), bf_lo(v.y), bf_hi(v.y), bf_lo(v.z), bf_hi(v.z), bf_lo(v.w), bf_hi(v.w)};
          const float rc = sample ? 1.0f / (float)w : 1.0f / fminf((float)(t0 + r) + 1.0f, (float)w); float d[8];
#pragma unroll
          for (int j = 0; j < 8; ++j) { sum[j] += x[j]; d[j] = sum[j] * rc - x[j]; }
          *(LAS v4u*)(lds + L_DF + r * RS + ch * 16) = pg8::pack8((f32x4){d[0], d[1], d[2], d[3]}, (f32x4){d[4], d[5], d[6], d[7]});
          const v4u o = *(const LAS v4u*)(lds + L_UT + (15 + r - (w - 1)) * RS + ch * 16);
          sum[0] -= bf_lo(o.x); sum[1] -= bf_hi(o.x); sum[2] -= bf_lo(o.y); sum[3] -= bf_hi(o.y); sum[4] -= bf_lo(o.z); sum[5] -= bf_hi(o.z); sum[6] -= bf_lo(o.w); sum[7] -= bf_hi(o.w); } }
    HG_BAR();
    f32x16 acc[4] = {zero16(), zero16(), zero16(), zero16()};
#pragma unroll
    for (int st = 0; st < 16; ++st) { const bf16x8 a = wf[st];
#pragma unroll
        for (int rb = 0; rb < 4; ++rb) { const bf16x8 bb = *(const LAS bf16x8*)(lds + L_DF + (32 * rb + l31) * RS + (16 * st + 8 * hh) * 2); acc[rb] = mfma32(a, bb, acc[rb]); } }
    HG_BAR();
    constexpr int TS = 1040;
    static_assert(128 * TS <= L_END, "pool output image");
#pragma unroll
    for (int rb = 0; rb < 4; ++rb)
#pragma unroll
        for (int gg = 0; gg < 4; ++gg) { const f32x4 t = {acc[rb][4 * gg] * scv[gg][0], acc[rb][4 * gg + 1] * scv[gg][1], acc[rb][4 * gg + 2] * scv[gg][2], acc[rb][4 * gg + 3] * scv[gg][3]};
            *(LAS f32x4*)(lds + (32 * rb + l31) * TS + (32 * wave + 8 * gg + 4 * hh) * 4) = t; }
    HG_BAR();
#pragma unroll
    for (int q = 0; q < 8; ++q) { const int cq = tid + 512 * q, row = cq >> 5, ch8 = cq & 31;
        if (row < nrows) { const f32x4 a = *(const LAS f32x4*)(lds + row * TS + ch8 * 32), b = *(const LAS f32x4*)(lds + row * TS + ch8 * 32 + 16); const v4u s = sgq[q];
            const f32x4 ga = {bf_lo(s.x), bf_hi(s.x), bf_lo(s.y), bf_hi(s.y)}, gb = {bf_lo(s.z), bf_hi(s.z), bf_lo(s.w), bf_hi(s.w)};
            *(GAS v4u*)(YA + (rowbase + t0 + row) * 1024 + 256 * g + 8 * ch8) = pg8::pack8(a * ga, b * gb); } }
    HG_BAR();
}
}

#ifndef MERGE_TAIL
#define MERGE_TAIL 6
#endif
#ifndef WGM_PROJ
#define WGM_PROJ 4
#endif
#ifndef WGM_SQ
#define WGM_SQ 1
#endif
constexpr int U_HG_P = BATCH * 8, U_HG_S = DBATCH * 8;
constexpr int U0_HGS = U_HG_P, U0_ATT = U0_HGS + U_HG_S, U0_POOL = U0_ATT + sb::NUNITS, U_TOTAL = U0_POOL + pl::NUNITS;
__device__ __forceinline__ void phase_mixers(Frame& F, int layer, int qslot) {
    GAS unsigned* head = F.ctl() + CW_QUEUE + 64 * qslot;
    for (;;) {
        if (F.tid_() == 0) F.MISC[4] = __hip_atomic_fetch_add(head, 1u, __ATOMIC_RELAXED, __HIP_MEMORY_SCOPE_AGENT);
        HG_BAR();
        int u = (int)F.MISC[4];
        HG_BAR();
        if (u >= U_TOTAL) break;
        if (u >= U0_HGS && u < U0_POOL) u = u < U0_HGS + sb::NUNITS ? u + U_HG_S : u - sb::NUNITS;
        if (u < U0_ATT) { const bool smp = u >= U0_HGS; const int x = smp ? u - U0_HGS : u; hg::chain(F, layer, smp, x >> 3, x & 7); }
        else if (u < U0_POOL) { const int x = u - U0_ATT; if (x < sb::NU_P) sb::block_unit<1>(F, layer, x); else sb::block_unit<4>(F, layer, x - sb::NU_P); }
        else pl::unit(F, layer, u - U0_POOL);
    }
}

__device__ __forceinline__ void combine_merge(Frame& F) {
    pg8::Gemm g{nullptr, nullptr, 0, 0, MTOT / 256, D / 256, 3, D, MERGE_TAIL, WGM_SQ}; pg8::Order S; S.init(g, F.G, 0); if (!S.tail) return;
    const int gw = F.vcu * 8 + F.wave, NGW = F.G * 8, lane = F.lane_(), nrows = (S.nwg - S.G) * 256;
    const GAS bf16* sl = (const GAS bf16*)(F.wsp() + WS_SLAB_M); GAS bf16* M = (GAS bf16*)(F.wsp() + WS_MERGED);
    for (int x = gw; x < nrows; x += NGW) { const int j = x >> 8, r = x & 255; int pm, pn; S.tile_of(S.G + j, pm, pn);
        const GAS bf16* p = sl + (size_t)(MERGE_TAIL * j) * 65536 + (size_t)r * 256 + 4 * lane;
        f32x4 v = {0.f, 0.f, 0.f, 0.f};
#pragma unroll
        for (int q = 0; q < MERGE_TAIL; ++q) { const v2u t = *(const GAS v2u*)(p + (size_t)q * 65536); v += (f32x4){bf_lo(t.x), bf_hi(t.x), bf_lo(t.y), bf_hi(t.y)}; }
        v2u o; o.x = cvt_pk_bf16(v[0], v[1]); o.y = cvt_pk_bf16(v[2], v[3]); *(GAS v2u*)(M + (size_t)(256 * pm + r) * 1024 + 256 * pn + 4 * lane) = o; }
}
__device__ __forceinline__ f32x4 slab4_sum(const GAS bf16* p) {
    const v2u a = *(const GAS v2u*)p, b = *(const GAS v2u*)(p + 65536), c = *(const GAS v2u*)(p + 2 * 65536), d = *(const GAS v2u*)(p + 3 * 65536);
    return ((f32x4){bf_lo(a.x), bf_hi(a.x), bf_lo(a.y), bf_hi(a.y)} + (f32x4){bf_lo(b.x), bf_hi(b.x), bf_lo(b.y), bf_hi(b.y)}) + ((f32x4){bf_lo(c.x), bf_hi(c.x), bf_lo(c.y), bf_hi(c.y)} + (f32x4){bf_lo(d.x), bf_hi(d.x), bf_lo(d.y), bf_hi(d.y)}); }
__device__ __forceinline__ void combine_out(Frame& F, int last) {
    pg8::Gemm g{nullptr, nullptr, 0, 0, MTOT / 256, D / 256, 1, D, 4, WGM_SQ}; pg8::Order S; S.init(g, F.G, 0); if (!S.tail) return;
    const int gw = F.vcu * 8 + F.wave, NGW = F.G * 8, lane = F.lane_(), nrows = (S.nwg - S.G) * 256;
    const GAS bf16* sl = (const GAS bf16*)(F.wsp() + WS_SLAB_O); GAS bf16* HB = (GAS bf16*)(F.wsp() + WS_H); GAS float* out = F.outp();
    for (int x = gw; x < nrows; x += NGW) { const int j = x >> 8, r = x & 255; int pm, pn; S.tile_of(S.G + j, pm, pn);
        const GAS bf16* p = sl + (size_t)(4 * j) * 65536 + (size_t)r * 256 + 4 * lane; const int row = 256 * pm + r, col = 256 * pn + 4 * lane;
        const v2u hb = *(const GAS v2u*)(HB + (size_t)row * 1024 + col);
        const f32x4 v = (f32x4){bf_lo(hb.x), bf_hi(hb.x), bf_lo(hb.y), bf_hi(hb.y)} + slab4_sum(p);
        if (!last) { v2u o; o.x = cvt_pk_bf16(v[0], v[1]); o.y = cvt_pk_bf16(v[2], v[3]); *(GAS v2u*)(HB + (size_t)row * 1024 + col) = o; }
        else if (row >= MPAD) *(GAS f32x4*)(out + O_YS + (size_t)(row - MPAD) * 1024 + col) = v;
        else if (row < MP) { const int b = row / LP, t = row - b * LP; if (t >= NMETA) *(GAS f32x4*)(out + O_YP + ((size_t)b * SEQ + (t - NMETA)) * 1024 + col) = v; } }
}
__device__ __forceinline__ void phase_xn_fused(Frame& F, int l) {
    pg8::Gemm g{nullptr, nullptr, 0, 0, MTOT / 256, D / 256, 1, D, 4, WGM_SQ}; pg8::Order S; S.init(g, F.G, 0);
    LAS int* tab = (LAS int*)F.lds; const int tid = F.tid_(), lane = F.lane_();
    for (int i = tid; i < (MTOT / 256) * 4; i += 512) tab[i] = -1;
    __syncthreads();
    if (S.tail && tid < S.nwg - S.G) { int pm, pn; S.tile_of(S.G + tid, pm, pn); tab[4 * pm + pn] = tid; }
    __syncthreads();
    const int gw = F.vcu * 8 + F.wave, NGW = F.G * 8;
    GAS bf16* HB = (GAS bf16*)(F.wsp() + WS_H); GAS bf16* XN = (GAS bf16*)(F.wsp() + WS_XN); const GAS bf16* sl = (const GAS bf16*)(F.wsp() + WS_SLAB_O); const GAS float* gn = F_norm_g + (size_t)l * D;
    v2u nx[4];
    if (gw < MTOT) { const GAS v2u* p0 = (const GAS v2u*)(HB + (size_t)gw * D) + lane;
#pragma unroll
        for (int j = 0; j < 4; ++j) nx[j] = p0[64 * j]; }
    for (int r = gw; r < MTOT; r += NGW) {
        const v2u cur[4] = {nx[0], nx[1], nx[2], nx[3]};
        if (r + NGW < MTOT) { const GAS v2u* p1 = (const GAS v2u*)(HB + (size_t)(r + NGW) * D) + lane;
#pragma unroll
            for (int j = 0; j < 4; ++j) nx[j] = p1[64 * j]; }
        if (r >= MP && r < MPAD) { zero_xn_row(XN + (size_t)r * D, lane); continue; }
        GAS v2u* xb = (GAS v2u*)(HB + (size_t)r * D) + lane; const int pm = r >> 8, rr = r & 255;
        f32x4 v[4]; float s = 0.f;
#pragma unroll
        for (int j = 0; j < 4; ++j) { const int idx = tab[4 * pm + j]; const v2u t = cur[j]; v[j] = (f32x4){bf_lo(t.x), bf_hi(t.x), bf_lo(t.y), bf_hi(t.y)};
            if (idx >= 0) { v[j] += slab4_sum(sl + (size_t)(4 * idx) * 65536 + (size_t)rr * 256 + 4 * lane); v2u o; o.x = cvt_pk_bf16(v[j][0], v[j][1]); o.y = cvt_pk_bf16(v[j][2], v[j][3]); xb[64 * j] = o; }
            s += (v[j].x * v[j].x + v[j].y * v[j].y) + (v[j].z * v[j].z + v[j].w * v[j].w); }
        const float rs = frsq(wave_sum(s) * (1.f / D) + EPS);
        GAS v2u* o8 = (GAS v2u*)(XN + (size_t)r * D) + lane;
#pragma unroll
        for (int j = 0; j < 4; ++j) { const f32x4 gg = ((const GAS f32x4*)gn)[lane + 64 * j]; v2u o; o.x = cvt_pk_bf16(v[j].x * rs * gg.x, v[j].y * rs * gg.y); o.y = cvt_pk_bf16(v[j].z * rs * gg.z, v[j].w * rs * gg.w); o8[64 * j] = o; }
    }
    __syncthreads();
}
constexpr int NPHASES = 1 + 5 * DEPTH;
__global__ void __launch_bounds__(512, 2) mega_fwd(Params p) {
    extern __shared__ __attribute__((aligned(16))) unsigned char lds_raw[];
    Frame F;
    F.lds = (LAS unsigned char*)lds_raw; F.MISC = (volatile LAS unsigned*)(F.lds + LDS_MISC);
    F.wave = __builtin_amdgcn_readfirstlane((int)threadIdx.x >> 6);
    F.G = gridDim.x; { const int bx = blockIdx.x; F.vcu = (F.G % 8 == 0) ? (bx % 8) * (F.G / 8) + bx / 8 : bx; }
    if (threadIdx.x < 64) F.MISC[threadIdx.x] = 0u;
    if (threadIdx.x == 0) { LAS unsigned long long* P = (LAS unsigned long long*)(F.lds + LDS_PARAM);
        P[0] = (unsigned long long)p.in[0]; P[1] = (unsigned long long)p.in[1]; P[2] = (unsigned long long)p.in[2]; P[3] = (unsigned long long)p.in[3]; P[4] = (unsigned long long)p.in[4];
        P[5] = (unsigned long long)p.in[5]; P[6] = (unsigned long long)p.in[6]; P[7] = (unsigned long long)p.in[7]; P[8] = (unsigned long long)p.in[8]; P[9] = (unsigned long long)p.in[9];
        P[10] = (unsigned long long)p.in[10]; P[11] = (unsigned long long)p.in[11]; P[12] = (unsigned long long)p.in[12]; P[13] = (unsigned long long)p.in[13]; P[14] = (unsigned long long)p.in[14];
        P[15] = (unsigned long long)p.in[15]; P[16] = (unsigned long long)p.in[16]; P[17] = (unsigned long long)p.out; P[18] = (unsigned long long)p.ws; }
    __syncthreads();
    const int lo = p.ph_lo, hi = p.ph_hi;
    XcdBarrier bar; bar.bar = F.ctl() + CW_BAR; bar.x = 0; bar.st = nullptr; bar.leader = false;
    if (hi - lo > 1) bar = xcd_barrier_post(F.ctl() + CW_BAR, F.MISC, F.wave);
#define IN(k) (lo <= (k) && (k) < hi)
#define SEAM(k) do { if (IN(k) && IN((k) + 1)) xcd_barrier(bar, F.wave); } while (0)
    if (IN(0)) { phase_prologue(F); } SEAM(0);
    for (int l = 0; l < DEPTH; ++l) {
        const int pb = 1 + 5 * l;
        if (IN(pb)) { if (l > 0) phase_xn_fused(F, l); }
        if (l > 0) SEAM(pb);
        if (IN(pb + 1)) { pg8::Gemm g{(const GAS bf16*)(F.wsp() + WS_XN), (const GAS bf16*)(F.wsp() + WS_WIN) + (size_t)l * NPROJ * D, 0, 0, MTOT / 256, NPROJ / 256, 1, D, 0, WGM_PROJ};
            pg8::Order S; S.init(g, F.G, (int)blockIdx.x);
            pg8::EpiProj E{l, F.wsp(), F.outp(), F_qng + l * 128, F_kng + l * 128, (const GAS float*)(F.wsp() + WS_LB) + l * 1024};
            pg8::gemm_phase(F.lds, g, S, E, F.wave);
            } SEAM(pb + 1);
        if (IN(pb + 2)) { phase_mixers(F, l, l); } SEAM(pb + 2);
        if (IN(pb + 3)) { pg8::Gemm g{(const GAS bf16*)(F.wsp() + WS_Y), (const GAS bf16*)(F.wsp() + WS_WBR) + (size_t)l * 3 * D * D, (size_t)MTOT * 1024, (size_t)D * D, MTOT / 256, D / 256, 3, D, MERGE_TAIL, WGM_SQ};
            pg8::Order S; S.init(g, F.G, (int)blockIdx.x);
            pg8::EpiMerge E{F.wsp()};
            pg8::gemm_phase(F.lds, g, S, E, F.wave);
            { __syncthreads(); pg8::EpiMergeSlab E2{F.wsp()}; pg8::gemm_phase<pg8::EpiMergeSlab, 1>(F.lds, g, S, E2, F.wave); }
            } SEAM(pb + 3);
        if (IN(pb + 4)) { combine_merge(F); xcd_barrier(bar, F.wave);
            pg8::Gemm g{(const GAS bf16*)(F.wsp() + WS_MERGED), (const GAS bf16*)(F.wsp() + WS_WOUT) + (size_t)l * D * D, 0, 0, MTOT / 256, D / 256, 1, D, 4, WGM_SQ};
            pg8::Order S; S.init(g, F.G, (int)blockIdx.x);
            pg8::EpiOut E{F.wsp(), F.outp(), l == DEPTH - 1 ? 1 : 0};
            pg8::gemm_phase(F.lds, g, S, E, F.wave);
            { __syncthreads(); pg8::EpiOutSlab E2{F.wsp()}; pg8::gemm_phase<pg8::EpiOutSlab, 1>(F.lds, g, S, E2, F.wave); }
            xcd_barrier(bar, F.wave); if (l == DEPTH - 1) combine_out(F, 1);
            }
    }
#undef IN
#undef SEAM
}
extern "C" void kernel_launch(void* const* d_in, const int* in_sizes, int n_in, void* d_out, int out_size, void* d_ws, size_t ws_size, hipStream_t stream) {
    static int grid = 0;
    if (grid == 0) {
        if (n_in != 17 || out_size != (int)O_END || ws_size < WS_FAST_END) { fprintf(stderr, "kernel_launch: unexpected sizes (n_in %d, out %d, ws %zu < %zu)\n", n_in, out_size, ws_size, (size_t)WS_FAST_END); grid = -1; return; }
        int dev = 0, cus = 0, per_cu = 0;
        if (hipGetDevice(&dev) != hipSuccess || hipDeviceGetAttribute(&cus, hipDeviceAttributeMultiprocessorCount, dev) != hipSuccess) { grid = -1; return; }
        if (hipFuncSetAttribute((const void*)mega_fwd, hipFuncAttributeMaxDynamicSharedMemorySize, LDS_BYTES) != hipSuccess) { fprintf(stderr, "kernel_launch: hipFuncSetAttribute failed\n"); grid = -1; return; }
        if (hipOccupancyMaxActiveBlocksPerMultiprocessor(&per_cu, (const void*)mega_fwd, 512, LDS_BYTES) != hipSuccess || per_cu < 1) { fprintf(stderr, "kernel_launch: occupancy query says %d blocks per CU\n", per_cu); (void)hipGetLastError(); grid = -1; return; }
        grid = cus;
    }
    if (grid < 0) return;
    (void)hipMemsetAsync((char*)d_ws + WS_CTL, 0, CTL_ZERO_BYTES, stream);
    Params p{};
    for (int i = 0; i < 17; ++i) p.in[i] = (const float*)d_in[i];
    p.out = (float*)d_out; p.ws = (unsigned char*)d_ws;
    p.ph_lo = 0; p.ph_hi = NPHASES;
    hipLaunchKernelGGL(mega_fwd, dim3(grid), dim3(512), LDS_BYTES, stream, p);
}
```
